# Optimizing an MI355X kernel written in HIP

```python
import jax, jax.numpy as jnp
from jax import lax
import numpy as np

D_MODEL = 1024
BATCH = 32
SEQ = 256
DEPTH = 2
DEC_BATCH = 8
DEC_SEQ = 1024
PAST_LEN = 256

GRID_W = 64
BRANCH_WIDTH = D_MODEL // 2
N_BRANCH = 3
NA_HEADS = 8
NA_HEAD_DIM = BRANCH_WIDTH // NA_HEADS
NA_WIDTH = NA_HEADS * NA_HEAD_DIM
NA_WIN_H_MAX = 8
NA_WIN_W = 16
NA_QCOL_BLOCK = 16
NA_KCOL_BLOCK = NA_QCOL_BLOCK + NA_WIN_W
SGU_GROUPS = 4
SGU_CHUNK = 128
SGU_WIDTH = BRANCH_WIDTH
SGU_GROUP_DIM = SGU_WIDTH // SGU_GROUPS
MLA_HEADS = 8
MLA_NOPE = 64
MLA_ROPE = 32
MLA_V = BRANCH_WIDTH // MLA_HEADS
MLA_WIDTH = MLA_HEADS * MLA_V
MLA_Q_LORA = 384
MLA_KV_LORA = 256
ROPE_THETA = 10000.0
Q_BLOCK = 128
IN_COLS = 4 * NA_WIDTH + 3 * SGU_WIDTH + MLA_Q_LORA + MLA_KV_LORA + MLA_ROPE + MLA_WIDTH + N_BRANCH * D_MODEL
EPS = 1e-6
NEG_INF = -1e30

kernel_name = 'hybrid_diffusion_na_sgu_mla_step'


def _rmsnorm(x, g):
    xf = x.astype(jnp.float32)
    y = xf * lax.rsqrt(jnp.mean(xf * xf, axis=-1, keepdims=True) + EPS)
    return (y * g.astype(jnp.float32)).astype(x.dtype)


def _layernorm(x):
    xf = x.astype(jnp.float32)
    mu = jnp.mean(xf, axis=-1, keepdims=True)
    var = jnp.mean(jnp.square(xf - mu), axis=-1, keepdims=True)
    return ((xf - mu) * lax.rsqrt(var + EPS)).astype(x.dtype)


def _modulation(cond, w_mod, b_mod):
    m = jnp.einsum('...d,de->...e', jax.nn.silu(cond), w_mod) + b_mod
    return jnp.split(m, 3, axis=-1)


def _split_cols(p):
    sizes = (NA_WIDTH,) * 4 + (SGU_WIDTH,) * 3 + (MLA_Q_LORA, MLA_KV_LORA, MLA_ROPE, MLA_WIDTH, N_BRANCH * D_MODEL)
    return jnp.split(p, np.cumsum(sizes)[:-1].tolist(), axis=-1)


def _pre_mixer(x, shift, scale, norm_g, w_in):
    h = _rmsnorm(x, norm_g) * (1 + scale) + shift
    return _split_cols(jnp.einsum('bnd,de->bne', h, w_in))


def _axial_rope(n_tokens):
    pos = jnp.arange(n_tokens, dtype=jnp.int32)
    row = (pos // GRID_W).astype(jnp.float32)
    col = (pos % GRID_W).astype(jnp.float32)
    n_freq = MLA_ROPE // 4
    inv = ROPE_THETA ** (-jnp.arange(n_freq, dtype=jnp.float32) / n_freq)
    ang = jnp.concatenate([row[:, None] * inv, col[:, None] * inv], axis=-1)
    return jnp.cos(ang), jnp.sin(ang)


def _rope(x, cos, sin):
    x1, x2 = jnp.split(x.astype(jnp.float32), 2, axis=-1)
    return jnp.concatenate([x1 * cos - x2 * sin, x1 * sin + x2 * cos], axis=-1).astype(x.dtype)


def _over_query_blocks(fn, q):
    B, N = q.shape[:2]
    qb = jnp.moveaxis(q.reshape((B, N // Q_BLOCK, Q_BLOCK) + q.shape[2:]), 1, 0)
    o = lax.map(fn, qb)
    return jnp.moveaxis(o, 0, 1).reshape((B, N) + o.shape[3:])


def _context_attention(q, k, v):
    scale = q.shape[-1] ** -0.5

    def block(qi):
        s = jnp.einsum('bqhd,bmhd->bhqm', qi, k).astype(jnp.float32) * scale
        p = jax.nn.softmax(s, axis=-1).astype(v.dtype)
        return jnp.einsum('bhqm,bmhd->bqhd', p, v)

    o = _over_query_blocks(block, q)
    return o.reshape(o.shape[0], o.shape[1], -1)


def _na_latent_attention(q, k, v, k_ctx, v_ctx, rpb):
    B, N, H, dh = q.shape
    rows = N // GRID_W
    wh = min(NA_WIN_H_MAX, rows)
    n_cb = GRID_W // NA_QCOL_BLOCK
    r = np.arange(rows)
    row_idx = np.clip(r - wh // 2, 0, rows - wh)[:, None] + np.arange(wh)[None, :]
    qcol = np.arange(GRID_W).reshape(n_cb, NA_QCOL_BLOCK)
    col_idx = np.clip(qcol[:, 0] - NA_WIN_W // 2, 0, GRID_W - NA_KCOL_BLOCK)[:, None] + np.arange(NA_KCOL_BLOCK)[None, :]
    win_lo = np.clip(qcol - NA_WIN_W // 2, 0, GRID_W - NA_WIN_W)
    in_win = (col_idx[:, None, :] >= win_lo[:, :, None]) & (col_idx[:, None, :] < win_lo[:, :, None] + NA_WIN_W)
    rel_r = row_idx - r[:, None] + NA_WIN_H_MAX - 1
    rel_c = np.clip(col_idx[:, None, :] - qcol[:, :, None] + NA_WIN_W - 1, 0, 2 * NA_WIN_W - 2)
    bias = rpb.astype(jnp.float32)[:, rel_r[:, None, None, :, None], rel_c[None, :, :, None, :]]
    bias = jnp.where(in_win[None, None, :, :, None, :], bias, NEG_INF)
    qb = q.reshape(B, rows, n_cb, NA_QCOL_BLOCK, H, dh)
    gather_r = row_idx[:, :, None, None]
    gather_c = col_idx[None, None, :, :]
    kg = k.reshape(B, rows, GRID_W, H, dh)[:, gather_r, gather_c]
    vg = v.reshape(B, rows, GRID_W, H, dh)[:, gather_r, gather_c]
    scale = dh ** -0.5
    s_loc = jnp.einsum('brjqhd,brwjkhd->bhrjqwk', qb, kg).astype(jnp.float32) * scale + bias
    s_ctx = jnp.einsum('brjqhd,bmhd->bhrjqm', qb, k_ctx).astype(jnp.float32) * scale
    n_loc = wh * NA_KCOL_BLOCK
    s = jnp.concatenate([s_loc.reshape(B, H, rows, n_cb, NA_QCOL_BLOCK, n_loc), s_ctx], axis=-1)
    p = jax.nn.softmax(s, axis=-1).astype(v.dtype)
    p_loc = p[..., :n_loc].reshape(B, H, rows, n_cb, NA_QCOL_BLOCK, wh, NA_KCOL_BLOCK)
    p_ctx = p[..., n_loc:]
    o = jnp.einsum('bhrjqwk,brwjkhd->brjqhd', p_loc, vg) + jnp.einsum('bhrjqm,bmhd->brjqhd', p_ctx, v_ctx)
    return o.reshape(B, N, H * dh)


def _sgu(u, v, w_s, b_s):
    B, N, _ = u.shape
    nc = N // SGU_CHUNK
    u = jax.nn.gelu(u)
    v = _layernorm(jax.nn.gelu(v))
    vg = v.reshape(B, nc, SGU_CHUNK, SGU_GROUPS, SGU_GROUP_DIM)
    mixed = jnp.einsum('gpq,bnqgc->bnpgc', w_s, vg) + b_s.T[:, :, None]
    return u * mixed.reshape(B, N, SGU_WIDTH)


def _mla_q(dq, q_norm, w_uq):
    B, N, _ = dq.shape
    q = jnp.einsum('bnr,re->bne', _rmsnorm(dq, q_norm), w_uq)
    return q.reshape(B, N, MLA_HEADS, MLA_NOPE + MLA_ROPE)


def _mla_expand(c_kv, w_ukv):
    B, L, _ = c_kv.shape
    kv = jnp.einsum('blr,re->ble', c_kv, w_ukv).reshape(B, L, MLA_HEADS, MLA_NOPE + MLA_V)
    return kv[..., :MLA_NOPE], kv[..., MLA_NOPE:]


def _mla_attention(q, k_nope, k_rope, v):
    scale = (MLA_NOPE + MLA_ROPE) ** -0.5

    def block(qi):
        s = (jnp.einsum('bqhd,bmhd->bhqm', qi[..., :MLA_NOPE], k_nope)
             + jnp.einsum('bqhr,bmr->bhqm', qi[..., MLA_NOPE:], k_rope)).astype(jnp.float32) * scale
        p = jax.nn.softmax(s, axis=-1).astype(v.dtype)
        return jnp.einsum('bhqm,bmhd->bqhd', p, v)

    o = _over_query_blocks(block, q)
    return o.reshape(o.shape[0], o.shape[1], MLA_WIDTH)


def _merge(ys, zs, merge_logits, w_branch, w_out):
    B, N, _ = merge_logits.shape
    gated = jnp.stack([y * jax.nn.silu(z) for y, z in zip(ys, zs)], axis=2)
    branch = jnp.einsum('bnkw,kwd->bnkd', gated, w_branch)
    gates = jax.nn.sigmoid(merge_logits).reshape(B, N, N_BRANCH, D_MODEL)
    merged = jnp.sum(gates * branch, axis=2)
    return jnp.einsum('bnd,de->bne', merged, w_out)


def _context_layer(x, c_ctx, lp):
    norm_g, w_mod, b_mod, w_in, na_rpb, sgu_w, sgu_b, q_norm, w_uq, kv_norm, w_ukv, w_branch, w_out = lp
    shift, scale, gate = _modulation(c_ctx, w_mod, b_mod)
    na_q, na_k, na_v, na_z, su, sv, sz, dq, dkv, kr, mz, mg = _pre_mixer(x, shift, scale, norm_g, w_in)
    B, L, _ = x.shape
    hs = (B, L, NA_HEADS, NA_HEAD_DIM)
    k_c, v_c = na_k.reshape(hs), na_v.reshape(hs)
    y_na = _context_attention(na_q.reshape(hs), k_c, v_c)
    y_sgu = _sgu(su, sv, sgu_w, sgu_b)
    q = _mla_q(dq, q_norm, w_uq)
    ckv = _rmsnorm(dkv, kv_norm)
    k_nope, v = _mla_expand(ckv, w_ukv)
    y_mla = _mla_attention(q, k_nope, kr, v)
    out = _merge((y_na, y_sgu, y_mla), (na_z, sz, mz), mg, w_branch, w_out)
    return x + gate * out, k_c, v_c, ckv, kr


def _latent_layer(x, c, k_ctx, v_ctx, ckv_ctx, kr_ctx, cos, sin, lp):
    norm_g, w_mod, b_mod, w_in, na_rpb, sgu_w, sgu_b, q_norm, w_uq, kv_norm, w_ukv, w_branch, w_out = lp
    shift, scale, gate = (m[:, None, :] for m in _modulation(c, w_mod, b_mod))
    na_q, na_k, na_v, na_z, su, sv, sz, dq, dkv, kr, mz, mg = _pre_mixer(x, shift, scale, norm_g, w_in)
    B, N, _ = x.shape
    hs = (B, N, NA_HEADS, NA_HEAD_DIM)
    y_na = _na_latent_attention(na_q.reshape(hs), na_k.reshape(hs), na_v.reshape(hs), k_ctx, v_ctx, na_rpb)
    y_sgu = _sgu(su, sv, sgu_w, sgu_b)
    q = _mla_q(dq, q_norm, w_uq)
    q = jnp.concatenate([q[..., :MLA_NOPE], _rope(q[..., MLA_NOPE:], cos[:, None, :], sin[:, None, :])], axis=-1)
    ckv_all = jnp.concatenate([ckv_ctx, _rmsnorm(dkv, kv_norm)], axis=1)
    kr_all = jnp.concatenate([kr_ctx, _rope(kr, cos, sin)], axis=1)
    k_nope, v = _mla_expand(ckv_all, w_ukv)
    y_mla = _mla_attention(q, k_nope, kr_all, v)
    out = _merge((y_na, y_sgu, y_mla), (na_z, sz, mz), mg, w_branch, w_out)
    return x + gate * out


def setup_inputs(seed: int = 0) -> dict:
    key = jax.random.key(seed)
    ks = jax.random.split(key, 24)
    f32 = jnp.float32

    def nrm(k, shape, s):
        return jax.random.normal(k, shape, f32) * s

    return {
        'x_prompt': nrm(ks[0], (BATCH, SEQ, D_MODEL), 1.0),
        'x_sample': nrm(ks[1], (DEC_BATCH, DEC_SEQ, D_MODEL), 1.0),
        'cache_na_k': nrm(ks[2], (DEC_BATCH, DEPTH, PAST_LEN, NA_HEADS, NA_HEAD_DIM), 1.0),
        'cache_na_v': nrm(ks[3], (DEC_BATCH, DEPTH, PAST_LEN, NA_HEADS, NA_HEAD_DIM), 1.0),
        'cache_mla_ckv': nrm(ks[4], (DEC_BATCH, DEPTH, PAST_LEN, MLA_KV_LORA), 1.0),
        'cache_mla_krope': nrm(ks[5], (DEC_BATCH, DEPTH, PAST_LEN, MLA_ROPE), 1.0),
        'c': nrm(ks[6], (DEC_BATCH, D_MODEL), 1.0),
        'c_ctx': nrm(ks[7], (D_MODEL,), 1.0),
        'norm_g': 1.0 + nrm(ks[8], (DEPTH, D_MODEL), 0.02),
        'w_mod': nrm(ks[9], (DEPTH, D_MODEL, 3 * D_MODEL), D_MODEL ** -0.5),
        'b_mod': nrm(ks[10], (DEPTH, 3 * D_MODEL), 0.02),
        'w_in': nrm(ks[11], (DEPTH, D_MODEL, IN_COLS), D_MODEL ** -0.5),
        'na_rpb': nrm(ks[12], (DEPTH, NA_HEADS, 2 * NA_WIN_H_MAX - 1, 2 * NA_WIN_W - 1), 0.1),
        'sgu_w': nrm(ks[13], (DEPTH, SGU_GROUPS, SGU_CHUNK, SGU_CHUNK), SGU_CHUNK ** -0.5),
        'sgu_b': nrm(ks[14], (DEPTH, SGU_GROUPS, SGU_CHUNK), 0.02),
        'mla_q_norm': 1.0 + nrm(ks[15], (DEPTH, MLA_Q_LORA), 0.02),
        'mla_w_uq': nrm(ks[16], (DEPTH, MLA_Q_LORA, MLA_HEADS * (MLA_NOPE + MLA_ROPE)), MLA_Q_LORA ** -0.5),
        'mla_kv_norm': 1.0 + nrm(ks[17], (DEPTH, MLA_KV_LORA), 0.02),
        'mla_w_ukv': nrm(ks[18], (DEPTH, MLA_KV_LORA, MLA_HEADS * (MLA_NOPE + MLA_V)), MLA_KV_LORA ** -0.5),
        'w_branch': nrm(ks[19], (DEPTH, N_BRANCH, BRANCH_WIDTH, D_MODEL), BRANCH_WIDTH ** -0.5),
        'w_out': nrm(ks[20], (DEPTH, D_MODEL, D_MODEL), D_MODEL ** -0.5),
        'final_norm_g': 1.0 + nrm(ks[21], (D_MODEL,), 0.02),
    }


def reference(x_prompt, x_sample, cache_na_k, cache_na_v, cache_mla_ckv, cache_mla_krope, c, c_ctx,
              norm_g, w_mod, b_mod, w_in, na_rpb, sgu_w, sgu_b, mla_q_norm, mla_w_uq, mla_kv_norm,
              mla_w_ukv, w_branch, w_out, final_norm_g):
    xp = x_prompt
    xs = x_sample
    cos, sin = _axial_rope(x_sample.shape[1])
    ks_, vs_, ckvs_, krs_ = [], [], [], []
    for l in range(DEPTH):
        lp = (norm_g[l], w_mod[l], b_mod[l], w_in[l], na_rpb[l], sgu_w[l], sgu_b[l], mla_q_norm[l],
              mla_w_uq[l], mla_kv_norm[l], mla_w_ukv[l], w_branch[l], w_out[l])
        xp, k_c, v_c, ckv_c, kr_c = _context_layer(xp, c_ctx, lp)
        ks_.append(k_c)
        vs_.append(v_c)
        ckvs_.append(ckv_c)
        krs_.append(kr_c)
        xs = _latent_layer(xs, c, cache_na_k[:, l], cache_na_v[:, l], cache_mla_ckv[:, l],
                           cache_mla_krope[:, l], cos, sin, lp)
    y_prompt = _rmsnorm(xp, final_norm_g)
    y_sample = _rmsnorm(xs, final_norm_g)
    state_na_k = jnp.stack(ks_, axis=1)
    state_na_v = jnp.stack(vs_, axis=1)
    state_mla_ckv = jnp.stack(ckvs_, axis=1)
    state_mla_krope = jnp.stack(krs_, axis=1)
    return (y_prompt, y_sample, state_na_k, state_na_v, state_mla_ckv, state_mla_krope)
```

```cpp
#include <hip/hip_runtime.h>
#include <hip/hip_cooperative_groups.h>
#include <cstdio>
namespace cg = cooperative_groups;

#ifndef USE_COOP
#define USE_COOP 0
#endif

typedef unsigned short u16;
typedef __attribute__((ext_vector_type(8))) __bf16 bf16x8;
typedef __attribute__((ext_vector_type(16))) float f32x16;
#define DEV __device__ __forceinline__

constexpr size_t A256(size_t x) { return (x + 255) & ~(size_t)255; }
constexpr size_t O_WIN = 0;
constexpr size_t O_WUQ = O_WIN + A256(2ull * 7936 * 1024 * 2);
constexpr size_t O_WUKV = O_WUQ + A256(2ull * 768 * 384 * 2);
constexpr size_t O_WBR = O_WUKV + A256(2ull * 1024 * 256 * 2);
constexpr size_t O_WOUT = O_WBR + A256(2ull * 3 * 1024 * 512 * 2);
constexpr size_t O_SGUW = O_WOUT + A256(2ull * 1024 * 1024 * 2);
constexpr size_t O_KC = O_SGUW + A256(2ull * 4 * 128 * 128 * 2);
constexpr size_t O_VTC = O_KC + A256(2ull * 8 * 256 * 512 * 2);
constexpr size_t O_MOD = O_VTC + A256(2ull * 8 * 256 * 512 * 2);
constexpr size_t O_H = O_MOD + A256(2ull * 9 * 3072 * 4);
constexpr size_t O_QNA = O_H + A256(8192ull * 1024 * 2);
constexpr size_t O_KNA = O_QNA + A256(8192ull * 512 * 2);
constexpr size_t O_VTNA = O_KNA + A256(8192ull * 512 * 2);
constexpr size_t O_ZA = O_VTNA + A256(8192ull * 512 * 2);
constexpr size_t O_ZB = O_ZA + A256(8192ull * 512 * 2);
constexpr size_t O_ZC = O_ZB + A256(8192ull * 512 * 2);
constexpr size_t O_GU = O_ZC + A256(8192ull * 512 * 2);
constexpr size_t O_GVT = O_GU + A256(8192ull * 512 * 2);
constexpr size_t O_DQ = O_GVT + A256(8192ull * 512 * 2);
constexpr size_t O_DKV = O_DQ + A256(8192ull * 384 * 2);
constexpr size_t O_KRF = O_DKV + A256(8192ull * 256 * 2);
constexpr size_t O_GATES = O_KRF + A256(8192ull * 32 * 4);
constexpr size_t O_CKV = O_GATES + A256(8192ull * 3072 * 2);
constexpr size_t O_KR = O_CKV + A256(10240ull * 256 * 2);
constexpr size_t O_KNOPE = O_KR + A256(10240ull * 32 * 2);
constexpr size_t O_VTM = O_KNOPE + A256(10240ull * 512 * 2);
constexpr size_t O_END = O_VTM + A256(10240ull * 512 * 2);
static_assert(O_END <= 256ull * 1024 * 1024, "workspace too large");

constexpr size_t OUT_Y = 0;
constexpr size_t OUT_SK = 16777216;
constexpr size_t OUT_SV = 25165824;
constexpr size_t OUT_CKV = 33554432;
constexpr size_t OUT_SKR = 37748736;

struct Params {
  const float *x_prompt, *x_sample, *cache_na_k, *cache_na_v, *cache_ckv, *cache_kr, *c, *c_ctx;
  const float *norm_g, *w_mod, *b_mod, *w_in, *na_rpb, *sgu_w, *sgu_b, *q_norm, *w_uq, *kv_norm, *w_ukv, *w_branch, *w_out, *final_g;
  float* out;
  char* ws;
};

DEV u16 f2bf(float f) { unsigned u = __float_as_uint(f); u += 0x7fffu + ((u >> 16) & 1u); return (u16)(u >> 16); }
DEV float bf2f(u16 h) { return __uint_as_float(((unsigned)h) << 16); }
DEV unsigned pack2(float a, float b) { return (unsigned)f2bf(a) | ((unsigned)f2bf(b) << 16); }
DEV void st4bf(u16* p, float a, float b, float c, float d) { uint2 v; v.x = pack2(a, b); v.y = pack2(c, d); *(uint2*)p = v; }
DEV void ld4bf(const u16* p, float& a, float& b, float& c, float& d) {
  uint2 v = *(const uint2*)p;
  a = __uint_as_float(v.x << 16); b = __uint_as_float(v.x & 0xffff0000u);
  c = __uint_as_float(v.y << 16); d = __uint_as_float(v.y & 0xffff0000u);
}
DEV float wave_sum(float v) {
#pragma unroll
  for (int o = 32; o > 0; o >>= 1) v += __shfl_xor(v, o);
  return v;
}
DEV float sigmoid_f(float x) { return 1.f / (1.f + __expf(-x)); }
DEV float silu_f(float x) { return x / (1.f + __expf(-x)); }
DEV float gelu_f(float x) { float u = 0.7978845608028654f * (x + 0.044715f * x * x * x); return x / (1.f + __expf(-2.f * u)); }

DEV void gemm_mainloop(const u16* __restrict__ P, int ldp, const u16* __restrict__ Q, int ldq, int K, char* smem, f32x16 (&acc)[2][2]) {
  const int t = threadIdx.x, lane = t & 63, w = t >> 6, wm = w >> 1, wn = w & 1;
  const int lr = t >> 3, ch = t & 7;
  const u16* pg = P + (size_t)lr * ldp + ch * 8;
  const u16* qg = Q + (size_t)lr * ldq + ch * 8;
  const int soff = lr * 128 + ((ch ^ ((t >> 4) & 7)) << 4);
  const int sw = (lane >> 1) & 7;
  const int prow = (wm * 64 + (lane & 31)) * 128;
  const int qrow = (wn * 64 + (lane & 31)) * 128;
  uint4 rp[4], rq[4];
#pragma unroll
  for (int i = 0; i < 4; i++) {
    rp[i] = *(const uint4*)(pg + (size_t)i * 32 * ldp);
    rq[i] = *(const uint4*)(qg + (size_t)i * 32 * ldq);
  }
#pragma unroll
  for (int i = 0; i < 4; i++) {
    *(uint4*)(smem + soff + i * 4096) = rp[i];
    *(uint4*)(smem + 16384 + soff + i * 4096) = rq[i];
  }
  __syncthreads();
  const int nk = K >> 6;
  for (int kt = 0; kt < nk; kt++) {
    const bool more = (kt + 1 < nk);
    if (more) {
      const int k0 = (kt + 1) << 6;
#pragma unroll
      for (int i = 0; i < 4; i++) {
        rp[i] = *(const uint4*)(pg + (size_t)i * 32 * ldp + k0);
        rq[i] = *(const uint4*)(qg + (size_t)i * 32 * ldq + k0);
      }
    }
    const char* bP = smem + (kt & 1) * 32768;
    const char* bQ = bP + 16384;
#pragma unroll
    for (int s = 0; s < 4; s++) {
      const int co = ((s * 2 + (lane >> 5)) ^ sw) << 4;
      bf16x8 pf[2], qf[2];
#pragma unroll
      for (int a = 0; a < 2; a++) pf[a] = *(const bf16x8*)(bP + prow + a * 4096 + co);
#pragma unroll
      for (int b = 0; b < 2; b++) qf[b] = *(const bf16x8*)(bQ + qrow + b * 4096 + co);
#pragma unroll
      for (int a = 0; a < 2; a++)
#pragma unroll
        for (int b = 0; b < 2; b++) acc[a][b] = __builtin_amdgcn_mfma_f32_32x32x16_bf16(qf[b], pf[a], acc[a][b], 0, 0, 0);
    }
    if (more) {
      char* nb = smem + ((kt + 1) & 1) * 32768;
#pragma unroll
      for (int i = 0; i < 4; i++) {
        *(uint4*)(nb + soff + i * 4096) = rp[i];
        *(uint4*)(nb + 16384 + soff + i * 4096) = rq[i];
      }
    }
    __syncthreads();
  }
}

DEV void acc_zero(f32x16 (&acc)[2][2]) {
#pragma unroll
  for (int a = 0; a < 2; a++)
#pragma unroll
    for (int b = 0; b < 2; b++)
#pragma unroll
      for (int r = 0; r < 16; r++) acc[a][b][r] = 0.f;
}

template <class F>
DEV void epi_foreach(const f32x16 (&acc)[2][2], F f) {
  const int lane = threadIdx.x & 63, w = threadIdx.x >> 6, wm = w >> 1, wn = w & 1;
#pragma unroll
  for (int a = 0; a < 2; a++)
#pragma unroll
    for (int b = 0; b < 2; b++)
#pragma unroll
      for (int rg = 0; rg < 4; rg++) {
        const int i = wm * 64 + a * 32 + (lane & 31);
        const int j = wn * 64 + b * 32 + rg * 8 + (lane >> 5) * 4;
        f(i, j, acc[a][b][rg * 4 + 0], acc[a][b][rg * 4 + 1], acc[a][b][rg * 4 + 2], acc[a][b][rg * 4 + 3]);
      }
}

DEV void tile_map(int li, int MPX, int xcd, int& m, int& n) {
  const int g = MPX * 8;
  const int ng = li / g, wv = li % g;
  m = xcd * MPX + (wv % MPX);
  n = ng * 8 + (wv / MPX);
}

DEV void tconv_tile(const float* __restrict__ src, int ldsrc, int k0, int n0, u16* __restrict__ dst, int lddst, int drow0, float* tile) {
  const int t = threadIdx.x;
  {
    const int n = t & 31, kk = t >> 5;
#pragma unroll
    for (int p = 0; p < 8; p++) {
      const int k = kk + p * 8;
      tile[k * 33 + n] = src[(size_t)(k0 + k) * ldsrc + n0 + n];
    }
  }
  __syncthreads();
  {
    const int k = t & 63, nn = t >> 6;
#pragma unroll
    for (int p = 0; p < 8; p++) {
      const int n2 = nn + p * 4;
      dst[(size_t)(drow0 + n2) * lddst + k0 + k] = f2bf(tile[k * 33 + n2]);
    }
  }
  __syncthreads();
}

DEV void phase_prep(const Params& p, char* smem) {
  const int t = threadIdx.x;
  constexpr int N_MOD = 192;
  constexpr int T_IN = 3920, T_UQ = 144, T_UKV = 128, T_BR = 768, T_OUT = 512, T_CV = 512;
  constexpr int T_L = T_IN + T_UQ + T_UKV + T_BR + T_OUT + T_CV;
  constexpr int N_TC = 2 * T_L;
  constexpr int N_SG = 64, N_KC = 1024;
  constexpr int TOTAL = N_MOD + N_TC + N_SG + N_KC;
  float* MOD = (float*)(p.ws + O_MOD);
  for (int item = blockIdx.x; item < TOTAL; item += gridDim.x) {
    if (item < N_MOD) {
      const int l = item / 96, e0 = (item % 96) * 32;
      float* sc = (float*)smem;
      for (int idx = t; idx < 9216; idx += 256) {
        const int c9 = idx >> 10, d = idx & 1023;
        const float v = (c9 == 0) ? p.c_ctx[d] : p.c[(c9 - 1) * 1024 + d];
        sc[idx] = silu_f(v);
      }
      __syncthreads();
      const int col = t & 31, slab = t >> 5;
      float a[9];
#pragma unroll
      for (int c9 = 0; c9 < 9; c9++) a[c9] = 0.f;
      const float* wp = p.w_mod + ((size_t)l * 1024 + slab * 128) * 3072 + e0 + col;
#pragma unroll 4
      for (int dd = 0; dd < 128; dd++) {
        const float wv = wp[(size_t)dd * 3072];
        const int d = slab * 128 + dd;
#pragma unroll
        for (int c9 = 0; c9 < 9; c9++) a[c9] += sc[c9 * 1024 + d] * wv;
      }
      float* red = sc + 9216;
#pragma unroll
      for (int c9 = 0; c9 < 9; c9++) red[(slab * 9 + c9) * 32 + col] = a[c9];
      __syncthreads();
      for (int idx = t; idx < 288; idx += 256) {
        const int c9 = idx >> 5, cc = idx & 31;
        float sum = 0.f;
#pragma unroll
        for (int sl = 0; sl < 8; sl++) sum += red[(sl * 9 + c9) * 32 + cc];
        MOD[(l * 9 + c9) * 3072 + e0 + cc] = sum + p.b_mod[l * 3072 + e0 + cc];
      }
      __syncthreads();
    } else if (item < N_MOD + N_TC) {
      const int ti = item - N_MOD;
      const int l = ti / T_L;
      int r = ti % T_L;
      const float* src; u16* dst; int ldsrc, lddst, k0, n0, drow;
      if (r < T_IN) {
        const int nt = r >> 4, kt = r & 15;
        src = p.w_in + (size_t)l * 1024 * 7840; ldsrc = 7840; k0 = kt * 64; n0 = nt * 32;
        dst = (u16*)(p.ws + O_WIN) + (size_t)l * 7936 * 1024; lddst = 1024;
        drow = (n0 < 4224) ? n0 : (n0 == 4224 ? 7808 : n0 - 32);
      } else if ((r -= T_IN) < T_UQ) {
        const int nt = r / 6, kt = r % 6;
        src = p.w_uq + (size_t)l * 384 * 768; ldsrc = 768; k0 = kt * 64; n0 = nt * 32;
        dst = (u16*)(p.ws + O_WUQ) + (size_t)l * 768 * 384; lddst = 384; drow = n0;
      } else if ((r -= T_UQ) < T_UKV) {
        const int nt = r >> 2, kt = r & 3;
        src = p.w_ukv + (size_t)l * 256 * 1024; ldsrc = 1024; k0 = kt * 64; n0 = nt * 32;
        dst = (u16*)(p.ws + O_WUKV) + (size_t)l * 1024 * 256; lddst = 256;
        const int hh = n0 >> 7, jj = n0 & 127;
        drow = (jj < 64) ? (hh * 64 + jj) : (512 + hh * 64 + jj - 64);
      } else if ((r -= T_UKV) < T_BR) {
        const int kb = r >> 8, r2 = r & 255;
        const int nt = r2 >> 3, kt = r2 & 7;
        src = p.w_branch + (size_t)(l * 3 + kb) * 512 * 1024; ldsrc = 1024; k0 = kt * 64; n0 = nt * 32;
        dst = (u16*)(p.ws + O_WBR) + (size_t)(l * 3 + kb) * 1024 * 512; lddst = 512; drow = n0;
      } else if ((r -= T_BR) < T_OUT) {
        const int nt = r >> 4, kt = r & 15;
        src = p.w_out + (size_t)l * 1024 * 1024; ldsrc = 1024; k0 = kt * 64; n0 = nt * 32;
        dst = (u16*)(p.ws + O_WOUT) + (size_t)l * 1024 * 1024; lddst = 1024; drow = n0;
      } else {
        r -= T_OUT;
        const int b = r >> 6, r2 = r & 63;
        const int nt = r2 >> 2, kt = r2 & 3;
        src = p.cache_na_v + (size_t)(b * 2 + l) * 256 * 512; ldsrc = 512; k0 = kt * 64; n0 = nt * 32;
        dst = (u16*)(p.ws + O_VTC) + (size_t)(l * 8 + b) * 512 * 256; lddst = 256; drow = n0;
      }
      tconv_tile(src, ldsrc, k0, n0, dst, lddst, drow, (float*)smem);
    } else if (item < N_MOD + N_TC + N_SG) {
      const int it = item - N_MOD - N_TC;
      const size_t e = (size_t)it * 2048 + t * 8;
      const float4 a = *(const float4*)(p.sgu_w + e), b = *(const float4*)(p.sgu_w + e + 4);
      u16* d = (u16*)(p.ws + O_SGUW) + e;
      st4bf(d, a.x, a.y, a.z, a.w); st4bf(d + 4, b.x, b.y, b.z, b.w);
    } else {
      const int it = item - N_MOD - N_TC - N_SG;
      const size_t e = (size_t)it * 2048 + t * 8;
      const int l = (int)(e >> 20), b = (int)(e >> 17) & 7; const size_t rest = e & 131071;
      const float* s = p.cache_na_k + ((size_t)(b * 2 + l) << 17) + rest;
      const float4 a = *(const float4*)s, bb = *(const float4*)(s + 4);
      u16* d = (u16*)(p.ws + O_KC) + e;
      st4bf(d, a.x, a.y, a.z, a.w); st4bf(d + 4, bb.x, bb.y, bb.z, bb.w);
    }
  }
}

DEV const float* xrow_in(const Params& p, int l, int s, int tl) {
  if (l == 0) return (s == 0 ? p.x_prompt : p.x_sample) + (size_t)tl * 1024;
  return p.out + OUT_Y + (size_t)s * 8388608 + (size_t)tl * 1024;
}
DEV int cond_idx(int s, int tl) { return s == 0 ? 0 : 1 + (tl >> 10); }

DEV void phase_h(const Params& p, int l, int s) {
  const int lane = threadIdx.x & 63, wave = threadIdx.x >> 6;
  u16* H = (u16*)(p.ws + O_H);
  const float* MOD = (const float*)(p.ws + O_MOD);
  for (int item = blockIdx.x; item < 2048; item += gridDim.x) {
    const int tl = item * 4 + wave;
    const float* x = xrow_in(p, l, s, tl);
    const float* mod = MOD + (size_t)(l * 9 + cond_idx(s, tl)) * 3072;
    float4 v[4];
    float ss = 0.f;
#pragma unroll
    for (int i = 0; i < 4; i++) {
      v[i] = *(const float4*)(x + i * 256 + lane * 4);
      ss += v[i].x * v[i].x + v[i].y * v[i].y + v[i].z * v[i].z + v[i].w * v[i].w;
    }
    ss = wave_sum(ss);
    const float rstd = rsqrtf(ss * (1.f / 1024.f) + 1e-6f);
#pragma unroll
    for (int i = 0; i < 4; i++) {
      const int col = i * 256 + lane * 4;
      const float4 g = *(const float4*)(p.norm_g + l * 1024 + col);
      const float4 sh = *(const float4*)(mod + col);
      const float4 sc = *(const float4*)(mod + 1024 + col);
      st4bf(H + (size_t)tl * 1024 + col, v[i].x * rstd * g.x * (1.f + sc.x) + sh.x, v[i].y * rstd * g.y * (1.f + sc.y) + sh.y,
            v[i].z * rstd * g.z * (1.f + sc.z) + sh.z, v[i].w * rstd * g.w * (1.f + sc.w) + sh.w);
    }
  }
}

DEV void phase_in(const Params& p, int l, int s, char* smem) {
  const int xcd = blockIdx.x & 7, lb = blockIdx.x >> 3, nb = gridDim.x >> 3;
  const u16* H = (const u16*)(p.ws + O_H);
  const u16* W = (const u16*)(p.ws + O_WIN) + (size_t)l * 7936 * 1024;
  u16* QNA = (u16*)(p.ws + O_QNA); u16* KNA = (u16*)(p.ws + O_KNA); u16* VTNA = (u16*)(p.ws + O_VTNA);
  u16* ZA = (u16*)(p.ws + O_ZA); u16* ZB = (u16*)(p.ws + O_ZB); u16* ZC = (u16*)(p.ws + O_ZC);
  u16* GU = (u16*)(p.ws + O_GU); u16* GVT = (u16*)(p.ws + O_GVT);
  u16* DQ = (u16*)(p.ws + O_DQ); u16* DKV = (u16*)(p.ws + O_DKV); float* KRF = (float*)(p.ws + O_KRF);
  u16* GATES = (u16*)(p.ws + O_GATES);
  float* out = p.out;
  for (int li = lb; li < 8 * 62; li += nb) {
    int m, n;
    tile_map(li, 8, xcd, m, n);
    const int m0 = m * 128, n0 = n * 128;
    const bool swapped = (n >= 8 && n < 12) || (n >= 20 && n < 24);
    const u16* Hm = H + (size_t)m0 * 1024;
    const u16* Wn = W + (size_t)n0 * 1024;
    f32x16 acc[2][2];
    acc_zero(acc);
    gemm_mainloop(swapped ? Wn : Hm, 1024, swapped ? Hm : Wn, 1024, 1024, smem, acc);
    if (n < 4) {
      epi_foreach(acc, [&](int i, int j, float v0, float v1, float v2, float v3) {
        st4bf(QNA + (size_t)(m0 + i) * 512 + n0 + j, v0, v1, v2, v3);
      });
    } else if (n < 8) {
      epi_foreach(acc, [&](int i, int j, float v0, float v1, float v2, float v3) {
        const int T = m0 + i, col = n0 - 512 + j;
        st4bf(KNA + (size_t)T * 512 + col, v0, v1, v2, v3);
        if (s == 0) {
          const int b = T >> 8, sq = T & 255;
          *(float4*)(out + OUT_SK + ((size_t)(b * 2 + l) * 256 + sq) * 512 + col) = make_float4(v0, v1, v2, v3);
        }
      });
    } else if (n < 12) {
      epi_foreach(acc, [&](int i, int j, float v0, float v1, float v2, float v3) {
        const int dva = n0 - 1024 + i, tok = m0 + j;
        if (s == 0) {
          const int b = tok >> 8, sq = tok & 255;
          st4bf(VTNA + ((size_t)(b * 512 + dva)) * 256 + sq, v0, v1, v2, v3);
          float* o = out + OUT_SV + ((size_t)(b * 2 + l) * 256 + sq) * 512 + dva;
          o[0] = v0; o[512] = v1; o[1024] = v2; o[1536] = v3;
        } else {
          const int b = tok >> 10, nn = tok & 1023;
          st4bf(VTNA + ((size_t)(b * 512 + dva)) * 1024 + nn, v0, v1, v2, v3);
        }
      });
    } else if (n < 16) {
      epi_foreach(acc, [&](int i, int j, float v0, float v1, float v2, float v3) {
        st4bf(ZA + (size_t)(m0 + i) * 512 + n0 - 1536 + j, silu_f(v0), silu_f(v1), silu_f(v2), silu_f(v3));
      });
    } else if (n < 20) {
      epi_foreach(acc, [&](int i, int j, float v0, float v1, float v2, float v3) {
        st4bf(GU + (size_t)(m0 + i) * 512 + n0 - 2048 + j, gelu_f(v0), gelu_f(v1), gelu_f(v2), gelu_f(v3));
      });
    } else if (n < 24) {
      epi_foreach(acc, [&](int i, int j, float v0, float v1, float v2, float v3) {
        const int c = n0 - 2560 + i, tok = m0 + j;
        const int chunk = tok >> 7, q = tok & 127;
        st4bf(GVT + ((size_t)chunk * 512 + c) * 128 + q, gelu_f(v0), gelu_f(v1), gelu_f(v2), gelu_f(v3));
      });
    } else if (n < 28) {
      epi_foreach(acc, [&](int i, int j, float v0, float v1, float v2, float v3) {
        st4bf(ZB + (size_t)(m0 + i) * 512 + n0 - 3072 + j, silu_f(v0), silu_f(v1), silu_f(v2), silu_f(v3));
      });
    } else if (n < 31) {
      epi_foreach(acc, [&](int i, int j, float v0, float v1, float v2, float v3) {
        st4bf(DQ + (size_t)(m0 + i) * 384 + n0 - 3584 + j, v0, v1, v2, v3);
      });
    } else if (n < 33) {
      epi_foreach(acc, [&](int i, int j, float v0, float v1, float v2, float v3) {
        st4bf(DKV + (size_t)(m0 + i) * 256 + n0 - 3968 + j, v0, v1, v2, v3);
      });
    } else if (n < 37) {
      epi_foreach(acc, [&](int i, int j, float v0, float v1, float v2, float v3) {
        st4bf(ZC + (size_t)(m0 + i) * 512 + n0 - 4224 + j, silu_f(v0), silu_f(v1), silu_f(v2), silu_f(v3));
      });
    } else if (n < 61) {
      epi_foreach(acc, [&](int i, int j, float v0, float v1, float v2, float v3) {
        st4bf(GATES + (size_t)(m0 + i) * 3072 + n0 - 4736 + j, sigmoid_f(v0), sigmoid_f(v1), sigmoid_f(v2), sigmoid_f(v3));
      });
    } else {
      epi_foreach(acc, [&](int i, int j, float v0, float v1, float v2, float v3) {
        if (j < 32) {
          const int T = m0 + i;
          *(float4*)(KRF + (size_t)T * 32 + j) = make_float4(v0, v1, v2, v3);
          if (s == 0) {
            const int b = T >> 8, sq = T & 255;
            *(float4*)(out + OUT_SKR + ((size_t)(b * 2 + l) * 256 + sq) * 32 + j) = make_float4(v0, v1, v2, v3);
          }
        }
      });
    }
  }
}

DEV void phase_rows(const Params& p, int l, int s, char* smem) {
  const int t = threadIdx.x, lane = t & 63, wave = t >> 6;
  u16* DQ = (u16*)(p.ws + O_DQ); const u16* DKV = (const u16*)(p.ws + O_DKV); const float* KRF = (const float*)(p.ws + O_KRF);
  u16* CKV = (u16*)(p.ws + O_CKV); u16* KR = (u16*)(p.ws + O_KR); u16* GVT = (u16*)(p.ws + O_GVT);
  const int n_row = 2048, n_ln = 64, n_cache = (s == 1) ? 512 : 0;
  const int total = n_row + n_ln + n_cache;
  for (int item = blockIdx.x; item < total; item += gridDim.x) {
    if (item < n_row) {
      const int tl = item * 4 + wave;
      {
        u16* r = DQ + (size_t)tl * 384;
        float v[6]; float ss = 0.f;
#pragma unroll
        for (int i = 0; i < 6; i++) { v[i] = bf2f(r[i * 64 + lane]); ss += v[i] * v[i]; }
        ss = wave_sum(ss);
        const float rstd = rsqrtf(ss * (1.f / 384.f) + 1e-6f);
#pragma unroll
        for (int i = 0; i < 6; i++) r[i * 64 + lane] = f2bf(v[i] * rstd * p.q_norm[l * 384 + i * 64 + lane]);
      }
      {
        float a, b, c, d;
        ld4bf(DKV + (size_t)tl * 256 + lane * 4, a, b, c, d);
        float ss = wave_sum(a * a + b * b + c * c + d * d);
        const float rstd = rsqrtf(ss * (1.f / 256.f) + 1e-6f);
        const float4 g = *(const float4*)(p.kv_norm + l * 256 + lane * 4);
        a *= rstd * g.x; b *= rstd * g.y; c *= rstd * g.z; d *= rstd * g.w;
        const int row = (s == 0) ? tl : ((tl >> 10) * 1280 + 256 + (tl & 1023));
        st4bf(CKV + (size_t)row * 256 + lane * 4, a, b, c, d);
        if (s == 0) {
          const int bb = tl >> 8, sq = tl & 255;
          *(float4*)(p.out + OUT_CKV + ((size_t)(bb * 2 + l) * 256 + sq) * 256 + lane * 4) = make_float4(a, b, c, d);
        }
      }
      if (lane < 16) {
        const float x1 = KRF[(size_t)tl * 32 + lane], x2 = KRF[(size_t)tl * 32 + 16 + lane];
        if (s == 0) {
          KR[(size_t)tl * 32 + lane] = f2bf(x1);
          KR[(size_t)tl * 32 + 16 + lane] = f2bf(x2);
        } else {
          const int nn = tl & 1023;
          const float pos = (lane < 8) ? (float)(nn >> 6) : (float)(nn & 63);
          const float inv = powf(10000.f, -(float)(lane & 7) * 0.125f);
          const float ang = pos * inv;
          const float cs = cosf(ang), sn = sinf(ang);
          const int row = (tl >> 10) * 1280 + 256 + nn;
          KR[(size_t)row * 32 + lane] = f2bf(x1 * cs - x2 * sn);
          KR[(size_t)row * 32 + 16 + lane] = f2bf(x1 * sn + x2 * cs);
        }
      }
    } else if (item < n_row + n_ln) {
      const int chunk = item - n_row;
      u16* g = GVT + (size_t)chunk * 512 * 128;
      const int q = t & 127, half = t >> 7;
      float sum = 0.f, sq = 0.f;
      for (int c = half * 256; c < half * 256 + 256; c++) { const float v = bf2f(g[c * 128 + q]); sum += v; sq += v * v; }
      float* red = (float*)smem;
      red[(half * 2 + 0) * 128 + q] = sum; red[(half * 2 + 1) * 128 + q] = sq;
      __syncthreads();
      sum = red[q] + red[256 + q]; sq = red[128 + q] + red[384 + q];
      const float mu = sum * (1.f / 512.f);
      const float var = fmaxf(sq * (1.f / 512.f) - mu * mu, 0.f);
      const float rstd = rsqrtf(var + 1e-6f);
      for (int c = half * 256; c < half * 256 + 256; c++) { const float v = bf2f(g[c * 128 + q]); g[c * 128 + q] = f2bf((v - mu) * rstd); }
      __syncthreads();
    } else {
      const int rowi = (item - n_row - n_ln) * 4 + wave;
      const int b = rowi >> 8, m = rowi & 255;
      const float4 a = *(const float4*)(p.cache_ckv + ((size_t)(b * 2 + l) * 256 + m) * 256 + lane * 4);
      st4bf(CKV + (size_t)(b * 1280 + m) * 256 + lane * 4, a.x, a.y, a.z, a.w);
      if (lane < 32) KR[(size_t)(b * 1280 + m) * 32 + lane] = f2bf(p.cache_kr[((size_t)(b * 2 + l) * 256 + m) * 32 + lane]);
    }
  }
}

DEV void attn_upd(float sc, const u16* vt, int vs, float (&o)[64], float& mx, float& ls) {
  const float mn = fmaxf(mx, sc);
  const float al = __expf(mx - mn), pe = __expf(sc - mn);
  mx = mn; ls = ls * al + pe;
#pragma unroll
  for (int d = 0; d < 64; d++) o[d] = o[d] * al + pe * bf2f(vt[(size_t)d * vs]);
}
template <int N>
DEV void loadq(const u16* qp, float (&q)[N], float scale) {
#pragma unroll
  for (int d = 0; d < N; d += 4) { ld4bf(qp + d, q[d], q[d + 1], q[d + 2], q[d + 3]); q[d] *= scale; q[d + 1] *= scale; q[d + 2] *= scale; q[d + 3] *= scale; }
}
template <int N>
DEV float dotq(const float (&q)[N], const u16* kp) {
  float s = 0.f;
#pragma unroll
  for (int d = 0; d < N; d += 8) {
    const uint4 kk = *(const uint4*)(kp + d);
    s += q[d] * __uint_as_float(kk.x << 16) + q[d + 1] * __uint_as_float(kk.x & 0xffff0000u) + q[d + 2] * __uint_as_float(kk.y << 16) +
         q[d + 3] * __uint_as_float(kk.y & 0xffff0000u) + q[d + 4] * __uint_as_float(kk.z << 16) + q[d + 5] * __uint_as_float(kk.z & 0xffff0000u) +
         q[d + 6] * __uint_as_float(kk.w << 16) + q[d + 7] * __uint_as_float(kk.w & 0xffff0000u);
  }
  return s;
}
DEV void attn_store(const float (&o)[64], float ls, u16* z) {
  const float inv = 1.f / ls;
#pragma unroll
  for (int d = 0; d < 64; d += 4) {
    float a, b, c, e;
    ld4bf(z + d, a, b, c, e);
    st4bf(z + d, o[d] * inv * a, o[d + 1] * inv * b, o[d + 2] * inv * c, o[d + 3] * inv * e);
  }
}

DEV void na_ctx_item(const Params& p, int it) {
  const int b = it >> 3, h = it & 7, t = threadIdx.x;
  const u16* QNA = (const u16*)(p.ws + O_QNA); const u16* KNA = (const u16*)(p.ws + O_KNA); const u16* VTNA = (const u16*)(p.ws + O_VTNA);
  u16* ZA = (u16*)(p.ws + O_ZA);
  const int tl = b * 256 + t;
  float q[64], o[64];
  loadq<64>(QNA + (size_t)tl * 512 + h * 64, q, 0.125f);
#pragma unroll
  for (int d = 0; d < 64; d++) o[d] = 0.f;
  float mx = -1e30f, ls = 0.f;
  for (int m = 0; m < 256; m++) {
    const float sc = dotq<64>(q, KNA + (size_t)(b * 256 + m) * 512 + h * 64);
    attn_upd(sc, VTNA + (size_t)(b * 512 + h * 64) * 256 + m, 256, o, mx, ls);
  }
  attn_store(o, ls, ZA + (size_t)tl * 512 + h * 64);
}

DEV void na_lat_item(const Params& p, int l, int it) {
  const int quarter = it & 3, h = (it >> 2) & 7, b = it >> 5, t = threadIdx.x;
  const u16* QNA = (const u16*)(p.ws + O_QNA); const u16* KNA = (const u16*)(p.ws + O_KNA); const u16* VTNA = (const u16*)(p.ws + O_VTNA);
  const u16* KC = (const u16*)(p.ws + O_KC); const u16* VTC = (const u16*)(p.ws + O_VTC);
  u16* ZA = (u16*)(p.ws + O_ZA);
  const int nn = quarter * 256 + t, tl = b * 1024 + nn;
  const int r = nn >> 6, qc = nn & 63;
  const int wr0 = min(max(r - 4, 0), 8), wlo = min(max(qc - 8, 0), 48);
  float q[64], o[64];
  loadq<64>(QNA + (size_t)tl * 512 + h * 64, q, 0.125f);
#pragma unroll
  for (int d = 0; d < 64; d++) o[d] = 0.f;
  float mx = -1e30f, ls = 0.f;
  for (int wr = 0; wr < 8; wr++) {
    const int krow = wr0 + wr;
    const float* bias = p.na_rpb + ((size_t)(l * 8 + h) * 15 + (krow - r + 7)) * 31 + (15 - qc);
    for (int kc = wlo; kc < wlo + 16; kc++) {
      const int n2 = krow * 64 + kc;
      const float sc = dotq<64>(q, KNA + (size_t)(b * 1024 + n2) * 512 + h * 64) + bias[kc];
      attn_upd(sc, VTNA + (size_t)(b * 512 + h * 64) * 1024 + n2, 1024, o, mx, ls);
    }
  }
  for (int m = 0; m < 256; m++) {
    const float sc = dotq<64>(q, KC + ((size_t)(l * 8 + b) * 256 + m) * 512 + h * 64);
    attn_upd(sc, VTC + ((size_t)(l * 8 + b) * 512 + h * 64) * 256 + m, 256, o, mx, ls);
  }
  attn_store(o, ls, ZA + (size_t)tl * 512 + h * 64);
}

DEV void mla_item(const Params& p, int s, int it) {
  const int t = threadIdx.x;
  const u16* QM = (const u16*)(p.ws + O_H); const u16* KNOPE = (const u16*)(p.ws + O_KNOPE); const u16* KR = (const u16*)(p.ws + O_KR);
  const u16* VTM = (const u16*)(p.ws + O_VTM);
  u16* ZC = (u16*)(p.ws + O_ZC);
  int b, h, tl, S, nn = 0;
  if (s == 0) { b = it >> 3; h = it & 7; tl = b * 256 + t; S = 256; }
  else { const int quarter = it & 3; h = (it >> 2) & 7; b = it >> 5; nn = quarter * 256 + t; tl = b * 1024 + nn; S = 1280; }
  const float scale = 0.10206207261596575f;
  float qn[64], qr[32], o[64];
  loadq<64>(QM + (size_t)tl * 768 + h * 96, qn, scale);
  loadq<32>(QM + (size_t)tl * 768 + h * 96 + 64, qr, scale);
  if (s == 1) {
    const float row = (float)(nn >> 6), col = (float)(nn & 63);
#pragma unroll
    for (int jj = 0; jj < 16; jj++) {
      const float inv = powf(10000.f, -(float)(jj & 7) * 0.125f);
      const float ang = ((jj < 8) ? row : col) * inv;
      const float cs = cosf(ang), sn = sinf(ang);
      const float x1 = qr[jj], x2 = qr[16 + jj];
      qr[jj] = x1 * cs - x2 * sn; qr[16 + jj] = x1 * sn + x2 * cs;
    }
  }
#pragma unroll
  for (int d = 0; d < 64; d++) o[d] = 0.f;
  float mx = -1e30f, ls = 0.f;
  for (int m = 0; m < S; m++) {
    const size_t krow = (size_t)b * S + m;
    const float sc = dotq<64>(qn, KNOPE + krow * 512 + h * 64) + dotq<32>(qr, KR + krow * 32);
    attn_upd(sc, VTM + ((size_t)b * 512 + h * 64) * S + m, S, o, mx, ls);
  }
  attn_store(o, ls, ZC + (size_t)tl * 512 + h * 64);
}

DEV void phase_mix(const Params& p, int l, int s, char* smem) {
  const int n_att = 256;
  const int n_sgu = 256, n_q = 384, n_kv = (s == 0) ? 512 : 640;
  const int total = n_att + n_sgu + n_q + n_kv;
  for (int item = blockIdx.x; item < total; item += gridDim.x) {
    if (item < n_att) {
      if (s == 0) na_ctx_item(p, item); else na_lat_item(p, l, item);
    } else if (item < n_att + n_sgu) {
      const int it = item - n_att, chunk = it >> 2, g = it & 3;
      const u16* Wg = (const u16*)(p.ws + O_SGUW) + (size_t)(l * 4 + g) * 128 * 128;
      const u16* V = (const u16*)(p.ws + O_GVT) + ((size_t)chunk * 512 + g * 128) * 128;
      const u16* GU = (const u16*)(p.ws + O_GU); u16* ZB = (u16*)(p.ws + O_ZB);
      f32x16 acc[2][2];
      acc_zero(acc);
      gemm_mainloop(Wg, 128, V, 128, 128, smem, acc);
      epi_foreach(acc, [&](int i, int j, float v0, float v1, float v2, float v3) {
        const float bs = p.sgu_b[(l * 4 + g) * 128 + i];
        const size_t off = (size_t)(chunk * 128 + i) * 512 + g * 128 + j;
        float u0, u1, u2, u3, z0, z1, z2, z3;
        ld4bf(GU + off, u0, u1, u2, u3);
        ld4bf(ZB + off, z0, z1, z2, z3);
        st4bf(ZB + off, u0 * (v0 + bs) * z0, u1 * (v1 + bs) * z1, u2 * (v2 + bs) * z2, u3 * (v3 + bs) * z3);
      });
    } else if (item < n_att + n_sgu + n_q) {
      const int it = item - n_att - n_sgu, m = it / 6, n = it % 6;
      const u16* DQ = (const u16*)(p.ws + O_DQ) + (size_t)m * 128 * 384;
      const u16* W = (const u16*)(p.ws + O_WUQ) + (size_t)l * 768 * 384 + (size_t)n * 128 * 384;
      u16* QM = (u16*)(p.ws + O_H);
      f32x16 acc[2][2];
      acc_zero(acc);
      gemm_mainloop(DQ, 384, W, 384, 384, smem, acc);
      epi_foreach(acc, [&](int i, int j, float v0, float v1, float v2, float v3) {
        st4bf(QM + (size_t)(m * 128 + i) * 768 + n * 128 + j, v0, v1, v2, v3);
      });
    } else {
      const int it = item - n_att - n_sgu - n_q, m = it >> 3, n = it & 7;
      const u16* C = (const u16*)(p.ws + O_CKV) + (size_t)m * 128 * 256;
      const u16* W = (const u16*)(p.ws + O_WUKV) + (size_t)l * 1024 * 256 + (size_t)n * 128 * 256;
      const bool swapped = n >= 4;
      f32x16 acc[2][2];
      acc_zero(acc);
      gemm_mainloop(swapped ? W : C, 256, swapped ? C : W, 256, 256, smem, acc);
      if (!swapped) {
        u16* KNOPE = (u16*)(p.ws + O_KNOPE);
        epi_foreach(acc, [&](int i, int j, float v0, float v1, float v2, float v3) {
          st4bf(KNOPE + (size_t)(m * 128 + i) * 512 + n * 128 + j, v0, v1, v2, v3);
        });
      } else {
        u16* VTM = (u16*)(p.ws + O_VTM);
        const int S = (s == 0) ? 256 : 1280;
        epi_foreach(acc, [&](int i, int j, float v0, float v1, float v2, float v3) {
          const int ch = (n - 4) * 128 + i, row = m * 128 + j;
          const int b = row / S, mm = row % S;
          st4bf(VTM + ((size_t)b * 512 + ch) * S + mm, v0, v1, v2, v3);
        });
      }
    }
  }
}

DEV void phase_mla(const Params& p, int l, int s) {
  for (int item = blockIdx.x; item < 256; item += gridDim.x) mla_item(p, s, item);
}

DEV void phase_merge(const Params& p, int l, int s, char* smem) {
  const int xcd = blockIdx.x & 7, lb = blockIdx.x >> 3, nb = gridDim.x >> 3;
  const u16* GATES = (const u16*)(p.ws + O_GATES);
  u16* MG = (u16*)(p.ws + O_H);
  for (int li = lb; li < 64; li += nb) {
    int m, n;
    tile_map(li, 8, xcd, m, n);
    f32x16 macc[2][2];
    acc_zero(macc);
#pragma unroll 1
    for (int k = 0; k < 3; k++) {
      const u16* A = (const u16*)(p.ws + (k == 0 ? O_ZA : (k == 1 ? O_ZB : O_ZC))) + (size_t)m * 128 * 512;
      const u16* W = (const u16*)(p.ws + O_WBR) + (size_t)(l * 3 + k) * 1024 * 512 + (size_t)n * 128 * 512;
      f32x16 acc[2][2];
      acc_zero(acc);
      gemm_mainloop(A, 512, W, 512, 512, smem, acc);
      const int lane = threadIdx.x & 63, w = threadIdx.x >> 6, wm = w >> 1, wn = w & 1;
#pragma unroll
      for (int a = 0; a < 2; a++)
#pragma unroll
        for (int b = 0; b < 2; b++)
#pragma unroll
          for (int rg = 0; rg < 4; rg++) {
            const int i = wm * 64 + a * 32 + (lane & 31);
            const int j = wn * 64 + b * 32 + rg * 8 + (lane >> 5) * 4;
            float g0, g1, g2, g3;
            ld4bf(GATES + (size_t)(m * 128 + i) * 3072 + k * 1024 + n * 128 + j, g0, g1, g2, g3);
            macc[a][b][rg * 4 + 0] += g0 * acc[a][b][rg * 4 + 0];
            macc[a][b][rg * 4 + 1] += g1 * acc[a][b][rg * 4 + 1];
            macc[a][b][rg * 4 + 2] += g2 * acc[a][b][rg * 4 + 2];
            macc[a][b][rg * 4 + 3] += g3 * acc[a][b][rg * 4 + 3];
          }
    }
    epi_foreach(macc, [&](int i, int j, float v0, float v1, float v2, float v3) {
      st4bf(MG + (size_t)(m * 128 + i) * 1024 + n * 128 + j, v0, v1, v2, v3);
    });
  }
}

DEV void phase_out(const Params& p, int l, int s, char* smem) {
  const int xcd = blockIdx.x & 7, lb = blockIdx.x >> 3, nb = gridDim.x >> 3;
  const u16* MG = (const u16*)(p.ws + O_H);
  const float* MOD = (const float*)(p.ws + O_MOD);
  for (int li = lb; li < 64; li += nb) {
    int m, n;
    tile_map(li, 8, xcd, m, n);
    f32x16 acc[2][2];
    acc_zero(acc);
    gemm_mainloop(MG + (size_t)m * 128 * 1024, 1024, (const u16*)(p.ws + O_WOUT) + (size_t)l * 1024 * 1024 + (size_t)n * 128 * 1024, 1024, 1024, smem, acc);
    epi_foreach(acc, [&](int i, int j, float v0, float v1, float v2, float v3) {
      const int tl = m * 128 + i, col = n * 128 + j;
      const float4 x = *(const float4*)(xrow_in(p, l, s, tl) + col);
      const float4 g = *(const float4*)(MOD + (size_t)(l * 9 + cond_idx(s, tl)) * 3072 + 2048 + col);
      *(float4*)(p.out + OUT_Y + (size_t)s * 8388608 + (size_t)tl * 1024 + col) =
          make_float4(x.x + g.x * v0, x.y + g.y * v1, x.z + g.z * v2, x.w + g.w * v3);
    });
  }
}

DEV void phase_final(const Params& p) {
  const int lane = threadIdx.x & 63, wave = threadIdx.x >> 6;
  for (int item = blockIdx.x; item < 4096; item += gridDim.x) {
    float* x = p.out + OUT_Y + (size_t)(item * 4 + wave) * 1024;
    float4 v[4];
    float ss = 0.f;
#pragma unroll
    for (int i = 0; i < 4; i++) {
      v[i] = *(const float4*)(x + i * 256 + lane * 4);
      ss += v[i].x * v[i].x + v[i].y * v[i].y + v[i].z * v[i].z + v[i].w * v[i].w;
    }
    ss = wave_sum(ss);
    const float rstd = rsqrtf(ss * (1.f / 1024.f) + 1e-6f);
#pragma unroll
    for (int i = 0; i < 4; i++) {
      const int col = i * 256 + lane * 4;
      const float4 g = *(const float4*)(p.final_g + col);
      *(float4*)(x + col) = make_float4(v[i].x * rstd * g.x, v[i].y * rstd * g.y, v[i].z * rstd * g.z, v[i].w * rstd * g.w);
    }
  }
}

DEV void run_phase(const Params& p, int ph, int l, int s, char* smem) {
  switch (ph) {
    case 0: phase_prep(p, smem); break;
    case 1: phase_h(p, l, s); break;
    case 2: phase_in(p, l, s, smem); break;
    case 3: phase_rows(p, l, s, smem); break;
    case 4: phase_mix(p, l, s, smem); break;
    case 5: phase_mla(p, l, s); break;
    case 6: phase_merge(p, l, s, smem); break;
    case 7: phase_out(p, l, s, smem); break;
    default: phase_final(p); break;
  }
}

__global__ void __launch_bounds__(256) phase_kernel(Params p, int ph, int l, int s) {
  __shared__ __attribute__((aligned(16))) char smem[65536];
  run_phase(p, ph, l, s, smem);
}

__global__ void __launch_bounds__(256) mega_kernel(Params p) {
  __shared__ __attribute__((aligned(16))) char smem[65536];
  cg::grid_group grid = cg::this_grid();
  phase_prep(p, smem);
  grid.sync();
  for (int l = 0; l < 2; l++)
    for (int s = 0; s < 2; s++) {
      for (int ph = 1; ph <= 7; ph++) {
        run_phase(p, ph, l, s, smem);
        grid.sync();
      }
    }
  phase_final(p);
}

extern "C" void kernel_launch(void* const* d_in, const int* in_sizes, int n_in, void* d_out, int out_size, void* d_ws, size_t ws_size,
                              hipStream_t stream) {
  Params p{};
  const float** pp = (const float**)&p;
  for (int i = 0; i < 22; i++) pp[i] = (const float*)d_in[i];
  p.out = (float*)d_out;
  p.ws = (char*)d_ws;
#if USE_COOP
  static int grid_blocks = 0;
  if (!grid_blocks) {
    int dev = 0, cus = 0, per_cu = 0;
    hipGetDevice(&dev);
    hipDeviceGetAttribute(&cus, hipDeviceAttributeMultiprocessorCount, dev);
    hipOccupancyMaxActiveBlocksPerMultiprocessor(&per_cu, mega_kernel, 256, 0);
    if (per_cu > 2) per_cu = 2;
    grid_blocks = cus * per_cu;
    grid_blocks &= ~7;
  }
  void* args[] = {&p};
  hipError_t e = hipLaunchCooperativeKernel((void*)mega_kernel, dim3(grid_blocks), dim3(256), args, 0, stream);
  if (e != hipSuccess) fprintf(stderr, "cooperative launch failed: %s (grid %d)\n", hipGetErrorString(e), grid_blocks);
#else
  const int G = 512;
  phase_kernel<<<G, 256, 0, stream>>>(p, 0, 0, 0);
  for (int l = 0; l < 2; l++)
    for (int s = 0; s < 2; s++)
      for (int ph = 1; ph <= 7; ph++) phase_kernel<<<G, 256, 0, stream>>>(p, ph, l, s);
  phase_kernel<<<G, 256, 0, stream>>>(p, 8, 0, 0);
#endif
}
```

```cpp
#include <hip/hip_runtime.h>
#include <hip/hip_cooperative_groups.h>
#include <cstdio>
namespace cg = cooperative_groups;

#ifndef USE_COOP
#define USE_COOP 1
#endif

typedef unsigned short u16;
typedef __attribute__((ext_vector_type(8))) __bf16 bf16x8;
typedef __attribute__((ext_vector_type(16))) float f32x16;
#define DEV __device__ __forceinline__

constexpr size_t A256(size_t x) { return (x + 255) & ~(size_t)255; }
constexpr size_t O_WIN = 0;
constexpr size_t O_WUQ = O_WIN + A256(2ull * 7936 * 1024 * 2);
constexpr size_t O_WUKV = O_WUQ + A256(2ull * 768 * 384 * 2);
constexpr size_t O_WBR = O_WUKV + A256(2ull * 1024 * 256 * 2);
constexpr size_t O_WOUT = O_WBR + A256(2ull * 3 * 1024 * 512 * 2);
constexpr size_t O_SGUW = O_WOUT + A256(2ull * 1024 * 1024 * 2);
constexpr size_t O_KC = O_SGUW + A256(2ull * 4 * 128 * 128 * 2);
constexpr size_t O_VTC = O_KC + A256(2ull * 8 * 256 * 512 * 2);
constexpr size_t O_MOD = O_VTC + A256(2ull * 8 * 256 * 512 * 2);
constexpr size_t O_H = O_MOD + A256(2ull * 9 * 3072 * 4);
constexpr size_t O_QNA = O_H + A256(8192ull * 1024 * 2);
constexpr size_t O_KNA = O_QNA + A256(8192ull * 512 * 2);
constexpr size_t O_VTNA = O_KNA + A256(8192ull * 512 * 2);
constexpr size_t O_ZA = O_VTNA + A256(8192ull * 512 * 2);
constexpr size_t O_ZB = O_ZA + A256(8192ull * 512 * 2);
constexpr size_t O_ZC = O_ZB + A256(8192ull * 512 * 2);
constexpr size_t O_GU = O_ZC + A256(8192ull * 512 * 2);
constexpr size_t O_GVT = O_GU + A256(8192ull * 512 * 2);
constexpr size_t O_DQ = O_GVT + A256(8192ull * 512 * 2);
constexpr size_t O_DKV = O_DQ + A256(8192ull * 384 * 2);
constexpr size_t O_KRF = O_DKV + A256(8192ull * 256 * 2);
constexpr size_t O_GATES = O_KRF + A256(8192ull * 32 * 4);
constexpr size_t O_CKV = O_GATES + A256(8192ull * 3072 * 2);
constexpr size_t O_KR = O_CKV + A256(10240ull * 256 * 2);
constexpr size_t O_KNOPE = O_KR + A256(10240ull * 32 * 2);
constexpr size_t O_VTM = O_KNOPE + A256(10240ull * 512 * 2);
constexpr size_t O_END = O_VTM + A256(10240ull * 512 * 2);
static_assert(O_END <= 256ull * 1024 * 1024, "workspace too large");

constexpr size_t OUT_Y = 0;
constexpr size_t OUT_SK = 16777216;
constexpr size_t OUT_SV = 25165824;
constexpr size_t OUT_CKV = 33554432;
constexpr size_t OUT_SKR = 37748736;

struct Params {
  const float *x_prompt, *x_sample, *cache_na_k, *cache_na_v, *cache_ckv, *cache_kr, *c, *c_ctx;
  const float *norm_g, *w_mod, *b_mod, *w_in, *na_rpb, *sgu_w, *sgu_b, *q_norm, *w_uq, *kv_norm, *w_ukv, *w_branch, *w_out, *final_g;
  float* out;
  char* ws;
};

DEV u16 f2bf(float f) { unsigned u = __float_as_uint(f); u += 0x7fffu + ((u >> 16) & 1u); return (u16)(u >> 16); }
DEV float bf2f(u16 h) { return __uint_as_float(((unsigned)h) << 16); }
DEV unsigned pack2(float a, float b) { return (unsigned)f2bf(a) | ((unsigned)f2bf(b) << 16); }
DEV void st4bf(u16* p, float a, float b, float c, float d) { uint2 v; v.x = pack2(a, b); v.y = pack2(c, d); *(uint2*)p = v; }
DEV void ld4bf(const u16* p, float& a, float& b, float& c, float& d) {
  uint2 v = *(const uint2*)p;
  a = __uint_as_float(v.x << 16); b = __uint_as_float(v.x & 0xffff0000u);
  c = __uint_as_float(v.y << 16); d = __uint_as_float(v.y & 0xffff0000u);
}
DEV float wave_sum(float v) {
#pragma unroll
  for (int o = 32; o > 0; o >>= 1) v += __shfl_xor(v, o);
  return v;
}
DEV float sigmoid_f(float x) { return 1.f / (1.f + __expf(-x)); }
DEV float silu_f(float x) { return x / (1.f + __expf(-x)); }
DEV float gelu_f(float x) { float u = 0.7978845608028654f * (x + 0.044715f * x * x * x); return x / (1.f + __expf(-2.f * u)); }

DEV void gemm_mainloop(const u16* __restrict__ P, int ldp, const u16* __restrict__ Q, int ldq, int K, char* smem, f32x16 (&acc)[2][2]) {
  const int t = threadIdx.x, lane = t & 63, w = t >> 6, wm = w >> 1, wn = w & 1;
  const int lr = t >> 3, ch = t & 7;
  const u16* pg = P + (size_t)lr * ldp + ch * 8;
  const u16* qg = Q + (size_t)lr * ldq + ch * 8;
  const int soff = lr * 128 + ((ch ^ ((t >> 4) & 7)) << 4);
  const int sw = (lane >> 1) & 7;
  const int prow = (wm * 64 + (lane & 31)) * 128;
  const int qrow = (wn * 64 + (lane & 31)) * 128;
  uint4 rp[4], rq[4];
#pragma unroll
  for (int i = 0; i < 4; i++) {
    rp[i] = *(const uint4*)(pg + (size_t)i * 32 * ldp);
    rq[i] = *(const uint4*)(qg + (size_t)i * 32 * ldq);
  }
#pragma unroll
  for (int i = 0; i < 4; i++) {
    *(uint4*)(smem + soff + i * 4096) = rp[i];
    *(uint4*)(smem + 16384 + soff + i * 4096) = rq[i];
  }
  __syncthreads();
  const int nk = K >> 6;
  for (int kt = 0; kt < nk; kt++) {
    const bool more = (kt + 1 < nk);
    if (more) {
      const int k0 = (kt + 1) << 6;
#pragma unroll
      for (int i = 0; i < 4; i++) {
        rp[i] = *(const uint4*)(pg + (size_t)i * 32 * ldp + k0);
        rq[i] = *(const uint4*)(qg + (size_t)i * 32 * ldq + k0);
      }
    }
    const char* bP = smem + (kt & 1) * 32768;
    const char* bQ = bP + 16384;
#pragma unroll
    for (int s = 0; s < 4; s++) {
      const int co = ((s * 2 + (lane >> 5)) ^ sw) << 4;
      bf16x8 pf[2], qf[2];
#pragma unroll
      for (int a = 0; a < 2; a++) pf[a] = *(const bf16x8*)(bP + prow + a * 4096 + co);
#pragma unroll
      for (int b = 0; b < 2; b++) qf[b] = *(const bf16x8*)(bQ + qrow + b * 4096 + co);
#pragma unroll
      for (int a = 0; a < 2; a++)
#pragma unroll
        for (int b = 0; b < 2; b++) acc[a][b] = __builtin_amdgcn_mfma_f32_32x32x16_bf16(qf[b], pf[a], acc[a][b], 0, 0, 0);
    }
    if (more) {
      char* nb = smem + ((kt + 1) & 1) * 32768;
#pragma unroll
      for (int i = 0; i < 4; i++) {
        *(uint4*)(nb + soff + i * 4096) = rp[i];
        *(uint4*)(nb + 16384 + soff + i * 4096) = rq[i];
      }
    }
    __syncthreads();
  }
}

DEV void acc_zero(f32x16 (&acc)[2][2]) {
#pragma unroll
  for (int a = 0; a < 2; a++)
#pragma unroll
    for (int b = 0; b < 2; b++)
#pragma unroll
      for (int r = 0; r < 16; r++) acc[a][b][r] = 0.f;
}

template <class F>
DEV void epi_foreach(const f32x16 (&acc)[2][2], F f) {
  const int lane = threadIdx.x & 63, w = threadIdx.x >> 6, wm = w >> 1, wn = w & 1;
#pragma unroll
  for (int a = 0; a < 2; a++)
#pragma unroll
    for (int b = 0; b < 2; b++)
#pragma unroll
      for (int rg = 0; rg < 4; rg++) {
        const int i = wm * 64 + a * 32 + (lane & 31);
        const int j = wn * 64 + b * 32 + rg * 8 + (lane >> 5) * 4;
        f(i, j, acc[a][b][rg * 4 + 0], acc[a][b][rg * 4 + 1], acc[a][b][rg * 4 + 2], acc[a][b][rg * 4 + 3]);
      }
}

DEV void tile_map(int li, int MPX, int xcd, int& m, int& n) {
  const int g = MPX * 8;
  const int ng = li / g, wv = li % g;
  m = xcd * MPX + (wv % MPX);
  n = ng * 8 + (wv / MPX);
}

DEV void tconv_tile(const float* __restrict__ src, int ldsrc, int k0, int n0, u16* __restrict__ dst, int lddst, int drow0, float* tile) {
  const int t = threadIdx.x;
  {
    const int n = t & 31, kk = t >> 5;
#pragma unroll
    for (int p = 0; p < 8; p++) {
      const int k = kk + p * 8;
      tile[k * 33 + n] = src[(size_t)(k0 + k) * ldsrc + n0 + n];
    }
  }
  __syncthreads();
  {
    const int k = t & 63, nn = t >> 6;
#pragma unroll
    for (int p = 0; p < 8; p++) {
      const int n2 = nn + p * 4;
      dst[(size_t)(drow0 + n2) * lddst + k0 + k] = f2bf(tile[k * 33 + n2]);
    }
  }
  __syncthreads();
}

DEV void phase_prep(const Params& p, char* smem) {
  const int t = threadIdx.x;
  constexpr int N_MOD = 192;
  constexpr int T_IN = 3920, T_UQ = 144, T_UKV = 128, T_BR = 768, T_OUT = 512, T_CV = 512;
  constexpr int T_L = T_IN + T_UQ + T_UKV + T_BR + T_OUT + T_CV;
  constexpr int N_TC = 2 * T_L;
  constexpr int N_SG = 64, N_KC = 1024;
  constexpr int TOTAL = N_MOD + N_TC + N_SG + N_KC;
  float* MOD = (float*)(p.ws + O_MOD);
  for (int item = blockIdx.x; item < TOTAL; item += gridDim.x) {
    if (item < N_MOD) {
      const int l = item / 96, e0 = (item % 96) * 32;
      float* sc = (float*)smem;
      for (int idx = t; idx < 9216; idx += 256) {
        const int c9 = idx >> 10, d = idx & 1023;
        const float v = (c9 == 0) ? p.c_ctx[d] : p.c[(c9 - 1) * 1024 + d];
        sc[idx] = silu_f(v);
      }
      __syncthreads();
      const int col = t & 31, slab = t >> 5;
      float a[9];
#pragma unroll
      for (int c9 = 0; c9 < 9; c9++) a[c9] = 0.f;
      const float* wp = p.w_mod + ((size_t)l * 1024 + slab * 128) * 3072 + e0 + col;
#pragma unroll 4
      for (int dd = 0; dd < 128; dd++) {
        const float wv = wp[(size_t)dd * 3072];
        const int d = slab * 128 + dd;
#pragma unroll
        for (int c9 = 0; c9 < 9; c9++) a[c9] += sc[c9 * 1024 + d] * wv;
      }
      float* red = sc + 9216;
#pragma unroll
      for (int c9 = 0; c9 < 9; c9++) red[(slab * 9 + c9) * 32 + col] = a[c9];
      __syncthreads();
      for (int idx = t; idx < 288; idx += 256) {
        const int c9 = idx >> 5, cc = idx & 31;
        float sum = 0.f;
#pragma unroll
        for (int sl = 0; sl < 8; sl++) sum += red[(sl * 9 + c9) * 32 + cc];
        MOD[(l * 9 + c9) * 3072 + e0 + cc] = sum + p.b_mod[l * 3072 + e0 + cc];
      }
      __syncthreads();
    } else if (item < N_MOD + N_TC) {
      const int ti = item - N_MOD;
      const int l = ti / T_L;
      int r = ti % T_L;
      const float* src; u16* dst; int ldsrc, lddst, k0, n0, drow;
      if (r < T_IN) {
        const int nt = r >> 4, kt = r & 15;
        src = p.w_in + (size_t)l * 1024 * 7840; ldsrc = 7840; k0 = kt * 64; n0 = nt * 32;
        dst = (u16*)(p.ws + O_WIN) + (size_t)l * 7936 * 1024; lddst = 1024;
        drow = (n0 < 4224) ? n0 : (n0 == 4224 ? 7808 : n0 - 32);
      } else if ((r -= T_IN) < T_UQ) {
        const int nt = r / 6, kt = r % 6;
        src = p.w_uq + (size_t)l * 384 * 768; ldsrc = 768; k0 = kt * 64; n0 = nt * 32;
        dst = (u16*)(p.ws + O_WUQ) + (size_t)l * 768 * 384; lddst = 384; drow = n0;
      } else if ((r -= T_UQ) < T_UKV) {
        const int nt = r >> 2, kt = r & 3;
        src = p.w_ukv + (size_t)l * 256 * 1024; ldsrc = 1024; k0 = kt * 64; n0 = nt * 32;
        dst = (u16*)(p.ws + O_WUKV) + (size_t)l * 1024 * 256; lddst = 256;
        const int hh = n0 >> 7, jj = n0 & 127;
        drow = (jj < 64) ? (hh * 64 + jj) : (512 + hh * 64 + jj - 64);
      } else if ((r -= T_UKV) < T_BR) {
        const int kb = r >> 8, r2 = r & 255;
        const int nt = r2 >> 3, kt = r2 & 7;
        src = p.w_branch + (size_t)(l * 3 + kb) * 512 * 1024; ldsrc = 1024; k0 = kt * 64; n0 = nt * 32;
        dst = (u16*)(p.ws + O_WBR) + (size_t)(l * 3 + kb) * 1024 * 512; lddst = 512; drow = n0;
      } else if ((r -= T_BR) < T_OUT) {
        const int nt = r >> 4, kt = r & 15;
        src = p.w_out + (size_t)l * 1024 * 1024; ldsrc = 1024; k0 = kt * 64; n0 = nt * 32;
        dst = (u16*)(p.ws + O_WOUT) + (size_t)l * 1024 * 1024; lddst = 1024; drow = n0;
      } else {
        r -= T_OUT;
        const int b = r >> 6, r2 = r & 63;
        const int nt = r2 >> 2, kt = r2 & 3;
        src = p.cache_na_v + (size_t)(b * 2 + l) * 256 * 512; ldsrc = 512; k0 = kt * 64; n0 = nt * 32;
        dst = (u16*)(p.ws + O_VTC) + (size_t)(l * 8 + b) * 512 * 256; lddst = 256; drow = n0;
      }
      tconv_tile(src, ldsrc, k0, n0, dst, lddst, drow, (float*)smem);
    } else if (item < N_MOD + N_TC + N_SG) {
      const int it = item - N_MOD - N_TC;
      const size_t e = (size_t)it * 2048 + t * 8;
      const float4 a = *(const float4*)(p.sgu_w + e), b = *(const float4*)(p.sgu_w + e + 4);
      u16* d = (u16*)(p.ws + O_SGUW) + e;
      st4bf(d, a.x, a.y, a.z, a.w); st4bf(d + 4, b.x, b.y, b.z, b.w);
    } else {
      const int it = item - N_MOD - N_TC - N_SG;
      const size_t e = (size_t)it * 2048 + t * 8;
      const int l = (int)(e >> 20), b = (int)(e >> 17) & 7; const size_t rest = e & 131071;
      const float* s = p.cache_na_k + ((size_t)(b * 2 + l) << 17) + rest;
      const float4 a = *(const float4*)s, bb = *(const float4*)(s + 4);
      u16* d = (u16*)(p.ws + O_KC) + e;
      st4bf(d, a.x, a.y, a.z, a.w); st4bf(d + 4, bb.x, bb.y, bb.z, bb.w);
    }
  }
}

DEV const float* xrow_in(const Params& p, int l, int s, int tl) {
  if (l == 0) return (s == 0 ? p.x_prompt : p.x_sample) + (size_t)tl * 1024;
  return p.out + OUT_Y + (size_t)s * 8388608 + (size_t)tl * 1024;
}
DEV int cond_idx(int s, int tl) { return s == 0 ? 0 : 1 + (tl >> 10); }

DEV void phase_h(const Params& p, int l, int s) {
  const int lane = threadIdx.x & 63, wave = threadIdx.x >> 6;
  u16* H = (u16*)(p.ws + O_H);
  const float* MOD = (const float*)(p.ws + O_MOD);
  for (int item = blockIdx.x; item < 2048; item += gridDim.x) {
    const int tl = item * 4 + wave;
    const float* x = xrow_in(p, l, s, tl);
    const float* mod = MOD + (size_t)(l * 9 + cond_idx(s, tl)) * 3072;
    float4 v[4];
    float ss = 0.f;
#pragma unroll
    for (int i = 0; i < 4; i++) {
      v[i] = *(const float4*)(x + i * 256 + lane * 4);
      ss += v[i].x * v[i].x + v[i].y * v[i].y + v[i].z * v[i].z + v[i].w * v[i].w;
    }
    ss = wave_sum(ss);
    const float rstd = rsqrtf(ss * (1.f / 1024.f) + 1e-6f);
#pragma unroll
    for (int i = 0; i < 4; i++) {
      const int col = i * 256 + lane * 4;
      const float4 g = *(const float4*)(p.norm_g + l * 1024 + col);
      const float4 sh = *(const float4*)(mod + col);
      const float4 sc = *(const float4*)(mod + 1024 + col);
      st4bf(H + (size_t)tl * 1024 + col, v[i].x * rstd * g.x * (1.f + sc.x) + sh.x, v[i].y * rstd * g.y * (1.f + sc.y) + sh.y,
            v[i].z * rstd * g.z * (1.f + sc.z) + sh.z, v[i].w * rstd * g.w * (1.f + sc.w) + sh.w);
    }
  }
}

DEV void phase_in(const Params& p, int l, int s, char* smem) {
  const int xcd = blockIdx.x & 7, lb = blockIdx.x >> 3, nb = gridDim.x >> 3;
  const u16* H = (const u16*)(p.ws + O_H);
  const u16* W = (const u16*)(p.ws + O_WIN) + (size_t)l * 7936 * 1024;
  u16* QNA = (u16*)(p.ws + O_QNA); u16* KNA = (u16*)(p.ws + O_KNA); u16* VTNA = (u16*)(p.ws + O_VTNA);
  u16* ZA = (u16*)(p.ws + O_ZA); u16* ZB = (u16*)(p.ws + O_ZB); u16* ZC = (u16*)(p.ws + O_ZC);
  u16* GU = (u16*)(p.ws + O_GU); u16* GVT = (u16*)(p.ws + O_GVT);
  u16* DQ = (u16*)(p.ws + O_DQ); u16* DKV = (u16*)(p.ws + O_DKV); float* KRF = (float*)(p.ws + O_KRF);
  u16* GATES = (u16*)(p.ws + O_GATES);
  float* out = p.out;
  for (int li = lb; li < 8 * 62; li += nb) {
    int m, n;
    tile_map(li, 8, xcd, m, n);
    const int m0 = m * 128, n0 = n * 128;
    const bool swapped = (n >= 8 && n < 12) || (n >= 20 && n < 24);
    const u16* Hm = H + (size_t)m0 * 1024;
    const u16* Wn = W + (size_t)n0 * 1024;
    f32x16 acc[2][2];
    acc_zero(acc);
    gemm_mainloop(swapped ? Wn : Hm, 1024, swapped ? Hm : Wn, 1024, 1024, smem, acc);
    if (n < 4) {
      epi_foreach(acc, [&](int i, int j, float v0, float v1, float v2, float v3) {
        st4bf(QNA + (size_t)(m0 + i) * 512 + n0 + j, v0, v1, v2, v3);
      });
    } else if (n < 8) {
      epi_foreach(acc, [&](int i, int j, float v0, float v1, float v2, float v3) {
        const int T = m0 + i, col = n0 - 512 + j;
        st4bf(KNA + (size_t)T * 512 + col, v0, v1, v2, v3);
        if (s == 0) {
          const int b = T >> 8, sq = T & 255;
          *(float4*)(out + OUT_SK + ((size_t)(b * 2 + l) * 256 + sq) * 512 + col) = make_float4(v0, v1, v2, v3);
        }
      });
    } else if (n < 12) {
      epi_foreach(acc, [&](int i, int j, float v0, float v1, float v2, float v3) {
        const int dva = n0 - 1024 + i, tok = m0 + j;
        if (s == 0) {
          const int b = tok >> 8, sq = tok & 255;
          st4bf(VTNA + ((size_t)(b * 512 + dva)) * 256 + sq, v0, v1, v2, v3);
          float* o = out + OUT_SV + ((size_t)(b * 2 + l) * 256 + sq) * 512 + dva;
          o[0] = v0; o[512] = v1; o[1024] = v2; o[1536] = v3;
        } else {
          const int b = tok >> 10, nn = tok & 1023;
          st4bf(VTNA + ((size_t)(b * 512 + dva)) * 1024 + nn, v0, v1, v2, v3);
        }
      });
    } else if (n < 16) {
      epi_foreach(acc, [&](int i, int j, float v0, float v1, float v2, float v3) {
        st4bf(ZA + (size_t)(m0 + i) * 512 + n0 - 1536 + j, silu_f(v0), silu_f(v1), silu_f(v2), silu_f(v3));
      });
    } else if (n < 20) {
      epi_foreach(acc, [&](int i, int j, float v0, float v1, float v2, float v3) {
        st4bf(GU + (size_t)(m0 + i) * 512 + n0 - 2048 + j, gelu_f(v0), gelu_f(v1), gelu_f(v2), gelu_f(v3));
      });
    } else if (n < 24) {
      epi_foreach(acc, [&](int i, int j, float v0, float v1, float v2, float v3) {
        const int c = n0 - 2560 + i, tok = m0 + j;
        const int chunk = tok >> 7, q = tok & 127;
        st4bf(GVT + ((size_t)chunk * 512 + c) * 128 + q, gelu_f(v0), gelu_f(v1), gelu_f(v2), gelu_f(v3));
      });
    } else if (n < 28) {
      epi_foreach(acc, [&](int i, int j, float v0, float v1, float v2, float v3) {
        st4bf(ZB + (size_t)(m0 + i) * 512 + n0 - 3072 + j, silu_f(v0), silu_f(v1), silu_f(v2), silu_f(v3));
      });
    } else if (n < 31) {
      epi_foreach(acc, [&](int i, int j, float v0, float v1, float v2, float v3) {
        st4bf(DQ + (size_t)(m0 + i) * 384 + n0 - 3584 + j, v0, v1, v2, v3);
      });
    } else if (n < 33) {
      epi_foreach(acc, [&](int i, int j, float v0, float v1, float v2, float v3) {
        st4bf(DKV + (size_t)(m0 + i) * 256 + n0 - 3968 + j, v0, v1, v2, v3);
      });
    } else if (n < 37) {
      epi_foreach(acc, [&](int i, int j, float v0, float v1, float v2, float v3) {
        st4bf(ZC + (size_t)(m0 + i) * 512 + n0 - 4224 + j, silu_f(v0), silu_f(v1), silu_f(v2), silu_f(v3));
      });
    } else if (n < 61) {
      epi_foreach(acc, [&](int i, int j, float v0, float v1, float v2, float v3) {
        st4bf(GATES + (size_t)(m0 + i) * 3072 + n0 - 4736 + j, sigmoid_f(v0), sigmoid_f(v1), sigmoid_f(v2), sigmoid_f(v3));
      });
    } else {
      epi_foreach(acc, [&](int i, int j, float v0, float v1, float v2, float v3) {
        if (j < 32) {
          const int T = m0 + i;
          *(float4*)(KRF + (size_t)T * 32 + j) = make_float4(v0, v1, v2, v3);
          if (s == 0) {
            const int b = T >> 8, sq = T & 255;
            *(float4*)(out + OUT_SKR + ((size_t)(b * 2 + l) * 256 + sq) * 32 + j) = make_float4(v0, v1, v2, v3);
          }
        }
      });
    }
  }
}

DEV void phase_rows(const Params& p, int l, int s, char* smem) {
  const int t = threadIdx.x, lane = t & 63, wave = t >> 6;
  u16* DQ = (u16*)(p.ws + O_DQ); const u16* DKV = (const u16*)(p.ws + O_DKV); const float* KRF = (const float*)(p.ws + O_KRF);
  u16* CKV = (u16*)(p.ws + O_CKV); u16* KR = (u16*)(p.ws + O_KR); u16* GVT = (u16*)(p.ws + O_GVT);
  const int n_row = 2048, n_ln = 64, n_cache = (s == 1) ? 512 : 0;
  const int total = n_row + n_ln + n_cache;
  for (int item = blockIdx.x; item < total; item += gridDim.x) {
    if (item < n_row) {
      const int tl = item * 4 + wave;
      {
        u16* r = DQ + (size_t)tl * 384;
        float v[6]; float ss = 0.f;
#pragma unroll
        for (int i = 0; i < 6; i++) { v[i] = bf2f(r[i * 64 + lane]); ss += v[i] * v[i]; }
        ss = wave_sum(ss);
        const float rstd = rsqrtf(ss * (1.f / 384.f) + 1e-6f);
#pragma unroll
        for (int i = 0; i < 6; i++) r[i * 64 + lane] = f2bf(v[i] * rstd * p.q_norm[l * 384 + i * 64 + lane]);
      }
      {
        float a, b, c, d;
        ld4bf(DKV + (size_t)tl * 256 + lane * 4, a, b, c, d);
        float ss = wave_sum(a * a + b * b + c * c + d * d);
        const float rstd = rsqrtf(ss * (1.f / 256.f) + 1e-6f);
        const float4 g = *(const float4*)(p.kv_norm + l * 256 + lane * 4);
        a *= rstd * g.x; b *= rstd * g.y; c *= rstd * g.z; d *= rstd * g.w;
        const int row = (s == 0) ? tl : ((tl >> 10) * 1280 + 256 + (tl & 1023));
        st4bf(CKV + (size_t)row * 256 + lane * 4, a, b, c, d);
        if (s == 0) {
          const int bb = tl >> 8, sq = tl & 255;
          *(float4*)(p.out + OUT_CKV + ((size_t)(bb * 2 + l) * 256 + sq) * 256 + lane * 4) = make_float4(a, b, c, d);
        }
      }
      if (lane < 16) {
        const float x1 = KRF[(size_t)tl * 32 + lane], x2 = KRF[(size_t)tl * 32 + 16 + lane];
        if (s == 0) {
          KR[(size_t)tl * 32 + lane] = f2bf(x1);
          KR[(size_t)tl * 32 + 16 + lane] = f2bf(x2);
        } else {
          const int nn = tl & 1023;
          const float pos = (lane < 8) ? (float)(nn >> 6) : (float)(nn & 63);
          const float inv = powf(10000.f, -(float)(lane & 7) * 0.125f);
          const float ang = pos * inv;
          const float cs = cosf(ang), sn = sinf(ang);
          const int row = (tl >> 10) * 1280 + 256 + nn;
          KR[(size_t)row * 32 + lane] = f2bf(x1 * cs - x2 * sn);
          KR[(size_t)row * 32 + 16 + lane] = f2bf(x1 * sn + x2 * cs);
        }
      }
    } else if (item < n_row + n_ln) {
      const int chunk = item - n_row;
      u16* g = GVT + (size_t)chunk * 512 * 128;
      const int q = t & 127, half = t >> 7;
      float sum = 0.f, sq = 0.f;
      for (int c = half * 256; c < half * 256 + 256; c++) { const float v = bf2f(g[c * 128 + q]); sum += v; sq += v * v; }
      float* red = (float*)smem;
      red[(half * 2 + 0) * 128 + q] = sum; red[(half * 2 + 1) * 128 + q] = sq;
      __syncthreads();
      sum = red[q] + red[256 + q]; sq = red[128 + q] + red[384 + q];
      const float mu = sum * (1.f / 512.f);
      const float var = fmaxf(sq * (1.f / 512.f) - mu * mu, 0.f);
      const float rstd = rsqrtf(var + 1e-6f);
      for (int c = half * 256; c < half * 256 + 256; c++) { const float v = bf2f(g[c * 128 + q]); g[c * 128 + q] = f2bf((v - mu) * rstd); }
      __syncthreads();
    } else {
      const int rowi = (item - n_row - n_ln) * 4 + wave;
      const int b = rowi >> 8, m = rowi & 255;
      const float4 a = *(const float4*)(p.cache_ckv + ((size_t)(b * 2 + l) * 256 + m) * 256 + lane * 4);
      st4bf(CKV + (size_t)(b * 1280 + m) * 256 + lane * 4, a.x, a.y, a.z, a.w);
      if (lane < 32) KR[(size_t)(b * 1280 + m) * 32 + lane] = f2bf(p.cache_kr[((size_t)(b * 2 + l) * 256 + m) * 32 + lane]);
    }
  }
}

DEV void attn_upd(float sc, const u16* vt, int vs, float (&o)[64], float& mx, float& ls) {
  const float mn = fmaxf(mx, sc);
  const float al = __expf(mx - mn), pe = __expf(sc - mn);
  mx = mn; ls = ls * al + pe;
#pragma unroll
  for (int d = 0; d < 64; d++) o[d] = o[d] * al + pe * bf2f(vt[(size_t)d * vs]);
}
template <int N>
DEV void loadq(const u16* qp, float (&q)[N], float scale) {
#pragma unroll
  for (int d = 0; d < N; d += 4) { ld4bf(qp + d, q[d], q[d + 1], q[d + 2], q[d + 3]); q[d] *= scale; q[d + 1] *= scale; q[d + 2] *= scale; q[d + 3] *= scale; }
}
template <int N>
DEV float dotq(const float (&q)[N], const u16* kp) {
  float s = 0.f;
#pragma unroll
  for (int d = 0; d < N; d += 8) {
    const uint4 kk = *(const uint4*)(kp + d);
    s += q[d] * __uint_as_float(kk.x << 16) + q[d + 1] * __uint_as_float(kk.x & 0xffff0000u) + q[d + 2] * __uint_as_float(kk.y << 16) +
         q[d + 3] * __uint_as_float(kk.y & 0xffff0000u) + q[d + 4] * __uint_as_float(kk.z << 16) + q[d + 5] * __uint_as_float(kk.z & 0xffff0000u) +
         q[d + 6] * __uint_as_float(kk.w << 16) + q[d + 7] * __uint_as_float(kk.w & 0xffff0000u);
  }
  return s;
}
DEV void attn_store(const float (&o)[64], float ls, u16* z) {
  const float inv = 1.f / ls;
#pragma unroll
  for (int d = 0; d < 64; d += 4) {
    float a, b, c, e;
    ld4bf(z + d, a, b, c, e);
    st4bf(z + d, o[d] * inv * a, o[d + 1] * inv * b, o[d + 2] * inv * c, o[d + 3] * inv * e);
  }
}

DEV void na_ctx_item(const Params& p, int it) {
  const int b = it >> 3, h = it & 7, t = threadIdx.x;
  const u16* QNA = (const u16*)(p.ws + O_QNA); const u16* KNA = (const u16*)(p.ws + O_KNA); const u16* VTNA = (const u16*)(p.ws + O_VTNA);
  u16* ZA = (u16*)(p.ws + O_ZA);
  const int tl = b * 256 + t;
  float q[64], o[64];
  loadq<64>(QNA + (size_t)tl * 512 + h * 64, q, 0.125f);
#pragma unroll
  for (int d = 0; d < 64; d++) o[d] = 0.f;
  float mx = -1e30f, ls = 0.f;
  for (int m = 0; m < 256; m++) {
    const float sc = dotq<64>(q, KNA + (size_t)(b * 256 + m) * 512 + h * 64);
    attn_upd(sc, VTNA + (size_t)(b * 512 + h * 64) * 256 + m, 256, o, mx, ls);
  }
  attn_store(o, ls, ZA + (size_t)tl * 512 + h * 64);
}

DEV void na_lat_item(const Params& p, int l, int it) {
  const int quarter = it & 3, h = (it >> 2) & 7, b = it >> 5, t = threadIdx.x;
  const u16* QNA = (const u16*)(p.ws + O_QNA); const u16* KNA = (const u16*)(p.ws + O_KNA); const u16* VTNA = (const u16*)(p.ws + O_VTNA);
  const u16* KC = (const u16*)(p.ws + O_KC); const u16* VTC = (const u16*)(p.ws + O_VTC);
  u16* ZA = (u16*)(p.ws + O_ZA);
  const int nn = quarter * 256 + t, tl = b * 1024 + nn;
  const int r = nn >> 6, qc = nn & 63;
  const int wr0 = min(max(r - 4, 0), 8), wlo = min(max(qc - 8, 0), 48);
  float q[64], o[64];
  loadq<64>(QNA + (size_t)tl * 512 + h * 64, q, 0.125f);
#pragma unroll
  for (int d = 0; d < 64; d++) o[d] = 0.f;
  float mx = -1e30f, ls = 0.f;
  for (int wr = 0; wr < 8; wr++) {
    const int krow = wr0 + wr;
    const float* bias = p.na_rpb + ((size_t)(l * 8 + h) * 15 + (krow - r + 7)) * 31 + (15 - qc);
    for (int kc = wlo; kc < wlo + 16; kc++) {
      const int n2 = krow * 64 + kc;
      const float sc = dotq<64>(q, KNA + (size_t)(b * 1024 + n2) * 512 + h * 64) + bias[kc];
      attn_upd(sc, VTNA + (size_t)(b * 512 + h * 64) * 1024 + n2, 1024, o, mx, ls);
    }
  }
  for (int m = 0; m < 256; m++) {
    const float sc = dotq<64>(q, KC + ((size_t)(l * 8 + b) * 256 + m) * 512 + h * 64);
    attn_upd(sc, VTC + ((size_t)(l * 8 + b) * 512 + h * 64) * 256 + m, 256, o, mx, ls);
  }
  attn_store(o, ls, ZA + (size_t)tl * 512 + h * 64);
}

DEV void mla_item(const Params& p, int s, int it) {
  const int t = threadIdx.x;
  const u16* QM = (const u16*)(p.ws + O_H); const u16* KNOPE = (const u16*)(p.ws + O_KNOPE); const u16* KR = (const u16*)(p.ws + O_KR);
  const u16* VTM = (const u16*)(p.ws + O_VTM);
  u16* ZC = (u16*)(p.ws + O_ZC);
  int b, h, tl, S, nn = 0;
  if (s == 0) { b = it >> 3; h = it & 7; tl = b * 256 + t; S = 256; }
  else { const int quarter = it & 3; h = (it >> 2) & 7; b = it >> 5; nn = quarter * 256 + t; tl = b * 1024 + nn; S = 1280; }
  const float scale = 0.10206207261596575f;
  float qn[64], qr[32], o[64];
  loadq<64>(QM + (size_t)tl * 768 + h * 96, qn, scale);
  loadq<32>(QM + (size_t)tl * 768 + h * 96 + 64, qr, scale);
  if (s == 1) {
    const float row = (float)(nn >> 6), col = (float)(nn & 63);
#pragma unroll
    for (int jj = 0; jj < 16; jj++) {
      const float inv = powf(10000.f, -(float)(jj & 7) * 0.125f);
      const float ang = ((jj < 8) ? row : col) * inv;
      const float cs = cosf(ang), sn = sinf(ang);
      const float x1 = qr[jj], x2 = qr[16 + jj];
      qr[jj] = x1 * cs - x2 * sn; qr[16 + jj] = x1 * sn + x2 * cs;
    }
  }
#pragma unroll
  for (int d = 0; d < 64; d++) o[d] = 0.f;
  float mx = -1e30f, ls = 0.f;
  for (int m = 0; m < S; m++) {
    const size_t krow = (size_t)b * S + m;
    const float sc = dotq<64>(qn, KNOPE + krow * 512 + h * 64) + dotq<32>(qr, KR + krow * 32);
    attn_upd(sc, VTM + ((size_t)b * 512 + h * 64) * S + m, S, o, mx, ls);
  }
  attn_store(o, ls, ZC + (size_t)tl * 512 + h * 64);
}

DEV void phase_mix(const Params& p, int l, int s, char* smem) {
  const int n_att = 256;
  const int n_sgu = 256, n_q = 384, n_kv = (s == 0) ? 512 : 640;
  const int total = n_att + n_sgu + n_q + n_kv;
  for (int item = blockIdx.x; item < total; item += gridDim.x) {
    if (item < n_att) {
      if (s == 0) na_ctx_item(p, item); else na_lat_item(p, l, item);
    } else if (item < n_att + n_sgu) {
      const int it = item - n_att, chunk = it >> 2, g = it & 3;
      const u16* Wg = (const u16*)(p.ws + O_SGUW) + (size_t)(l * 4 + g) * 128 * 128;
      const u16* V = (const u16*)(p.ws + O_GVT) + ((size_t)chunk * 512 + g * 128) * 128;
      const u16* GU = (const u16*)(p.ws + O_GU); u16* ZB = (u16*)(p.ws + O_ZB);
      f32x16 acc[2][2];
      acc_zero(acc);
      gemm_mainloop(Wg, 128, V, 128, 128, smem, acc);
      epi_foreach(acc, [&](int i, int j, float v0, float v1, float v2, float v3) {
        const float bs = p.sgu_b[(l * 4 + g) * 128 + i];
        const size_t off = (size_t)(chunk * 128 + i) * 512 + g * 128 + j;
        float u0, u1, u2, u3, z0, z1, z2, z3;
        ld4bf(GU + off, u0, u1, u2, u3);
        ld4bf(ZB + off, z0, z1, z2, z3);
        st4bf(ZB + off, u0 * (v0 + bs) * z0, u1 * (v1 + bs) * z1, u2 * (v2 + bs) * z2, u3 * (v3 + bs) * z3);
      });
    } else if (item < n_att + n_sgu + n_q) {
      const int it = item - n_att - n_sgu, m = it / 6, n = it % 6;
      const u16* DQ = (const u16*)(p.ws + O_DQ) + (size_t)m * 128 * 384;
      const u16* W = (const u16*)(p.ws + O_WUQ) + (size_t)l * 768 * 384 + (size_t)n * 128 * 384;
      u16* QM = (u16*)(p.ws + O_H);
      f32x16 acc[2][2];
      acc_zero(acc);
      gemm_mainloop(DQ, 384, W, 384, 384, smem, acc);
      epi_foreach(acc, [&](int i, int j, float v0, float v1, float v2, float v3) {
        st4bf(QM + (size_t)(m * 128 + i) * 768 + n * 128 + j, v0, v1, v2, v3);
      });
    } else {
      const int it = item - n_att - n_sgu - n_q, m = it >> 3, n = it & 7;
      const u16* C = (const u16*)(p.ws + O_CKV) + (size_t)m * 128 * 256;
      const u16* W = (const u16*)(p.ws + O_WUKV) + (size_t)l * 1024 * 256 + (size_t)n * 128 * 256;
      const bool swapped = n >= 4;
      f32x16 acc[2][2];
      acc_zero(acc);
      gemm_mainloop(swapped ? W : C, 256, swapped ? C : W, 256, 256, smem, acc);
      if (!swapped) {
        u16* KNOPE = (u16*)(p.ws + O_KNOPE);
        epi_foreach(acc, [&](int i, int j, float v0, float v1, float v2, float v3) {
          st4bf(KNOPE + (size_t)(m * 128 + i) * 512 + n * 128 + j, v0, v1, v2, v3);
        });
      } else {
        u16* VTM = (u16*)(p.ws + O_VTM);
        const int S = (s == 0) ? 256 : 1280;
        epi_foreach(acc, [&](int i, int j, float v0, float v1, float v2, float v3) {
          const int ch = (n - 4) * 128 + i, row = m * 128 + j;
          const int b = row / S, mm = row % S;
          st4bf(VTM + ((size_t)b * 512 + ch) * S + mm, v0, v1, v2, v3);
        });
      }
    }
  }
}

DEV void phase_mla(const Params& p, int l, int s) {
  for (int item = blockIdx.x; item < 256; item += gridDim.x) mla_item(p, s, item);
}

DEV void phase_merge(const Params& p, int l, int s, char* smem) {
  const int xcd = blockIdx.x & 7, lb = blockIdx.x >> 3, nb = gridDim.x >> 3;
  const u16* GATES = (const u16*)(p.ws + O_GATES);
  u16* MG = (u16*)(p.ws + O_H);
  for (int li = lb; li < 64; li += nb) {
    int m, n;
    tile_map(li, 8, xcd, m, n);
    f32x16 macc[2][2];
    acc_zero(macc);
#pragma unroll 1
    for (int k = 0; k < 3; k++) {
      const u16* A = (const u16*)(p.ws + (k == 0 ? O_ZA : (k == 1 ? O_ZB : O_ZC))) + (size_t)m * 128 * 512;
      const u16* W = (const u16*)(p.ws + O_WBR) + (size_t)(l * 3 + k) * 1024 * 512 + (size_t)n * 128 * 512;
      f32x16 acc[2][2];
      acc_zero(acc);
      gemm_mainloop(A, 512, W, 512, 512, smem, acc);
      const int lane = threadIdx.x & 63, w = threadIdx.x >> 6, wm = w >> 1, wn = w & 1;
#pragma unroll
      for (int a = 0; a < 2; a++)
#pragma unroll
        for (int b = 0; b < 2; b++)
#pragma unroll
          for (int rg = 0; rg < 4; rg++) {
            const int i = wm * 64 + a * 32 + (lane & 31);
            const int j = wn * 64 + b * 32 + rg * 8 + (lane >> 5) * 4;
            float g0, g1, g2, g3;
            ld4bf(GATES + (size_t)(m * 128 + i) * 3072 + k * 1024 + n * 128 + j, g0, g1, g2, g3);
            macc[a][b][rg * 4 + 0] += g0 * acc[a][b][rg * 4 + 0];
            macc[a][b][rg * 4 + 1] += g1 * acc[a][b][rg * 4 + 1];
            macc[a][b][rg * 4 + 2] += g2 * acc[a][b][rg * 4 + 2];
            macc[a][b][rg * 4 + 3] += g3 * acc[a][b][rg * 4 + 3];
          }
    }
    epi_foreach(macc, [&](int i, int j, float v0, float v1, float v2, float v3) {
      st4bf(MG + (size_t)(m * 128 + i) * 1024 + n * 128 + j, v0, v1, v2, v3);
    });
  }
}

DEV void phase_out(const Params& p, int l, int s, char* smem) {
  const int xcd = blockIdx.x & 7, lb = blockIdx.x >> 3, nb = gridDim.x >> 3;
  const u16* MG = (const u16*)(p.ws + O_H);
  const float* MOD = (const float*)(p.ws + O_MOD);
  for (int li = lb; li < 64; li += nb) {
    int m, n;
    tile_map(li, 8, xcd, m, n);
    f32x16 acc[2][2];
    acc_zero(acc);
    gemm_mainloop(MG + (size_t)m * 128 * 1024, 1024, (const u16*)(p.ws + O_WOUT) + (size_t)l * 1024 * 1024 + (size_t)n * 128 * 1024, 1024, 1024, smem, acc);
    epi_foreach(acc, [&](int i, int j, float v0, float v1, float v2, float v3) {
      const int tl = m * 128 + i, col = n * 128 + j;
      const float4 x = *(const float4*)(xrow_in(p, l, s, tl) + col);
      const float4 g = *(const float4*)(MOD + (size_t)(l * 9 + cond_idx(s, tl)) * 3072 + 2048 + col);
      *(float4*)(p.out + OUT_Y + (size_t)s * 8388608 + (size_t)tl * 1024 + col) =
          make_float4(x.x + g.x * v0, x.y + g.y * v1, x.z + g.z * v2, x.w + g.w * v3);
    });
  }
}

DEV void phase_final(const Params& p) {
  const int lane = threadIdx.x & 63, wave = threadIdx.x >> 6;
  for (int item = blockIdx.x; item < 4096; item += gridDim.x) {
    float* x = p.out + OUT_Y + (size_t)(item * 4 + wave) * 1024;
    float4 v[4];
    float ss = 0.f;
#pragma unroll
    for (int i = 0; i < 4; i++) {
      v[i] = *(const float4*)(x + i * 256 + lane * 4);
      ss += v[i].x * v[i].x + v[i].y * v[i].y + v[i].z * v[i].z + v[i].w * v[i].w;
    }
    ss = wave_sum(ss);
    const float rstd = rsqrtf(ss * (1.f / 1024.f) + 1e-6f);
#pragma unroll
    for (int i = 0; i < 4; i++) {
      const int col = i * 256 + lane * 4;
      const float4 g = *(const float4*)(p.final_g + col);
      *(float4*)(x + col) = make_float4(v[i].x * rstd * g.x, v[i].y * rstd * g.y, v[i].z * rstd * g.z, v[i].w * rstd * g.w);
    }
  }
}

DEV void run_phase(const Params& p, int ph, int l, int s, char* smem) {
  switch (ph) {
    case 0: phase_prep(p, smem); break;
    case 1: phase_h(p, l, s); break;
    case 2: phase_in(p, l, s, smem); break;
    case 3: phase_rows(p, l, s, smem); break;
    case 4: phase_mix(p, l, s, smem); break;
    case 5: phase_mla(p, l, s); break;
    case 6: phase_merge(p, l, s, smem); break;
    case 7: phase_out(p, l, s, smem); break;
    default: phase_final(p); break;
  }
}

__global__ void __launch_bounds__(256) phase_kernel(Params p, int ph, int l, int s) {
  __shared__ __attribute__((aligned(16))) char smem[65536];
  run_phase(p, ph, l, s, smem);
}

__global__ void __launch_bounds__(256) mega_kernel(Params p) {
  __shared__ __attribute__((aligned(16))) char smem[65536];
  cg::grid_group grid = cg::this_grid();
  phase_prep(p, smem);
  grid.sync();
  for (int l = 0; l < 2; l++)
    for (int s = 0; s < 2; s++) {
      for (int ph = 1; ph <= 7; ph++) {
        run_phase(p, ph, l, s, smem);
        grid.sync();
      }
    }
  phase_final(p);
}

extern "C" void kernel_launch(void* const* d_in, const int* in_sizes, int n_in, void* d_out, int out_size, void* d_ws, size_t ws_size,
                              hipStream_t stream) {
  Params p{};
  const float** pp = (const float**)&p;
  for (int i = 0; i < 22; i++) pp[i] = (const float*)d_in[i];
  p.out = (float*)d_out;
  p.ws = (char*)d_ws;
#if USE_COOP
  static int grid_blocks = 0;
  if (!grid_blocks) {
    int dev = 0, cus = 0, per_cu = 0;
    hipGetDevice(&dev);
    hipDeviceGetAttribute(&cus, hipDeviceAttributeMultiprocessorCount, dev);
    hipOccupancyMaxActiveBlocksPerMultiprocessor(&per_cu, mega_kernel, 256, 0);
    if (per_cu > 2) per_cu = 2;
    grid_blocks = cus * per_cu;
    grid_blocks &= ~7;
  }
  void* args[] = {&p};
  hipError_t e = hipLaunchCooperativeKernel((void*)mega_kernel, dim3(grid_blocks), dim3(256), args, 0, stream);
  if (e != hipSuccess) fprintf(stderr, "cooperative launch failed: %s (grid %d)\n", hipGetErrorString(e), grid_blocks);
#else
  const int G = 512;
  phase_kernel<<<G, 256, 0, stream>>>(p, 0, 0, 0);
  for (int l = 0; l < 2; l++)
    for (int s = 0; s < 2; s++)
      for (int ph = 1; ph <= 7; ph++) phase_kernel<<<G, 256, 0, stream>>>(p, ph, l, s);
  phase_kernel<<<G, 256, 0, stream>>>(p, 8, 0, 0);
#endif
}
```

```cpp
#include <hip/hip_runtime.h>
#include <hip/hip_cooperative_groups.h>
#include <cstdio>
namespace cg = cooperative_groups;

#ifndef USE_COOP
#define USE_COOP 1
#endif

typedef unsigned short u16;
typedef __attribute__((ext_vector_type(8))) __bf16 bf16x8;
typedef __attribute__((ext_vector_type(16))) float f32x16;
#define DEV __device__ __forceinline__
__device__ __forceinline__ int tid_opaque() { int t = threadIdx.x; asm volatile("" : "+v"(t)); return t; }
#define TIDX tid_

constexpr size_t A256(size_t x) { return (x + 255) & ~(size_t)255; }
constexpr size_t O_WIN = 0;
constexpr size_t O_WUQ = O_WIN + A256(2ull * 7936 * 1024 * 2);
constexpr size_t O_WUKV = O_WUQ + A256(2ull * 768 * 384 * 2);
constexpr size_t O_WBR = O_WUKV + A256(2ull * 1024 * 256 * 2);
constexpr size_t O_WOUT = O_WBR + A256(2ull * 3 * 1024 * 512 * 2);
constexpr size_t O_SGUW = O_WOUT + A256(2ull * 1024 * 1024 * 2);
constexpr size_t O_KC = O_SGUW + A256(2ull * 4 * 128 * 128 * 2);
constexpr size_t O_VTC = O_KC + A256(2ull * 8 * 256 * 512 * 2);
constexpr size_t O_MOD = O_VTC + A256(2ull * 8 * 256 * 512 * 2);
constexpr size_t O_H = O_MOD + A256(2ull * 9 * 3072 * 4);
constexpr size_t O_QNA = O_H + A256(8192ull * 1024 * 2);
constexpr size_t O_KNA = O_QNA + A256(8192ull * 512 * 2);
constexpr size_t O_VTNA = O_KNA + A256(8192ull * 512 * 2);
constexpr size_t O_ZA = O_VTNA + A256(8192ull * 512 * 2);
constexpr size_t O_ZB = O_ZA + A256(8192ull * 512 * 2);
constexpr size_t O_ZC = O_ZB + A256(8192ull * 512 * 2);
constexpr size_t O_GU = O_ZC + A256(8192ull * 512 * 2);
constexpr size_t O_GVT = O_GU + A256(8192ull * 512 * 2);
constexpr size_t O_DQ = O_GVT + A256(8192ull * 512 * 2);
constexpr size_t O_DKV = O_DQ + A256(8192ull * 384 * 2);
constexpr size_t O_KRF = O_DKV + A256(8192ull * 256 * 2);
constexpr size_t O_GATES = O_KRF + A256(8192ull * 32 * 4);
constexpr size_t O_CKV = O_GATES + A256(8192ull * 3072 * 2);
constexpr size_t O_KR = O_CKV + A256(10240ull * 256 * 2);
constexpr size_t O_KNOPE = O_KR + A256(10240ull * 32 * 2);
constexpr size_t O_VTM = O_KNOPE + A256(10240ull * 512 * 2);
constexpr size_t O_END = O_VTM + A256(10240ull * 512 * 2);
static_assert(O_END <= 256ull * 1024 * 1024, "workspace too large");

constexpr size_t OUT_Y = 0;
constexpr size_t OUT_SK = 16777216;
constexpr size_t OUT_SV = 25165824;
constexpr size_t OUT_CKV = 33554432;
constexpr size_t OUT_SKR = 37748736;

struct Params {
  const float *x_prompt, *x_sample, *cache_na_k, *cache_na_v, *cache_ckv, *cache_kr, *c, *c_ctx;
  const float *norm_g, *w_mod, *b_mod, *w_in, *na_rpb, *sgu_w, *sgu_b, *q_norm, *w_uq, *kv_norm, *w_ukv, *w_branch, *w_out, *final_g;
  float* out;
  char* ws;
};

DEV u16 f2bf(float f) { unsigned u = __float_as_uint(f); u += 0x7fffu + ((u >> 16) & 1u); return (u16)(u >> 16); }
DEV float bf2f(u16 h) { return __uint_as_float(((unsigned)h) << 16); }
typedef __attribute__((ext_vector_type(2))) __bf16 bf16x2;
DEV unsigned pack2(float a, float b) { bf16x2 v; v[0] = (__bf16)a; v[1] = (__bf16)b; return __builtin_bit_cast(unsigned, v); }
DEV void st4bf(u16* p, float a, float b, float c, float d) { uint2 v; v.x = pack2(a, b); v.y = pack2(c, d); *(uint2*)p = v; }
DEV void ld4bf(const u16* p, float& a, float& b, float& c, float& d) {
  uint2 v = *(const uint2*)p;
  a = __uint_as_float(v.x << 16); b = __uint_as_float(v.x & 0xffff0000u);
  c = __uint_as_float(v.y << 16); d = __uint_as_float(v.y & 0xffff0000u);
}
DEV float wave_sum(float v) {
#pragma unroll
  for (int o = 32; o > 0; o >>= 1) v += __shfl_xor(v, o);
  return v;
}
DEV float sigmoid_f(float x) { return 1.f / (1.f + __expf(-x)); }
DEV float silu_f(float x) { return x / (1.f + __expf(-x)); }
DEV float gelu_f(float x) { float u = 0.7978845608028654f * (x + 0.044715f * x * x * x); return x / (1.f + __expf(-2.f * u)); }

DEV void gemm_mainloop(const u16* P, int ldp, const u16* Q, int ldq, int K, char* smem, f32x16 (&acc)[2][2], const int tid_) {
  const int t = TIDX, lane = t & 63, w = t >> 6, wm = w >> 1, wn = w & 1;
  const int lr = t >> 3, ch = t & 7;
  const u16* pg = P + (size_t)lr * ldp + ch * 8;
  const u16* qg = Q + (size_t)lr * ldq + ch * 8;
  const size_t sp = (size_t)32 * ldp, sq = (size_t)32 * ldq;
  const int soff = lr * 128 + ((ch ^ ((t >> 4) & 7)) << 4);
  const int sw = (lane >> 1) & 7;
  const int prow = (wm * 64 + (lane & 31)) * 128;
  const int qrow = (wn * 64 + (lane & 31)) * 128;
  uint4 p0, p1, p2, p3, q0, q1, q2, q3;
#define GLOAD(k0) do { p0 = *(const uint4*)(pg + (k0)); p1 = *(const uint4*)(pg + sp + (k0)); p2 = *(const uint4*)(pg + 2 * sp + (k0)); p3 = *(const uint4*)(pg + 3 * sp + (k0)); \
                       q0 = *(const uint4*)(qg + (k0)); q1 = *(const uint4*)(qg + sq + (k0)); q2 = *(const uint4*)(qg + 2 * sq + (k0)); q3 = *(const uint4*)(qg + 3 * sq + (k0)); } while (0)
#define SWRITE(base) do { char* b_ = (base) + soff; *(uint4*)(b_) = p0; *(uint4*)(b_ + 4096) = p1; *(uint4*)(b_ + 8192) = p2; *(uint4*)(b_ + 12288) = p3; \
                          *(uint4*)(b_ + 16384) = q0; *(uint4*)(b_ + 20480) = q1; *(uint4*)(b_ + 24576) = q2; *(uint4*)(b_ + 28672) = q3; } while (0)
  GLOAD(0);
  SWRITE(smem);
  __syncthreads();
  const int nk = K >> 6;
  for (int kt = 0; kt < nk; kt++) {
    const int k0 = min(kt + 1, nk - 1) << 6;
    GLOAD(k0);
    asm volatile("" ::: "memory"); __builtin_amdgcn_sched_barrier(0);
    const char* bP = smem + (kt & 1) * 32768;
    const char* bQ = bP + 16384;
#pragma unroll
    for (int s = 0; s < 4; s++) {
      const int co = ((s * 2 + (lane >> 5)) ^ sw) << 4;
      const bf16x8 pf0 = *(const bf16x8*)(bP + prow + co), pf1 = *(const bf16x8*)(bP + prow + 4096 + co);
      const bf16x8 qf0 = *(const bf16x8*)(bQ + qrow + co), qf1 = *(const bf16x8*)(bQ + qrow + 4096 + co);
      acc[0][0] = __builtin_amdgcn_mfma_f32_32x32x16_bf16(qf0, pf0, acc[0][0], 0, 0, 0);
      acc[0][1] = __builtin_amdgcn_mfma_f32_32x32x16_bf16(qf1, pf0, acc[0][1], 0, 0, 0);
      acc[1][0] = __builtin_amdgcn_mfma_f32_32x32x16_bf16(qf0, pf1, acc[1][0], 0, 0, 0);
      acc[1][1] = __builtin_amdgcn_mfma_f32_32x32x16_bf16(qf1, pf1, acc[1][1], 0, 0, 0);
    }
    asm volatile("" ::: "memory"); __builtin_amdgcn_sched_barrier(0);
    SWRITE(smem + ((kt + 1) & 1) * 32768);
    __syncthreads();
  }
#undef GLOAD
#undef SWRITE
}

DEV void gemm_mainloop64(const u16* P, int ldp, const u16* Q, int ldq, int K, char* smem, f32x16 (&acc)[2], const int tid_) {
  const int t = TIDX, lane = t & 63, w = t >> 6, wm = w >> 1, wn = w & 1;
  const int lr = t >> 3, ch = t & 7;
  const u16* pg = P + (size_t)lr * ldp + ch * 8;
  const u16* qg = Q + (size_t)lr * ldq + ch * 8;
  const size_t sp = (size_t)32 * ldp, sq = (size_t)32 * ldq;
  const int soff = lr * 128 + ((ch ^ ((t >> 4) & 7)) << 4);
  const int sw = (lane >> 1) & 7;
  const int prow = (wm * 32 + (lane & 31)) * 128;
  const int qrow = (wn * 64 + (lane & 31)) * 128;
  uint4 p0, p1, q0, q1, q2, q3;
#define GLOAD(k0) do { p0 = *(const uint4*)(pg + (k0)); p1 = *(const uint4*)(pg + sp + (k0)); \
                       q0 = *(const uint4*)(qg + (k0)); q1 = *(const uint4*)(qg + sq + (k0)); q2 = *(const uint4*)(qg + 2 * sq + (k0)); q3 = *(const uint4*)(qg + 3 * sq + (k0)); } while (0)
#define SWRITE(base) do { char* b_ = (base) + soff; *(uint4*)(b_) = p0; *(uint4*)(b_ + 4096) = p1; \
                          *(uint4*)(b_ + 16384) = q0; *(uint4*)(b_ + 20480) = q1; *(uint4*)(b_ + 24576) = q2; *(uint4*)(b_ + 28672) = q3; } while (0)
  GLOAD(0);
  SWRITE(smem);
  __syncthreads();
  const int nk = K >> 6;
  for (int kt = 0; kt < nk; kt++) {
    const int k0 = min(kt + 1, nk - 1) << 6;
    GLOAD(k0);
    asm volatile("" ::: "memory"); __builtin_amdgcn_sched_barrier(0);
    const char* bP = smem + (kt & 1) * 32768;
    const char* bQ = bP + 16384;
#pragma unroll
    for (int s = 0; s < 4; s++) {
      const int co = ((s * 2 + (lane >> 5)) ^ sw) << 4;
      const bf16x8 pf0 = *(const bf16x8*)(bP + prow + co);
      const bf16x8 qf0 = *(const bf16x8*)(bQ + qrow + co), qf1 = *(const bf16x8*)(bQ + qrow + 4096 + co);
      acc[0] = __builtin_amdgcn_mfma_f32_32x32x16_bf16(qf0, pf0, acc[0], 0, 0, 0);
      acc[1] = __builtin_amdgcn_mfma_f32_32x32x16_bf16(qf1, pf0, acc[1], 0, 0, 0);
    }
    asm volatile("" ::: "memory"); __builtin_amdgcn_sched_barrier(0);
    SWRITE(smem + ((kt + 1) & 1) * 32768);
    __syncthreads();
  }
#undef GLOAD
#undef SWRITE
}

DEV void acc_zero(f32x16 (&acc)[2][2]) {
#pragma unroll
  for (int a = 0; a < 2; a++)
#pragma unroll
    for (int b = 0; b < 2; b++)
#pragma unroll
      for (int r = 0; r < 16; r++) acc[a][b][r] = 0.f;
}

template <class F>
DEV void epi_foreach(const f32x16 (&acc)[2][2], const int tid_, F f) {
  const int lane = TIDX & 63, w = TIDX >> 6, wm = w >> 1, wn = w & 1;
#pragma unroll
  for (int a = 0; a < 2; a++)
#pragma unroll
    for (int b = 0; b < 2; b++)
#pragma unroll
      for (int rg = 0; rg < 4; rg++) {
        const int i = wm * 64 + a * 32 + (lane & 31);
        const int j = wn * 64 + b * 32 + rg * 8 + (lane >> 5) * 4;
        f(i, j, acc[a][b][rg * 4 + 0], acc[a][b][rg * 4 + 1], acc[a][b][rg * 4 + 2], acc[a][b][rg * 4 + 3]);
      }
}

DEV void tile_map(int li, int MPX, int xcd, int& m, int& n) {
  const int g = MPX * 8;
  const int ng = li / g, wv = li % g;
  m = xcd * MPX + (wv % MPX);
  n = ng * 8 + (wv / MPX);
}

DEV void tconv_tile(const float* __restrict__ src, int ldsrc, int k0, int n0, u16* __restrict__ dst, int lddst, int drow0, float* tile, const int tid_) {
  const int t = TIDX;
  {
    const int n = t & 31, kk = t >> 5;
#pragma unroll
    for (int p = 0; p < 8; p++) {
      const int k = kk + p * 8;
      tile[k * 33 + n] = src[(size_t)(k0 + k) * ldsrc + n0 + n];
    }
  }
  __syncthreads();
  {
    const int k = t & 63, nn = t >> 6;
#pragma unroll
    for (int p = 0; p < 8; p++) {
      const int n2 = nn + p * 4;
      dst[(size_t)(drow0 + n2) * lddst + k0 + k] = f2bf(tile[k * 33 + n2]);
    }
  }
  __syncthreads();
}

DEV void phase_prep(const Params& p, char* smem, const int tid_) {
  const int t = TIDX;
  constexpr int N_MOD = 192;
  constexpr int T_IN = 3920, T_UQ = 144, T_UKV = 128, T_BR = 768, T_OUT = 512, T_CV = 512;
  constexpr int T_L = T_IN + T_UQ + T_UKV + T_BR + T_OUT + T_CV;
  constexpr int N_TC = 2 * T_L;
  constexpr int N_SG = 64, N_KC = 1024;
  constexpr int TOTAL = N_MOD + N_TC + N_SG + N_KC;
  float* MOD = (float*)(p.ws + O_MOD);
  for (int item = blockIdx.x; item < TOTAL; item += gridDim.x) {
    if (item < N_MOD) {
      const int l = item / 96, e0 = (item % 96) * 32;
      float* sc = (float*)smem;
      for (int idx = t; idx < 9216; idx += 256) {
        const int c9 = idx >> 10, d = idx & 1023;
        const float v = (c9 == 0) ? p.c_ctx[d] : p.c[(c9 - 1) * 1024 + d];
        sc[idx] = silu_f(v);
      }
      __syncthreads();
      const int col = t & 31, slab = t >> 5;
      float a[9];
#pragma unroll
      for (int c9 = 0; c9 < 9; c9++) a[c9] = 0.f;
      const float* wp = p.w_mod + ((size_t)l * 1024 + slab * 128) * 3072 + e0 + col;
#pragma unroll 4
      for (int dd = 0; dd < 128; dd++) {
        const float wv = wp[(size_t)dd * 3072];
        const int d = slab * 128 + dd;
#pragma unroll
        for (int c9 = 0; c9 < 9; c9++) a[c9] += sc[c9 * 1024 + d] * wv;
      }
      float* red = sc + 9216;
#pragma unroll
      for (int c9 = 0; c9 < 9; c9++) red[(slab * 9 + c9) * 32 + col] = a[c9];
      __syncthreads();
      for (int idx = t; idx < 288; idx += 256) {
        const int c9 = idx >> 5, cc = idx & 31;
        float sum = 0.f;
#pragma unroll
        for (int sl = 0; sl < 8; sl++) sum += red[(sl * 9 + c9) * 32 + cc];
        MOD[(l * 9 + c9) * 3072 + e0 + cc] = sum + p.b_mod[l * 3072 + e0 + cc];
      }
      __syncthreads();
    } else if (item < N_MOD + N_TC) {
      const int ti = item - N_MOD;
      const int l = ti / T_L;
      int r = ti % T_L;
      const float* src; u16* dst; int ldsrc, lddst, k0, n0, drow;
      if (r < T_IN) {
        const int nt = r >> 4, kt = r & 15;
        src = p.w_in + (size_t)l * 1024 * 7840; ldsrc = 7840; k0 = kt * 64; n0 = nt * 32;
        dst = (u16*)(p.ws + O_WIN) + (size_t)l * 7936 * 1024; lddst = 1024;
        drow = (n0 < 4224) ? n0 : (n0 == 4224 ? 7808 : n0 - 32);
      } else if ((r -= T_IN) < T_UQ) {
        const int nt = r / 6, kt = r % 6;
        src = p.w_uq + (size_t)l * 384 * 768; ldsrc = 768; k0 = kt * 64; n0 = nt * 32;
        dst = (u16*)(p.ws + O_WUQ) + (size_t)l * 768 * 384; lddst = 384; drow = n0;
      } else if ((r -= T_UQ) < T_UKV) {
        const int nt = r >> 2, kt = r & 3;
        src = p.w_ukv + (size_t)l * 256 * 1024; ldsrc = 1024; k0 = kt * 64; n0 = nt * 32;
        dst = (u16*)(p.ws + O_WUKV) + (size_t)l * 1024 * 256; lddst = 256;
        const int hh = n0 >> 7, jj = n0 & 127;
        drow = (jj < 64) ? (hh * 64 + jj) : (512 + hh * 64 + jj - 64);
      } else if ((r -= T_UKV) < T_BR) {
        const int kb = r >> 8, r2 = r & 255;
        const int nt = r2 >> 3, kt = r2 & 7;
        src = p.w_branch + (size_t)(l * 3 + kb) * 512 * 1024; ldsrc = 1024; k0 = kt * 64; n0 = nt * 32;
        dst = (u16*)(p.ws + O_WBR) + (size_t)(l * 3 + kb) * 1024 * 512; lddst = 512; drow = n0;
      } else if ((r -= T_BR) < T_OUT) {
        const int nt = r >> 4, kt = r & 15;
        src = p.w_out + (size_t)l * 1024 * 1024; ldsrc = 1024; k0 = kt * 64; n0 = nt * 32;
        dst = (u16*)(p.ws + O_WOUT) + (size_t)l * 1024 * 1024; lddst = 1024; drow = n0;
      } else {
        r -= T_OUT;
        const int b = r >> 6, r2 = r & 63;
        const int nt = r2 >> 2, kt = r2 & 3;
        src = p.cache_na_v + (size_t)(b * 2 + l) * 256 * 512; ldsrc = 512; k0 = kt * 64; n0 = nt * 32;
        dst = (u16*)(p.ws + O_VTC) + (size_t)(l * 8 + b) * 512 * 256; lddst = 256; drow = n0;
      }
      tconv_tile(src, ldsrc, k0, n0, dst, lddst, drow, (float*)smem, tid_);
    } else if (item < N_MOD + N_TC + N_SG) {
      const int it = item - N_MOD - N_TC;
      const size_t e = (size_t)it * 2048 + t * 8;
      const float4 a = *(const float4*)(p.sgu_w + e), b = *(const float4*)(p.sgu_w + e + 4);
      u16* d = (u16*)(p.ws + O_SGUW) + e;
      st4bf(d, a.x, a.y, a.z, a.w); st4bf(d + 4, b.x, b.y, b.z, b.w);
    } else {
      const int it = item - N_MOD - N_TC - N_SG;
      const size_t e = (size_t)it * 2048 + t * 8;
      const int l = (int)(e >> 20), b = (int)(e >> 17) & 7; const size_t rest = e & 131071;
      const float* s = p.cache_na_k + ((size_t)(b * 2 + l) << 17) + rest;
      const float4 a = *(const float4*)s, bb = *(const float4*)(s + 4);
      u16* d = (u16*)(p.ws + O_KC) + e;
      st4bf(d, a.x, a.y, a.z, a.w); st4bf(d + 4, bb.x, bb.y, bb.z, bb.w);
    }
  }
}

DEV const float* xrow_in(const Params& p, int l, int s, int tl) {
  if (l == 0) return (s == 0 ? p.x_prompt : p.x_sample) + (size_t)tl * 1024;
  return p.out + OUT_Y + (size_t)s * 8388608 + (size_t)tl * 1024;
}
DEV int cond_idx(int s, int tl) { return s == 0 ? 0 : 1 + (tl >> 10); }

DEV void phase_h(const Params& p, int l, int s, const int tid_) {
  const int lane = TIDX & 63, wave = TIDX >> 6;
  u16* H = (u16*)(p.ws + O_H);
  const float* MOD = (const float*)(p.ws + O_MOD);
  for (int item = blockIdx.x; item < 2048; item += gridDim.x) {
    const int tl = item * 4 + wave;
    const float* x = xrow_in(p, l, s, tl);
    const float* mod = MOD + (size_t)(l * 9 + cond_idx(s, tl)) * 3072;
    float4 v[4];
    float ss = 0.f;
#pragma unroll
    for (int i = 0; i < 4; i++) {
      v[i] = *(const float4*)(x + i * 256 + lane * 4);
      ss += v[i].x * v[i].x + v[i].y * v[i].y + v[i].z * v[i].z + v[i].w * v[i].w;
    }
    ss = wave_sum(ss);
    const float rstd = rsqrtf(ss * (1.f / 1024.f) + 1e-6f);
#pragma unroll
    for (int i = 0; i < 4; i++) {
      const int col = i * 256 + lane * 4;
      const float4 g = *(const float4*)(p.norm_g + l * 1024 + col);
      const float4 sh = *(const float4*)(mod + col);
      const float4 sc = *(const float4*)(mod + 1024 + col);
      st4bf(H + (size_t)tl * 1024 + col, v[i].x * rstd * g.x * (1.f + sc.x) + sh.x, v[i].y * rstd * g.y * (1.f + sc.y) + sh.y,
            v[i].z * rstd * g.z * (1.f + sc.z) + sh.z, v[i].w * rstd * g.w * (1.f + sc.w) + sh.w);
    }
  }
}

DEV void phase_in(const Params& p, int l, int s, char* smem, const int tid_) {
  const int xcd = blockIdx.x & 7, lb = blockIdx.x >> 3, nb = gridDim.x >> 3;
  const u16* H = (const u16*)(p.ws + O_H);
  const u16* W = (const u16*)(p.ws + O_WIN) + (size_t)l * 7936 * 1024;
  u16* QNA = (u16*)(p.ws + O_QNA); u16* KNA = (u16*)(p.ws + O_KNA); u16* VTNA = (u16*)(p.ws + O_VTNA);
  u16* ZA = (u16*)(p.ws + O_ZA); u16* ZB = (u16*)(p.ws + O_ZB); u16* ZC = (u16*)(p.ws + O_ZC);
  u16* GU = (u16*)(p.ws + O_GU); u16* GVT = (u16*)(p.ws + O_GVT);
  u16* DQ = (u16*)(p.ws + O_DQ); u16* DKV = (u16*)(p.ws + O_DKV); float* KRF = (float*)(p.ws + O_KRF);
  u16* GATES = (u16*)(p.ws + O_GATES);
  float* out = p.out;
  for (int li = lb; li < 8 * 62; li += nb) {
    int m, n;
    tile_map(li, 8, xcd, m, n);
    const int m0 = m * 128, n0 = n * 128;
    const bool swapped = (n >= 8 && n < 12) || (n >= 20 && n < 24);
    const u16* Hm = H + (size_t)m0 * 1024;
    const u16* Wn = W + (size_t)n0 * 1024;
    f32x16 acc[2][2];
    acc_zero(acc);
    gemm_mainloop(swapped ? Wn : Hm, 1024, swapped ? Hm : Wn, 1024, 1024, smem, acc, tid_);
    if (n < 4) {
      epi_foreach(acc, tid_, [&](int i, int j, float v0, float v1, float v2, float v3) {
        st4bf(QNA + (size_t)(m0 + i) * 512 + n0 + j, v0, v1, v2, v3);
      });
    } else if (n < 8) {
      epi_foreach(acc, tid_, [&](int i, int j, float v0, float v1, float v2, float v3) {
        const int T = m0 + i, col = n0 - 512 + j;
        st4bf(KNA + (size_t)T * 512 + col, v0, v1, v2, v3);
        if (s == 0) {
          const int b = T >> 8, sq = T & 255;
          *(float4*)(out + OUT_SK + ((size_t)(b * 2 + l) * 256 + sq) * 512 + col) = make_float4(v0, v1, v2, v3);
        }
      });
    } else if (n < 12) {
      epi_foreach(acc, tid_, [&](int i, int j, float v0, float v1, float v2, float v3) {
        const int dva = n0 - 1024 + i, tok = m0 + j;
        if (s == 0) {
          const int b = tok >> 8, sq = tok & 255;
          st4bf(VTNA + ((size_t)(b * 512 + dva)) * 256 + sq, v0, v1, v2, v3);
          float* o = out + OUT_SV + ((size_t)(b * 2 + l) * 256 + sq) * 512 + dva;
          o[0] = v0; o[512] = v1; o[1024] = v2; o[1536] = v3;
        } else {
          const int b = tok >> 10, nn = tok & 1023;
          st4bf(VTNA + ((size_t)(b * 512 + dva)) * 1024 + nn, v0, v1, v2, v3);
        }
      });
    } else if (n < 16) {
      epi_foreach(acc, tid_, [&](int i, int j, float v0, float v1, float v2, float v3) {
        st4bf(ZA + (size_t)(m0 + i) * 512 + n0 - 1536 + j, silu_f(v0), silu_f(v1), silu_f(v2), silu_f(v3));
      });
    } else if (n < 20) {
      epi_foreach(acc, tid_, [&](int i, int j, float v0, float v1, float v2, float v3) {
        st4bf(GU + (size_t)(m0 + i) * 512 + n0 - 2048 + j, gelu_f(v0), gelu_f(v1), gelu_f(v2), gelu_f(v3));
      });
    } else if (n < 24) {
      epi_foreach(acc, tid_, [&](int i, int j, float v0, float v1, float v2, float v3) {
        const int c = n0 - 2560 + i, tok = m0 + j;
        const int chunk = tok >> 7, q = tok & 127;
        st4bf(GVT + ((size_t)chunk * 512 + c) * 128 + q, gelu_f(v0), gelu_f(v1), gelu_f(v2), gelu_f(v3));
      });
    } else if (n < 28) {
      epi_foreach(acc, tid_, [&](int i, int j, float v0, float v1, float v2, float v3) {
        st4bf(ZB + (size_t)(m0 + i) * 512 + n0 - 3072 + j, silu_f(v0), silu_f(v1), silu_f(v2), silu_f(v3));
      });
    } else if (n < 31) {
      epi_foreach(acc, tid_, [&](int i, int j, float v0, float v1, float v2, float v3) {
        st4bf(DQ + (size_t)(m0 + i) * 384 + n0 - 3584 + j, v0, v1, v2, v3);
      });
    } else if (n < 33) {
      epi_foreach(acc, tid_, [&](int i, int j, float v0, float v1, float v2, float v3) {
        st4bf(DKV + (size_t)(m0 + i) * 256 + n0 - 3968 + j, v0, v1, v2, v3);
      });
    } else if (n < 37) {
      epi_foreach(acc, tid_, [&](int i, int j, float v0, float v1, float v2, float v3) {
        st4bf(ZC + (size_t)(m0 + i) * 512 + n0 - 4224 + j, silu_f(v0), silu_f(v1), silu_f(v2), silu_f(v3));
      });
    } else if (n < 61) {
      epi_foreach(acc, tid_, [&](int i, int j, float v0, float v1, float v2, float v3) {
        st4bf(GATES + (size_t)(m0 + i) * 3072 + n0 - 4736 + j, sigmoid_f(v0), sigmoid_f(v1), sigmoid_f(v2), sigmoid_f(v3));
      });
    } else {
      epi_foreach(acc, tid_, [&](int i, int j, float v0, float v1, float v2, float v3) {
        if (j < 32) {
          const int T = m0 + i;
          *(float4*)(KRF + (size_t)T * 32 + j) = make_float4(v0, v1, v2, v3);
          if (s == 0) {
            const int b = T >> 8, sq = T & 255;
            *(float4*)(out + OUT_SKR + ((size_t)(b * 2 + l) * 256 + sq) * 32 + j) = make_float4(v0, v1, v2, v3);
          }
        }
      });
    }
  }
}

DEV void phase_rows(const Params& p, int l, int s, char* smem, const int tid_) {
  const int t = TIDX, lane = t & 63, wave = t >> 6;
  u16* DQ = (u16*)(p.ws + O_DQ); const u16* DKV = (const u16*)(p.ws + O_DKV); const float* KRF = (const float*)(p.ws + O_KRF);
  u16* CKV = (u16*)(p.ws + O_CKV); u16* KR = (u16*)(p.ws + O_KR); u16* GVT = (u16*)(p.ws + O_GVT);
  const int n_row = 2048, n_ln = 64, n_cache = (s == 1) ? 512 : 0;
  const int total = n_row + n_ln + n_cache;
  for (int item = blockIdx.x; item < total; item += gridDim.x) {
    if (item < n_row) {
      const int tl = item * 4 + wave;
      {
        u16* r = DQ + (size_t)tl * 384;
        float v[6]; float ss = 0.f;
#pragma unroll
        for (int i = 0; i < 6; i++) { v[i] = bf2f(r[i * 64 + lane]); ss += v[i] * v[i]; }
        ss = wave_sum(ss);
        const float rstd = rsqrtf(ss * (1.f / 384.f) + 1e-6f);
#pragma unroll
        for (int i = 0; i < 6; i++) r[i * 64 + lane] = f2bf(v[i] * rstd * p.q_norm[l * 384 + i * 64 + lane]);
      }
      {
        float a, b, c, d;
        ld4bf(DKV + (size_t)tl * 256 + lane * 4, a, b, c, d);
        float ss = wave_sum(a * a + b * b + c * c + d * d);
        const float rstd = rsqrtf(ss * (1.f / 256.f) + 1e-6f);
        const float4 g = *(const float4*)(p.kv_norm + l * 256 + lane * 4);
        a *= rstd * g.x; b *= rstd * g.y; c *= rstd * g.z; d *= rstd * g.w;
        const int row = (s == 0) ? tl : ((tl >> 10) * 1280 + 256 + (tl & 1023));
        st4bf(CKV + (size_t)row * 256 + lane * 4, a, b, c, d);
        if (s == 0) {
          const int bb = tl >> 8, sq = tl & 255;
          *(float4*)(p.out + OUT_CKV + ((size_t)(bb * 2 + l) * 256 + sq) * 256 + lane * 4) = make_float4(a, b, c, d);
        }
      }
      if (lane < 16) {
        const float x1 = KRF[(size_t)tl * 32 + lane], x2 = KRF[(size_t)tl * 32 + 16 + lane];
        if (s == 0) {
          KR[(size_t)tl * 32 + lane] = f2bf(x1);
          KR[(size_t)tl * 32 + 16 + lane] = f2bf(x2);
        } else {
          const int nn = tl & 1023;
          const float pos = (lane < 8) ? (float)(nn >> 6) : (float)(nn & 63);
          const float inv = powf(10000.f, -(float)(lane & 7) * 0.125f);
          const float ang = pos * inv;
          const float cs = cosf(ang), sn = sinf(ang);
          const int row = (tl >> 10) * 1280 + 256 + nn;
          KR[(size_t)row * 32 + lane] = f2bf(x1 * cs - x2 * sn);
          KR[(size_t)row * 32 + 16 + lane] = f2bf(x1 * sn + x2 * cs);
        }
      }
    } else if (item < n_row + n_ln) {
      const int chunk = item - n_row;
      u16* g = GVT + (size_t)chunk * 512 * 128;
      const int q = t & 127, half = t >> 7;
      float sum = 0.f, sq = 0.f;
      for (int c = half * 256; c < half * 256 + 256; c++) { const float v = bf2f(g[c * 128 + q]); sum += v; sq += v * v; }
      float* red = (float*)smem;
      red[(half * 2 + 0) * 128 + q] = sum; red[(half * 2 + 1) * 128 + q] = sq;
      __syncthreads();
      sum = red[q] + red[256 + q]; sq = red[128 + q] + red[384 + q];
      const float mu = sum * (1.f / 512.f);
      const float var = fmaxf(sq * (1.f / 512.f) - mu * mu, 0.f);
      const float rstd = rsqrtf(var + 1e-6f);
      for (int c = half * 256; c < half * 256 + 256; c++) { const float v = bf2f(g[c * 128 + q]); g[c * 128 + q] = f2bf((v - mu) * rstd); }
      __syncthreads();
    } else {
      const int rowi = (item - n_row - n_ln) * 4 + wave;
      const int b = rowi >> 8, m = rowi & 255;
      const float4 a = *(const float4*)(p.cache_ckv + ((size_t)(b * 2 + l) * 256 + m) * 256 + lane * 4);
      st4bf(CKV + (size_t)(b * 1280 + m) * 256 + lane * 4, a.x, a.y, a.z, a.w);
      if (lane < 32) KR[(size_t)(b * 1280 + m) * 32 + lane] = f2bf(p.cache_kr[((size_t)(b * 2 + l) * 256 + m) * 32 + lane]);
    }
  }
}

typedef __attribute__((ext_vector_type(4))) float f32x4;
struct AttnSrc { const u16* k; const u16* kr; const u16* vt; int vts; };
struct AttnState { f32x4 o[4]; float mx, ls; };
constexpr int ATT_VST = 136;

struct AttnRegs { uint4 k0, k1, k2, v0, v1; };
template <int DQK>
DEV void attn_gload(const AttnSrc& src, AttnRegs& r, int t) {
  const int row = t >> 3, c8 = (t & 7) * 8;
  r.k0 = *(const uint4*)(src.k + (size_t)row * 512 + c8);
  r.k1 = *(const uint4*)(src.k + (size_t)(row + 32) * 512 + c8);
  r.v0 = *(const uint4*)(src.vt + (size_t)row * src.vts + c8);
  r.v1 = *(const uint4*)(src.vt + (size_t)(row + 32) * src.vts + c8);
  if (DQK == 96) r.k2 = *(const uint4*)(src.kr + (size_t)(t >> 2) * 32 + (t & 3) * 8);
}
template <int DQK>
DEV void attn_swrite(char* buf, const AttnRegs& r, int t) {
  constexpr int KST = DQK * 2 + 16;
  const int row = t >> 3, c16 = (t & 7) * 16;
  char* vb = buf + 64 * KST;
  *(uint4*)(buf + row * KST + c16) = make_uint4(r.k0.x, r.k0.y, r.k0.z, r.k0.w);
  *(uint4*)(buf + (row + 32) * KST + c16) = make_uint4(r.k1.x, r.k1.y, r.k1.z, r.k1.w);
  char* vp = vb + row * ATT_VST + c16;
  *(uint2*)vp = make_uint2(r.v0.x, r.v0.y);
  *(uint2*)(vp + 8) = make_uint2(r.v0.z, r.v0.w);
  vp += 32 * ATT_VST;
  *(uint2*)vp = make_uint2(r.v1.x, r.v1.y);
  *(uint2*)(vp + 8) = make_uint2(r.v1.z, r.v1.w);
  if (DQK == 96) *(uint4*)(buf + (t >> 2) * KST + 128 + (t & 3) * 16) = make_uint4(r.k2.x, r.k2.y, r.k2.z, r.k2.w);
}

template <int DQK, int NT, bool LOCAL>
DEV void attn_compute(const char* buf, const bf16x8 qf0, const bf16x8 qf1, const bf16x8 qf2, AttnState& st, float scale, int koff0, const float* biasrow, int qc, int wlo, const int tid_) {
  constexpr int KST = DQK * 2 + 16;
  const int lane = TIDX & 63, r16 = lane & 15, g = lane >> 4;
  const char* vb = buf + 64 * KST;
  f32x4 s[NT];
#pragma unroll
  for (int t = 0; t < NT; t++) {
    s[t] = f32x4{0.f, 0.f, 0.f, 0.f};
    const char* kp = buf + (koff0 + t * 16 + r16) * KST + g * 16;
    s[t] = __builtin_amdgcn_mfma_f32_16x16x32_bf16(*(const bf16x8*)(kp), qf0, s[t], 0, 0, 0);
    s[t] = __builtin_amdgcn_mfma_f32_16x16x32_bf16(*(const bf16x8*)(kp + 64), qf1, s[t], 0, 0, 0);
    if (DQK == 96) s[t] = __builtin_amdgcn_mfma_f32_16x16x32_bf16(*(const bf16x8*)(kp + 128), qf2, s[t], 0, 0, 0);
  }
  float mloc = st.mx;
#pragma unroll
  for (int t = 0; t < NT; t++)
#pragma unroll
    for (int e = 0; e < 4; e++) {
      float v = s[t][e] * scale;
      if (LOCAL) {
        const int kc = koff0 + t * 16 + 4 * g + e;
        const int bi = min(max(kc - qc + 15, 0), 30);
        const float bv = biasrow[bi];
        v = (kc >= wlo && kc < wlo + 16) ? v + bv : -1e30f;
      }
      s[t][e] = v;
      mloc = fmaxf(mloc, v);
    }
  mloc = fmaxf(mloc, __shfl_xor(mloc, 16));
  mloc = fmaxf(mloc, __shfl_xor(mloc, 32));
  const float alpha = __expf(st.mx - mloc);
  st.mx = mloc;
  float psum = 0.f;
#pragma unroll
  for (int t = 0; t < NT; t++)
#pragma unroll
    for (int e = 0; e < 4; e++) {
      const float pv = __expf(s[t][e] - mloc);
      s[t][e] = pv;
      psum += pv;
    }
  st.ls = st.ls * alpha + psum;
#pragma unroll
  for (int dt = 0; dt < 4; dt++) st.o[dt] *= alpha;
#pragma unroll
  for (int kb = 0; kb < NT / 2; kb++) {
    bf16x8 pf;
#pragma unroll
    for (int e = 0; e < 4; e++) { pf[e] = (__bf16)s[2 * kb][e]; pf[4 + e] = (__bf16)s[2 * kb + 1][e]; }
#pragma unroll
    for (int dt = 0; dt < 4; dt++) {
      const char* vp = vb + (dt * 16 + r16) * ATT_VST + (koff0 + 4 * g) * 2 + kb * 64;
      const uint2 a0 = *(const uint2*)vp, a1 = *(const uint2*)(vp + 32);
      const uint4 av = make_uint4(a0.x, a0.y, a1.x, a1.y);
      st.o[dt] = __builtin_amdgcn_mfma_f32_16x16x32_bf16(__builtin_bit_cast(bf16x8, av), pf, st.o[dt], 0, 0, 0);
    }
  }
}

template <int MODE>
DEV void attn_item(const Params& p, int l, int it, char* smem, const int tid_) {
  constexpr int DQK = (MODE >= 2) ? 96 : 64;
  constexpr int KST = DQK * 2 + 16;
  constexpr int BUFSZ = 64 * KST + 64 * ATT_VST;
  const int t = TIDX, lane = t & 63, w = t >> 6, r16 = lane & 15, g = lane >> 4;
  int b, h, tl0, nst, r = 0;
  if (MODE == 0 || MODE == 2) { b = it >> 5; h = (it >> 2) & 7; tl0 = b * 256 + (it & 3) * 64; nst = 4; }
  else { b = it >> 7; h = (it >> 4) & 7; r = it & 15; tl0 = b * 1024 + r * 64; nst = (MODE == 1) ? 12 : 20; }
  const int tl = tl0 + w * 16 + r16;
  const int wr0 = min(max(r - 4, 0), 8);
  const u16* KNA = (const u16*)(p.ws + O_KNA); const u16* VTNA = (const u16*)(p.ws + O_VTNA);
  const u16* KC = (const u16*)(p.ws + O_KC); const u16* VTC = (const u16*)(p.ws + O_VTC);
  const u16* KNOPE = (const u16*)(p.ws + O_KNOPE); const u16* KR = (const u16*)(p.ws + O_KR); const u16* VTM = (const u16*)(p.ws + O_VTM);
  auto get_src = [&](int st) {
    AttnSrc s;
    s.kr = nullptr;
    if (MODE == 0) {
      s.k = KNA + (size_t)(b * 256 + st * 64) * 512 + h * 64; s.vt = VTNA + (size_t)(b * 512 + h * 64) * 256 + st * 64; s.vts = 256;
    } else if (MODE == 1) {
      if (st < 8) {
        const int krow = wr0 + st;
        s.k = KNA + (size_t)(b * 1024 + krow * 64) * 512 + h * 64; s.vt = VTNA + (size_t)(b * 512 + h * 64) * 1024 + krow * 64; s.vts = 1024;
      } else {
        const int m0 = (st - 8) * 64;
        s.k = KC + ((size_t)(l * 8 + b) * 256 + m0) * 512 + h * 64; s.vt = VTC + ((size_t)(l * 8 + b) * 512 + h * 64) * 256 + m0; s.vts = 256;
      }
    } else if (MODE == 2) {
      s.k = KNOPE + (size_t)(b * 256 + st * 64) * 512 + h * 64; s.kr = KR + (size_t)(b * 256 + st * 64) * 32;
      s.vt = VTM + (size_t)(b * 512 + h * 64) * 256 + st * 64; s.vts = 256;
    } else {
      s.k = KNOPE + (size_t)(b * 1280 + st * 64) * 512 + h * 64; s.kr = KR + (size_t)(b * 1280 + st * 64) * 32;
      s.vt = VTM + (size_t)(b * 512 + h * 64) * 1280 + st * 64; s.vts = 1280;
    }
    return s;
  };
  bf16x8 qf0, qf1, qf2;
  if (MODE < 2) {
    const u16* qp = (const u16*)(p.ws + O_QNA) + (size_t)tl * 512 + h * 64 + 8 * g;
    qf0 = *(const bf16x8*)qp; qf1 = *(const bf16x8*)(qp + 32); qf2 = qf0;
  } else {
    const u16* qp = (const u16*)(p.ws + O_H) + (size_t)tl * 768 + h * 96;
    qf0 = *(const bf16x8*)(qp + 8 * g); qf1 = *(const bf16x8*)(qp + 32 + 8 * g);
    if (MODE == 2) {
      qf2 = *(const bf16x8*)(qp + 64 + 8 * g);
    } else {
      const uint4 own = *(const uint4*)(qp + 64 + 8 * g), oth = *(const uint4*)(qp + 64 + 8 * (g ^ 2));
      const unsigned ow[4] = {own.x, own.y, own.z, own.w}, ot[4] = {oth.x, oth.y, oth.z, oth.w};
      const int nn = tl & 1023;
      const float pos = (g & 1) ? (float)(nn & 63) : (float)(nn >> 6);
      bf16x8 qr;
#pragma unroll
      for (int e = 0; e < 8; e++) {
        const float a = __uint_as_float((e & 1) ? (ow[e >> 1] & 0xffff0000u) : (ow[e >> 1] << 16));
        const float c = __uint_as_float((e & 1) ? (ot[e >> 1] & 0xffff0000u) : (ot[e >> 1] << 16));
        const float inv = powf(10000.f, -(float)e * 0.125f);
        const float ang = pos * inv;
        const float cs = cosf(ang), sn = sinf(ang);
        const float v = (g < 2) ? (a * cs - c * sn) : (c * sn + a * cs);
        qr[e] = (__bf16)v;
      }
      qf2 = qr;
    }
  }
  float* biasl = (float*)(smem + 2 * BUFSZ);
  if (MODE == 1) {
    for (int i = t; i < 465; i += 256) biasl[i] = p.na_rpb[(size_t)(l * 8 + h) * 465 + i];
  }
  AttnState st;
#pragma unroll
  for (int dt = 0; dt < 4; dt++) st.o[dt] = f32x4{0.f, 0.f, 0.f, 0.f};
  st.mx = -1e30f; st.ls = 0.f;
  const float scale = (MODE >= 2) ? 0.10206207261596575f : 0.125f;
  const int qc = w * 16 + r16;
  const int wlo = min(max(qc - 8, 0), 48);
  const int wstart = min(max(16 * w - 8, 0), 32);
  AttnRegs rg;
  rg.k2 = make_uint4(0, 0, 0, 0);
  {
    const AttnSrc s0 = get_src(0);
    attn_gload<DQK>(s0, rg, t);
    attn_swrite<DQK>(smem, rg, t);
  }
  __syncthreads();
  for (int sidx = 0; sidx < nst; sidx++) {
    { const AttnSrc sn = get_src(min(sidx + 1, nst - 1)); attn_gload<DQK>(sn, rg, t); }
    asm volatile("" ::: "memory"); __builtin_amdgcn_sched_barrier(0);
    const char* buf = smem + (sidx & 1) * BUFSZ;
    if (MODE == 1 && sidx < 8) attn_compute<DQK, 2, true>(buf, qf0, qf1, qf2, st, scale, wstart, biasl + (wr0 + sidx - r + 7) * 31, qc, wlo, tid_);
    else attn_compute<DQK, 4, false>(buf, qf0, qf1, qf2, st, scale, 0, nullptr, 0, 0, tid_);
    asm volatile("" ::: "memory"); __builtin_amdgcn_sched_barrier(0);
    attn_swrite<DQK>(smem + ((sidx + 1) & 1) * BUFSZ, rg, t);
    __syncthreads();
  }
  float lt = st.ls;
  lt += __shfl_xor(lt, 16);
  lt += __shfl_xor(lt, 32);
  const float inv = 1.f / lt;
  u16* Z = (u16*)(p.ws + (MODE < 2 ? O_ZA : O_ZC)) + (size_t)tl * 512 + h * 64 + 4 * g;
#pragma unroll
  for (int dt = 0; dt < 4; dt++) {
    float a, bb, c, d;
    ld4bf(Z + dt * 16, a, bb, c, d);
    st4bf(Z + dt * 16, st.o[dt][0] * inv * a, st.o[dt][1] * inv * bb, st.o[dt][2] * inv * c, st.o[dt][3] * inv * d);
  }
}

DEV void phase_mix(const Params& p, int l, int s, char* smem, const int tid_) {
  const int n_att = 1024;
  const int n_sgu = 256, n_q = 384, n_kv = (s == 0) ? 512 : 640;
  const int total = n_att + n_sgu + n_q + n_kv;
  for (int item = blockIdx.x; item < total; item += gridDim.x) {
    if (item < n_att) {
      if (s == 0) attn_item<0>(p, l, item, smem, tid_); else attn_item<1>(p, l, item, smem, tid_);
    } else if (item < n_att + n_sgu) {
      const int it = item - n_att, chunk = it >> 2, g = it & 3;
      const u16* Wg = (const u16*)(p.ws + O_SGUW) + (size_t)(l * 4 + g) * 128 * 128;
      const u16* V = (const u16*)(p.ws + O_GVT) + ((size_t)chunk * 512 + g * 128) * 128;
      const u16* GU = (const u16*)(p.ws + O_GU); u16* ZB = (u16*)(p.ws + O_ZB);
      f32x16 acc[2][2];
      acc_zero(acc);
      gemm_mainloop(Wg, 128, V, 128, 128, smem, acc, tid_);
      epi_foreach(acc, tid_, [&](int i, int j, float v0, float v1, float v2, float v3) {
        const float bs = p.sgu_b[(l * 4 + g) * 128 + i];
        const size_t off = (size_t)(chunk * 128 + i) * 512 + g * 128 + j;
        float u0, u1, u2, u3, z0, z1, z2, z3;
        ld4bf(GU + off, u0, u1, u2, u3);
        ld4bf(ZB + off, z0, z1, z2, z3);
        st4bf(ZB + off, u0 * (v0 + bs) * z0, u1 * (v1 + bs) * z1, u2 * (v2 + bs) * z2, u3 * (v3 + bs) * z3);
      });
    } else if (item < n_att + n_sgu + n_q) {
      const int it = item - n_att - n_sgu, m = it / 6, n = it % 6;
      const u16* DQ = (const u16*)(p.ws + O_DQ) + (size_t)m * 128 * 384;
      const u16* W = (const u16*)(p.ws + O_WUQ) + (size_t)l * 768 * 384 + (size_t)n * 128 * 384;
      u16* QM = (u16*)(p.ws + O_H);
      f32x16 acc[2][2];
      acc_zero(acc);
      gemm_mainloop(DQ, 384, W, 384, 384, smem, acc, tid_);
      epi_foreach(acc, tid_, [&](int i, int j, float v0, float v1, float v2, float v3) {
        st4bf(QM + (size_t)(m * 128 + i) * 768 + n * 128 + j, v0, v1, v2, v3);
      });
    } else {
      const int it = item - n_att - n_sgu - n_q, m = it >> 3, n = it & 7;
      const u16* C = (const u16*)(p.ws + O_CKV) + (size_t)m * 128 * 256;
      const u16* W = (const u16*)(p.ws + O_WUKV) + (size_t)l * 1024 * 256 + (size_t)n * 128 * 256;
      const bool swapped = n >= 4;
      f32x16 acc[2][2];
      acc_zero(acc);
      gemm_mainloop(swapped ? W : C, 256, swapped ? C : W, 256, 256, smem, acc, tid_);
      if (!swapped) {
        u16* KNOPE = (u16*)(p.ws + O_KNOPE);
        epi_foreach(acc, tid_, [&](int i, int j, float v0, float v1, float v2, float v3) {
          st4bf(KNOPE + (size_t)(m * 128 + i) * 512 + n * 128 + j, v0, v1, v2, v3);
        });
      } else {
        u16* VTM = (u16*)(p.ws + O_VTM);
        const int S = (s == 0) ? 256 : 1280;
        epi_foreach(acc, tid_, [&](int i, int j, float v0, float v1, float v2, float v3) {
          const int ch = (n - 4) * 128 + i, row = m * 128 + j;
          const int b = row / S, mm = row % S;
          st4bf(VTM + ((size_t)b * 512 + ch) * S + mm, v0, v1, v2, v3);
        });
      }
    }
  }
}

DEV void phase_mla(const Params& p, int l, int s, char* smem, const int tid_) {
  for (int item = blockIdx.x; item < 1024; item += gridDim.x) {
    if (s == 0) attn_item<2>(p, l, item, smem, tid_); else attn_item<3>(p, l, item, smem, tid_);
  }
}

DEV void phase_merge(const Params& p, int l, int s, char* smem, const int tid_) {
  const int xcd = blockIdx.x & 7, lb = blockIdx.x >> 3, nb = gridDim.x >> 3;
  const u16* GATES = (const u16*)(p.ws + O_GATES);
  u16* MG = (u16*)(p.ws + O_H);
  const int lane = TIDX & 63, w = TIDX >> 6, wm = w >> 1, wn = w & 1;
  for (int li = lb; li < 128; li += nb) {
    int m, n;
    tile_map(li, 16, xcd, m, n);
    f32x16 macc[2];
#pragma unroll
    for (int b = 0; b < 2; b++)
#pragma unroll
      for (int r = 0; r < 16; r++) macc[b][r] = 0.f;
    const int i = wm * 32 + (lane & 31);
#pragma unroll 1
    for (int k = 0; k < 3; k++) {
      const u16* A = (const u16*)(p.ws + (k == 0 ? O_ZA : (k == 1 ? O_ZB : O_ZC))) + (size_t)m * 64 * 512;
      const u16* W = (const u16*)(p.ws + O_WBR) + (size_t)(l * 3 + k) * 1024 * 512 + (size_t)n * 128 * 512;
      f32x16 acc[2];
#pragma unroll
      for (int b = 0; b < 2; b++)
#pragma unroll
        for (int r = 0; r < 16; r++) acc[b][r] = 0.f;
      gemm_mainloop64(A, 512, W, 512, 512, smem, acc, tid_);
#pragma unroll
      for (int b = 0; b < 2; b++)
#pragma unroll
        for (int rg = 0; rg < 4; rg++) {
          const int j = wn * 64 + b * 32 + rg * 8 + (lane >> 5) * 4;
          float g0, g1, g2, g3;
          ld4bf(GATES + (size_t)(m * 64 + i) * 3072 + k * 1024 + n * 128 + j, g0, g1, g2, g3);
          macc[b][rg * 4 + 0] += g0 * acc[b][rg * 4 + 0];
          macc[b][rg * 4 + 1] += g1 * acc[b][rg * 4 + 1];
          macc[b][rg * 4 + 2] += g2 * acc[b][rg * 4 + 2];
          macc[b][rg * 4 + 3] += g3 * acc[b][rg * 4 + 3];
        }
    }
#pragma unroll
    for (int b = 0; b < 2; b++)
#pragma unroll
      for (int rg = 0; rg < 4; rg++) {
        const int j = wn * 64 + b * 32 + rg * 8 + (lane >> 5) * 4;
        st4bf(MG + (size_t)(m * 64 + i) * 1024 + n * 128 + j, macc[b][rg * 4 + 0], macc[b][rg * 4 + 1], macc[b][rg * 4 + 2], macc[b][rg * 4 + 3]);
      }
  }
}

DEV void phase_out(const Params& p, int l, int s, char* smem, const int tid_) {
  const int xcd = blockIdx.x & 7, lb = blockIdx.x >> 3, nb = gridDim.x >> 3;
  const u16* MG = (const u16*)(p.ws + O_H);
  const float* MOD = (const float*)(p.ws + O_MOD);
  for (int li = lb; li < 64; li += nb) {
    int m, n;
    tile_map(li, 8, xcd, m, n);
    f32x16 acc[2][2];
    acc_zero(acc);
    gemm_mainloop(MG + (size_t)m * 128 * 1024, 1024, (const u16*)(p.ws + O_WOUT) + (size_t)l * 1024 * 1024 + (size_t)n * 128 * 1024, 1024, 1024, smem, acc, tid_);
    epi_foreach(acc, tid_, [&](int i, int j, float v0, float v1, float v2, float v3) {
      const int tl = m * 128 + i, col = n * 128 + j;
      const float4 x = *(const float4*)(xrow_in(p, l, s, tl) + col);
      const float4 g = *(const float4*)(MOD + (size_t)(l * 9 + cond_idx(s, tl)) * 3072 + 2048 + col);
      *(float4*)(p.out + OUT_Y + (size_t)s * 8388608 + (size_t)tl * 1024 + col) =
          make_float4(x.x + g.x * v0, x.y + g.y * v1, x.z + g.z * v2, x.w + g.w * v3);
    });
  }
}

DEV void phase_final(const Params& p, const int tid_) {
  const int lane = TIDX & 63, wave = TIDX >> 6;
  for (int item = blockIdx.x; item < 4096; item += gridDim.x) {
    float* x = p.out + OUT_Y + (size_t)(item * 4 + wave) * 1024;
    float4 v[4];
    float ss = 0.f;
#pragma unroll
    for (int i = 0; i < 4; i++) {
      v[i] = *(const float4*)(x + i * 256 + lane * 4);
      ss += v[i].x * v[i].x + v[i].y * v[i].y + v[i].z * v[i].z + v[i].w * v[i].w;
    }
    ss = wave_sum(ss);
    const float rstd = rsqrtf(ss * (1.f / 1024.f) + 1e-6f);
#pragma unroll
    for (int i = 0; i < 4; i++) {
      const int col = i * 256 + lane * 4;
      const float4 g = *(const float4*)(p.final_g + col);
      *(float4*)(x + col) = make_float4(v[i].x * rstd * g.x, v[i].y * rstd * g.y, v[i].z * rstd * g.z, v[i].w * rstd * g.w);
    }
  }
}

DEV void run_phase(const Params& p, int ph, int l, int s, char* smem) {
  const int tid_ = tid_opaque();
  switch (ph) {
    case 0: phase_prep(p, smem, tid_); break;
    case 1: phase_h(p, l, s, tid_); break;
    case 2: phase_in(p, l, s, smem, tid_); break;
    case 3: phase_rows(p, l, s, smem, tid_); break;
    case 4: phase_mix(p, l, s, smem, tid_); break;
    case 5: phase_mla(p, l, s, smem, tid_); break;
    case 6: phase_merge(p, l, s, smem, tid_); break;
    case 7: phase_out(p, l, s, smem, tid_); break;
    default: phase_final(p, tid_); break;
  }
}

__global__ void __launch_bounds__(256, 2) phase_kernel(Params p, int ph, int l, int s) {
  __shared__ __attribute__((aligned(16))) char smem[65536];
  run_phase(p, ph, l, s, smem);
}

__global__ void __launch_bounds__(256, 2) mega_kernel(Params p) {
  __shared__ __attribute__((aligned(16))) char smem[65536];
  cg::grid_group grid = cg::this_grid();
#pragma unroll 1
  for (int step = 0; step < 30; step++) {
    int ph, l = 0, s = 0;
    if (step == 0) ph = 0;
    else if (step == 29) ph = 8;
    else { const int q = (step - 1) / 7; ph = 1 + (step - 1) % 7; l = q >> 1; s = q & 1; }
    run_phase(p, ph, l, s, smem);
    if (step < 29) grid.sync();
  }
}

extern "C" void kernel_launch(void* const* d_in, const int* in_sizes, int n_in, void* d_out, int out_size, void* d_ws, size_t ws_size,
                              hipStream_t stream) {
  Params p{};
  const float** pp = (const float**)&p;
  for (int i = 0; i < 22; i++) pp[i] = (const float*)d_in[i];
  p.out = (float*)d_out;
  p.ws = (char*)d_ws;
#if USE_COOP
  static int grid_blocks = 0;
  if (!grid_blocks) {
    int dev = 0, cus = 0, per_cu = 0;
    hipGetDevice(&dev);
    hipDeviceGetAttribute(&cus, hipDeviceAttributeMultiprocessorCount, dev);
    hipOccupancyMaxActiveBlocksPerMultiprocessor(&per_cu, mega_kernel, 256, 0);
    if (per_cu > 2) per_cu = 2;
    grid_blocks = cus * per_cu;
    grid_blocks &= ~7;
  }
  void* args[] = {&p};
  hipError_t e = hipLaunchCooperativeKernel((void*)mega_kernel, dim3(grid_blocks), dim3(256), args, 0, stream);
  if (e != hipSuccess) fprintf(stderr, "cooperative launch failed: %s (grid %d)\n", hipGetErrorString(e), grid_blocks);
#else
  const int G = 512;
  phase_kernel<<<G, 256, 0, stream>>>(p, 0, 0, 0);
  for (int l = 0; l < 2; l++)
    for (int s = 0; s < 2; s++)
      for (int ph = 1; ph <= 7; ph++) phase_kernel<<<G, 256, 0, stream>>>(p, ph, l, s);
  phase_kernel<<<G, 256, 0, stream>>>(p, 8, 0, 0);
#endif
}
```

```cpp
#include <hip/hip_runtime.h>
#include <hip/hip_cooperative_groups.h>
#include <cstdio>
namespace cg = cooperative_groups;

#ifndef PROBE_DUP
#define PROBE_DUP -1
#endif
#ifndef PROBE_DUP2
#define PROBE_DUP2 -1
#endif
#ifndef PROBE_SYNC
#define PROBE_SYNC 0
#endif
#ifndef ATT_REP
#define ATT_REP 1
#endif
#ifndef USE_COOP
#define USE_COOP 1
#endif

typedef unsigned short u16;
typedef __attribute__((ext_vector_type(8))) __bf16 bf16x8;
typedef __attribute__((ext_vector_type(16))) float f32x16;
#define DEV __device__ __forceinline__
__device__ __forceinline__ int tid_opaque() { int t = threadIdx.x; asm volatile("" : "+v"(t)); return t; }
#define TIDX tid_

constexpr size_t A256(size_t x) { return (x + 255) & ~(size_t)255; }
constexpr size_t O_WIN = 0;
constexpr size_t O_WUQ = O_WIN + A256(2ull * 7936 * 1024 * 2);
constexpr size_t O_WUKV = O_WUQ + A256(2ull * 768 * 384 * 2);
constexpr size_t O_WBR = O_WUKV + A256(2ull * 1024 * 256 * 2);
constexpr size_t O_WOUT = O_WBR + A256(2ull * 3 * 1024 * 512 * 2);
constexpr size_t O_SGUW = O_WOUT + A256(2ull * 1024 * 1024 * 2);
constexpr size_t O_KC = O_SGUW + A256(2ull * 4 * 128 * 128 * 2);
constexpr size_t O_VTC = O_KC + A256(2ull * 8 * 256 * 512 * 2);
constexpr size_t O_MOD = O_VTC + A256(2ull * 8 * 256 * 512 * 2);
constexpr size_t O_H = O_MOD + A256(2ull * 9 * 3072 * 4);
constexpr size_t O_QNA = O_H + A256(8192ull * 1024 * 2);
constexpr size_t O_KNA = O_QNA + A256(8192ull * 512 * 2);
constexpr size_t O_VTNA = O_KNA + A256(8192ull * 512 * 2);
constexpr size_t O_ZA = O_VTNA + A256(8192ull * 512 * 2);
constexpr size_t O_ZB = O_ZA + A256(8192ull * 512 * 2);
constexpr size_t O_ZC = O_ZB + A256(8192ull * 512 * 2);
constexpr size_t O_GU = O_ZC + A256(8192ull * 512 * 2);
constexpr size_t O_GVT = O_GU + A256(8192ull * 512 * 2);
constexpr size_t O_DQ = O_GVT + A256(8192ull * 512 * 2);
constexpr size_t O_DKV = O_DQ + A256(8192ull * 384 * 2);
constexpr size_t O_KRF = O_DKV + A256(8192ull * 256 * 2);
constexpr size_t O_GATES = O_KRF + A256(8192ull * 32 * 4);
constexpr size_t O_CKV = O_GATES + A256(8192ull * 3072 * 2);
constexpr size_t O_KR = O_CKV + A256(10240ull * 256 * 2);
constexpr size_t O_KNOPE = O_KR + A256(10240ull * 32 * 2);
constexpr size_t O_VTM = O_KNOPE + A256(10240ull * 512 * 2);
constexpr size_t O_END = O_VTM + A256(10240ull * 512 * 2);
constexpr size_t O_BAR = O_END;
constexpr size_t BAR_BYTES = 16384;
static_assert(O_BAR + BAR_BYTES <= 256ull * 1024 * 1024, "workspace too large");

constexpr size_t OUT_Y = 0;
constexpr size_t OUT_SK = 16777216;
constexpr size_t OUT_SV = 25165824;
constexpr size_t OUT_CKV = 33554432;
constexpr size_t OUT_SKR = 37748736;

struct Params {
  const float *x_prompt, *x_sample, *cache_na_k, *cache_na_v, *cache_ckv, *cache_kr, *c, *c_ctx;
  const float *norm_g, *w_mod, *b_mod, *w_in, *na_rpb, *sgu_w, *sgu_b, *q_norm, *w_uq, *kv_norm, *w_ukv, *w_branch, *w_out, *final_g;
  float* out;
  char* ws;
};

DEV u16 f2bf(float f) { unsigned u = __float_as_uint(f); u += 0x7fffu + ((u >> 16) & 1u); return (u16)(u >> 16); }
DEV float bf2f(u16 h) { return __uint_as_float(((unsigned)h) << 16); }
typedef __attribute__((ext_vector_type(2))) __bf16 bf16x2;
DEV unsigned pack2(float a, float b) { bf16x2 v; v[0] = (__bf16)a; v[1] = (__bf16)b; return __builtin_bit_cast(unsigned, v); }
DEV void st4bf(u16* p, float a, float b, float c, float d) { uint2 v; v.x = pack2(a, b); v.y = pack2(c, d); *(uint2*)p = v; }
DEV void ld4bf(const u16* p, float& a, float& b, float& c, float& d) {
  uint2 v = *(const uint2*)p;
  a = __uint_as_float(v.x << 16); b = __uint_as_float(v.x & 0xffff0000u);
  c = __uint_as_float(v.y << 16); d = __uint_as_float(v.y & 0xffff0000u);
}
DEV float wave_sum(float v) {
#pragma unroll
  for (int o = 32; o > 0; o >>= 1) v += __shfl_xor(v, o);
  return v;
}
DEV float sigmoid_f(float x) { return 1.f / (1.f + __expf(-x)); }
DEV float silu_f(float x) { return x / (1.f + __expf(-x)); }
DEV float gelu_f(float x) { float u = 0.7978845608028654f * (x + 0.044715f * x * x * x); return x / (1.f + __expf(-2.f * u)); }

DEV void gemm_mainloop(const u16* P, int ldp, const u16* Q, int ldq, int K, char* smem, f32x16 (&acc)[2][2], const int tid_) {
  const int t = TIDX, lane = t & 63, w = t >> 6, wm = w >> 1, wn = w & 1;
  const int lr = t >> 3, ch = t & 7;
  const u16* pg = P + (size_t)lr * ldp + ch * 8;
  const u16* qg = Q + (size_t)lr * ldq + ch * 8;
  const size_t sp = (size_t)32 * ldp, sq = (size_t)32 * ldq;
  const int soff = lr * 128 + ((ch ^ ((t >> 4) & 7)) << 4);
  const int sw = (lane >> 1) & 7;
  const int prow = (wm * 64 + (lane & 31)) * 128;
  const int qrow = (wn * 64 + (lane & 31)) * 128;
  uint4 p0, p1, p2, p3, q0, q1, q2, q3;
#define GLOAD(k0) do { p0 = *(const uint4*)(pg + (k0)); p1 = *(const uint4*)(pg + sp + (k0)); p2 = *(const uint4*)(pg + 2 * sp + (k0)); p3 = *(const uint4*)(pg + 3 * sp + (k0)); \
                       q0 = *(const uint4*)(qg + (k0)); q1 = *(const uint4*)(qg + sq + (k0)); q2 = *(const uint4*)(qg + 2 * sq + (k0)); q3 = *(const uint4*)(qg + 3 * sq + (k0)); } while (0)
#define SWRITE(base) do { char* b_ = (base) + soff; *(uint4*)(b_) = p0; *(uint4*)(b_ + 4096) = p1; *(uint4*)(b_ + 8192) = p2; *(uint4*)(b_ + 12288) = p3; \
                          *(uint4*)(b_ + 16384) = q0; *(uint4*)(b_ + 20480) = q1; *(uint4*)(b_ + 24576) = q2; *(uint4*)(b_ + 28672) = q3; } while (0)
  GLOAD(0);
  SWRITE(smem);
  __syncthreads();
  const int nk = K >> 6;
  for (int kt = 0; kt < nk; kt++) {
    const int k0 = min(kt + 1, nk - 1) << 6;
    GLOAD(k0);
    asm volatile("" ::: "memory"); __builtin_amdgcn_sched_barrier(0);
    const char* bP = smem + (kt & 1) * 32768;
    const char* bQ = bP + 16384;
#pragma unroll
    for (int s = 0; s < 4; s++) {
      const int co = ((s * 2 + (lane >> 5)) ^ sw) << 4;
      const bf16x8 pf0 = *(const bf16x8*)(bP + prow + co), pf1 = *(const bf16x8*)(bP + prow + 4096 + co);
      const bf16x8 qf0 = *(const bf16x8*)(bQ + qrow + co), qf1 = *(const bf16x8*)(bQ + qrow + 4096 + co);
      acc[0][0] = __builtin_amdgcn_mfma_f32_32x32x16_bf16(qf0, pf0, acc[0][0], 0, 0, 0);
      acc[0][1] = __builtin_amdgcn_mfma_f32_32x32x16_bf16(qf1, pf0, acc[0][1], 0, 0, 0);
      acc[1][0] = __builtin_amdgcn_mfma_f32_32x32x16_bf16(qf0, pf1, acc[1][0], 0, 0, 0);
      acc[1][1] = __builtin_amdgcn_mfma_f32_32x32x16_bf16(qf1, pf1, acc[1][1], 0, 0, 0);
    }
    asm volatile("" ::: "memory"); __builtin_amdgcn_sched_barrier(0);
    SWRITE(smem + ((kt + 1) & 1) * 32768);
    __syncthreads();
  }
#undef GLOAD
#undef SWRITE
}

DEV void gemm_mainloop64(const u16* P, int ldp, const u16* Q, int ldq, int K, char* smem, f32x16 (&acc)[2], const int tid_) {
  const int t = TIDX, lane = t & 63, w = t >> 6, wm = w >> 1, wn = w & 1;
  const int lr = t >> 3, ch = t & 7;
  const u16* pg = P + (size_t)lr * ldp + ch * 8;
  const u16* qg = Q + (size_t)lr * ldq + ch * 8;
  const size_t sp = (size_t)32 * ldp, sq = (size_t)32 * ldq;
  const int soff = lr * 128 + ((ch ^ ((t >> 4) & 7)) << 4);
  const int sw = (lane >> 1) & 7;
  const int prow = (wm * 32 + (lane & 31)) * 128;
  const int qrow = (wn * 64 + (lane & 31)) * 128;
  uint4 p0, p1, q0, q1, q2, q3;
#define GLOAD(k0) do { p0 = *(const uint4*)(pg + (k0)); p1 = *(const uint4*)(pg + sp + (k0)); \
                       q0 = *(const uint4*)(qg + (k0)); q1 = *(const uint4*)(qg + sq + (k0)); q2 = *(const uint4*)(qg + 2 * sq + (k0)); q3 = *(const uint4*)(qg + 3 * sq + (k0)); } while (0)
#define SWRITE(base) do { char* b_ = (base) + soff; *(uint4*)(b_) = p0; *(uint4*)(b_ + 4096) = p1; \
                          *(uint4*)(b_ + 16384) = q0; *(uint4*)(b_ + 20480) = q1; *(uint4*)(b_ + 24576) = q2; *(uint4*)(b_ + 28672) = q3; } while (0)
  GLOAD(0);
  SWRITE(smem);
  __syncthreads();
  const int nk = K >> 6;
  for (int kt = 0; kt < nk; kt++) {
    const int k0 = min(kt + 1, nk - 1) << 6;
    GLOAD(k0);
    asm volatile("" ::: "memory"); __builtin_amdgcn_sched_barrier(0);
    const char* bP = smem + (kt & 1) * 32768;
    const char* bQ = bP + 16384;
#pragma unroll
    for (int s = 0; s < 4; s++) {
      const int co = ((s * 2 + (lane >> 5)) ^ sw) << 4;
      const bf16x8 pf0 = *(const bf16x8*)(bP + prow + co);
      const bf16x8 qf0 = *(const bf16x8*)(bQ + qrow + co), qf1 = *(const bf16x8*)(bQ + qrow + 4096 + co);
      acc[0] = __builtin_amdgcn_mfma_f32_32x32x16_bf16(qf0, pf0, acc[0], 0, 0, 0);
      acc[1] = __builtin_amdgcn_mfma_f32_32x32x16_bf16(qf1, pf0, acc[1], 0, 0, 0);
    }
    asm volatile("" ::: "memory"); __builtin_amdgcn_sched_barrier(0);
    SWRITE(smem + ((kt + 1) & 1) * 32768);
    __syncthreads();
  }
#undef GLOAD
#undef SWRITE
}

DEV void acc_zero(f32x16 (&acc)[2][2]) {
#pragma unroll
  for (int a = 0; a < 2; a++)
#pragma unroll
    for (int b = 0; b < 2; b++)
#pragma unroll
      for (int r = 0; r < 16; r++) acc[a][b][r] = 0.f;
}

template <class F>
DEV void epi_foreach(const f32x16 (&acc)[2][2], const int tid_, F f) {
  const int lane = TIDX & 63, w = TIDX >> 6, wm = w >> 1, wn = w & 1;
#pragma unroll
  for (int a = 0; a < 2; a++)
#pragma unroll
    for (int b = 0; b < 2; b++)
#pragma unroll
      for (int rg = 0; rg < 4; rg++) {
        const int i = wm * 64 + a * 32 + (lane & 31);
        const int j = wn * 64 + b * 32 + rg * 8 + (lane >> 5) * 4;
        f(i, j, acc[a][b][rg * 4 + 0], acc[a][b][rg * 4 + 1], acc[a][b][rg * 4 + 2], acc[a][b][rg * 4 + 3]);
      }
}

DEV void tile_map(int li, int MPX, int xcd, int& m, int& n) {
  const int g = MPX * 8;
  const int ng = li / g, wv = li % g;
  m = xcd * MPX + (wv % MPX);
  n = ng * 8 + (wv / MPX);
}

DEV void tconv_tile(const float* __restrict__ src, int ldsrc, int k0, int n0, u16* __restrict__ dst, int lddst, int drow0, float* tile, const int tid_) {
  const int t = TIDX;
  {
    const int n = t & 31, kk = t >> 5;
#pragma unroll
    for (int p = 0; p < 8; p++) {
      const int k = kk + p * 8;
      tile[k * 33 + n] = src[(size_t)(k0 + k) * ldsrc + n0 + n];
    }
  }
  __syncthreads();
  {
    const int k = t & 63, nn = t >> 6;
#pragma unroll
    for (int p = 0; p < 8; p++) {
      const int n2 = nn + p * 4;
      dst[(size_t)(drow0 + n2) * lddst + k0 + k] = f2bf(tile[k * 33 + n2]);
    }
  }
  __syncthreads();
}

DEV void phase_prep(const Params& p, char* smem, const int tid_) {
  const int t = TIDX;
  constexpr int N_MOD = 192;
  constexpr int T_IN = 3920, T_UQ = 144, T_UKV = 128, T_BR = 768, T_OUT = 512, T_CV = 512;
  constexpr int T_L = T_IN + T_UQ + T_UKV + T_BR + T_OUT + T_CV;
  constexpr int N_TC = 2 * T_L;
  constexpr int N_SG = 64, N_KC = 1024;
  constexpr int TOTAL = N_MOD + N_TC + N_SG + N_KC;
  float* MOD = (float*)(p.ws + O_MOD);
  for (int item = blockIdx.x; item < TOTAL; item += gridDim.x) {
    if (item < N_MOD) {
      const int l = item / 96, e0 = (item % 96) * 32;
      float* sc = (float*)smem;
      for (int idx = t; idx < 9216; idx += 256) {
        const int c9 = idx >> 10, d = idx & 1023;
        const float v = (c9 == 0) ? p.c_ctx[d] : p.c[(c9 - 1) * 1024 + d];
        sc[idx] = silu_f(v);
      }
      __syncthreads();
      const int col = t & 31, slab = t >> 5;
      float a[9];
#pragma unroll
      for (int c9 = 0; c9 < 9; c9++) a[c9] = 0.f;
      const float* wp = p.w_mod + ((size_t)l * 1024 + slab * 128) * 3072 + e0 + col;
#pragma unroll 4
      for (int dd = 0; dd < 128; dd++) {
        const float wv = wp[(size_t)dd * 3072];
        const int d = slab * 128 + dd;
#pragma unroll
        for (int c9 = 0; c9 < 9; c9++) a[c9] += sc[c9 * 1024 + d] * wv;
      }
      float* red = sc + 9216;
#pragma unroll
      for (int c9 = 0; c9 < 9; c9++) red[(slab * 9 + c9) * 32 + col] = a[c9];
      __syncthreads();
      for (int idx = t; idx < 288; idx += 256) {
        const int c9 = idx >> 5, cc = idx & 31;
        float sum = 0.f;
#pragma unroll
        for (int sl = 0; sl < 8; sl++) sum += red[(sl * 9 + c9) * 32 + cc];
        MOD[(l * 9 + c9) * 3072 + e0 + cc] = sum + p.b_mod[l * 3072 + e0 + cc];
      }
      __syncthreads();
    } else if (item < N_MOD + N_TC) {
      const int ti = item - N_MOD;
      const int l = ti / T_L;
      int r = ti % T_L;
      const float* src; u16* dst; int ldsrc, lddst, k0, n0, drow;
      if (r < T_IN) {
        const int nt = r >> 4, kt = r & 15;
        src = p.w_in + (size_t)l * 1024 * 7840; ldsrc = 7840; k0 = kt * 64; n0 = nt * 32;
        dst = (u16*)(p.ws + O_WIN) + (size_t)l * 7936 * 1024; lddst = 1024;
        drow = (n0 < 4224) ? n0 : (n0 == 4224 ? 7808 : n0 - 32);
      } else if ((r -= T_IN) < T_UQ) {
        const int nt = r / 6, kt = r % 6;
        src = p.w_uq + (size_t)l * 384 * 768; ldsrc = 768; k0 = kt * 64; n0 = nt * 32;
        dst = (u16*)(p.ws + O_WUQ) + (size_t)l * 768 * 384; lddst = 384; drow = n0;
      } else if ((r -= T_UQ) < T_UKV) {
        const int nt = r >> 2, kt = r & 3;
        src = p.w_ukv + (size_t)l * 256 * 1024; ldsrc = 1024; k0 = kt * 64; n0 = nt * 32;
        dst = (u16*)(p.ws + O_WUKV) + (size_t)l * 1024 * 256; lddst = 256;
        const int hh = n0 >> 7, jj = n0 & 127;
        drow = (jj < 64) ? (hh * 64 + jj) : (512 + hh * 64 + jj - 64);
      } else if ((r -= T_UKV) < T_BR) {
        const int kb = r >> 8, r2 = r & 255;
        const int nt = r2 >> 3, kt = r2 & 7;
        src = p.w_branch + (size_t)(l * 3 + kb) * 512 * 1024; ldsrc = 1024; k0 = kt * 64; n0 = nt * 32;
        dst = (u16*)(p.ws + O_WBR) + (size_t)(l * 3 + kb) * 1024 * 512; lddst = 512; drow = n0;
      } else if ((r -= T_BR) < T_OUT) {
        const int nt = r >> 4, kt = r & 15;
        src = p.w_out + (size_t)l * 1024 * 1024; ldsrc = 1024; k0 = kt * 64; n0 = nt * 32;
        dst = (u16*)(p.ws + O_WOUT) + (size_t)l * 1024 * 1024; lddst = 1024; drow = n0;
      } else {
        r -= T_OUT;
        const int b = r >> 6, r2 = r & 63;
        const int nt = r2 >> 2, kt = r2 & 3;
        src = p.cache_na_v + (size_t)(b * 2 + l) * 256 * 512; ldsrc = 512; k0 = kt * 64; n0 = nt * 32;
        dst = (u16*)(p.ws + O_VTC) + (size_t)(l * 8 + b) * 512 * 256; lddst = 256; drow = n0;
      }
      tconv_tile(src, ldsrc, k0, n0, dst, lddst, drow, (float*)smem, tid_);
    } else if (item < N_MOD + N_TC + N_SG) {
      const int it = item - N_MOD - N_TC;
      const size_t e = (size_t)it * 2048 + t * 8;
      const float4 a = *(const float4*)(p.sgu_w + e), b = *(const float4*)(p.sgu_w + e + 4);
      u16* d = (u16*)(p.ws + O_SGUW) + e;
      st4bf(d, a.x, a.y, a.z, a.w); st4bf(d + 4, b.x, b.y, b.z, b.w);
    } else {
      const int it = item - N_MOD - N_TC - N_SG;
      const size_t e = (size_t)it * 2048 + t * 8;
      const int l = (int)(e >> 20), b = (int)(e >> 17) & 7; const size_t rest = e & 131071;
      const float* s = p.cache_na_k + ((size_t)(b * 2 + l) << 17) + rest;
      const float4 a = *(const float4*)s, bb = *(const float4*)(s + 4);
      u16* d = (u16*)(p.ws + O_KC) + e;
      st4bf(d, a.x, a.y, a.z, a.w); st4bf(d + 4, bb.x, bb.y, bb.z, bb.w);
    }
  }
}

DEV const float* xrow_in(const Params& p, int l, int s, int tl) {
  if (l == 0) return (s == 0 ? p.x_prompt : p.x_sample) + (size_t)tl * 1024;
  return p.out + OUT_Y + (size_t)s * 8388608 + (size_t)tl * 1024;
}
DEV int cond_idx(int s, int tl) { return s == 0 ? 0 : 1 + (tl >> 10); }

DEV void phase_h(const Params& p, int l, int s, const int tid_) {
  const int lane = TIDX & 63, wave = TIDX >> 6;
  u16* H = (u16*)(p.ws + O_H);
  const float* MOD = (const float*)(p.ws + O_MOD);
  for (int item = blockIdx.x; item < 2048; item += gridDim.x) {
    const int tl = item * 4 + wave;
    const float* x = xrow_in(p, l, s, tl);
    const float* mod = MOD + (size_t)(l * 9 + cond_idx(s, tl)) * 3072;
    float4 v[4];
    float ss = 0.f;
#pragma unroll
    for (int i = 0; i < 4; i++) {
      v[i] = *(const float4*)(x + i * 256 + lane * 4);
      ss += v[i].x * v[i].x + v[i].y * v[i].y + v[i].z * v[i].z + v[i].w * v[i].w;
    }
    ss = wave_sum(ss);
    const float rstd = rsqrtf(ss * (1.f / 1024.f) + 1e-6f);
#pragma unroll
    for (int i = 0; i < 4; i++) {
      const int col = i * 256 + lane * 4;
      const float4 g = *(const float4*)(p.norm_g + l * 1024 + col);
      const float4 sh = *(const float4*)(mod + col);
      const float4 sc = *(const float4*)(mod + 1024 + col);
      st4bf(H + (size_t)tl * 1024 + col, v[i].x * rstd * g.x * (1.f + sc.x) + sh.x, v[i].y * rstd * g.y * (1.f + sc.y) + sh.y,
            v[i].z * rstd * g.z * (1.f + sc.z) + sh.z, v[i].w * rstd * g.w * (1.f + sc.w) + sh.w);
    }
  }
}

DEV void phase_in(const Params& p, int l, int s, char* smem, const int tid_) {
  const int xcd = blockIdx.x & 7, lb = blockIdx.x >> 3, nb = gridDim.x >> 3;
  const u16* H = (const u16*)(p.ws + O_H);
  const u16* W = (const u16*)(p.ws + O_WIN) + (size_t)l * 7936 * 1024;
  u16* QNA = (u16*)(p.ws + O_QNA); u16* KNA = (u16*)(p.ws + O_KNA); u16* VTNA = (u16*)(p.ws + O_VTNA);
  u16* ZA = (u16*)(p.ws + O_ZA); u16* ZB = (u16*)(p.ws + O_ZB); u16* ZC = (u16*)(p.ws + O_ZC);
  u16* GU = (u16*)(p.ws + O_GU); u16* GVT = (u16*)(p.ws + O_GVT);
  u16* DQ = (u16*)(p.ws + O_DQ); u16* DKV = (u16*)(p.ws + O_DKV); float* KRF = (float*)(p.ws + O_KRF);
  u16* GATES = (u16*)(p.ws + O_GATES);
  float* out = p.out;
  for (int li = lb; li < 8 * 62; li += nb) {
    int m, n;
    tile_map(li, 8, xcd, m, n);
    const int m0 = m * 128, n0 = n * 128;
    const bool swapped = (n >= 8 && n < 12) || (n >= 20 && n < 24);
    const u16* Hm = H + (size_t)m0 * 1024;
    const u16* Wn = W + (size_t)n0 * 1024;
    f32x16 acc[2][2];
    acc_zero(acc);
    gemm_mainloop(swapped ? Wn : Hm, 1024, swapped ? Hm : Wn, 1024, 1024, smem, acc, tid_);
    if (n < 4) {
      epi_foreach(acc, tid_, [&](int i, int j, float v0, float v1, float v2, float v3) {
        st4bf(QNA + (size_t)(m0 + i) * 512 + n0 + j, v0, v1, v2, v3);
      });
    } else if (n < 8) {
      epi_foreach(acc, tid_, [&](int i, int j, float v0, float v1, float v2, float v3) {
        const int T = m0 + i, col = n0 - 512 + j;
        st4bf(KNA + (size_t)T * 512 + col, v0, v1, v2, v3);
        if (s == 0) {
          const int b = T >> 8, sq = T & 255;
          *(float4*)(out + OUT_SK + ((size_t)(b * 2 + l) * 256 + sq) * 512 + col) = make_float4(v0, v1, v2, v3);
        }
      });
    } else if (n < 12) {
      epi_foreach(acc, tid_, [&](int i, int j, float v0, float v1, float v2, float v3) {
        const int dva = n0 - 1024 + i, tok = m0 + j;
        if (s == 0) {
          const int b = tok >> 8, sq = tok & 255;
          st4bf(VTNA + ((size_t)(b * 512 + dva)) * 256 + sq, v0, v1, v2, v3);
          float* o = out + OUT_SV + ((size_t)(b * 2 + l) * 256 + sq) * 512 + dva;
          o[0] = v0; o[512] = v1; o[1024] = v2; o[1536] = v3;
        } else {
          const int b = tok >> 10, nn = tok & 1023;
          st4bf(VTNA + ((size_t)(b * 512 + dva)) * 1024 + nn, v0, v1, v2, v3);
        }
      });
    } else if (n < 16) {
      epi_foreach(acc, tid_, [&](int i, int j, float v0, float v1, float v2, float v3) {
        st4bf(ZA + (size_t)(m0 + i) * 512 + n0 - 1536 + j, silu_f(v0), silu_f(v1), silu_f(v2), silu_f(v3));
      });
    } else if (n < 20) {
      epi_foreach(acc, tid_, [&](int i, int j, float v0, float v1, float v2, float v3) {
        st4bf(GU + (size_t)(m0 + i) * 512 + n0 - 2048 + j, gelu_f(v0), gelu_f(v1), gelu_f(v2), gelu_f(v3));
      });
    } else if (n < 24) {
      epi_foreach(acc, tid_, [&](int i, int j, float v0, float v1, float v2, float v3) {
        const int c = n0 - 2560 + i, tok = m0 + j;
        const int chunk = tok >> 7, q = tok & 127;
        st4bf(GVT + ((size_t)chunk * 512 + c) * 128 + q, gelu_f(v0), gelu_f(v1), gelu_f(v2), gelu_f(v3));
      });
    } else if (n < 28) {
      epi_foreach(acc, tid_, [&](int i, int j, float v0, float v1, float v2, float v3) {
        st4bf(ZB + (size_t)(m0 + i) * 512 + n0 - 3072 + j, silu_f(v0), silu_f(v1), silu_f(v2), silu_f(v3));
      });
    } else if (n < 31) {
      epi_foreach(acc, tid_, [&](int i, int j, float v0, float v1, float v2, float v3) {
        st4bf(DQ + (size_t)(m0 + i) * 384 + n0 - 3584 + j, v0, v1, v2, v3);
      });
    } else if (n < 33) {
      epi_foreach(acc, tid_, [&](int i, int j, float v0, float v1, float v2, float v3) {
        st4bf(DKV + (size_t)(m0 + i) * 256 + n0 - 3968 + j, v0, v1, v2, v3);
      });
    } else if (n < 37) {
      epi_foreach(acc, tid_, [&](int i, int j, float v0, float v1, float v2, float v3) {
        st4bf(ZC + (size_t)(m0 + i) * 512 + n0 - 4224 + j, silu_f(v0), silu_f(v1), silu_f(v2), silu_f(v3));
      });
    } else if (n < 61) {
      epi_foreach(acc, tid_, [&](int i, int j, float v0, float v1, float v2, float v3) {
        st4bf(GATES + (size_t)(m0 + i) * 3072 + n0 - 4736 + j, sigmoid_f(v0), sigmoid_f(v1), sigmoid_f(v2), sigmoid_f(v3));
      });
    } else {
      epi_foreach(acc, tid_, [&](int i, int j, float v0, float v1, float v2, float v3) {
        if (j < 32) {
          const int T = m0 + i;
          *(float4*)(KRF + (size_t)T * 32 + j) = make_float4(v0, v1, v2, v3);
          if (s == 0) {
            const int b = T >> 8, sq = T & 255;
            *(float4*)(out + OUT_SKR + ((size_t)(b * 2 + l) * 256 + sq) * 32 + j) = make_float4(v0, v1, v2, v3);
          }
        }
      });
    }
  }
}

DEV void phase_rows(const Params& p, int l, int s, char* smem, const int tid_) {
  const int t = TIDX, lane = t & 63, wave = t >> 6;
  u16* DQ = (u16*)(p.ws + O_DQ); const u16* DKV = (const u16*)(p.ws + O_DKV); const float* KRF = (const float*)(p.ws + O_KRF);
  u16* CKV = (u16*)(p.ws + O_CKV); u16* KR = (u16*)(p.ws + O_KR); u16* GVT = (u16*)(p.ws + O_GVT);
  const int n_row = 2048, n_ln = 64, n_cache = (s == 1) ? 512 : 0;
  const int total = n_row + n_ln + n_cache;
  for (int item = blockIdx.x; item < total; item += gridDim.x) {
    if (item < n_row) {
      const int tl = item * 4 + wave;
      {
        u16* r = DQ + (size_t)tl * 384;
        float v[6]; float ss = 0.f;
#pragma unroll
        for (int i = 0; i < 6; i++) { v[i] = bf2f(r[i * 64 + lane]); ss += v[i] * v[i]; }
        ss = wave_sum(ss);
        const float rstd = rsqrtf(ss * (1.f / 384.f) + 1e-6f);
#pragma unroll
        for (int i = 0; i < 6; i++) r[i * 64 + lane] = f2bf(v[i] * rstd * p.q_norm[l * 384 + i * 64 + lane]);
      }
      {
        float a, b, c, d;
        ld4bf(DKV + (size_t)tl * 256 + lane * 4, a, b, c, d);
        float ss = wave_sum(a * a + b * b + c * c + d * d);
        const float rstd = rsqrtf(ss * (1.f / 256.f) + 1e-6f);
        const float4 g = *(const float4*)(p.kv_norm + l * 256 + lane * 4);
        a *= rstd * g.x; b *= rstd * g.y; c *= rstd * g.z; d *= rstd * g.w;
        const int row = (s == 0) ? tl : ((tl >> 10) * 1280 + 256 + (tl & 1023));
        st4bf(CKV + (size_t)row * 256 + lane * 4, a, b, c, d);
        if (s == 0) {
          const int bb = tl >> 8, sq = tl & 255;
          *(float4*)(p.out + OUT_CKV + ((size_t)(bb * 2 + l) * 256 + sq) * 256 + lane * 4) = make_float4(a, b, c, d);
        }
      }
      if (lane < 16) {
        const float x1 = KRF[(size_t)tl * 32 + lane], x2 = KRF[(size_t)tl * 32 + 16 + lane];
        if (s == 0) {
          KR[(size_t)tl * 32 + lane] = f2bf(x1);
          KR[(size_t)tl * 32 + 16 + lane] = f2bf(x2);
        } else {
          const int nn = tl & 1023;
          const float pos = (lane < 8) ? (float)(nn >> 6) : (float)(nn & 63);
          const float inv = powf(10000.f, -(float)(lane & 7) * 0.125f);
          const float ang = pos * inv;
          const float cs = cosf(ang), sn = sinf(ang);
          const int row = (tl >> 10) * 1280 + 256 + nn;
          KR[(size_t)row * 32 + lane] = f2bf(x1 * cs - x2 * sn);
          KR[(size_t)row * 32 + 16 + lane] = f2bf(x1 * sn + x2 * cs);
        }
      }
    } else if (item < n_row + n_ln) {
      const int chunk = item - n_row;
      u16* g = GVT + (size_t)chunk * 512 * 128;
      const int q = t & 127, half = t >> 7;
      float sum = 0.f, sq = 0.f;
      for (int c = half * 256; c < half * 256 + 256; c++) { const float v = bf2f(g[c * 128 + q]); sum += v; sq += v * v; }
      float* red = (float*)smem;
      red[(half * 2 + 0) * 128 + q] = sum; red[(half * 2 + 1) * 128 + q] = sq;
      __syncthreads();
      sum = red[q] + red[256 + q]; sq = red[128 + q] + red[384 + q];
      const float mu = sum * (1.f / 512.f);
      const float var = fmaxf(sq * (1.f / 512.f) - mu * mu, 0.f);
      const float rstd = rsqrtf(var + 1e-6f);
      for (int c = half * 256; c < half * 256 + 256; c++) { const float v = bf2f(g[c * 128 + q]); g[c * 128 + q] = f2bf((v - mu) * rstd); }
      __syncthreads();
    } else {
      const int rowi = (item - n_row - n_ln) * 4 + wave;
      const int b = rowi >> 8, m = rowi & 255;
      const float4 a = *(const float4*)(p.cache_ckv + ((size_t)(b * 2 + l) * 256 + m) * 256 + lane * 4);
      st4bf(CKV + (size_t)(b * 1280 + m) * 256 + lane * 4, a.x, a.y, a.z, a.w);
      if (lane < 32) KR[(size_t)(b * 1280 + m) * 32 + lane] = f2bf(p.cache_kr[((size_t)(b * 2 + l) * 256 + m) * 32 + lane]);
    }
  }
}

typedef __attribute__((ext_vector_type(4))) float f32x4;
struct AttnSrc { const u16* k; const u16* kr; const u16* vt; int vts; };
struct AttnState { f32x4 o[4]; float mx, ls; };
constexpr int ATT_VST = 136;

struct AttnRegs { uint4 k0, k1, k2, v0, v1; };
template <int DQK>
DEV void attn_gload(const AttnSrc& src, AttnRegs& r, int t) {
  const int row = t >> 3, c8 = (t & 7) * 8;
  r.k0 = *(const uint4*)(src.k + (size_t)row * 512 + c8);
  r.k1 = *(const uint4*)(src.k + (size_t)(row + 32) * 512 + c8);
  r.v0 = *(const uint4*)(src.vt + (size_t)row * src.vts + c8);
  r.v1 = *(const uint4*)(src.vt + (size_t)(row + 32) * src.vts + c8);
  if (DQK == 96) r.k2 = *(const uint4*)(src.kr + (size_t)(t >> 2) * 32 + (t & 3) * 8);
}
template <int DQK>
DEV void attn_swrite(char* buf, const AttnRegs& r, int t) {
  constexpr int KST = DQK * 2 + 16;
  const int row = t >> 3, c16 = (t & 7) * 16;
  char* vb = buf + 64 * KST;
  *(uint4*)(buf + row * KST + c16) = make_uint4(r.k0.x, r.k0.y, r.k0.z, r.k0.w);
  *(uint4*)(buf + (row + 32) * KST + c16) = make_uint4(r.k1.x, r.k1.y, r.k1.z, r.k1.w);
  char* vp = vb + row * ATT_VST + c16;
  *(uint2*)vp = make_uint2(r.v0.x, r.v0.y);
  *(uint2*)(vp + 8) = make_uint2(r.v0.z, r.v0.w);
  vp += 32 * ATT_VST;
  *(uint2*)vp = make_uint2(r.v1.x, r.v1.y);
  *(uint2*)(vp + 8) = make_uint2(r.v1.z, r.v1.w);
  if (DQK == 96) *(uint4*)(buf + (t >> 2) * KST + 128 + (t & 3) * 16) = make_uint4(r.k2.x, r.k2.y, r.k2.z, r.k2.w);
}

template <int DQK, int NT, bool LOCAL>
DEV void attn_compute(const char* buf, const bf16x8 qf0, const bf16x8 qf1, const bf16x8 qf2, AttnState& st, float scale, int koff0, const float* biasrow, int qc, int wlo, const int tid_) {
  constexpr int KST = DQK * 2 + 16;
  const int lane = TIDX & 63, r16 = lane & 15, g = lane >> 4;
  const char* vb = buf + 64 * KST;
  f32x4 s[NT];
#pragma unroll
  for (int t = 0; t < NT; t++) {
    s[t] = f32x4{0.f, 0.f, 0.f, 0.f};
    const char* kp = buf + (koff0 + t * 16 + r16) * KST + g * 16;
    s[t] = __builtin_amdgcn_mfma_f32_16x16x32_bf16(*(const bf16x8*)(kp), qf0, s[t], 0, 0, 0);
    s[t] = __builtin_amdgcn_mfma_f32_16x16x32_bf16(*(const bf16x8*)(kp + 64), qf1, s[t], 0, 0, 0);
    if (DQK == 96) s[t] = __builtin_amdgcn_mfma_f32_16x16x32_bf16(*(const bf16x8*)(kp + 128), qf2, s[t], 0, 0, 0);
  }
  float mloc = st.mx;
#pragma unroll
  for (int t = 0; t < NT; t++)
#pragma unroll
    for (int e = 0; e < 4; e++) {
      float v = s[t][e] * scale;
      if (LOCAL) {
        const int kc = koff0 + t * 16 + 4 * g + e;
        const int bi = min(max(kc - qc + 15, 0), 30);
        const float bv = biasrow[bi];
        v = (kc >= wlo && kc < wlo + 16) ? v + bv : -1e30f;
      }
      s[t][e] = v;
      mloc = fmaxf(mloc, v);
    }
  mloc = fmaxf(mloc, __shfl_xor(mloc, 16));
  mloc = fmaxf(mloc, __shfl_xor(mloc, 32));
  const float alpha = __expf(st.mx - mloc);
  st.mx = mloc;
  float psum = 0.f;
#pragma unroll
  for (int t = 0; t < NT; t++)
#pragma unroll
    for (int e = 0; e < 4; e++) {
      const float pv = __expf(s[t][e] - mloc);
      s[t][e] = pv;
      psum += pv;
    }
  st.ls = st.ls * alpha + psum;
#pragma unroll
  for (int dt = 0; dt < 4; dt++) st.o[dt] *= alpha;
#pragma unroll
  for (int kb = 0; kb < NT / 2; kb++) {
    bf16x8 pf;
#pragma unroll
    for (int e = 0; e < 4; e++) { pf[e] = (__bf16)s[2 * kb][e]; pf[4 + e] = (__bf16)s[2 * kb + 1][e]; }
#pragma unroll
    for (int dt = 0; dt < 4; dt++) {
      const char* vp = vb + (dt * 16 + r16) * ATT_VST + (koff0 + 4 * g) * 2 + kb * 64;
      const uint2 a0 = *(const uint2*)vp, a1 = *(const uint2*)(vp + 32);
      const uint4 av = make_uint4(a0.x, a0.y, a1.x, a1.y);
      st.o[dt] = __builtin_amdgcn_mfma_f32_16x16x32_bf16(__builtin_bit_cast(bf16x8, av), pf, st.o[dt], 0, 0, 0);
    }
  }
}

template <int MODE>
DEV void attn_item(const Params& p, int l, int it, char* smem, const int tid_) {
  constexpr int DQK = (MODE >= 2) ? 96 : 64;
  constexpr int KST = DQK * 2 + 16;
  constexpr int BUFSZ = 64 * KST + 64 * ATT_VST;
  const int t = TIDX, lane = t & 63, w = t >> 6, r16 = lane & 15, g = lane >> 4;
  int b, h, tl0, nst, r = 0;
  if (MODE == 0 || MODE == 2) { b = it >> 5; h = (it >> 2) & 7; tl0 = b * 256 + (it & 3) * 64; nst = 4; }
  else { b = it >> 7; h = (it >> 4) & 7; r = it & 15; tl0 = b * 1024 + r * 64; nst = (MODE == 1) ? 12 : 20; }
  const int tl = tl0 + w * 16 + r16;
  const int wr0 = min(max(r - 4, 0), 8);
  const u16* KNA = (const u16*)(p.ws + O_KNA); const u16* VTNA = (const u16*)(p.ws + O_VTNA);
  const u16* KC = (const u16*)(p.ws + O_KC); const u16* VTC = (const u16*)(p.ws + O_VTC);
  const u16* KNOPE = (const u16*)(p.ws + O_KNOPE); const u16* KR = (const u16*)(p.ws + O_KR); const u16* VTM = (const u16*)(p.ws + O_VTM);
  auto get_src = [&](int st) {
    AttnSrc s;
    s.kr = nullptr;
    if (MODE == 0) {
      s.k = KNA + (size_t)(b * 256 + st * 64) * 512 + h * 64; s.vt = VTNA + (size_t)(b * 512 + h * 64) * 256 + st * 64; s.vts = 256;
    } else if (MODE == 1) {
      if (st < 8) {
        const int krow = wr0 + st;
        s.k = KNA + (size_t)(b * 1024 + krow * 64) * 512 + h * 64; s.vt = VTNA + (size_t)(b * 512 + h * 64) * 1024 + krow * 64; s.vts = 1024;
      } else {
        const int m0 = (st - 8) * 64;
        s.k = KC + ((size_t)(l * 8 + b) * 256 + m0) * 512 + h * 64; s.vt = VTC + ((size_t)(l * 8 + b) * 512 + h * 64) * 256 + m0; s.vts = 256;
      }
    } else if (MODE == 2) {
      s.k = KNOPE + (size_t)(b * 256 + st * 64) * 512 + h * 64; s.kr = KR + (size_t)(b * 256 + st * 64) * 32;
      s.vt = VTM + (size_t)(b * 512 + h * 64) * 256 + st * 64; s.vts = 256;
    } else {
      s.k = KNOPE + (size_t)(b * 1280 + st * 64) * 512 + h * 64; s.kr = KR + (size_t)(b * 1280 + st * 64) * 32;
      s.vt = VTM + (size_t)(b * 512 + h * 64) * 1280 + st * 64; s.vts = 1280;
    }
    return s;
  };
  bf16x8 qf0, qf1, qf2;
  if (MODE < 2) {
    const u16* qp = (const u16*)(p.ws + O_QNA) + (size_t)tl * 512 + h * 64 + 8 * g;
    qf0 = *(const bf16x8*)qp; qf1 = *(const bf16x8*)(qp + 32); qf2 = qf0;
  } else {
    const u16* qp = (const u16*)(p.ws + O_H) + (size_t)tl * 768 + h * 96;
    qf0 = *(const bf16x8*)(qp + 8 * g); qf1 = *(const bf16x8*)(qp + 32 + 8 * g);
    if (MODE == 2) {
      qf2 = *(const bf16x8*)(qp + 64 + 8 * g);
    } else {
      const uint4 own = *(const uint4*)(qp + 64 + 8 * g), oth = *(const uint4*)(qp + 64 + 8 * (g ^ 2));
      const unsigned ow[4] = {own.x, own.y, own.z, own.w}, ot[4] = {oth.x, oth.y, oth.z, oth.w};
      const int nn = tl & 1023;
      const float pos = (g & 1) ? (float)(nn & 63) : (float)(nn >> 6);
      bf16x8 qr;
#pragma unroll
      for (int e = 0; e < 8; e++) {
        const float a = __uint_as_float((e & 1) ? (ow[e >> 1] & 0xffff0000u) : (ow[e >> 1] << 16));
        const float c = __uint_as_float((e & 1) ? (ot[e >> 1] & 0xffff0000u) : (ot[e >> 1] << 16));
        const float inv = powf(10000.f, -(float)e * 0.125f);
        const float ang = pos * inv;
        const float cs = cosf(ang), sn = sinf(ang);
        const float v = (g < 2) ? (a * cs - c * sn) : (c * sn + a * cs);
        qr[e] = (__bf16)v;
      }
      qf2 = qr;
    }
  }
  float* biasl = (float*)(smem + 2 * BUFSZ);
  if (MODE == 1) {
    for (int i = t; i < 465; i += 256) biasl[i] = p.na_rpb[(size_t)(l * 8 + h) * 465 + i];
  }
  AttnState st;
#pragma unroll 1
  for (int rep = 0; rep < ATT_REP; rep++) {
  if (ATT_REP > 1) asm volatile("" :: "v"(st.o[0][0]), "v"(st.ls));
#pragma unroll
  for (int dt = 0; dt < 4; dt++) st.o[dt] = f32x4{0.f, 0.f, 0.f, 0.f};
  st.mx = -1e30f; st.ls = 0.f;
  const float scale = (MODE >= 2) ? 0.10206207261596575f : 0.125f;
  const int qc = w * 16 + r16;
  const int wlo = min(max(qc - 8, 0), 48);
  const int wstart = min(max(16 * w - 8, 0), 32);
  AttnRegs rg;
  rg.k2 = make_uint4(0, 0, 0, 0);
  {
    const AttnSrc s0 = get_src(0);
    attn_gload<DQK>(s0, rg, t);
    attn_swrite<DQK>(smem, rg, t);
  }
  __syncthreads();
  for (int sidx = 0; sidx < nst; sidx++) {
    { const AttnSrc sn = get_src(min(sidx + 1, nst - 1)); attn_gload<DQK>(sn, rg, t); }
    asm volatile("" ::: "memory"); __builtin_amdgcn_sched_barrier(0);
    const char* buf = smem + (sidx & 1) * BUFSZ;
    if (MODE == 1 && sidx < 8) attn_compute<DQK, 2, true>(buf, qf0, qf1, qf2, st, scale, wstart, biasl + (wr0 + sidx - r + 7) * 31, qc, wlo, tid_);
    else attn_compute<DQK, 4, false>(buf, qf0, qf1, qf2, st, scale, 0, nullptr, 0, 0, tid_);
    asm volatile("" ::: "memory"); __builtin_amdgcn_sched_barrier(0);
    attn_swrite<DQK>(smem + ((sidx + 1) & 1) * BUFSZ, rg, t);
    __syncthreads();
  }
  }
  float lt = st.ls;
  lt += __shfl_xor(lt, 16);
  lt += __shfl_xor(lt, 32);
  const float inv = 1.f / lt;
  u16* Z = (u16*)(p.ws + (MODE < 2 ? O_ZA : O_ZC)) + (size_t)tl * 512 + h * 64 + 4 * g;
#pragma unroll
  for (int dt = 0; dt < 4; dt++) {
    float a, bb, c, d;
    ld4bf(Z + dt * 16, a, bb, c, d);
    st4bf(Z + dt * 16, st.o[dt][0] * inv * a, st.o[dt][1] * inv * bb, st.o[dt][2] * inv * c, st.o[dt][3] * inv * d);
  }
}

DEV void phase_mix(const Params& p, int l, int s, char* smem, const int tid_) {
  const int n_att = 1024;
  const int n_sgu = 256, n_q = 384, n_kv = (s == 0) ? 512 : 640;
  const int total = n_att + n_sgu + n_q + n_kv;
  for (int item = blockIdx.x; item < total; item += gridDim.x) {
    if (item < n_att) {
      if (s == 0) attn_item<0>(p, l, item, smem, tid_); else attn_item<1>(p, l, item, smem, tid_);
    } else if (item < n_att + n_sgu) {
      const int it = item - n_att, chunk = it >> 2, g = it & 3;
      const u16* Wg = (const u16*)(p.ws + O_SGUW) + (size_t)(l * 4 + g) * 128 * 128;
      const u16* V = (const u16*)(p.ws + O_GVT) + ((size_t)chunk * 512 + g * 128) * 128;
      const u16* GU = (const u16*)(p.ws + O_GU); u16* ZB = (u16*)(p.ws + O_ZB);
      f32x16 acc[2][2];
      acc_zero(acc);
      gemm_mainloop(Wg, 128, V, 128, 128, smem, acc, tid_);
      epi_foreach(acc, tid_, [&](int i, int j, float v0, float v1, float v2, float v3) {
        const float bs = p.sgu_b[(l * 4 + g) * 128 + i];
        const size_t off = (size_t)(chunk * 128 + i) * 512 + g * 128 + j;
        float u0, u1, u2, u3, z0, z1, z2, z3;
        ld4bf(GU + off, u0, u1, u2, u3);
        ld4bf(ZB + off, z0, z1, z2, z3);
        st4bf(ZB + off, u0 * (v0 + bs) * z0, u1 * (v1 + bs) * z1, u2 * (v2 + bs) * z2, u3 * (v3 + bs) * z3);
      });
    } else if (item < n_att + n_sgu + n_q) {
      const int it = item - n_att - n_sgu, m = it / 6, n = it % 6;
      const u16* DQ = (const u16*)(p.ws + O_DQ) + (size_t)m * 128 * 384;
      const u16* W = (const u16*)(p.ws + O_WUQ) + (size_t)l * 768 * 384 + (size_t)n * 128 * 384;
      u16* QM = (u16*)(p.ws + O_H);
      f32x16 acc[2][2];
      acc_zero(acc);
      gemm_mainloop(DQ, 384, W, 384, 384, smem, acc, tid_);
      epi_foreach(acc, tid_, [&](int i, int j, float v0, float v1, float v2, float v3) {
        st4bf(QM + (size_t)(m * 128 + i) * 768 + n * 128 + j, v0, v1, v2, v3);
      });
    } else {
      const int it = item - n_att - n_sgu - n_q, m = it >> 3, n = it & 7;
      const u16* C = (const u16*)(p.ws + O_CKV) + (size_t)m * 128 * 256;
      const u16* W = (const u16*)(p.ws + O_WUKV) + (size_t)l * 1024 * 256 + (size_t)n * 128 * 256;
      const bool swapped = n >= 4;
      f32x16 acc[2][2];
      acc_zero(acc);
      gemm_mainloop(swapped ? W : C, 256, swapped ? C : W, 256, 256, smem, acc, tid_);
      if (!swapped) {
        u16* KNOPE = (u16*)(p.ws + O_KNOPE);
        epi_foreach(acc, tid_, [&](int i, int j, float v0, float v1, float v2, float v3) {
          st4bf(KNOPE + (size_t)(m * 128 + i) * 512 + n * 128 + j, v0, v1, v2, v3);
        });
      } else {
        u16* VTM = (u16*)(p.ws + O_VTM);
        const int S = (s == 0) ? 256 : 1280;
        epi_foreach(acc, tid_, [&](int i, int j, float v0, float v1, float v2, float v3) {
          const int ch = (n - 4) * 128 + i, row = m * 128 + j;
          const int b = row / S, mm = row % S;
          st4bf(VTM + ((size_t)b * 512 + ch) * S + mm, v0, v1, v2, v3);
        });
      }
    }
  }
}

DEV void phase_mla(const Params& p, int l, int s, char* smem, const int tid_) {
  for (int item = blockIdx.x; item < 1024; item += gridDim.x) {
    if (s == 0) attn_item<2>(p, l, item, smem, tid_); else attn_item<3>(p, l, item, smem, tid_);
  }
}

DEV void phase_merge(const Params& p, int l, int s, char* smem, const int tid_) {
  const int xcd = blockIdx.x & 7, lb = blockIdx.x >> 3, nb = gridDim.x >> 3;
  const u16* GATES = (const u16*)(p.ws + O_GATES);
  u16* MG = (u16*)(p.ws + O_H);
  const int lane = TIDX & 63, w = TIDX >> 6, wm = w >> 1, wn = w & 1;
  for (int li = lb; li < 128; li += nb) {
    int m, n;
    tile_map(li, 16, xcd, m, n);
    f32x16 macc[2];
#pragma unroll
    for (int b = 0; b < 2; b++)
#pragma unroll
      for (int r = 0; r < 16; r++) macc[b][r] = 0.f;
    const int i = wm * 32 + (lane & 31);
#pragma unroll 1
    for (int k = 0; k < 3; k++) {
      const u16* A = (const u16*)(p.ws + (k == 0 ? O_ZA : (k == 1 ? O_ZB : O_ZC))) + (size_t)m * 64 * 512;
      const u16* W = (const u16*)(p.ws + O_WBR) + (size_t)(l * 3 + k) * 1024 * 512 + (size_t)n * 128 * 512;
      f32x16 acc[2];
#pragma unroll
      for (int b = 0; b < 2; b++)
#pragma unroll
        for (int r = 0; r < 16; r++) acc[b][r] = 0.f;
      gemm_mainloop64(A, 512, W, 512, 512, smem, acc, tid_);
#pragma unroll
      for (int b = 0; b < 2; b++)
#pragma unroll
        for (int rg = 0; rg < 4; rg++) {
          const int j = wn * 64 + b * 32 + rg * 8 + (lane >> 5) * 4;
          float g0, g1, g2, g3;
          ld4bf(GATES + (size_t)(m * 64 + i) * 3072 + k * 1024 + n * 128 + j, g0, g1, g2, g3);
          macc[b][rg * 4 + 0] += g0 * acc[b][rg * 4 + 0];
          macc[b][rg * 4 + 1] += g1 * acc[b][rg * 4 + 1];
          macc[b][rg * 4 + 2] += g2 * acc[b][rg * 4 + 2];
          macc[b][rg * 4 + 3] += g3 * acc[b][rg * 4 + 3];
        }
    }
#pragma unroll
    for (int b = 0; b < 2; b++)
#pragma unroll
      for (int rg = 0; rg < 4; rg++) {
        const int j = wn * 64 + b * 32 + rg * 8 + (lane >> 5) * 4;
        st4bf(MG + (size_t)(m * 64 + i) * 1024 + n * 128 + j, macc[b][rg * 4 + 0], macc[b][rg * 4 + 1], macc[b][rg * 4 + 2], macc[b][rg * 4 + 3]);
      }
  }
}

DEV void phase_out(const Params& p, int l, int s, char* smem, const int tid_) {
  const int xcd = blockIdx.x & 7, lb = blockIdx.x >> 3, nb = gridDim.x >> 3;
  const u16* MG = (const u16*)(p.ws + O_H);
  const float* MOD = (const float*)(p.ws + O_MOD);
  for (int li = lb; li < 64; li += nb) {
    int m, n;
    tile_map(li, 8, xcd, m, n);
    f32x16 acc[2][2];
    acc_zero(acc);
    gemm_mainloop(MG + (size_t)m * 128 * 1024, 1024, (const u16*)(p.ws + O_WOUT) + (size_t)l * 1024 * 1024 + (size_t)n * 128 * 1024, 1024, 1024, smem, acc, tid_);
    epi_foreach(acc, tid_, [&](int i, int j, float v0, float v1, float v2, float v3) {
      const int tl = m * 128 + i, col = n * 128 + j;
      const float4 x = *(const float4*)(xrow_in(p, l, s, tl) + col);
      const float4 g = *(const float4*)(MOD + (size_t)(l * 9 + cond_idx(s, tl)) * 3072 + 2048 + col);
      *(float4*)(p.out + OUT_Y + (size_t)s * 8388608 + (size_t)tl * 1024 + col) =
          make_float4(x.x + g.x * v0, x.y + g.y * v1, x.z + g.z * v2, x.w + g.w * v3);
    });
  }
}

DEV void phase_final(const Params& p, const int tid_) {
  const int lane = TIDX & 63, wave = TIDX >> 6;
  for (int item = blockIdx.x; item < 4096; item += gridDim.x) {
    float* x = p.out + OUT_Y + (size_t)(item * 4 + wave) * 1024;
    float4 v[4];
    float ss = 0.f;
#pragma unroll
    for (int i = 0; i < 4; i++) {
      v[i] = *(const float4*)(x + i * 256 + lane * 4);
      ss += v[i].x * v[i].x + v[i].y * v[i].y + v[i].z * v[i].z + v[i].w * v[i].w;
    }
    ss = wave_sum(ss);
    const float rstd = rsqrtf(ss * (1.f / 1024.f) + 1e-6f);
#pragma unroll
    for (int i = 0; i < 4; i++) {
      const int col = i * 256 + lane * 4;
      const float4 g = *(const float4*)(p.final_g + col);
      *(float4*)(x + col) = make_float4(v[i].x * rstd * g.x, v[i].y * rstd * g.y, v[i].z * rstd * g.z, v[i].w * rstd * g.w);
    }
  }
}

#define XB_TMO      128
#define XB_XCNT(j)  (256  + 64 * (j))
#define XB_XSUB(j)  (1280 + 64 * (j))
#define XB_XGEN(j)  (2304 + 64 * (j))
#define XB_TOP      3328
#define XB_TOPGEN   3392
#define XCD_BAR_WORDS 3456
#define XB_SPIN_CAP (1u << 18)
#define LAS __attribute__((address_space(3)))

__device__ __forceinline__ unsigned xb_ld(unsigned* p)              { return __hip_atomic_load(p, __ATOMIC_RELAXED, __HIP_MEMORY_SCOPE_AGENT); }
__device__ __forceinline__ unsigned xb_add(unsigned* p, unsigned v) { return __hip_atomic_fetch_add(p, v, __ATOMIC_RELAXED, __HIP_MEMORY_SCOPE_AGENT); }
__device__ __forceinline__ unsigned xb_xcc_id() { return (unsigned)__builtin_amdgcn_s_getreg((3 << 11) | 20) & 0xFu; }
#define XB_SPIN(cond, bar) do { unsigned _sp = 0; while (cond) { __builtin_amdgcn_s_sleep(1); \
    if ((++_sp & 255u) == 0u) { if (xb_ld(&(bar)[XB_TMO])) break; if (_sp > XB_SPIN_CAP) { atomicAdd(&(bar)[XB_TMO], 1u); break; } } } } while (0)

struct XcdBarrier {
    unsigned* bar; unsigned x;
    volatile LAS unsigned* st;
};

__device__ __forceinline__ XcdBarrier xcd_barrier_post(unsigned* bar, volatile LAS unsigned* st) {
    XcdBarrier b; b.bar = bar; b.x = xb_xcc_id(); b.st = st;
    if ((int)threadIdx.x == 0) (void)xb_add(&bar[XB_XCNT(b.x)], 1u);
    return b;
}
__device__ __forceinline__ void xcd_barrier_complete(unsigned* bar, unsigned x, unsigned& nloc, unsigned& nx) {
    const unsigned G = gridDim.x * gridDim.y * gridDim.z;
    unsigned sum, cnt, mine, sp = 0u;
    for (;;) {
        sum = 0u; cnt = 0u; mine = 0u;
#pragma unroll
        for (unsigned j = 0; j < 16; ++j) { const unsigned c = xb_ld(&bar[XB_XCNT(j)]); sum += c; cnt += (c > 0u) ? 1u : 0u; mine = (j == x) ? c : mine; }
        if (sum == G) break;
        __builtin_amdgcn_s_sleep(1);
        if ((++sp & 255u) == 0u) { if (xb_ld(&bar[XB_TMO])) break; if (sp > XB_SPIN_CAP) { atomicAdd(&bar[XB_TMO], 1u); break; } }
    }
    nloc = mine > 0u ? mine : 1u; nx = cnt > 0u ? cnt : 1u;
}

__device__ __forceinline__ void xcd_barrier(const XcdBarrier& b) {
    asm volatile("s_waitcnt vmcnt(0)" ::: "memory");
    __syncthreads();
    if ((int)threadIdx.x == 0) {
        unsigned* bar = b.bar;
        __builtin_amdgcn_s_waitcnt(0);
        unsigned nloc = b.st[0], nx = b.st[1];
        if (nloc == 0u) { xcd_barrier_complete(bar, b.x, nloc, nx); b.st[0] = nloc; b.st[1] = nx; }
        const unsigned old = xb_add(&bar[XB_XSUB(b.x)], 1u);
        const unsigned gen = old / nloc;
        if (old + 1u == (gen + 1u) * nloc) {
            __builtin_amdgcn_fence(__ATOMIC_RELEASE, "agent");
            asm volatile("s_waitcnt vmcnt(0)" ::: "memory");
            const unsigned og = xb_add(&bar[XB_TOP], 1u);
            const unsigned tg = og / nx;
            if (og + 1u == (tg + 1u) * nx) xb_add(&bar[XB_TOPGEN], 1u);
            else XB_SPIN(xb_ld(&bar[XB_TOPGEN]) == tg, bar);
            __builtin_amdgcn_fence(__ATOMIC_ACQUIRE, "agent");
            xb_add(&bar[XB_XGEN(b.x)], 1u);
            asm volatile("s_waitcnt vmcnt(0)" ::: "memory");
        } else {
            XB_SPIN(xb_ld(&bar[XB_XGEN(b.x)]) == gen, bar);
            __builtin_amdgcn_fence(__ATOMIC_ACQUIRE, "agent");
            asm volatile("s_waitcnt vmcnt(0)" ::: "memory");
        }
    }
    __syncthreads();
}


DEV void run_phase(const Params& p, int ph, int l, int s, char* smem) {
  const int tid_ = tid_opaque();
  switch (ph) {
    case 0: phase_prep(p, smem, tid_); break;
    case 1: phase_h(p, l, s, tid_); break;
    case 2: phase_in(p, l, s, smem, tid_); break;
    case 3: phase_rows(p, l, s, smem, tid_); break;
    case 4: phase_mix(p, l, s, smem, tid_); break;
    case 5: phase_mla(p, l, s, smem, tid_); break;
    case 6: phase_merge(p, l, s, smem, tid_); break;
    case 7: phase_out(p, l, s, smem, tid_); break;
    default: phase_final(p, tid_); break;
  }
}

__global__ void __launch_bounds__(256, 2) phase_kernel(Params p, int ph, int l, int s) {
  __shared__ __attribute__((aligned(16))) char smem[65536];
  run_phase(p, ph, l, s, smem);
}

__global__ void __launch_bounds__(256, 2) mega_kernel(Params p) {
  __shared__ __attribute__((aligned(16))) char smem[65536];
  __shared__ uint4 xb_words;
  if (threadIdx.x == 0) xb_words = make_uint4(0u, 0u, 0u, 0u);
  __syncthreads();
  XcdBarrier xb = xcd_barrier_post((unsigned*)(p.ws + O_BAR), (volatile LAS unsigned*)&xb_words);
  if (p.ws == nullptr) cg::this_grid().sync();
#pragma unroll 1
  for (int step = 0; step < 30; step++) {
    int ph, l = 0, s = 0;
    if (step == 0) ph = 0;
    else if (step == 29) ph = 8;
    else { const int q = (step - 1) / 7; ph = 1 + (step - 1) % 7; l = q >> 1; s = q & 1; }
    run_phase(p, ph, l, s, smem);
    if (ph == PROBE_DUP || ph == PROBE_DUP2) { xcd_barrier(xb); run_phase(p, ph, l, s, smem); }
    if (PROBE_SYNC) xcd_barrier(xb);
    if (step < 29) xcd_barrier(xb);
  }
}

extern "C" void kernel_launch(void* const* d_in, const int* in_sizes, int n_in, void* d_out, int out_size, void* d_ws, size_t ws_size,
                              hipStream_t stream) {
  Params p{};
  const float** pp = (const float**)&p;
  for (int i = 0; i < 22; i++) pp[i] = (const float*)d_in[i];
  p.out = (float*)d_out;
  p.ws = (char*)d_ws;
#if USE_COOP
  static int grid_blocks = 0;
  if (!grid_blocks) {
    int dev = 0, cus = 0, per_cu = 0;
    hipGetDevice(&dev);
    hipDeviceGetAttribute(&cus, hipDeviceAttributeMultiprocessorCount, dev);
    hipOccupancyMaxActiveBlocksPerMultiprocessor(&per_cu, mega_kernel, 256, 0);
    if (per_cu > 2) per_cu = 2;
    grid_blocks = cus * per_cu;
    grid_blocks &= ~7;
  }
  hipMemsetAsync((char*)d_ws + O_BAR, 0, BAR_BYTES, stream);
  void* args[] = {&p};
  hipError_t e = hipLaunchCooperativeKernel((void*)mega_kernel, dim3(grid_blocks), dim3(256), args, 0, stream);
  if (e != hipSuccess) fprintf(stderr, "cooperative launch failed: %s (grid %d)\n", hipGetErrorString(e), grid_blocks);
#else
  const int G = 512;
  phase_kernel<<<G, 256, 0, stream>>>(p, 0, 0, 0);
  for (int l = 0; l < 2; l++)
    for (int s = 0; s < 2; s++)
      for (int ph = 1; ph <= 7; ph++) phase_kernel<<<G, 256, 0, stream>>>(p, ph, l, s);
  phase_kernel<<<G, 256, 0, stream>>>(p, 8, 0, 0);
#endif
}
```

```cpp
#include <hip/hip_runtime.h>
#include <hip/hip_cooperative_groups.h>
#include <cstdio>
namespace cg = cooperative_groups;

#ifndef PROBE_DUP
#define PROBE_DUP -1
#endif
#ifndef PROBE_DUP2
#define PROBE_DUP2 -1
#endif
#ifndef PROBE_SYNC
#define PROBE_SYNC 0
#endif
#ifndef ATT_REP
#define ATT_REP 1
#endif
#ifndef USE_COOP
#define USE_COOP 1
#endif

typedef unsigned short u16;
typedef __attribute__((ext_vector_type(8))) __bf16 bf16x8;
typedef __attribute__((ext_vector_type(16))) float f32x16;
#define DEV __device__ __forceinline__
__device__ __forceinline__ int tid_opaque() { int t = threadIdx.x; asm volatile("" : "+v"(t)); return t; }
#define TIDX tid_

constexpr size_t A256(size_t x) { return (x + 255) & ~(size_t)255; }
constexpr size_t O_WIN = 0;
constexpr size_t O_WUQ = O_WIN + A256(2ull * 7936 * 1024 * 2);
constexpr size_t O_WUKV = O_WUQ + A256(2ull * 768 * 384 * 2);
constexpr size_t O_WBR = O_WUKV + A256(2ull * 1024 * 256 * 2);
constexpr size_t O_WOUT = O_WBR + A256(2ull * 3 * 1024 * 512 * 2);
constexpr size_t O_SGUW = O_WOUT + A256(2ull * 1024 * 1024 * 2);
constexpr size_t O_KC = O_SGUW + A256(2ull * 4 * 128 * 128 * 2);
constexpr size_t O_VTC = O_KC + A256(2ull * 8 * 256 * 512 * 2);
constexpr size_t O_MOD = O_VTC + A256(2ull * 8 * 256 * 512 * 2);
constexpr size_t O_H = O_MOD + A256(2ull * 9 * 3072 * 4);
constexpr size_t O_QNA = O_H + A256(8192ull * 1024 * 2);
constexpr size_t O_KNA = O_QNA + A256(8192ull * 512 * 2);
constexpr size_t O_VTNA = O_KNA + A256(8192ull * 512 * 2);
constexpr size_t O_ZA = O_VTNA + A256(8192ull * 512 * 2);
constexpr size_t O_ZB = O_ZA + A256(8192ull * 512 * 2);
constexpr size_t O_ZC = O_ZB + A256(8192ull * 512 * 2);
constexpr size_t O_GU = O_ZC + A256(8192ull * 512 * 2);
constexpr size_t O_GVT = O_GU + A256(8192ull * 512 * 2);
constexpr size_t O_DQ = O_GVT + A256(8192ull * 512 * 2);
constexpr size_t O_DKV = O_DQ + A256(8192ull * 384 * 2);
constexpr size_t O_KRF = O_DKV + A256(8192ull * 256 * 2);
constexpr size_t O_GATES = O_KRF + A256(8192ull * 32 * 4);
constexpr size_t O_CKV = O_GATES + A256(8192ull * 3072 * 2);
constexpr size_t O_KR = O_CKV + A256(10240ull * 256 * 2);
constexpr size_t O_KNOPE = O_KR + A256(10240ull * 32 * 2);
constexpr size_t O_VTM = O_KNOPE + A256(10240ull * 512 * 2);
constexpr size_t O_END = O_VTM + A256(10240ull * 512 * 2);
constexpr size_t O_DQN = O_END;
constexpr size_t O_BAR = O_DQN + A256(8192ull * 384 * 2);
constexpr size_t BAR_BYTES = 16384;
static_assert(O_BAR + BAR_BYTES <= 256ull * 1024 * 1024, "workspace too large");

constexpr size_t OUT_Y = 0;
constexpr size_t OUT_SK = 16777216;
constexpr size_t OUT_SV = 25165824;
constexpr size_t OUT_CKV = 33554432;
constexpr size_t OUT_SKR = 37748736;

struct Params {
  const float *x_prompt, *x_sample, *cache_na_k, *cache_na_v, *cache_ckv, *cache_kr, *c, *c_ctx;
  const float *norm_g, *w_mod, *b_mod, *w_in, *na_rpb, *sgu_w, *sgu_b, *q_norm, *w_uq, *kv_norm, *w_ukv, *w_branch, *w_out, *final_g;
  float* out;
  char* ws;
};

DEV u16 f2bf(float f) { unsigned u = __float_as_uint(f); u += 0x7fffu + ((u >> 16) & 1u); return (u16)(u >> 16); }
DEV float bf2f(u16 h) { return __uint_as_float(((unsigned)h) << 16); }
typedef __attribute__((ext_vector_type(2))) __bf16 bf16x2;
DEV unsigned pack2(float a, float b) { bf16x2 v; v[0] = (__bf16)a; v[1] = (__bf16)b; return __builtin_bit_cast(unsigned, v); }
DEV void st4bf(u16* p, float a, float b, float c, float d) { uint2 v; v.x = pack2(a, b); v.y = pack2(c, d); *(uint2*)p = v; }
DEV void ld4bf(const u16* p, float& a, float& b, float& c, float& d) {
  uint2 v = *(const uint2*)p;
  a = __uint_as_float(v.x << 16); b = __uint_as_float(v.x & 0xffff0000u);
  c = __uint_as_float(v.y << 16); d = __uint_as_float(v.y & 0xffff0000u);
}
DEV float wave_sum(float v) {
#pragma unroll
  for (int o = 32; o > 0; o >>= 1) v += __shfl_xor(v, o);
  return v;
}
DEV float sigmoid_f(float x) { return 1.f / (1.f + __expf(-x)); }
DEV float silu_f(float x) { return x / (1.f + __expf(-x)); }
DEV float gelu_f(float x) { float u = 0.7978845608028654f * (x + 0.044715f * x * x * x); return x / (1.f + __expf(-2.f * u)); }

DEV void gemm_mainloop(const u16* P, int ldp, const u16* Q, int ldq, int K, char* smem, f32x16 (&acc)[2][2], const int tid_) {
  const int t = TIDX, lane = t & 63, w = t >> 6, wm = w >> 1, wn = w & 1;
  const int lr = t >> 3, ch = t & 7;
  const u16* pg = P + (size_t)lr * ldp + ch * 8;
  const u16* qg = Q + (size_t)lr * ldq + ch * 8;
  const size_t sp = (size_t)32 * ldp, sq = (size_t)32 * ldq;
  const int soff = lr * 128 + ((ch ^ ((t >> 4) & 7)) << 4);
  const int sw = (lane >> 1) & 7;
  const int prow = (wm * 64 + (lane & 31)) * 128;
  const int qrow = (wn * 64 + (lane & 31)) * 128;
  uint4 a0, a1, a2, a3, a4, a5, a6, a7, b0, b1, b2, b3, b4, b5, b6, b7;
#define GLOAD_A(k0) do { a0 = *(const uint4*)(pg + (k0)); a1 = *(const uint4*)(pg + sp + (k0)); a2 = *(const uint4*)(pg + 2 * sp + (k0)); a3 = *(const uint4*)(pg + 3 * sp + (k0)); \
                         a4 = *(const uint4*)(qg + (k0)); a5 = *(const uint4*)(qg + sq + (k0)); a6 = *(const uint4*)(qg + 2 * sq + (k0)); a7 = *(const uint4*)(qg + 3 * sq + (k0)); } while (0)
#define GLOAD_B(k0) do { b0 = *(const uint4*)(pg + (k0)); b1 = *(const uint4*)(pg + sp + (k0)); b2 = *(const uint4*)(pg + 2 * sp + (k0)); b3 = *(const uint4*)(pg + 3 * sp + (k0)); \
                         b4 = *(const uint4*)(qg + (k0)); b5 = *(const uint4*)(qg + sq + (k0)); b6 = *(const uint4*)(qg + 2 * sq + (k0)); b7 = *(const uint4*)(qg + 3 * sq + (k0)); } while (0)
#define SWRITE_A(base) do { char* b_ = (base) + soff; *(uint4*)(b_) = a0; *(uint4*)(b_ + 4096) = a1; *(uint4*)(b_ + 8192) = a2; *(uint4*)(b_ + 12288) = a3; \
                            *(uint4*)(b_ + 16384) = a4; *(uint4*)(b_ + 20480) = a5; *(uint4*)(b_ + 24576) = a6; *(uint4*)(b_ + 28672) = a7; } while (0)
#define SWRITE_B(base) do { char* b_ = (base) + soff; *(uint4*)(b_) = b0; *(uint4*)(b_ + 4096) = b1; *(uint4*)(b_ + 8192) = b2; *(uint4*)(b_ + 12288) = b3; \
                            *(uint4*)(b_ + 16384) = b4; *(uint4*)(b_ + 20480) = b5; *(uint4*)(b_ + 24576) = b6; *(uint4*)(b_ + 28672) = b7; } while (0)
#define COMPUTE(base) do { const char* bP = (base); const char* bQ = bP + 16384; \
    _Pragma("unroll") for (int s = 0; s < 4; s++) { \
      const int co = ((s * 2 + (lane >> 5)) ^ sw) << 4; \
      const bf16x8 pf0 = *(const bf16x8*)(bP + prow + co), pf1 = *(const bf16x8*)(bP + prow + 4096 + co); \
      const bf16x8 qf0 = *(const bf16x8*)(bQ + qrow + co), qf1 = *(const bf16x8*)(bQ + qrow + 4096 + co); \
      acc[0][0] = __builtin_amdgcn_mfma_f32_32x32x16_bf16(qf0, pf0, acc[0][0], 0, 0, 0); \
      acc[0][1] = __builtin_amdgcn_mfma_f32_32x32x16_bf16(qf1, pf0, acc[0][1], 0, 0, 0); \
      acc[1][0] = __builtin_amdgcn_mfma_f32_32x32x16_bf16(qf0, pf1, acc[1][0], 0, 0, 0); \
      acc[1][1] = __builtin_amdgcn_mfma_f32_32x32x16_bf16(qf1, pf1, acc[1][1], 0, 0, 0); } } while (0)
#define PIN() do { asm volatile("" ::: "memory"); __builtin_amdgcn_sched_barrier(0); } while (0)
  const int nk = K >> 6;
  GLOAD_A(0);
  SWRITE_A(smem);
  GLOAD_A(64);
  __syncthreads();
  for (int kt = 0; kt < nk; kt += 2) {
    GLOAD_B(min(kt + 2, nk - 1) << 6);
    PIN();
    COMPUTE(smem);
    PIN();
    SWRITE_A(smem + 32768);
    __syncthreads();
    GLOAD_A(min(kt + 3, nk - 1) << 6);
    PIN();
    COMPUTE(smem + 32768);
    PIN();
    SWRITE_B(smem);
    __syncthreads();
  }
#undef GLOAD_A
#undef GLOAD_B
#undef SWRITE_A
#undef SWRITE_B
#undef COMPUTE
}

DEV void gemm_mainloop64(const u16* P, int ldp, const u16* Q, int ldq, int K, char* smem, f32x16 (&acc)[2], const int tid_) {
  const int t = TIDX, lane = t & 63, w = t >> 6, wm = w >> 1, wn = w & 1;
  const int lr = t >> 3, ch = t & 7;
  const u16* pg = P + (size_t)lr * ldp + ch * 8;
  const u16* qg = Q + (size_t)lr * ldq + ch * 8;
  const size_t sp = (size_t)32 * ldp, sq = (size_t)32 * ldq;
  const int soff = lr * 128 + ((ch ^ ((t >> 4) & 7)) << 4);
  const int sw = (lane >> 1) & 7;
  const int prow = (wm * 32 + (lane & 31)) * 128;
  const int qrow = (wn * 64 + (lane & 31)) * 128;
  uint4 a0, a1, a4, a5, a6, a7, b0, b1, b4, b5, b6, b7;
#define GLOAD_A(k0) do { a0 = *(const uint4*)(pg + (k0)); a1 = *(const uint4*)(pg + sp + (k0)); \
                         a4 = *(const uint4*)(qg + (k0)); a5 = *(const uint4*)(qg + sq + (k0)); a6 = *(const uint4*)(qg + 2 * sq + (k0)); a7 = *(const uint4*)(qg + 3 * sq + (k0)); } while (0)
#define GLOAD_B(k0) do { b0 = *(const uint4*)(pg + (k0)); b1 = *(const uint4*)(pg + sp + (k0)); \
                         b4 = *(const uint4*)(qg + (k0)); b5 = *(const uint4*)(qg + sq + (k0)); b6 = *(const uint4*)(qg + 2 * sq + (k0)); b7 = *(const uint4*)(qg + 3 * sq + (k0)); } while (0)
#define SWRITE_A(base) do { char* b_ = (base) + soff; *(uint4*)(b_) = a0; *(uint4*)(b_ + 4096) = a1; \
                            *(uint4*)(b_ + 16384) = a4; *(uint4*)(b_ + 20480) = a5; *(uint4*)(b_ + 24576) = a6; *(uint4*)(b_ + 28672) = a7; } while (0)
#define SWRITE_B(base) do { char* b_ = (base) + soff; *(uint4*)(b_) = b0; *(uint4*)(b_ + 4096) = b1; \
                            *(uint4*)(b_ + 16384) = b4; *(uint4*)(b_ + 20480) = b5; *(uint4*)(b_ + 24576) = b6; *(uint4*)(b_ + 28672) = b7; } while (0)
#define COMPUTE(base) do { const char* bP = (base); const char* bQ = bP + 16384; \
    _Pragma("unroll") for (int s = 0; s < 4; s++) { \
      const int co = ((s * 2 + (lane >> 5)) ^ sw) << 4; \
      const bf16x8 pf0 = *(const bf16x8*)(bP + prow + co); \
      const bf16x8 qf0 = *(const bf16x8*)(bQ + qrow + co), qf1 = *(const bf16x8*)(bQ + qrow + 4096 + co); \
      acc[0] = __builtin_amdgcn_mfma_f32_32x32x16_bf16(qf0, pf0, acc[0], 0, 0, 0); \
      acc[1] = __builtin_amdgcn_mfma_f32_32x32x16_bf16(qf1, pf0, acc[1], 0, 0, 0); } } while (0)
  const int nk = K >> 6;
  GLOAD_A(0);
  SWRITE_A(smem);
  GLOAD_A(64);
  __syncthreads();
  for (int kt = 0; kt < nk; kt += 2) {
    GLOAD_B(min(kt + 2, nk - 1) << 6);
    PIN();
    COMPUTE(smem);
    PIN();
    SWRITE_A(smem + 32768);
    __syncthreads();
    GLOAD_A(min(kt + 3, nk - 1) << 6);
    PIN();
    COMPUTE(smem + 32768);
    PIN();
    SWRITE_B(smem);
    __syncthreads();
  }
#undef GLOAD_A
#undef GLOAD_B
#undef SWRITE_A
#undef SWRITE_B
#undef COMPUTE
#undef PIN
}

DEV void acc_zero(f32x16 (&acc)[2][2]) {
#pragma unroll
  for (int a = 0; a < 2; a++)
#pragma unroll
    for (int b = 0; b < 2; b++)
#pragma unroll
      for (int r = 0; r < 16; r++) acc[a][b][r] = 0.f;
}

template <class F>
DEV void epi_foreach(const f32x16 (&acc)[2][2], const int tid_, F f) {
  const int lane = TIDX & 63, w = TIDX >> 6, wm = w >> 1, wn = w & 1;
#pragma unroll
  for (int a = 0; a < 2; a++)
#pragma unroll
    for (int b = 0; b < 2; b++)
#pragma unroll
      for (int rg = 0; rg < 4; rg++) {
        const int i = wm * 64 + a * 32 + (lane & 31);
        const int j = wn * 64 + b * 32 + rg * 8 + (lane >> 5) * 4;
        f(i, j, acc[a][b][rg * 4 + 0], acc[a][b][rg * 4 + 1], acc[a][b][rg * 4 + 2], acc[a][b][rg * 4 + 3]);
      }
}

DEV void tile_map(int li, int MPX, int xcd, int& m, int& n) {
  const int g = MPX * 8;
  const int ng = li / g, wv = li % g;
  m = xcd * MPX + (wv % MPX);
  n = ng * 8 + (wv / MPX);
}

DEV void tconv_tile(const float* __restrict__ src, int ldsrc, int k0, int n0, u16* __restrict__ dst, int lddst, int drow0, float* tile, const int tid_) {
  const int t = TIDX;
  {
    const int n = t & 31, kk = t >> 5;
#pragma unroll
    for (int p = 0; p < 16; p++) {
      const int k = kk + p * 8;
      tile[k * 33 + n] = src[(size_t)(k0 + k) * ldsrc + n0 + n];
    }
  }
  __syncthreads();
  {
    const int k2 = (t & 63) * 2, nn = t >> 6;
#pragma unroll
    for (int p = 0; p < 8; p++) {
      const int n2 = nn + p * 4;
      *(unsigned*)(dst + (size_t)(drow0 + n2) * lddst + k0 + k2) = pack2(tile[k2 * 33 + n2], tile[(k2 + 1) * 33 + n2]);
    }
  }
  __syncthreads();
}

DEV void phase_prep(const Params& p, char* smem, const int tid_) {
  const int t = TIDX;
  constexpr int N_MOD = 192;
  constexpr int T_IN = 1960, T_UQ = 72, T_UKV = 64, T_BR = 384, T_OUT = 256, T_CV = 256;
  constexpr int T_L = T_IN + T_UQ + T_UKV + T_BR + T_OUT + T_CV;
  constexpr int N_TC = 2 * T_L;
  constexpr int N_SG = 64, N_KC = 1024;
  constexpr int TOTAL = N_MOD + N_TC + N_SG + N_KC;
  float* MOD = (float*)(p.ws + O_MOD);
  for (int item = blockIdx.x; item < TOTAL; item += gridDim.x) {
    if (item < N_MOD) {
      const int l = item / 96, e0 = (item % 96) * 32;
      float* sc = (float*)smem;
      for (int idx = t; idx < 9216; idx += 256) {
        const int c9 = idx >> 10, d = idx & 1023;
        const float v = (c9 == 0) ? p.c_ctx[d] : p.c[(c9 - 1) * 1024 + d];
        sc[idx] = silu_f(v);
      }
      __syncthreads();
      const int col = t & 31, slab = t >> 5;
      float a[9];
#pragma unroll
      for (int c9 = 0; c9 < 9; c9++) a[c9] = 0.f;
      const float* wp = p.w_mod + ((size_t)l * 1024 + slab * 128) * 3072 + e0 + col;
#pragma unroll 4
      for (int dd = 0; dd < 128; dd++) {
        const float wv = wp[(size_t)dd * 3072];
        const int d = slab * 128 + dd;
#pragma unroll
        for (int c9 = 0; c9 < 9; c9++) a[c9] += sc[c9 * 1024 + d] * wv;
      }
      float* red = sc + 9216;
#pragma unroll
      for (int c9 = 0; c9 < 9; c9++) red[(slab * 9 + c9) * 32 + col] = a[c9];
      __syncthreads();
      for (int idx = t; idx < 288; idx += 256) {
        const int c9 = idx >> 5, cc = idx & 31;
        float sum = 0.f;
#pragma unroll
        for (int sl = 0; sl < 8; sl++) sum += red[(sl * 9 + c9) * 32 + cc];
        MOD[(l * 9 + c9) * 3072 + e0 + cc] = sum + p.b_mod[l * 3072 + e0 + cc];
      }
      __syncthreads();
    } else if (item < N_MOD + N_TC) {
      const int ti = item - N_MOD;
      const int l = ti / T_L;
      int r = ti % T_L;
      const float* src; u16* dst; int ldsrc, lddst, k0, n0, drow;
      if (r < T_IN) {
        const int nt = r >> 3, kt = r & 7;
        src = p.w_in + (size_t)l * 1024 * 7840; ldsrc = 7840; k0 = kt * 128; n0 = nt * 32;
        dst = (u16*)(p.ws + O_WIN) + (size_t)l * 7936 * 1024; lddst = 1024;
        drow = (n0 < 4224) ? n0 : (n0 == 4224 ? 7808 : n0 - 32);
      } else if ((r -= T_IN) < T_UQ) {
        const int nt = r / 3, kt = r % 3;
        src = p.w_uq + (size_t)l * 384 * 768; ldsrc = 768; k0 = kt * 128; n0 = nt * 32;
        dst = (u16*)(p.ws + O_WUQ) + (size_t)l * 768 * 384; lddst = 384; drow = n0;
      } else if ((r -= T_UQ) < T_UKV) {
        const int nt = r >> 1, kt = r & 1;
        src = p.w_ukv + (size_t)l * 256 * 1024; ldsrc = 1024; k0 = kt * 128; n0 = nt * 32;
        dst = (u16*)(p.ws + O_WUKV) + (size_t)l * 1024 * 256; lddst = 256;
        const int hh = n0 >> 7, jj = n0 & 127;
        drow = (jj < 64) ? (hh * 64 + jj) : (512 + hh * 64 + jj - 64);
      } else if ((r -= T_UKV) < T_BR) {
        const int kb = r >> 7, r2 = r & 127;
        const int nt = r2 >> 2, kt = r2 & 3;
        src = p.w_branch + (size_t)(l * 3 + kb) * 512 * 1024; ldsrc = 1024; k0 = kt * 128; n0 = nt * 32;
        dst = (u16*)(p.ws + O_WBR) + (size_t)(l * 3 + kb) * 1024 * 512; lddst = 512; drow = n0;
      } else if ((r -= T_BR) < T_OUT) {
        const int nt = r >> 3, kt = r & 7;
        src = p.w_out + (size_t)l * 1024 * 1024; ldsrc = 1024; k0 = kt * 128; n0 = nt * 32;
        dst = (u16*)(p.ws + O_WOUT) + (size_t)l * 1024 * 1024; lddst = 1024; drow = n0;
      } else {
        r -= T_OUT;
        const int b = r >> 5, r2 = r & 31;
        const int nt = r2 >> 1, kt = r2 & 1;
        src = p.cache_na_v + (size_t)(b * 2 + l) * 256 * 512; ldsrc = 512; k0 = kt * 128; n0 = nt * 32;
        dst = (u16*)(p.ws + O_VTC) + (size_t)(l * 8 + b) * 512 * 256; lddst = 256; drow = n0;
      }
      tconv_tile(src, ldsrc, k0, n0, dst, lddst, drow, (float*)smem, tid_);
    } else if (item < N_MOD + N_TC + N_SG) {
      const int it = item - N_MOD - N_TC;
      const size_t e = (size_t)it * 2048 + t * 8;
      const float4 a = *(const float4*)(p.sgu_w + e), b = *(const float4*)(p.sgu_w + e + 4);
      u16* d = (u16*)(p.ws + O_SGUW) + e;
      st4bf(d, a.x, a.y, a.z, a.w); st4bf(d + 4, b.x, b.y, b.z, b.w);
    } else {
      const int it = item - N_MOD - N_TC - N_SG;
      const size_t e = (size_t)it * 2048 + t * 8;
      const int l = (int)(e >> 20), b = (int)(e >> 17) & 7; const size_t rest = e & 131071;
      const float* s = p.cache_na_k + ((size_t)(b * 2 + l) << 17) + rest;
      const float4 a = *(const float4*)s, bb = *(const float4*)(s + 4);
      u16* d = (u16*)(p.ws + O_KC) + e;
      st4bf(d, a.x, a.y, a.z, a.w); st4bf(d + 4, bb.x, bb.y, bb.z, bb.w);
    }
  }
}

DEV const float* xrow_in(const Params& p, int l, int s, int tl) {
  if (l == 0) return (s == 0 ? p.x_prompt : p.x_sample) + (size_t)tl * 1024;
  return p.out + OUT_Y + (size_t)s * 8388608 + (size_t)tl * 1024;
}
DEV int cond_idx(int s, int tl) { return s == 0 ? 0 : 1 + (tl >> 10); }

DEV void phase_h(const Params& p, int l, int s, const int tid_) {
  const int lane = TIDX & 63, wave = TIDX >> 6;
  u16* H = (u16*)(p.ws + O_H);
  const float* MOD = (const float*)(p.ws + O_MOD);
  for (int item = blockIdx.x; item < 2048; item += gridDim.x) {
    const int tl = item * 4 + wave;
    const float* x = xrow_in(p, l, s, tl);
    const float* mod = MOD + (size_t)(l * 9 + cond_idx(s, tl)) * 3072;
    float4 v[4];
    float ss = 0.f;
#pragma unroll
    for (int i = 0; i < 4; i++) {
      v[i] = *(const float4*)(x + i * 256 + lane * 4);
      ss += v[i].x * v[i].x + v[i].y * v[i].y + v[i].z * v[i].z + v[i].w * v[i].w;
    }
    ss = wave_sum(ss);
    const float rstd = rsqrtf(ss * (1.f / 1024.f) + 1e-6f);
#pragma unroll
    for (int i = 0; i < 4; i++) {
      const int col = i * 256 + lane * 4;
      const float4 g = *(const float4*)(p.norm_g + l * 1024 + col);
      const float4 sh = *(const float4*)(mod + col);
      const float4 sc = *(const float4*)(mod + 1024 + col);
      st4bf(H + (size_t)tl * 1024 + col, v[i].x * rstd * g.x * (1.f + sc.x) + sh.x, v[i].y * rstd * g.y * (1.f + sc.y) + sh.y,
            v[i].z * rstd * g.z * (1.f + sc.z) + sh.z, v[i].w * rstd * g.w * (1.f + sc.w) + sh.w);
    }
  }
}

DEV void phase_in(const Params& p, int l, int s, char* smem, const int tid_, const int vid_) {
  const int nb = gridDim.x >> 3, xcd = vid_ / nb, lb = vid_ % nb;
  const u16* H = (const u16*)(p.ws + O_H);
  const u16* W = (const u16*)(p.ws + O_WIN) + (size_t)l * 7936 * 1024;
  u16* QNA = (u16*)(p.ws + O_QNA); u16* KNA = (u16*)(p.ws + O_KNA); u16* VTNA = (u16*)(p.ws + O_VTNA);
  u16* ZA = (u16*)(p.ws + O_ZA); u16* ZB = (u16*)(p.ws + O_ZB); u16* ZC = (u16*)(p.ws + O_ZC);
  u16* GU = (u16*)(p.ws + O_GU); u16* GVT = (u16*)(p.ws + O_GVT);
  u16* DQ = (u16*)(p.ws + O_DQ); u16* DKV = (u16*)(p.ws + O_DKV); float* KRF = (float*)(p.ws + O_KRF);
  u16* GATES = (u16*)(p.ws + O_GATES);
  float* out = p.out;
  for (int li = lb; li < 8 * 62; li += nb) {
    int m, n;
    tile_map(li, 8, xcd, m, n);
    const int m0 = m * 128, n0 = n * 128;
    const bool swapped = (n >= 8 && n < 12) || (n >= 20 && n < 24);
    const u16* Hm = H + (size_t)m0 * 1024;
    const u16* Wn = W + (size_t)n0 * 1024;
    f32x16 acc[2][2];
    acc_zero(acc);
    gemm_mainloop(swapped ? Wn : Hm, 1024, swapped ? Hm : Wn, 1024, 1024, smem, acc, tid_);
    if (n < 4) {
      epi_foreach(acc, tid_, [&](int i, int j, float v0, float v1, float v2, float v3) {
        st4bf(QNA + (size_t)(m0 + i) * 512 + n0 + j, v0, v1, v2, v3);
      });
    } else if (n < 8) {
      epi_foreach(acc, tid_, [&](int i, int j, float v0, float v1, float v2, float v3) {
        const int T = m0 + i, col = n0 - 512 + j;
        st4bf(KNA + (size_t)T * 512 + col, v0, v1, v2, v3);
        if (s == 0) {
          const int b = T >> 8, sq = T & 255;
          *(float4*)(out + OUT_SK + ((size_t)(b * 2 + l) * 256 + sq) * 512 + col) = make_float4(v0, v1, v2, v3);
        }
      });
    } else if (n < 12) {
      epi_foreach(acc, tid_, [&](int i, int j, float v0, float v1, float v2, float v3) {
        const int dva = n0 - 1024 + i, tok = m0 + j;
        if (s == 0) {
          const int b = tok >> 8, sq = tok & 255;
          st4bf(VTNA + ((size_t)(b * 512 + dva)) * 256 + sq, v0, v1, v2, v3);
          float* o = out + OUT_SV + ((size_t)(b * 2 + l) * 256 + sq) * 512 + dva;
          o[0] = v0; o[512] = v1; o[1024] = v2; o[1536] = v3;
        } else {
          const int b = tok >> 10, nn = tok & 1023;
          st4bf(VTNA + ((size_t)(b * 512 + dva)) * 1024 + nn, v0, v1, v2, v3);
        }
      });
    } else if (n < 16) {
      epi_foreach(acc, tid_, [&](int i, int j, float v0, float v1, float v2, float v3) {
        st4bf(ZA + (size_t)(m0 + i) * 512 + n0 - 1536 + j, silu_f(v0), silu_f(v1), silu_f(v2), silu_f(v3));
      });
    } else if (n < 20) {
      epi_foreach(acc, tid_, [&](int i, int j, float v0, float v1, float v2, float v3) {
        st4bf(GU + (size_t)(m0 + i) * 512 + n0 - 2048 + j, gelu_f(v0), gelu_f(v1), gelu_f(v2), gelu_f(v3));
      });
    } else if (n < 24) {
      epi_foreach(acc, tid_, [&](int i, int j, float v0, float v1, float v2, float v3) {
        const int c = n0 - 2560 + i, tok = m0 + j;
        const int chunk = tok >> 7, q = tok & 127;
        st4bf(GVT + ((size_t)chunk * 512 + c) * 128 + q, gelu_f(v0), gelu_f(v1), gelu_f(v2), gelu_f(v3));
      });
    } else if (n < 28) {
      epi_foreach(acc, tid_, [&](int i, int j, float v0, float v1, float v2, float v3) {
        st4bf(ZB + (size_t)(m0 + i) * 512 + n0 - 3072 + j, silu_f(v0), silu_f(v1), silu_f(v2), silu_f(v3));
      });
    } else if (n < 31) {
      epi_foreach(acc, tid_, [&](int i, int j, float v0, float v1, float v2, float v3) {
        st4bf(DQ + (size_t)(m0 + i) * 384 + n0 - 3584 + j, v0, v1, v2, v3);
      });
    } else if (n < 33) {
      epi_foreach(acc, tid_, [&](int i, int j, float v0, float v1, float v2, float v3) {
        st4bf(DKV + (size_t)(m0 + i) * 256 + n0 - 3968 + j, v0, v1, v2, v3);
      });
    } else if (n < 37) {
      epi_foreach(acc, tid_, [&](int i, int j, float v0, float v1, float v2, float v3) {
        st4bf(ZC + (size_t)(m0 + i) * 512 + n0 - 4224 + j, silu_f(v0), silu_f(v1), silu_f(v2), silu_f(v3));
      });
    } else if (n < 61) {
      epi_foreach(acc, tid_, [&](int i, int j, float v0, float v1, float v2, float v3) {
        st4bf(GATES + (size_t)(m0 + i) * 3072 + n0 - 4736 + j, sigmoid_f(v0), sigmoid_f(v1), sigmoid_f(v2), sigmoid_f(v3));
      });
    } else {
      epi_foreach(acc, tid_, [&](int i, int j, float v0, float v1, float v2, float v3) {
        if (j < 32) {
          const int T = m0 + i;
          *(float4*)(KRF + (size_t)T * 32 + j) = make_float4(v0, v1, v2, v3);
          if (s == 0) {
            const int b = T >> 8, sq = T & 255;
            *(float4*)(out + OUT_SKR + ((size_t)(b * 2 + l) * 256 + sq) * 32 + j) = make_float4(v0, v1, v2, v3);
          }
        }
      });
    }
  }
}

DEV void phase_rows(const Params& p, int l, int s, char* smem, const int tid_) {
  const int t = TIDX, lane = t & 63, wave = t >> 6;
  const u16* DQ = (const u16*)(p.ws + O_DQ); const u16* DKV = (const u16*)(p.ws + O_DKV); const float* KRF = (const float*)(p.ws + O_KRF);
  u16* CKV = (u16*)(p.ws + O_CKV); u16* KR = (u16*)(p.ws + O_KR); u16* GVT = (u16*)(p.ws + O_GVT);
  const int n_row = 2048, n_ln = 256, n_cache = (s == 1) ? 512 : 0;
  const int total = n_row + n_ln + n_cache;
  for (int item = blockIdx.x; item < total; item += gridDim.x) {
    if (item < n_row) {
      const int tl = item * 4 + wave;
      {
        const u16* r = DQ + (size_t)tl * 384;
        u16* ro = (u16*)(p.ws + O_DQN) + (size_t)tl * 384;
        float v[6]; float ss = 0.f;
#pragma unroll
        for (int i = 0; i < 6; i++) { v[i] = bf2f(r[i * 64 + lane]); ss += v[i] * v[i]; }
        ss = wave_sum(ss);
        const float rstd = rsqrtf(ss * (1.f / 384.f) + 1e-6f);
#pragma unroll
        for (int i = 0; i < 6; i++) ro[i * 64 + lane] = f2bf(v[i] * rstd * p.q_norm[l * 384 + i * 64 + lane]);
      }
      {
        float a, b, c, d;
        ld4bf(DKV + (size_t)tl * 256 + lane * 4, a, b, c, d);
        float ss = wave_sum(a * a + b * b + c * c + d * d);
        const float rstd = rsqrtf(ss * (1.f / 256.f) + 1e-6f);
        const float4 g = *(const float4*)(p.kv_norm + l * 256 + lane * 4);
        a *= rstd * g.x; b *= rstd * g.y; c *= rstd * g.z; d *= rstd * g.w;
        const int row = (s == 0) ? tl : ((tl >> 10) * 1280 + 256 + (tl & 1023));
        st4bf(CKV + (size_t)row * 256 + lane * 4, a, b, c, d);
        if (s == 0) {
          const int bb = tl >> 8, sq = tl & 255;
          *(float4*)(p.out + OUT_CKV + ((size_t)(bb * 2 + l) * 256 + sq) * 256 + lane * 4) = make_float4(a, b, c, d);
        }
      }
      if (lane < 16) {
        const float x1 = KRF[(size_t)tl * 32 + lane], x2 = KRF[(size_t)tl * 32 + 16 + lane];
        if (s == 0) {
          KR[(size_t)tl * 32 + lane] = f2bf(x1);
          KR[(size_t)tl * 32 + 16 + lane] = f2bf(x2);
        } else {
          const int nn = tl & 1023;
          const float pos = (lane < 8) ? (float)(nn >> 6) : (float)(nn & 63);
          const float inv = powf(10000.f, -(float)(lane & 7) * 0.125f);
          const float ang = pos * inv;
          const float cs = cosf(ang), sn = sinf(ang);
          const int row = (tl >> 10) * 1280 + 256 + nn;
          KR[(size_t)row * 32 + lane] = f2bf(x1 * cs - x2 * sn);
          KR[(size_t)row * 32 + 16 + lane] = f2bf(x1 * sn + x2 * cs);
        }
      }
    } else if (item < n_row + n_ln) {
      const int it = item - n_row, chunk = it >> 2, slab = it & 3;
      u16* g = GVT + (size_t)chunk * 512 * 128 + slab * 32;
      const int q = t & 31, part = t >> 5;
      float v[64];
      float sum = 0.f, sq = 0.f;
#pragma unroll
      for (int c = 0; c < 64; c++) { v[c] = bf2f(g[(part * 64 + c) * 128 + q]); sum += v[c]; sq += v[c] * v[c]; }
      float* red = (float*)smem;
      red[(part * 2 + 0) * 32 + q] = sum; red[(part * 2 + 1) * 32 + q] = sq;
      __syncthreads();
      sum = 0.f; sq = 0.f;
#pragma unroll
      for (int pp = 0; pp < 8; pp++) { sum += red[(pp * 2 + 0) * 32 + q]; sq += red[(pp * 2 + 1) * 32 + q]; }
      const float mu = sum * (1.f / 512.f);
      const float var = fmaxf(sq * (1.f / 512.f) - mu * mu, 0.f);
      const float rstd = rsqrtf(var + 1e-6f);
#pragma unroll
      for (int c = 0; c < 64; c++) g[(part * 64 + c) * 128 + q] = f2bf((v[c] - mu) * rstd);
      __syncthreads();
    } else {
      const int rowi = (item - n_row - n_ln) * 4 + wave;
      const int b = rowi >> 8, m = rowi & 255;
      const float4 a = *(const float4*)(p.cache_ckv + ((size_t)(b * 2 + l) * 256 + m) * 256 + lane * 4);
      st4bf(CKV + (size_t)(b * 1280 + m) * 256 + lane * 4, a.x, a.y, a.z, a.w);
      if (lane < 32) KR[(size_t)(b * 1280 + m) * 32 + lane] = f2bf(p.cache_kr[((size_t)(b * 2 + l) * 256 + m) * 32 + lane]);
    }
  }
}

typedef __attribute__((ext_vector_type(4))) float f32x4;
struct AttnSrc { const u16* k; const u16* kr; const u16* vt; int vts; };
struct AttnState { f32x4 o[4]; float mx, ls; };
constexpr int ATT_VST = 136;

struct AttnRegs { uint4 k0, k1, k2, v0, v1; };
template <int DQK>
DEV void attn_gload(const AttnSrc& src, AttnRegs& r, int t) {
  const int row = t >> 3, c8 = (t & 7) * 8;
  r.k0 = *(const uint4*)(src.k + (size_t)row * 512 + c8);
  r.k1 = *(const uint4*)(src.k + (size_t)(row + 32) * 512 + c8);
  r.v0 = *(const uint4*)(src.vt + (size_t)row * src.vts + c8);
  r.v1 = *(const uint4*)(src.vt + (size_t)(row + 32) * src.vts + c8);
  if (DQK == 96) r.k2 = *(const uint4*)(src.kr + (size_t)(t >> 2) * 32 + (t & 3) * 8);
}
template <int DQK>
DEV void attn_swrite(char* buf, const AttnRegs& r, int t) {
  constexpr int KST = DQK * 2 + 16;
  const int row = t >> 3, c16 = (t & 7) * 16;
  char* vb = buf + 64 * KST;
  *(uint4*)(buf + row * KST + c16) = make_uint4(r.k0.x, r.k0.y, r.k0.z, r.k0.w);
  *(uint4*)(buf + (row + 32) * KST + c16) = make_uint4(r.k1.x, r.k1.y, r.k1.z, r.k1.w);
  char* vp = vb + row * ATT_VST + c16;
  *(uint2*)vp = make_uint2(r.v0.x, r.v0.y);
  *(uint2*)(vp + 8) = make_uint2(r.v0.z, r.v0.w);
  vp += 32 * ATT_VST;
  *(uint2*)vp = make_uint2(r.v1.x, r.v1.y);
  *(uint2*)(vp + 8) = make_uint2(r.v1.z, r.v1.w);
  if (DQK == 96) *(uint4*)(buf + (t >> 2) * KST + 128 + (t & 3) * 16) = make_uint4(r.k2.x, r.k2.y, r.k2.z, r.k2.w);
}

template <int DQK, int NT, bool LOCAL>
DEV void attn_compute(const char* buf, const bf16x8 qf0, const bf16x8 qf1, const bf16x8 qf2, AttnState& st, float scale, int koff0, const float* biasrow, int qc, int wlo, const int tid_) {
  constexpr int KST = DQK * 2 + 16;
  const int lane = TIDX & 63, r16 = lane & 15, g = lane >> 4;
  const char* vb = buf + 64 * KST;
  f32x4 s[NT];
#pragma unroll
  for (int t = 0; t < NT; t++) {
    s[t] = f32x4{0.f, 0.f, 0.f, 0.f};
    const char* kp = buf + (koff0 + t * 16 + r16) * KST + g * 16;
    s[t] = __builtin_amdgcn_mfma_f32_16x16x32_bf16(*(const bf16x8*)(kp), qf0, s[t], 0, 0, 0);
    s[t] = __builtin_amdgcn_mfma_f32_16x16x32_bf16(*(const bf16x8*)(kp + 64), qf1, s[t], 0, 0, 0);
    if (DQK == 96) s[t] = __builtin_amdgcn_mfma_f32_16x16x32_bf16(*(const bf16x8*)(kp + 128), qf2, s[t], 0, 0, 0);
  }
  float mloc = st.mx;
#pragma unroll
  for (int t = 0; t < NT; t++)
#pragma unroll
    for (int e = 0; e < 4; e++) {
      float v = s[t][e] * scale;
      if (LOCAL) {
        const int kc = koff0 + t * 16 + 4 * g + e;
        const int bi = min(max(kc - qc + 15, 0), 30);
        const float bv = biasrow[bi];
        v = (kc >= wlo && kc < wlo + 16) ? v + bv : -1e30f;
      }
      s[t][e] = v;
      mloc = fmaxf(mloc, v);
    }
  mloc = fmaxf(mloc, __shfl_xor(mloc, 16));
  mloc = fmaxf(mloc, __shfl_xor(mloc, 32));
  const float alpha = __expf(st.mx - mloc);
  st.mx = mloc;
  float psum = 0.f;
#pragma unroll
  for (int t = 0; t < NT; t++)
#pragma unroll
    for (int e = 0; e < 4; e++) {
      const float pv = __expf(s[t][e] - mloc);
      s[t][e] = pv;
      psum += pv;
    }
  st.ls = st.ls * alpha + psum;
#pragma unroll
  for (int dt = 0; dt < 4; dt++) st.o[dt] *= alpha;
#pragma unroll
  for (int kb = 0; kb < NT / 2; kb++) {
    bf16x8 pf;
#pragma unroll
    for (int e = 0; e < 4; e++) { pf[e] = (__bf16)s[2 * kb][e]; pf[4 + e] = (__bf16)s[2 * kb + 1][e]; }
#pragma unroll
    for (int dt = 0; dt < 4; dt++) {
      const char* vp = vb + (dt * 16 + r16) * ATT_VST + (koff0 + 4 * g) * 2 + kb * 64;
      const uint2 a0 = *(const uint2*)vp, a1 = *(const uint2*)(vp + 32);
      const uint4 av = make_uint4(a0.x, a0.y, a1.x, a1.y);
      st.o[dt] = __builtin_amdgcn_mfma_f32_16x16x32_bf16(__builtin_bit_cast(bf16x8, av), pf, st.o[dt], 0, 0, 0);
    }
  }
}

template <int MODE>
DEV void attn_item(const Params& p, int l, int it, char* smem, const int tid_) {
  constexpr int DQK = (MODE >= 2) ? 96 : 64;
  constexpr int KST = DQK * 2 + 16;
  constexpr int BUFSZ = 64 * KST + 64 * ATT_VST;
  const int t = TIDX, lane = t & 63, w = t >> 6, r16 = lane & 15, g = lane >> 4;
  int b, h, tl0, nst, r = 0;
  if (MODE == 0 || MODE == 2) { b = it >> 5; h = (it >> 2) & 7; tl0 = b * 256 + (it & 3) * 64; nst = 4; }
  else { b = it >> 7; h = (it >> 4) & 7; r = it & 15; tl0 = b * 1024 + r * 64; nst = (MODE == 1) ? 12 : 20; }
  const int tl = tl0 + w * 16 + r16;
  const int wr0 = min(max(r - 4, 0), 8);
  const u16* KNA = (const u16*)(p.ws + O_KNA); const u16* VTNA = (const u16*)(p.ws + O_VTNA);
  const u16* KC = (const u16*)(p.ws + O_KC); const u16* VTC = (const u16*)(p.ws + O_VTC);
  const u16* KNOPE = (const u16*)(p.ws + O_KNOPE); const u16* KR = (const u16*)(p.ws + O_KR); const u16* VTM = (const u16*)(p.ws + O_VTM);
  auto get_src = [&](int st) {
    AttnSrc s;
    s.kr = nullptr;
    if (MODE == 0) {
      s.k = KNA + (size_t)(b * 256 + st * 64) * 512 + h * 64; s.vt = VTNA + (size_t)(b * 512 + h * 64) * 256 + st * 64; s.vts = 256;
    } else if (MODE == 1) {
      if (st < 8) {
        const int krow = wr0 + st;
        s.k = KNA + (size_t)(b * 1024 + krow * 64) * 512 + h * 64; s.vt = VTNA + (size_t)(b * 512 + h * 64) * 1024 + krow * 64; s.vts = 1024;
      } else {
        const int m0 = (st - 8) * 64;
        s.k = KC + ((size_t)(l * 8 + b) * 256 + m0) * 512 + h * 64; s.vt = VTC + ((size_t)(l * 8 + b) * 512 + h * 64) * 256 + m0; s.vts = 256;
      }
    } else if (MODE == 2) {
      s.k = KNOPE + (size_t)(b * 256 + st * 64) * 512 + h * 64; s.kr = KR + (size_t)(b * 256 + st * 64) * 32;
      s.vt = VTM + (size_t)(b * 512 + h * 64) * 256 + st * 64; s.vts = 256;
    } else {
      s.k = KNOPE + (size_t)(b * 1280 + st * 64) * 512 + h * 64; s.kr = KR + (size_t)(b * 1280 + st * 64) * 32;
      s.vt = VTM + (size_t)(b * 512 + h * 64) * 1280 + st * 64; s.vts = 1280;
    }
    return s;
  };
  bf16x8 qf0, qf1, qf2;
  if (MODE < 2) {
    const u16* qp = (const u16*)(p.ws + O_QNA) + (size_t)tl * 512 + h * 64 + 8 * g;
    qf0 = *(const bf16x8*)qp; qf1 = *(const bf16x8*)(qp + 32); qf2 = qf0;
  } else {
    const u16* qp = (const u16*)(p.ws + O_H) + (size_t)tl * 768 + h * 96;
    qf0 = *(const bf16x8*)(qp + 8 * g); qf1 = *(const bf16x8*)(qp + 32 + 8 * g);
    if (MODE == 2) {
      qf2 = *(const bf16x8*)(qp + 64 + 8 * g);
    } else {
      const uint4 own = *(const uint4*)(qp + 64 + 8 * g), oth = *(const uint4*)(qp + 64 + 8 * (g ^ 2));
      const unsigned ow[4] = {own.x, own.y, own.z, own.w}, ot[4] = {oth.x, oth.y, oth.z, oth.w};
      const int nn = tl & 1023;
      const float pos = (g & 1) ? (float)(nn & 63) : (float)(nn >> 6);
      bf16x8 qr;
#pragma unroll
      for (int e = 0; e < 8; e++) {
        const float a = __uint_as_float((e & 1) ? (ow[e >> 1] & 0xffff0000u) : (ow[e >> 1] << 16));
        const float c = __uint_as_float((e & 1) ? (ot[e >> 1] & 0xffff0000u) : (ot[e >> 1] << 16));
        const float inv = powf(10000.f, -(float)e * 0.125f);
        const float ang = pos * inv;
        const float cs = cosf(ang), sn = sinf(ang);
        const float v = (g < 2) ? (a * cs - c * sn) : (c * sn + a * cs);
        qr[e] = (__bf16)v;
      }
      qf2 = qr;
    }
  }
  float* biasl = (float*)(smem + 2 * BUFSZ);
  if (MODE == 1) {
    for (int i = t; i < 465; i += 256) biasl[i] = p.na_rpb[(size_t)(l * 8 + h) * 465 + i];
  }
  AttnState st;
#pragma unroll 1
  for (int rep = 0; rep < ATT_REP; rep++) {
  if (ATT_REP > 1) asm volatile("" :: "v"(st.o[0][0]), "v"(st.ls));
#pragma unroll
  for (int dt = 0; dt < 4; dt++) st.o[dt] = f32x4{0.f, 0.f, 0.f, 0.f};
  st.mx = -1e30f; st.ls = 0.f;
  const float scale = (MODE >= 2) ? 0.10206207261596575f : 0.125f;
  const int qc = w * 16 + r16;
  const int wlo = min(max(qc - 8, 0), 48);
  const int wstart = min(max(16 * w - 8, 0), 32);
  AttnRegs rg;
  rg.k2 = make_uint4(0, 0, 0, 0);
  {
    const AttnSrc s0 = get_src(0);
    attn_gload<DQK>(s0, rg, t);
    attn_swrite<DQK>(smem, rg, t);
  }
  __syncthreads();
  for (int sidx = 0; sidx < nst; sidx++) {
    { const AttnSrc sn = get_src(min(sidx + 1, nst - 1)); attn_gload<DQK>(sn, rg, t); }
    asm volatile("" ::: "memory"); __builtin_amdgcn_sched_barrier(0);
    const char* buf = smem + (sidx & 1) * BUFSZ;
    if (MODE == 1 && sidx < 8) attn_compute<DQK, 2, true>(buf, qf0, qf1, qf2, st, scale, wstart, biasl + (wr0 + sidx - r + 7) * 31, qc, wlo, tid_);
    else attn_compute<DQK, 4, false>(buf, qf0, qf1, qf2, st, scale, 0, nullptr, 0, 0, tid_);
    asm volatile("" ::: "memory"); __builtin_amdgcn_sched_barrier(0);
    attn_swrite<DQK>(smem + ((sidx + 1) & 1) * BUFSZ, rg, t);
    __syncthreads();
  }
  }
  float lt = st.ls;
  lt += __shfl_xor(lt, 16);
  lt += __shfl_xor(lt, 32);
  const float inv = 1.f / lt;
  u16* Z = (u16*)(p.ws + (MODE < 2 ? O_ZA : O_ZC)) + (size_t)tl * 512 + h * 64 + 4 * g;
#pragma unroll
  for (int dt = 0; dt < 4; dt++) {
    float a, bb, c, d;
    ld4bf(Z + dt * 16, a, bb, c, d);
    st4bf(Z + dt * 16, st.o[dt][0] * inv * a, st.o[dt][1] * inv * bb, st.o[dt][2] * inv * c, st.o[dt][3] * inv * d);
  }
}

DEV void phase_mix(const Params& p, int l, int s, char* smem, const int tid_) {
  const int n_att = 1024;
  const int n_sgu = 256, n_q = 384, n_kv = (s == 0) ? 512 : 640;
  const int total = n_att + n_sgu + n_q + n_kv;
  for (int item = blockIdx.x; item < total; item += gridDim.x) {
    if (item < n_att) {
      if (s == 0) attn_item<0>(p, l, item, smem, tid_); else attn_item<1>(p, l, item, smem, tid_);
    } else if (item < n_att + n_sgu) {
      const int it = item - n_att, chunk = it >> 2, g = it & 3;
      const u16* Wg = (const u16*)(p.ws + O_SGUW) + (size_t)(l * 4 + g) * 128 * 128;
      const u16* V = (const u16*)(p.ws + O_GVT) + ((size_t)chunk * 512 + g * 128) * 128;
      const u16* GU = (const u16*)(p.ws + O_GU); u16* ZB = (u16*)(p.ws + O_ZB);
      f32x16 acc[2][2];
      acc_zero(acc);
      gemm_mainloop(Wg, 128, V, 128, 128, smem, acc, tid_);
      epi_foreach(acc, tid_, [&](int i, int j, float v0, float v1, float v2, float v3) {
        const float bs = p.sgu_b[(l * 4 + g) * 128 + i];
        const size_t off = (size_t)(chunk * 128 + i) * 512 + g * 128 + j;
        float u0, u1, u2, u3, z0, z1, z2, z3;
        ld4bf(GU + off, u0, u1, u2, u3);
        ld4bf(ZB + off, z0, z1, z2, z3);
        st4bf(ZB + off, u0 * (v0 + bs) * z0, u1 * (v1 + bs) * z1, u2 * (v2 + bs) * z2, u3 * (v3 + bs) * z3);
      });
    } else if (item < n_att + n_sgu + n_q) {
      const int it = item - n_att - n_sgu, m = it / 6, n = it % 6;
      const u16* DQ = (const u16*)(p.ws + O_DQN) + (size_t)m * 128 * 384;
      const u16* W = (const u16*)(p.ws + O_WUQ) + (size_t)l * 768 * 384 + (size_t)n * 128 * 384;
      u16* QM = (u16*)(p.ws + O_H);
      f32x16 acc[2][2];
      acc_zero(acc);
      gemm_mainloop(DQ, 384, W, 384, 384, smem, acc, tid_);
      epi_foreach(acc, tid_, [&](int i, int j, float v0, float v1, float v2, float v3) {
        st4bf(QM + (size_t)(m * 128 + i) * 768 + n * 128 + j, v0, v1, v2, v3);
      });
    } else {
      const int it = item - n_att - n_sgu - n_q, m = it >> 3, n = it & 7;
      const u16* C = (const u16*)(p.ws + O_CKV) + (size_t)m * 128 * 256;
      const u16* W = (const u16*)(p.ws + O_WUKV) + (size_t)l * 1024 * 256 + (size_t)n * 128 * 256;
      const bool swapped = n >= 4;
      f32x16 acc[2][2];
      acc_zero(acc);
      gemm_mainloop(swapped ? W : C, 256, swapped ? C : W, 256, 256, smem, acc, tid_);
      if (!swapped) {
        u16* KNOPE = (u16*)(p.ws + O_KNOPE);
        epi_foreach(acc, tid_, [&](int i, int j, float v0, float v1, float v2, float v3) {
          st4bf(KNOPE + (size_t)(m * 128 + i) * 512 + n * 128 + j, v0, v1, v2, v3);
        });
      } else {
        u16* VTM = (u16*)(p.ws + O_VTM);
        const int S = (s == 0) ? 256 : 1280;
        epi_foreach(acc, tid_, [&](int i, int j, float v0, float v1, float v2, float v3) {
          const int ch = (n - 4) * 128 + i, row = m * 128 + j;
          const int b = row / S, mm = row % S;
          st4bf(VTM + ((size_t)b * 512 + ch) * S + mm, v0, v1, v2, v3);
        });
      }
    }
  }
}

DEV void phase_mla(const Params& p, int l, int s, char* smem, const int tid_) {
  for (int item = blockIdx.x; item < 1024; item += gridDim.x) {
    if (s == 0) attn_item<2>(p, l, item, smem, tid_); else attn_item<3>(p, l, item, smem, tid_);
  }
}

DEV void phase_merge(const Params& p, int l, int s, char* smem, const int tid_, const int vid_) {
  const int nb = gridDim.x >> 3, xcd = vid_ / nb, lb = vid_ % nb;
  const u16* GATES = (const u16*)(p.ws + O_GATES);
  u16* MG = (u16*)(p.ws + O_H);
  const int lane = TIDX & 63, w = TIDX >> 6, wm = w >> 1, wn = w & 1;
  for (int li = lb; li < 128; li += nb) {
    int m, n;
    tile_map(li, 16, xcd, m, n);
    f32x16 macc[2];
#pragma unroll
    for (int b = 0; b < 2; b++)
#pragma unroll
      for (int r = 0; r < 16; r++) macc[b][r] = 0.f;
    const int i = wm * 32 + (lane & 31);
#pragma unroll 1
    for (int k = 0; k < 3; k++) {
      const u16* A = (const u16*)(p.ws + (k == 0 ? O_ZA : (k == 1 ? O_ZB : O_ZC))) + (size_t)m * 64 * 512;
      const u16* W = (const u16*)(p.ws + O_WBR) + (size_t)(l * 3 + k) * 1024 * 512 + (size_t)n * 128 * 512;
      f32x16 acc[2];
#pragma unroll
      for (int b = 0; b < 2; b++)
#pragma unroll
        for (int r = 0; r < 16; r++) acc[b][r] = 0.f;
      gemm_mainloop64(A, 512, W, 512, 512, smem, acc, tid_);
#pragma unroll
      for (int b = 0; b < 2; b++)
#pragma unroll
        for (int rg = 0; rg < 4; rg++) {
          const int j = wn * 64 + b * 32 + rg * 8 + (lane >> 5) * 4;
          float g0, g1, g2, g3;
          ld4bf(GATES + (size_t)(m * 64 + i) * 3072 + k * 1024 + n * 128 + j, g0, g1, g2, g3);
          macc[b][rg * 4 + 0] += g0 * acc[b][rg * 4 + 0];
          macc[b][rg * 4 + 1] += g1 * acc[b][rg * 4 + 1];
          macc[b][rg * 4 + 2] += g2 * acc[b][rg * 4 + 2];
          macc[b][rg * 4 + 3] += g3 * acc[b][rg * 4 + 3];
        }
    }
#pragma unroll
    for (int b = 0; b < 2; b++)
#pragma unroll
      for (int rg = 0; rg < 4; rg++) {
        const int j = wn * 64 + b * 32 + rg * 8 + (lane >> 5) * 4;
        st4bf(MG + (size_t)(m * 64 + i) * 1024 + n * 128 + j, macc[b][rg * 4 + 0], macc[b][rg * 4 + 1], macc[b][rg * 4 + 2], macc[b][rg * 4 + 3]);
      }
  }
}

DEV void phase_out(const Params& p, int l, int s, char* smem, const int tid_, const int vid_) {
  const int nb = gridDim.x >> 3, xcd = vid_ / nb, lb = vid_ % nb;
  const u16* MG = (const u16*)(p.ws + O_H);
  const float* MOD = (const float*)(p.ws + O_MOD);
  for (int li = lb; li < 64; li += nb) {
    int m, n;
    tile_map(li, 8, xcd, m, n);
    f32x16 acc[2][2];
    acc_zero(acc);
    gemm_mainloop(MG + (size_t)m * 128 * 1024, 1024, (const u16*)(p.ws + O_WOUT) + (size_t)l * 1024 * 1024 + (size_t)n * 128 * 1024, 1024, 1024, smem, acc, tid_);
    epi_foreach(acc, tid_, [&](int i, int j, float v0, float v1, float v2, float v3) {
      const int tl = m * 128 + i, col = n * 128 + j;
      const float4 x = *(const float4*)(xrow_in(p, l, s, tl) + col);
      const float4 g = *(const float4*)(MOD + (size_t)(l * 9 + cond_idx(s, tl)) * 3072 + 2048 + col);
      *(float4*)(p.out + OUT_Y + (size_t)s * 8388608 + (size_t)tl * 1024 + col) =
          make_float4(x.x + g.x * v0, x.y + g.y * v1, x.z + g.z * v2, x.w + g.w * v3);
    });
  }
}

DEV void phase_final(const Params& p, const int tid_) {
  const int lane = TIDX & 63, wave = TIDX >> 6;
  for (int item = blockIdx.x; item < 4096; item += gridDim.x) {
    float* x = p.out + OUT_Y + (size_t)(item * 4 + wave) * 1024;
    float4 v[4];
    float ss = 0.f;
#pragma unroll
    for (int i = 0; i < 4; i++) {
      v[i] = *(const float4*)(x + i * 256 + lane * 4);
      ss += v[i].x * v[i].x + v[i].y * v[i].y + v[i].z * v[i].z + v[i].w * v[i].w;
    }
    ss = wave_sum(ss);
    const float rstd = rsqrtf(ss * (1.f / 1024.f) + 1e-6f);
#pragma unroll
    for (int i = 0; i < 4; i++) {
      const int col = i * 256 + lane * 4;
      const float4 g = *(const float4*)(p.final_g + col);
      *(float4*)(x + col) = make_float4(v[i].x * rstd * g.x, v[i].y * rstd * g.y, v[i].z * rstd * g.z, v[i].w * rstd * g.w);
    }
  }
}

#define XB_TMO      128
#define XB_XCNT(j)  (256  + 64 * (j))
#define XB_XSUB(j)  (1280 + 64 * (j))
#define XB_XGEN(j)  (2304 + 64 * (j))
#define XB_TOP      3328
#define XB_TOPGEN   3392
#define XCD_BAR_WORDS 3456
#define XB_SPIN_CAP (1u << 18)
#define LAS __attribute__((address_space(3)))

__device__ __forceinline__ unsigned xb_ld(unsigned* p)              { return __hip_atomic_load(p, __ATOMIC_RELAXED, __HIP_MEMORY_SCOPE_AGENT); }
__device__ __forceinline__ unsigned xb_add(unsigned* p, unsigned v) { return __hip_atomic_fetch_add(p, v, __ATOMIC_RELAXED, __HIP_MEMORY_SCOPE_AGENT); }
__device__ __forceinline__ unsigned xb_xcc_id() { return (unsigned)__builtin_amdgcn_s_getreg((3 << 11) | 20) & 0xFu; }
#define XB_SPIN(cond, bar) do { unsigned _sp = 0; while (cond) { __builtin_amdgcn_s_sleep(1); \
    if ((++_sp & 255u) == 0u) { if (xb_ld(&(bar)[XB_TMO])) break; if (_sp > XB_SPIN_CAP) { atomicAdd(&(bar)[XB_TMO], 1u); break; } } } } while (0)

struct XcdBarrier {
    unsigned* bar; unsigned x;
    volatile LAS unsigned* st;
};

__device__ __forceinline__ XcdBarrier xcd_barrier_post(unsigned* bar, volatile LAS unsigned* st) {
    XcdBarrier b; b.bar = bar; b.x = xb_xcc_id(); b.st = st;
    if ((int)threadIdx.x == 0) st[2] = xb_add(&bar[XB_XCNT(b.x)], 1u);
    return b;
}
__device__ __forceinline__ void xcd_barrier_complete(unsigned* bar, unsigned x, unsigned& nloc, unsigned& nx) {
    const unsigned G = gridDim.x * gridDim.y * gridDim.z;
    unsigned sum, cnt, mine, sp = 0u;
    for (;;) {
        sum = 0u; cnt = 0u; mine = 0u;
#pragma unroll
        for (unsigned j = 0; j < 16; ++j) { const unsigned c = xb_ld(&bar[XB_XCNT(j)]); sum += c; cnt += (c > 0u) ? 1u : 0u; mine = (j == x) ? c : mine; }
        if (sum == G) break;
        __builtin_amdgcn_s_sleep(1);
        if ((++sp & 255u) == 0u) { if (xb_ld(&bar[XB_TMO])) break; if (sp > XB_SPIN_CAP) { atomicAdd(&bar[XB_TMO], 1u); break; } }
    }
    nloc = mine > 0u ? mine : 1u; nx = cnt > 0u ? cnt : 1u;
}

__device__ __forceinline__ void xcd_barrier(const XcdBarrier& b) {
    asm volatile("s_waitcnt vmcnt(0)" ::: "memory");
    __syncthreads();
    if ((int)threadIdx.x == 0) {
        unsigned* bar = b.bar;
        __builtin_amdgcn_s_waitcnt(0);
        unsigned nloc = b.st[0], nx = b.st[1];
        if (nloc == 0u) { xcd_barrier_complete(bar, b.x, nloc, nx); b.st[0] = nloc; b.st[1] = nx; }
        const unsigned old = xb_add(&bar[XB_XSUB(b.x)], 1u);
        const unsigned gen = old / nloc;
        if (old + 1u == (gen + 1u) * nloc) {
            __builtin_amdgcn_fence(__ATOMIC_RELEASE, "agent");
            asm volatile("s_waitcnt vmcnt(0)" ::: "memory");
            const unsigned og = xb_add(&bar[XB_TOP], 1u);
            const unsigned tg = og / nx;
            if (og + 1u == (tg + 1u) * nx) xb_add(&bar[XB_TOPGEN], 1u);
            else XB_SPIN(xb_ld(&bar[XB_TOPGEN]) == tg, bar);
            __builtin_amdgcn_fence(__ATOMIC_ACQUIRE, "agent");
            xb_add(&bar[XB_XGEN(b.x)], 1u);
            asm volatile("s_waitcnt vmcnt(0)" ::: "memory");
        } else {
            XB_SPIN(xb_ld(&bar[XB_XGEN(b.x)]) == gen, bar);
            __builtin_amdgcn_fence(__ATOMIC_ACQUIRE, "agent");
            asm volatile("s_waitcnt vmcnt(0)" ::: "memory");
        }
    }
    __syncthreads();
}


DEV void run_phase(const Params& p, int ph, int l, int s, char* smem, const int vid_) {
  const int tid_ = tid_opaque();
  switch (ph) {
    case 0: phase_prep(p, smem, tid_); break;
    case 1: phase_h(p, l, s, tid_); break;
    case 2: phase_in(p, l, s, smem, tid_, vid_); break;
    case 3: phase_rows(p, l, s, smem, tid_); break;
    case 4: phase_mix(p, l, s, smem, tid_); break;
    case 5: phase_mla(p, l, s, smem, tid_); break;
    case 6: phase_merge(p, l, s, smem, tid_, vid_); break;
    case 7: phase_out(p, l, s, smem, tid_, vid_); break;
    default: phase_final(p, tid_); break;
  }
}

__global__ void __launch_bounds__(256, 2) phase_kernel(Params p, int ph, int l, int s) {
  __shared__ __attribute__((aligned(16))) char smem[65536];
  run_phase(p, ph, l, s, smem, blockIdx.x);
}

__global__ void __launch_bounds__(256, 2) mega_kernel(Params p) {
  __shared__ __attribute__((aligned(16))) char smem[65536];
  __shared__ uint4 xb_words;
  if (threadIdx.x == 0) xb_words = make_uint4(0u, 0u, 0u, 0u);
  __syncthreads();
  XcdBarrier xb = xcd_barrier_post((unsigned*)(p.ws + O_BAR), (volatile LAS unsigned*)&xb_words);
  if (p.ws == nullptr) cg::this_grid().sync();
  int vid = blockIdx.x;
#pragma unroll 1
  for (int step = 0; step < 30; step++) {
    int ph, l = 0, s = 0;
    if (step == 0) ph = 0;
    else if (step == 29) ph = 8;
    else { const int q = (step - 1) / 7; ph = 1 + (step - 1) % 7; l = q >> 1; s = q & 1; }
    run_phase(p, ph, l, s, smem, vid);
    if (ph == PROBE_DUP || ph == PROBE_DUP2) { xcd_barrier(xb); run_phase(p, ph, l, s, smem, vid); }
    if (PROBE_SYNC) xcd_barrier(xb);
    if (step < 29) xcd_barrier(xb);
    if (step == 0) {
      if (threadIdx.x == 0) {
        unsigned base = 0;
        for (unsigned j = 0; j < 16; ++j) { const unsigned c = xb_ld(&xb.bar[XB_XCNT(j)]); if (j < xb.x) base += c; }
        unsigned v = base + xb_words.z;
        if (v >= gridDim.x) v = blockIdx.x;
        xb_words.w = v;
      }
      __syncthreads();
      vid = (int)xb_words.w;
    }
  }
}

extern "C" void kernel_launch(void* const* d_in, const int* in_sizes, int n_in, void* d_out, int out_size, void* d_ws, size_t ws_size,
                              hipStream_t stream) {
  Params p{};
  const float** pp = (const float**)&p;
  for (int i = 0; i < 22; i++) pp[i] = (const float*)d_in[i];
  p.out = (float*)d_out;
  p.ws = (char*)d_ws;
#if USE_COOP
  static int grid_blocks = 0;
  if (!grid_blocks) {
    int dev = 0, cus = 0, per_cu = 0;
    hipGetDevice(&dev);
    hipDeviceGetAttribute(&cus, hipDeviceAttributeMultiprocessorCount, dev);
    hipOccupancyMaxActiveBlocksPerMultiprocessor(&per_cu, mega_kernel, 256, 0);
    if (per_cu > 2) per_cu = 2;
    grid_blocks = cus * per_cu;
    grid_blocks &= ~7;
  }
  hipMemsetAsync((char*)d_ws + O_BAR, 0, BAR_BYTES, stream);
  void* args[] = {&p};
  hipError_t e = hipLaunchCooperativeKernel((void*)mega_kernel, dim3(grid_blocks), dim3(256), args, 0, stream);
  if (e != hipSuccess) fprintf(stderr, "cooperative launch failed: %s (grid %d)\n", hipGetErrorString(e), grid_blocks);
#else
  const int G = 512;
  phase_kernel<<<G, 256, 0, stream>>>(p, 0, 0, 0);
  for (int l = 0; l < 2; l++)
    for (int s = 0; s < 2; s++)
      for (int ph = 1; ph <= 7; ph++) phase_kernel<<<G, 256, 0, stream>>>(p, ph, l, s);
  phase_kernel<<<G, 256, 0, stream>>>(p, 8, 0, 0);
#endif
}
```

```cpp
#include <hip/hip_runtime.h>
#include <hip/hip_cooperative_groups.h>
#include <cstdio>
namespace cg = cooperative_groups;

typedef unsigned short u16;
typedef __attribute__((ext_vector_type(8))) __bf16 bf16x8;
typedef __attribute__((ext_vector_type(16))) float f32x16;
#define DEV __device__ __forceinline__
__device__ __forceinline__ int tid_opaque() { int t = threadIdx.x; asm volatile("" : "+v"(t)); return t; }
#define TIDX tid_

constexpr size_t A256(size_t x) { return (x + 255) & ~(size_t)255; }
constexpr size_t A512K(size_t x) { return (x + 524287) & ~(size_t)524287; }
constexpr size_t AUP(size_t x, size_t a) { return (x + a - 1) / a * a; }
constexpr size_t O_WIN = 0;
constexpr size_t O_H = O_WIN + A256(2ull * 7936 * 1024 * 2);
constexpr size_t O_WUQ = AUP(O_H + A256(8192ull * 1024 * 2), 196608);
constexpr size_t O_WUKV = AUP(O_WUQ + A256(2ull * 768 * 384 * 2), 131072);
constexpr size_t O_WBR = A512K(O_WUKV + A256(2ull * 1024 * 256 * 2));
constexpr size_t O_WOUT = A512K(O_WBR + A256(2ull * 3 * 1024 * 512 * 2));
constexpr size_t O_SGUW = O_WOUT + A256(2ull * 1024 * 1024 * 2);
constexpr size_t O_KC = O_SGUW + A256(2ull * 4 * 128 * 128 * 2);
constexpr size_t O_VTC = O_KC + A256(2ull * 8 * 256 * 512 * 2);
constexpr size_t O_MOD = O_VTC + A256(2ull * 8 * 256 * 512 * 2);
constexpr size_t O_QNA = A512K(O_MOD + A256(2ull * 9 * 3072 * 4));
constexpr size_t O_KNA = O_QNA + 8192ull * 512 * 2;
constexpr size_t O_VTNA = O_KNA + 8192ull * 512 * 2;
constexpr size_t O_GU = O_VTNA + 8192ull * 512 * 2;
constexpr size_t O_MG = O_QNA;
constexpr size_t O_ZA = A512K(O_GU + 8192ull * 512 * 2);
constexpr size_t O_ZB = O_ZA + 2 * 8192ull * 512 * 2;
constexpr size_t O_ZC = O_ZB + 2 * 8192ull * 512 * 2;
constexpr size_t O_GVT = O_ZC + 2 * 8192ull * 512 * 2;
constexpr size_t O_GATES = O_GVT + A256(8192ull * 512 * 2);
constexpr size_t O_CKV = AUP(O_GATES + A256(2ull * 8192 * 3072), 131072);
constexpr size_t O_KR = O_CKV + A256(10240ull * 256 * 2);
constexpr size_t O_KNOPE = O_KR + A256(10240ull * 32 * 2);
constexpr size_t O_VTM = O_KNOPE + A256(10240ull * 512 * 2);
constexpr size_t O_END = O_VTM + A256(10240ull * 512 * 2);
constexpr size_t O_DQN = AUP(O_END, 196608);
constexpr size_t O_DQ = O_DQN + A256(8192ull * 384 * 2);
constexpr size_t O_DKV = O_DQ + A256(8192ull * 384 * 2);
constexpr size_t O_KRF = O_DKV + A256(8192ull * 256 * 2);
constexpr size_t O_QM = O_DQ;
constexpr size_t O_BAR = O_QM + A256(8192ull * 768 * 2);
constexpr size_t BAR_BYTES = 16384;
constexpr size_t DYN_LDS = 131072 + 16;
static_assert(O_H % 524288 == 0 && O_WIN == 0 && O_WOUT % 524288 == 0, "K=1024 operands must be 256-row-tile aligned");
static_assert(O_WBR % 262144 == 0 && O_ZA % 262144 == 0 && O_ZB % 262144 == 0 && O_ZC % 262144 == 0, "K=512 operands must be 256-row-tile aligned");
static_assert(O_MG % 524288 == 0, "MERGED must be tile aligned");
static_assert(O_WUQ % 196608 == 0 && O_DQN % 196608 == 0 && O_WUKV % 131072 == 0 && O_CKV % 131072 == 0, "K=384 / K=256 operands must be 256-row-tile aligned");
static_assert(O_KRF + 8192ull * 32 * 4 <= O_BAR, "QM alias region must cover DQ/DKV/KRF");
static_assert(O_BAR + BAR_BYTES <= 256ull * 1024 * 1024, "workspace too large");

constexpr size_t OUT_Y = 0;
constexpr size_t OUT_SK = 16777216;
constexpr size_t OUT_SV = 25165824;
constexpr size_t OUT_CKV = 33554432;
constexpr size_t OUT_SKR = 37748736;

struct Params {
  const float *x_prompt, *x_sample, *cache_na_k, *cache_na_v, *cache_ckv, *cache_kr, *c, *c_ctx;
  const float *norm_g, *w_mod, *b_mod, *w_in, *na_rpb, *sgu_w, *sgu_b, *q_norm, *w_uq, *kv_norm, *w_ukv, *w_branch, *w_out, *final_g;
  float* out;
  char* ws;
};

DEV u16 f2bf(float f) { unsigned u = __float_as_uint(f); u += 0x7fffu + ((u >> 16) & 1u); return (u16)(u >> 16); }
DEV float bf2f(u16 h) { return __uint_as_float(((unsigned)h) << 16); }
typedef __attribute__((ext_vector_type(2))) __bf16 bf16x2;
DEV unsigned pack2(float a, float b) { bf16x2 v; v[0] = (__bf16)a; v[1] = (__bf16)b; return __builtin_bit_cast(unsigned, v); }
DEV void st4bf(u16* p, float a, float b, float c, float d) { uint2 v; v.x = pack2(a, b); v.y = pack2(c, d); *(uint2*)p = v; }
DEV void ld4bf(const u16* p, float& a, float& b, float& c, float& d) {
  uint2 v = *(const uint2*)p;
  a = __uint_as_float(v.x << 16); b = __uint_as_float(v.x & 0xffff0000u);
  c = __uint_as_float(v.y << 16); d = __uint_as_float(v.y & 0xffff0000u);
}
DEV size_t blk_off(int row, int k, int K) { return (size_t)(row >> 8) * 256 * K + (size_t)(k >> 6) * 16384 + (size_t)(row & 255) * 64 + (k & 63); }
DEV float wave_sum(float v) {
#pragma unroll
  for (int o = 32; o > 0; o >>= 1) v += __shfl_xor(v, o);
  return v;
}
DEV float sigmoid_f(float x) { return __builtin_amdgcn_rcpf(1.f + __expf(-x)); }
DEV float silu_f(float x) { return x * __builtin_amdgcn_rcpf(1.f + __expf(-x)); }
DEV float gelu_f(float x) { float u = 0.7978845608028654f * (x + 0.044715f * x * x * x); return x * __builtin_amdgcn_rcpf(1.f + __expf(-2.f * u)); }

DEV void gemm_mainloop_d1(const u16* P, int ldp, const u16* Q, int ldq, int K, char* smem, f32x16 (&acc)[2][2], const int tid_) {
  const int t = TIDX, lane = t & 63, w = t >> 6, wm = w >> 1, wn = w & 1;
  const int lr = t >> 3, ch = t & 7;
  const u16* pg = P + (size_t)lr * ldp + ch * 8;
  const u16* qg = Q + (size_t)lr * ldq + ch * 8;
  const size_t sp = (size_t)32 * ldp, sq = (size_t)32 * ldq;
  const int soff = lr * 128 + ((ch ^ ((t >> 4) & 7)) << 4);
  const int sw = (lane >> 1) & 7;
  const int prow = (wm * 64 + (lane & 31)) * 128;
  const int qrow = (wn * 64 + (lane & 31)) * 128;
  uint4 p0, p1, p2, p3, q0, q1, q2, q3;
#define GLOAD(k0) do { p0 = *(const uint4*)(pg + (k0)); p1 = *(const uint4*)(pg + sp + (k0)); p2 = *(const uint4*)(pg + 2 * sp + (k0)); p3 = *(const uint4*)(pg + 3 * sp + (k0)); \
                       q0 = *(const uint4*)(qg + (k0)); q1 = *(const uint4*)(qg + sq + (k0)); q2 = *(const uint4*)(qg + 2 * sq + (k0)); q3 = *(const uint4*)(qg + 3 * sq + (k0)); } while (0)
#define SWRITE(base) do { char* b_ = (base) + soff; *(uint4*)(b_) = p0; *(uint4*)(b_ + 4096) = p1; *(uint4*)(b_ + 8192) = p2; *(uint4*)(b_ + 12288) = p3; \
                          *(uint4*)(b_ + 16384) = q0; *(uint4*)(b_ + 20480) = q1; *(uint4*)(b_ + 24576) = q2; *(uint4*)(b_ + 28672) = q3; } while (0)
  GLOAD(0);
  SWRITE(smem);
  __syncthreads();
  const int nk = K >> 6;
  for (int kt = 0; kt < nk; kt++) {
    const int k0 = min(kt + 1, nk - 1) << 6;
    GLOAD(k0);
    asm volatile("" ::: "memory"); __builtin_amdgcn_sched_barrier(0);
    const char* bP = smem + (kt & 1) * 32768;
    const char* bQ = bP + 16384;
#pragma unroll
    for (int s = 0; s < 4; s++) {
      const int co = ((s * 2 + (lane >> 5)) ^ sw) << 4;
      const bf16x8 pf0 = *(const bf16x8*)(bP + prow + co), pf1 = *(const bf16x8*)(bP + prow + 4096 + co);
      const bf16x8 qf0 = *(const bf16x8*)(bQ + qrow + co), qf1 = *(const bf16x8*)(bQ + qrow + 4096 + co);
      acc[0][0] = __builtin_amdgcn_mfma_f32_32x32x16_bf16(qf0, pf0, acc[0][0], 0, 0, 0);
      acc[0][1] = __builtin_amdgcn_mfma_f32_32x32x16_bf16(qf1, pf0, acc[0][1], 0, 0, 0);
      acc[1][0] = __builtin_amdgcn_mfma_f32_32x32x16_bf16(qf0, pf1, acc[1][0], 0, 0, 0);
      acc[1][1] = __builtin_amdgcn_mfma_f32_32x32x16_bf16(qf1, pf1, acc[1][1], 0, 0, 0);
    }
    asm volatile("" ::: "memory"); __builtin_amdgcn_sched_barrier(0);
    SWRITE(smem + ((kt + 1) & 1) * 32768);
    __syncthreads();
  }
#undef GLOAD
#undef SWRITE
}

DEV void acc_zero(f32x16 (&acc)[2][2]) {
#pragma unroll
  for (int a = 0; a < 2; a++)
#pragma unroll
    for (int b = 0; b < 2; b++)
#pragma unroll
      for (int r = 0; r < 16; r++) acc[a][b][r] = 0.f;
}

template <class F>
DEV void epi_foreach(const f32x16 (&acc)[2][2], const int tid_, F f) {
  const int lane = TIDX & 63, w = TIDX >> 6, wm = w >> 1, wn = w & 1;
#pragma unroll
  for (int a = 0; a < 2; a++)
#pragma unroll
    for (int b = 0; b < 2; b++)
#pragma unroll
      for (int rg = 0; rg < 4; rg++) {
        const int i = wm * 64 + a * 32 + (lane & 31);
        const int j = wn * 64 + b * 32 + rg * 8 + (lane >> 5) * 4;
        f(i, j, acc[a][b][rg * 4 + 0], acc[a][b][rg * 4 + 1], acc[a][b][rg * 4 + 2], acc[a][b][rg * 4 + 3]);
      }
}

DEV void tile_map(int li, int MPX, int xcd, int& m, int& n) {
  const int g = MPX * 8;
  const int ng = li / g, wv = li % g;
  m = xcd * MPX + (wv % MPX);
  n = ng * 8 + (wv / MPX);
}

DEV void tconv_tile(const float* __restrict__ src, int ldsrc, int k0, int n0, u16* __restrict__ dst, int lddst, int drow0, float* tile, const int tid_, const int blkK = 0) {
  const int t = TIDX;
  {
    const int n = t & 31, kk = t >> 5;
    float v[16];
#pragma unroll
    for (int p = 0; p < 16; p++) v[p] = src[(size_t)(k0 + kk + p * 8) * ldsrc + n0 + n];
#pragma unroll
    for (int p = 0; p < 16; p++) tile[(kk + p * 8) * 33 + n] = v[p];
  }
  __syncthreads();
  {
    const int k2 = (t & 63) * 2, nn = t >> 6;
#pragma unroll
    for (int p = 0; p < 8; p++) {
      const int n2 = nn + p * 4;
      u16* dp = blkK ? (dst + blk_off(drow0 + n2, k0 + k2, blkK)) : (dst + (size_t)(drow0 + n2) * lddst + k0 + k2);
      *(unsigned*)dp = pack2(tile[k2 * 33 + n2], tile[(k2 + 1) * 33 + n2]);
    }
  }
  __syncthreads();
}

DEV void phase_prep(const Params& p, char* smem, const int tid_, const int vb_, const int vg_) {
  const int t = TIDX;
  constexpr int N_MOD = 192;
  constexpr int T_IN = 1960, T_UQ = 72, T_UKV = 64, T_BR = 384, T_OUT = 256, T_CV = 256;
  constexpr int T_L = T_IN + T_UQ + T_UKV + T_BR + T_OUT + T_CV;
  constexpr int N_TC = 2 * T_L;
  constexpr int N_SG = 64, N_KC = 1024;
  constexpr int TOTAL = N_MOD + N_TC + N_SG + N_KC;
  float* MOD = (float*)(p.ws + O_MOD);
  for (int item = vb_; item < TOTAL; item += vg_) {
    if (item < N_MOD) {
      const int l = item / 96, e0 = (item % 96) * 32;
      float* sc = (float*)smem;
      {
        float cv[36];
#pragma unroll
        for (int i = 0; i < 36; i++) { const int idx = t + i * 256; const int c9 = idx >> 10, d = idx & 1023; cv[i] = (c9 == 0) ? p.c_ctx[d] : p.c[(c9 - 1) * 1024 + d]; }
#pragma unroll
        for (int i = 0; i < 36; i++) sc[t + i * 256] = silu_f(cv[i]);
      }
      __syncthreads();
      const int col = t & 31, slab = t >> 5;
      float a[9];
#pragma unroll
      for (int c9 = 0; c9 < 9; c9++) a[c9] = 0.f;
      const float* wp = p.w_mod + ((size_t)l * 1024 + slab * 128) * 3072 + e0 + col;
#pragma unroll 1
      for (int d0 = 0; d0 < 128; d0 += 16) {
        float wv[16];
#pragma unroll
        for (int j = 0; j < 16; j++) wv[j] = wp[(size_t)(d0 + j) * 3072];
#pragma unroll
        for (int j = 0; j < 16; j++) {
          const int d = slab * 128 + d0 + j;
#pragma unroll
          for (int c9 = 0; c9 < 9; c9++) a[c9] += sc[c9 * 1024 + d] * wv[j];
        }
      }
      float* red = sc + 9216;
#pragma unroll
      for (int c9 = 0; c9 < 9; c9++) red[(slab * 9 + c9) * 32 + col] = a[c9];
      __syncthreads();
      for (int idx = t; idx < 288; idx += 256) {
        const int c9 = idx >> 5, cc = idx & 31;
        float sum = 0.f;
#pragma unroll
        for (int sl = 0; sl < 8; sl++) sum += red[(sl * 9 + c9) * 32 + cc];
        MOD[(l * 9 + c9) * 3072 + e0 + cc] = sum + p.b_mod[l * 3072 + e0 + cc];
      }
      __syncthreads();
    } else if (item < N_MOD + N_TC) {
      const int ti = item - N_MOD;
      const int l = ti / T_L;
      int r = ti % T_L;
      const float* src; u16* dst; int ldsrc, lddst, k0, n0, drow, blkK = 0;
      if (r < T_IN) {
        const int nt = r >> 3, kt = r & 7;
        src = p.w_in + (size_t)l * 1024 * 7840; ldsrc = 7840; k0 = kt * 128; n0 = nt * 32;
        dst = (u16*)(p.ws + O_WIN) + (size_t)l * 7936 * 1024; lddst = 1024; blkK = 1024;
        drow = (n0 < 4224) ? n0 : (n0 == 4224 ? 7808 : n0 - 32);
      } else if ((r -= T_IN) < T_UQ) {
        const int nt = r / 3, kt = r % 3;
        src = p.w_uq + (size_t)l * 384 * 768; ldsrc = 768; k0 = kt * 128; n0 = nt * 32;
        dst = (u16*)(p.ws + O_WUQ) + (size_t)l * 768 * 384; lddst = 384; drow = n0; blkK = 384;
      } else if ((r -= T_UQ) < T_UKV) {
        const int nt = r >> 1, kt = r & 1;
        src = p.w_ukv + (size_t)l * 256 * 1024; ldsrc = 1024; k0 = kt * 128; n0 = nt * 32;
        dst = (u16*)(p.ws + O_WUKV) + (size_t)l * 1024 * 256; lddst = 256;
        const int hh = n0 >> 7, jj = n0 & 127;
        drow = (jj < 64) ? (hh * 64 + jj) : (512 + hh * 64 + jj - 64);
        blkK = 256;
      } else if ((r -= T_UKV) < T_BR) {
        const int kb = r >> 7, r2 = r & 127;
        const int nt = r2 >> 2, kt = r2 & 3;
        src = p.w_branch + (size_t)(l * 3 + kb) * 512 * 1024; ldsrc = 1024; k0 = kt * 128; n0 = nt * 32;
        dst = (u16*)(p.ws + O_WBR) + (size_t)(l * 3 + kb) * 1024 * 512; lddst = 512; drow = n0; blkK = 512;
      } else if ((r -= T_BR) < T_OUT) {
        const int nt = r >> 3, kt = r & 7;
        src = p.w_out + (size_t)l * 1024 * 1024; ldsrc = 1024; k0 = kt * 128; n0 = nt * 32;
        dst = (u16*)(p.ws + O_WOUT) + (size_t)l * 1024 * 1024; lddst = 1024; drow = n0; blkK = 1024;
      } else {
        r -= T_OUT;
        const int b = r >> 5, r2 = r & 31;
        const int nt = r2 >> 1, kt = r2 & 1;
        src = p.cache_na_v + (size_t)(b * 2 + l) * 256 * 512; ldsrc = 512; k0 = kt * 128; n0 = nt * 32;
        dst = (u16*)(p.ws + O_VTC) + (size_t)(l * 8 + b) * 512 * 256; lddst = 256; drow = n0;
      }
      tconv_tile(src, ldsrc, k0, n0, dst, lddst, drow, (float*)smem, tid_, blkK);
    } else if (item < N_MOD + N_TC + N_SG) {
      const int it = item - N_MOD - N_TC;
      const size_t e = (size_t)it * 2048 + t * 8;
      const float4 a = *(const float4*)(p.sgu_w + e), b = *(const float4*)(p.sgu_w + e + 4);
      u16* d = (u16*)(p.ws + O_SGUW) + e;
      st4bf(d, a.x, a.y, a.z, a.w); st4bf(d + 4, b.x, b.y, b.z, b.w);
    } else {
      const int it = item - N_MOD - N_TC - N_SG;
      const size_t e = (size_t)it * 2048 + t * 8;
      const int l = (int)(e >> 20), b = (int)(e >> 17) & 7; const size_t rest = e & 131071;
      const float* s = p.cache_na_k + ((size_t)(b * 2 + l) << 17) + rest;
      const float4 a = *(const float4*)s, bb = *(const float4*)(s + 4);
      u16* d = (u16*)(p.ws + O_KC) + e;
      st4bf(d, a.x, a.y, a.z, a.w); st4bf(d + 4, bb.x, bb.y, bb.z, bb.w);
    }
  }
}

DEV const float* xrow_in(const Params& p, int l, int s, int tl) {
  if (l == 0) return (s == 0 ? p.x_prompt : p.x_sample) + (size_t)tl * 1024;
  return p.out + OUT_Y + (size_t)s * 8388608 + (size_t)tl * 1024;
}
DEV int cond_idx(int s, int tl) { return s == 0 ? 0 : 1 + (tl >> 10); }

DEV void phase_h(const Params& p, int l, int s, const int tid_, const int vb_, const int vg_) {
  const int lane = TIDX & 63, wave = TIDX >> 6;
  u16* H = (u16*)(p.ws + O_H);
  const float* MOD = (const float*)(p.ws + O_MOD);
  for (int item = vb_; item < 512; item += vg_) {
    const int tl0 = item * 16 + wave * 4;
    const float* x = xrow_in(p, l, s, tl0);
    const float* mod = MOD + (size_t)(l * 9 + cond_idx(s, tl0)) * 3072;
    float4 v[4][4];
#pragma unroll
    for (int r = 0; r < 4; r++)
#pragma unroll
      for (int i = 0; i < 4; i++) v[r][i] = *(const float4*)(x + (size_t)r * 1024 + i * 256 + lane * 4);
    float4 g[4], sh[4], sc[4];
#pragma unroll
    for (int i = 0; i < 4; i++) {
      const int col = i * 256 + lane * 4;
      g[i] = *(const float4*)(p.norm_g + l * 1024 + col);
      sh[i] = *(const float4*)(mod + col);
      sc[i] = *(const float4*)(mod + 1024 + col);
    }
    asm volatile("" ::: "memory");
    float ss[4];
#pragma unroll
    for (int r = 0; r < 4; r++) {
      ss[r] = 0.f;
#pragma unroll
      for (int i = 0; i < 4; i++) ss[r] += v[r][i].x * v[r][i].x + v[r][i].y * v[r][i].y + v[r][i].z * v[r][i].z + v[r][i].w * v[r][i].w;
    }
#pragma unroll
    for (int o = 32; o > 0; o >>= 1) {
#pragma unroll
      for (int r = 0; r < 4; r++) ss[r] += __shfl_xor(ss[r], o);
    }
#pragma unroll
    for (int r = 0; r < 4; r++) {
      const float rstd = rsqrtf(ss[r] * (1.f / 1024.f) + 1e-6f);
#pragma unroll
      for (int i = 0; i < 4; i++) {
        const int col = i * 256 + lane * 4;
        st4bf(H + blk_off(tl0 + r, col, 1024), v[r][i].x * rstd * g[i].x * (1.f + sc[i].x) + sh[i].x, v[r][i].y * rstd * g[i].y * (1.f + sc[i].y) + sh[i].y,
              v[r][i].z * rstd * g[i].z * (1.f + sc[i].z) + sh[i].z, v[r][i].w * rstd * g[i].w * (1.f + sc[i].w) + sh[i].w);
      }
    }
  }
}

DEV void phase_rows(const Params& p, int l, int s, char* smem, const int tid_, const int vb_, const int vg_) {
  const int t = TIDX, lane = t & 63, wave = t >> 6;
  const u16* DQ = (const u16*)(p.ws + O_DQ); const u16* DKV = (const u16*)(p.ws + O_DKV); const float* KRF = (const float*)(p.ws + O_KRF);
  u16* CKV = (u16*)(p.ws + O_CKV); u16* KR = (u16*)(p.ws + O_KR); u16* GVT = (u16*)(p.ws + O_GVT);
  const int n_row = 512, n_ln = 256, n_cache = (s == 1) ? 512 : 0;
  const int total = n_row + n_ln + n_cache;
  for (int item = vb_; item < total; item += vg_) {
    if (item < n_row) {
      const int tl0 = item * 16 + wave * 4;
      unsigned dqw[4][3]; uint2 dkw[4]; float k1[4], k2[4];
#pragma unroll
      for (int r = 0; r < 4; r++) {
        const unsigned* rp = (const unsigned*)(DQ + (size_t)(tl0 + r) * 384) + lane * 3;
        dqw[r][0] = rp[0]; dqw[r][1] = rp[1]; dqw[r][2] = rp[2];
        dkw[r] = *(const uint2*)(DKV + (size_t)(tl0 + r) * 256 + lane * 4);
        k1[r] = KRF[(size_t)(tl0 + r) * 32 + (lane & 15)]; k2[r] = KRF[(size_t)(tl0 + r) * 32 + 16 + (lane & 15)];
      }
      const float2* gq = (const float2*)(p.q_norm + l * 384) + lane * 3;
      const float2 g0 = gq[0], g1 = gq[1], g2 = gq[2];
      const float4 gk = *(const float4*)(p.kv_norm + l * 256 + lane * 4);
      asm volatile("" ::: "memory");
      float qv[4][6], kv4[4][4], sq[4], sk[4];
#pragma unroll
      for (int r = 0; r < 4; r++) {
#pragma unroll
        for (int j = 0; j < 3; j++) { qv[r][2 * j] = __uint_as_float(dqw[r][j] << 16); qv[r][2 * j + 1] = __uint_as_float(dqw[r][j] & 0xffff0000u); }
        kv4[r][0] = __uint_as_float(dkw[r].x << 16); kv4[r][1] = __uint_as_float(dkw[r].x & 0xffff0000u);
        kv4[r][2] = __uint_as_float(dkw[r].y << 16); kv4[r][3] = __uint_as_float(dkw[r].y & 0xffff0000u);
        sq[r] = 0.f; sk[r] = 0.f;
#pragma unroll
        for (int j = 0; j < 6; j++) sq[r] += qv[r][j] * qv[r][j];
#pragma unroll
        for (int j = 0; j < 4; j++) sk[r] += kv4[r][j] * kv4[r][j];
      }
#pragma unroll
      for (int o = 32; o > 0; o >>= 1) {
#pragma unroll
        for (int r = 0; r < 4; r++) { sq[r] += __shfl_xor(sq[r], o); sk[r] += __shfl_xor(sk[r], o); }
      }
#pragma unroll
      for (int r = 0; r < 4; r++) {
        const int tl = tl0 + r;
        const float rq = rsqrtf(sq[r] * (1.f / 384.f) + 1e-6f);
        u16* dqn = (u16*)(p.ws + O_DQN);
        *(unsigned*)(dqn + blk_off(tl, lane * 6 + 0, 384)) = pack2(qv[r][0] * rq * g0.x, qv[r][1] * rq * g0.y);
        *(unsigned*)(dqn + blk_off(tl, lane * 6 + 2, 384)) = pack2(qv[r][2] * rq * g1.x, qv[r][3] * rq * g1.y);
        *(unsigned*)(dqn + blk_off(tl, lane * 6 + 4, 384)) = pack2(qv[r][4] * rq * g2.x, qv[r][5] * rq * g2.y);
        const float rk = rsqrtf(sk[r] * (1.f / 256.f) + 1e-6f);
        const float a = kv4[r][0] * rk * gk.x, b = kv4[r][1] * rk * gk.y, c = kv4[r][2] * rk * gk.z, d = kv4[r][3] * rk * gk.w;
        const int row = (s == 0) ? tl : ((tl >> 10) * 1280 + 256 + (tl & 1023));
        st4bf(CKV + blk_off(row, lane * 4, 256), a, b, c, d);
        if (s == 0) {
          const int bb = tl >> 8, sqi = tl & 255;
          *(float4*)(p.out + OUT_CKV + ((size_t)(bb * 2 + l) * 256 + sqi) * 256 + lane * 4) = make_float4(a, b, c, d);
        }
        if (lane < 16) {
          const float x1 = k1[r], x2 = k2[r];
          if (s == 0) {
            KR[(size_t)tl * 32 + lane] = f2bf(x1);
            KR[(size_t)tl * 32 + 16 + lane] = f2bf(x2);
          } else {
            const int nn = tl & 1023;
            const float pos = (lane < 8) ? (float)(nn >> 6) : (float)(nn & 63);
            const float inv = powf(10000.f, -(float)(lane & 7) * 0.125f);
            const float ang = pos * inv;
            const float cs = cosf(ang), sn = sinf(ang);
            const int row2 = (tl >> 10) * 1280 + 256 + nn;
            KR[(size_t)row2 * 32 + lane] = f2bf(x1 * cs - x2 * sn);
            KR[(size_t)row2 * 32 + 16 + lane] = f2bf(x1 * sn + x2 * cs);
          }
        }
      }
    } else if (item < n_row + n_ln) {
      const int it = item - n_row, chunk = it >> 2, slab = it & 3;
      u16* g = GVT + (size_t)chunk * 512 * 128 + slab * 32;
      const int q = t & 31, part = t >> 5;
      float v[64];
      float sum = 0.f, sq = 0.f;
#pragma unroll
      for (int c = 0; c < 64; c++) { v[c] = gelu_f(bf2f(g[(part * 64 + c) * 128 + q])); sum += v[c]; sq += v[c] * v[c]; }
      float* red = (float*)smem;
      red[(part * 2 + 0) * 32 + q] = sum; red[(part * 2 + 1) * 32 + q] = sq;
      __syncthreads();
      sum = 0.f; sq = 0.f;
#pragma unroll
      for (int pp = 0; pp < 8; pp++) { sum += red[(pp * 2 + 0) * 32 + q]; sq += red[(pp * 2 + 1) * 32 + q]; }
      const float mu = sum * (1.f / 512.f);
      const float var = fmaxf(sq * (1.f / 512.f) - mu * mu, 0.f);
      const float rstd = rsqrtf(var + 1e-6f);
#pragma unroll
      for (int c = 0; c < 64; c++) g[(part * 64 + c) * 128 + q] = f2bf((v[c] - mu) * rstd);
      __syncthreads();
    } else {
      const int rowi = (item - n_row - n_ln) * 4 + wave;
      const int b = rowi >> 8, m = rowi & 255;
      const float4 a = *(const float4*)(p.cache_ckv + ((size_t)(b * 2 + l) * 256 + m) * 256 + lane * 4);
      st4bf(CKV + blk_off(b * 1280 + m, lane * 4, 256), a.x, a.y, a.z, a.w);
      if (lane < 32) KR[(size_t)(b * 1280 + m) * 32 + lane] = f2bf(p.cache_kr[((size_t)(b * 2 + l) * 256 + m) * 32 + lane]);
    }
  }
}

typedef __attribute__((ext_vector_type(4))) float f32x4;
struct AttnSrc { const u16* k; const u16* kr; const u16* vt; int vts; };
struct AttnState { f32x4 o[4]; float mx, ls; };
constexpr int ATT_VST = 136;

struct AttnRegs { uint4 k0, k1, k2, v0, v1; };
template <int DQK>
DEV void attn_gload(const AttnSrc& src, AttnRegs& r, int t) {
  const int row = t >> 3, c8 = (t & 7) * 8;
  r.k0 = *(const uint4*)(src.k + (size_t)row * 512 + c8);
  r.k1 = *(const uint4*)(src.k + (size_t)(row + 32) * 512 + c8);
  r.v0 = *(const uint4*)(src.vt + (size_t)row * src.vts + c8);
  r.v1 = *(const uint4*)(src.vt + (size_t)(row + 32) * src.vts + c8);
  if (DQK == 96) r.k2 = *(const uint4*)(src.kr + (size_t)(t >> 2) * 32 + (t & 3) * 8);
}
template <int DQK>
DEV void attn_swrite(char* buf, const AttnRegs& r, int t) {
  constexpr int KST = DQK * 2 + 16;
  const int row = t >> 3, c16 = (t & 7) * 16;
  char* vb = buf + 64 * KST;
  *(uint4*)(buf + row * KST + c16) = make_uint4(r.k0.x, r.k0.y, r.k0.z, r.k0.w);
  *(uint4*)(buf + (row + 32) * KST + c16) = make_uint4(r.k1.x, r.k1.y, r.k1.z, r.k1.w);
  char* vp = vb + row * ATT_VST + c16;
  *(uint2*)vp = make_uint2(r.v0.x, r.v0.y);
  *(uint2*)(vp + 8) = make_uint2(r.v0.z, r.v0.w);
  vp += 32 * ATT_VST;
  *(uint2*)vp = make_uint2(r.v1.x, r.v1.y);
  *(uint2*)(vp + 8) = make_uint2(r.v1.z, r.v1.w);
  if (DQK == 96) *(uint4*)(buf + (t >> 2) * KST + 128 + (t & 3) * 16) = make_uint4(r.k2.x, r.k2.y, r.k2.z, r.k2.w);
}

template <int DQK, int NT, bool LOCAL>
DEV void attn_compute(const char* buf, const bf16x8 qf0, const bf16x8 qf1, const bf16x8 qf2, AttnState& st, float scale, int koff0, const float* biasrow, int qc, int wlo, const int tid_) {
  constexpr int KST = DQK * 2 + 16;
  const int lane = TIDX & 63, r16 = lane & 15, g = lane >> 4;
  const char* vb = buf + 64 * KST;
  f32x4 s[NT];
#pragma unroll
  for (int t = 0; t < NT; t++) {
    s[t] = f32x4{0.f, 0.f, 0.f, 0.f};
    const char* kp = buf + (koff0 + t * 16 + r16) * KST + g * 16;
    s[t] = __builtin_amdgcn_mfma_f32_16x16x32_bf16(*(const bf16x8*)(kp), qf0, s[t], 0, 0, 0);
    s[t] = __builtin_amdgcn_mfma_f32_16x16x32_bf16(*(const bf16x8*)(kp + 64), qf1, s[t], 0, 0, 0);
    if (DQK == 96) s[t] = __builtin_amdgcn_mfma_f32_16x16x32_bf16(*(const bf16x8*)(kp + 128), qf2, s[t], 0, 0, 0);
  }
  float mloc = st.mx;
#pragma unroll
  for (int t = 0; t < NT; t++)
#pragma unroll
    for (int e = 0; e < 4; e++) {
      float v = s[t][e] * scale;
      if (LOCAL) {
        const int kc = koff0 + t * 16 + 4 * g + e;
        const int bi = min(max(kc - qc + 15, 0), 30);
        const float bv = biasrow[bi] * 1.4426950408889634f;
        v = (kc >= wlo && kc < wlo + 16) ? v + bv : -1e30f;
      }
      s[t][e] = v;
      mloc = fmaxf(mloc, v);
    }
  mloc = fmaxf(mloc, __shfl_xor(mloc, 16));
  mloc = fmaxf(mloc, __shfl_xor(mloc, 32));
  const float alpha = __builtin_amdgcn_exp2f(st.mx - mloc);
  st.mx = mloc;
  float psum = 0.f;
#pragma unroll
  for (int t = 0; t < NT; t++)
#pragma unroll
    for (int e = 0; e < 4; e++) {
      const float pv = __builtin_amdgcn_exp2f(s[t][e] - mloc);
      s[t][e] = pv;
      psum += pv;
    }
  st.ls = st.ls * alpha + psum;
#pragma unroll
  for (int dt = 0; dt < 4; dt++) st.o[dt] *= alpha;
#pragma unroll
  for (int kb = 0; kb < NT / 2; kb++) {
    bf16x8 pf;
#pragma unroll
    for (int e = 0; e < 4; e++) { pf[e] = (__bf16)s[2 * kb][e]; pf[4 + e] = (__bf16)s[2 * kb + 1][e]; }
#pragma unroll
    for (int dt = 0; dt < 4; dt++) {
      const char* vp = vb + (dt * 16 + r16) * ATT_VST + (koff0 + 4 * g) * 2 + kb * 64;
      const uint2 a0 = *(const uint2*)vp, a1 = *(const uint2*)(vp + 32);
      const uint4 av = make_uint4(a0.x, a0.y, a1.x, a1.y);
      st.o[dt] = __builtin_amdgcn_mfma_f32_16x16x32_bf16(__builtin_bit_cast(bf16x8, av), pf, st.o[dt], 0, 0, 0);
    }
  }
}

template <int MODE>
DEV void attn_item(const Params& p, int l, int it, char* smem, const int tid_) {
  constexpr int DQK = (MODE >= 2) ? 96 : 64;
  constexpr int KST = DQK * 2 + 16;
  constexpr int BUFSZ = 64 * KST + 64 * ATT_VST;
  const int t = TIDX, lane = t & 63, w = t >> 6, r16 = lane & 15, g = lane >> 4;
  constexpr int QB = (MODE >= 2) ? 2 : 1;
  int b, h, tl0, nst, r = 0;
  if (MODE == 0) { b = it >> 5; h = (it >> 2) & 7; tl0 = b * 256 + (it & 3) * 64; nst = 4; }
  else if (MODE == 1) { b = it >> 7; h = (it >> 4) & 7; r = it & 15; tl0 = b * 1024 + r * 64; nst = 12; }
  else if (MODE == 2) { b = it >> 4; h = (it >> 1) & 7; tl0 = b * 256 + (it & 1) * 128; nst = 4; }
  else { b = it >> 6; h = (it >> 3) & 7; tl0 = b * 1024 + (it & 7) * 128; nst = 20; }
  const int tl = tl0 + w * (16 * QB) + r16;
  const int wr0 = min(max(r - 4, 0), 8);
  const u16* KNA = (const u16*)(p.ws + O_KNA); const u16* VTNA = (const u16*)(p.ws + O_VTNA);
  const u16* KC = (const u16*)(p.ws + O_KC); const u16* VTC = (const u16*)(p.ws + O_VTC);
  const u16* KNOPE = (const u16*)(p.ws + O_KNOPE); const u16* KR = (const u16*)(p.ws + O_KR); const u16* VTM = (const u16*)(p.ws + O_VTM);
  auto get_src = [&](int st) {
    AttnSrc s;
    s.kr = nullptr;
    if (MODE == 0) {
      s.k = KNA + (size_t)(b * 256 + st * 64) * 512 + h * 64; s.vt = VTNA + (size_t)(b * 512 + h * 64) * 256 + st * 64; s.vts = 256;
    } else if (MODE == 1) {
      if (st < 8) {
        const int krow = wr0 + st;
        s.k = KNA + (size_t)(b * 1024 + krow * 64) * 512 + h * 64; s.vt = VTNA + (size_t)(b * 512 + h * 64) * 1024 + krow * 64; s.vts = 1024;
      } else {
        const int m0 = (st - 8) * 64;
        s.k = KC + ((size_t)(l * 8 + b) * 256 + m0) * 512 + h * 64; s.vt = VTC + ((size_t)(l * 8 + b) * 512 + h * 64) * 256 + m0; s.vts = 256;
      }
    } else if (MODE == 2) {
      s.k = KNOPE + (size_t)(b * 256 + st * 64) * 512 + h * 64; s.kr = KR + (size_t)(b * 256 + st * 64) * 32;
      s.vt = VTM + (size_t)(b * 512 + h * 64) * 256 + st * 64; s.vts = 256;
    } else {
      s.k = KNOPE + (size_t)(b * 1280 + st * 64) * 512 + h * 64; s.kr = KR + (size_t)(b * 1280 + st * 64) * 32;
      s.vt = VTM + (size_t)(b * 512 + h * 64) * 1280 + st * 64; s.vts = 1280;
    }
    return s;
  };
  AttnRegs rg;
  rg.k2 = make_uint4(0, 0, 0, 0);
  {
    const AttnSrc s0 = get_src(0);
    attn_gload<DQK>(s0, rg, t);
  }
  asm volatile("" ::: "memory");
  auto load_q = [&](int tl, bf16x8& qf0, bf16x8& qf1, bf16x8& qf2) {
  if (MODE < 2) {
    const u16* qp = (const u16*)(p.ws + O_QNA) + (size_t)tl * 512 + h * 64 + 8 * g;
    qf0 = *(const bf16x8*)qp; qf1 = *(const bf16x8*)(qp + 32); qf2 = qf0;
  } else {
    const u16* qp = (const u16*)(p.ws + O_QM) + (size_t)tl * 768 + h * 96;
    qf0 = *(const bf16x8*)(qp + 8 * g); qf1 = *(const bf16x8*)(qp + 32 + 8 * g);
    if (MODE == 2) {
      qf2 = *(const bf16x8*)(qp + 64 + 8 * g);
    } else {
      const uint4 own = *(const uint4*)(qp + 64 + 8 * g), oth = *(const uint4*)(qp + 64 + 8 * (g ^ 2));
      const unsigned ow[4] = {own.x, own.y, own.z, own.w}, ot[4] = {oth.x, oth.y, oth.z, oth.w};
      const int nn = tl & 1023;
      const float pos = (g & 1) ? (float)(nn & 63) : (float)(nn >> 6);
      bf16x8 qr;
#pragma unroll
      for (int e = 0; e < 8; e++) {
        const float a = __uint_as_float((e & 1) ? (ow[e >> 1] & 0xffff0000u) : (ow[e >> 1] << 16));
        const float c = __uint_as_float((e & 1) ? (ot[e >> 1] & 0xffff0000u) : (ot[e >> 1] << 16));
        const float inv = powf(10000.f, -(float)e * 0.125f);
        const float ang = pos * inv;
        const float cs = cosf(ang), sn = sinf(ang);
        const float v = (g < 2) ? (a * cs - c * sn) : (c * sn + a * cs);
        qr[e] = (__bf16)v;
      }
      qf2 = qr;
    }
  }
  };
  bf16x8 qf0, qf1, qf2, qg0, qg1, qg2;
  load_q(tl, qf0, qf1, qf2);
  if (QB == 2) load_q(tl + 16, qg0, qg1, qg2); else { qg0 = qf0; qg1 = qf1; qg2 = qf2; }
  float* biasl = (float*)(smem + 2 * BUFSZ);
  if (MODE == 1) {
    for (int i = t; i < 465; i += 256) biasl[i] = p.na_rpb[(size_t)(l * 8 + h) * 465 + i];
  }
  AttnState st, st2;
#pragma unroll
  for (int dt = 0; dt < 4; dt++) { st.o[dt] = f32x4{0.f, 0.f, 0.f, 0.f}; st2.o[dt] = f32x4{0.f, 0.f, 0.f, 0.f}; }
  st.mx = -1e30f; st.ls = 0.f; st2.mx = -1e30f; st2.ls = 0.f;
  const float scale = ((MODE >= 2) ? 0.10206207261596575f : 0.125f) * 1.4426950408889634f;
  const int qc = w * 16 + r16;
  const int wlo = min(max(qc - 8, 0), 48);
  const int wstart = min(max(16 * w - 8, 0), 32);
  asm volatile("" ::: "memory"); __builtin_amdgcn_sched_barrier(0);
  attn_swrite<DQK>(smem, rg, t);
  __syncthreads();
  for (int sidx = 0; sidx < nst; sidx++) {
    { const AttnSrc sn = get_src(min(sidx + 1, nst - 1)); attn_gload<DQK>(sn, rg, t); }
    asm volatile("" ::: "memory"); __builtin_amdgcn_sched_barrier(0);
    const char* buf = smem + (sidx & 1) * BUFSZ;
    if (MODE == 1 && sidx < 8) attn_compute<DQK, 2, true>(buf, qf0, qf1, qf2, st, scale, wstart, biasl + (wr0 + sidx - r + 7) * 31, qc, wlo, tid_);
    else {
      attn_compute<DQK, 4, false>(buf, qf0, qf1, qf2, st, scale, 0, nullptr, 0, 0, tid_);
      if (QB == 2) attn_compute<DQK, 4, false>(buf, qg0, qg1, qg2, st2, scale, 0, nullptr, 0, 0, tid_);
    }
    asm volatile("" ::: "memory"); __builtin_amdgcn_sched_barrier(0);
    attn_swrite<DQK>(smem + ((sidx + 1) & 1) * BUFSZ, rg, t);
    __syncthreads();
  }
  auto finish = [&](const AttnState& st, int tl) {
    float lt = st.ls;
    lt += __shfl_xor(lt, 16);
    lt += __shfl_xor(lt, 32);
    const float inv = 1.f / lt;
    u16* Z = (u16*)(p.ws + (MODE < 2 ? O_ZA : O_ZC)) + (size_t)(MODE & 1) * 8192 * 512 + blk_off(tl, h * 64 + 4 * g, 512);
#pragma unroll
    for (int dt = 0; dt < 4; dt++) {
      float a, bb, c, d;
      ld4bf(Z + dt * 16, a, bb, c, d);
      a = silu_f(a); bb = silu_f(bb); c = silu_f(c); d = silu_f(d);
      st4bf(Z + dt * 16, st.o[dt][0] * inv * a, st.o[dt][1] * inv * bb, st.o[dt][2] * inv * c, st.o[dt][3] * inv * d);
    }
  };
  finish(st, tl);
  if (QB == 2) finish(st2, tl + 16);
}

DEV void phase_mix(const Params& p, int l, int s, char* smem, const int tid_, const int vb_, const int vg_) {
  const int n_att = 1024;
  const int n_sgu = 256;
  const int total = n_att + n_sgu;
  for (int item = vb_; item < total; item += vg_) {
    if (item < n_att) {
      if (s == 0) attn_item<0>(p, l, item, smem, tid_); else attn_item<1>(p, l, item, smem, tid_);
    } else if (item < n_att + n_sgu) {
      const int it = item - n_att, chunk = it >> 2, g = it & 3;
      const u16* Wg = (const u16*)(p.ws + O_SGUW) + (size_t)(l * 4 + g) * 128 * 128;
      const u16* V = (const u16*)(p.ws + O_GVT) + ((size_t)chunk * 512 + g * 128) * 128;
      const u16* GU = (const u16*)(p.ws + O_GU); u16* ZB = (u16*)(p.ws + O_ZB) + (size_t)s * 8192 * 512;
      f32x16 acc[2][2];
      acc_zero(acc);
      gemm_mainloop_d1(Wg, 128, V, 128, 128, smem, acc, tid_);
      epi_foreach(acc, tid_, [&](int i, int j, float v0, float v1, float v2, float v3) {
        const float bs = p.sgu_b[(l * 4 + g) * 128 + i];
        const size_t off = (size_t)(chunk * 128 + i) * 512 + g * 128 + j;
        float u0, u1, u2, u3, z0, z1, z2, z3;
        ld4bf(GU + off, u0, u1, u2, u3);
        const size_t zoff = blk_off(chunk * 128 + i, g * 128 + j, 512);
        ld4bf(ZB + zoff, z0, z1, z2, z3);
        u0 = gelu_f(u0); u1 = gelu_f(u1); u2 = gelu_f(u2); u3 = gelu_f(u3);
        z0 = silu_f(z0); z1 = silu_f(z1); z2 = silu_f(z2); z3 = silu_f(z3);
        st4bf(ZB + zoff, u0 * (v0 + bs) * z0, u1 * (v1 + bs) * z1, u2 * (v2 + bs) * z2, u3 * (v3 + bs) * z3);
      });
    }
  }
}

DEV void phase_mla(const Params& p, int l, int s, char* smem, const int tid_, const int vb_, const int vg_) {
  for (int item = vb_; item < 512; item += vg_) {
    if (s == 0) attn_item<2>(p, l, item, smem, tid_); else attn_item<3>(p, l, item, smem, tid_);
  }
}

DEV void phase_final(const Params& p, const int tid_, const int vb_, const int vg_) {
  const int lane = TIDX & 63, wave = TIDX >> 6;
  for (int item = vb_; item < 1024; item += vg_) {
    float* x = p.out + OUT_Y + (size_t)(item * 16 + wave * 4) * 1024;
    float4 v[4][4];
#pragma unroll
    for (int r = 0; r < 4; r++)
#pragma unroll
      for (int i = 0; i < 4; i++) v[r][i] = *(const float4*)(x + (size_t)r * 1024 + i * 256 + lane * 4);
    float4 g[4];
#pragma unroll
    for (int i = 0; i < 4; i++) g[i] = *(const float4*)(p.final_g + i * 256 + lane * 4);
    asm volatile("" ::: "memory");
    float ss[4];
#pragma unroll
    for (int r = 0; r < 4; r++) {
      ss[r] = 0.f;
#pragma unroll
      for (int i = 0; i < 4; i++) ss[r] += v[r][i].x * v[r][i].x + v[r][i].y * v[r][i].y + v[r][i].z * v[r][i].z + v[r][i].w * v[r][i].w;
    }
#pragma unroll
    for (int o = 32; o > 0; o >>= 1) {
#pragma unroll
      for (int r = 0; r < 4; r++) ss[r] += __shfl_xor(ss[r], o);
    }
#pragma unroll
    for (int r = 0; r < 4; r++) {
      const float rstd = rsqrtf(ss[r] * (1.f / 1024.f) + 1e-6f);
#pragma unroll
      for (int i = 0; i < 4; i++)
        *(float4*)(x + (size_t)r * 1024 + i * 256 + lane * 4) =
            make_float4(v[r][i].x * rstd * g[i].x, v[r][i].y * rstd * g[i].y, v[r][i].z * rstd * g[i].z, v[r][i].w * rstd * g[i].w);
    }
  }
}

namespace pg8 {
#define PG8_LAS __attribute__((address_space(3)))
typedef unsigned short bf16_t;
typedef short bf16x8 __attribute__((ext_vector_type(8)));
typedef float f32x4 __attribute__((ext_vector_type(4)));
typedef unsigned u32x4 __attribute__((ext_vector_type(4)));
constexpr int BM = 256, BK = 64, HALF = 128, HTB = HALF * BK * 2  , STAGE_BYTES = 8 * HTB, NXCD = 8, WGM = 8;

__host__ __device__ __forceinline__ int lds_byte(int r, int c) { const int st = (r >> 4) * 2 + (c >> 5), rr = r & 15, cc = c & 31, ob = rr * 64 + cc * 2; return st * 1024 + (ob ^ (((ob >> 9) & 1) << 5)); }
__host__ __device__ __forceinline__ void stage_rc(int b, int& R, int& C) { const int st = b / 1024, sb = b % 1024, swz = sb ^ (((sb >> 9) & 1) << 5); R = (st >> 1) * 16 + swz / 64; C = (st & 1) * 32 + (swz % 64) / 2; }
__host__ __device__ __forceinline__ int perm32(int rho) { const int n = rho >> 4, i = rho & 15; return 8 * (i >> 2) + 4 * n + (i & 3); }

struct Unit { int pm, pn; };
struct Gemm { const bf16_t* A; const bf16_t* Bt; int M, N, K; };

template <class Epi, class Sched, bool STAMP = false>
__device__ __forceinline__ void gemm_phase(PG8_LAS unsigned char* lds, const Gemm g, const Sched& S, const Epi& E, unsigned long long* stamps) {
    const int tid = tid_opaque(), wid = __builtin_amdgcn_readfirstlane(tid >> 6), lane = tid & 63, wr = wid >> 2, wc = wid & 3, fr = lane & 15, fq = lane >> 4;
    const int K = g.K, nt = K / BK;
    int ts_lo = 0, ts_hi = 0, nts = 0; const unsigned long long rt_entry = STAMP ? (unsigned long long)wall_clock64() : 0ull;
#define PG8_STAMP() do { if (STAMP && wid == 0 && nts < 64) { const unsigned long long _c = (unsigned long long)clock64(); \
        ts_lo = (lane == nts) ? (int)(unsigned)_c : ts_lo; ts_hi = (lane == nts) ? (int)(unsigned)(_c >> 32) : ts_hi; ++nts; } } while (0)
    PG8_STAMP();
    unsigned voffA[2], voffB[2];
#pragma unroll
    for (int i = 0; i < 2; ++i) { int R, C; stage_rc(tid * 16 + i * 8192, R, C); const int Rb = Epi::PERM ? ((R & ~31) + perm32(R & 31)) : R;
        voffA[i] = (unsigned)(R * BK + C) * 2u; voffB[i] = (unsigned)(Rb * BK + C) * 2u; }
    const size_t kstep = (size_t)(BM * BK * 2);
    const size_t hstep = (size_t)HALF * BK * 2;
    const size_t tstep = (size_t)BM * K * 2;
    const unsigned ldsw = (unsigned)wid * 1024u;
    const int aoff = lds_byte(wr * 64 + fr, fq * 8), boff = lds_byte(wc * 32 + fr, fq * 8);
#define PG8_SA(b, h) (((b) * 2 + (h)) * HTB)
#define PG8_SB(b, h) ((4 + (b) * 2 + (h)) * HTB)
#define PG8_STAGE(bufoff, gbase, voff) do { _Pragma("unroll") for (int _i = 0; _i < 2; ++_i) \
        __builtin_amdgcn_global_load_lds((const unsigned*)((const char*)(gbase) + (voff)[_i]), (PG8_LAS unsigned*)(lds + (bufoff) + ldsw + _i * 8192), 16, 0, 0); } while (0)
#define PG8_LDA(dst, b, h) do { _Pragma("unroll") for (int m = 0; m < 4; ++m) _Pragma("unroll") for (int k = 0; k < 2; ++k) dst[m][k] = *(const PG8_LAS bf16x8*)(lds + PG8_SA(b, h) + aoff + m * 2048 + k * 1024); } while (0)
#define PG8_LDB(dst, b, h) do { _Pragma("unroll") for (int n = 0; n < 2; ++n) _Pragma("unroll") for (int k = 0; k < 2; ++k) dst[n][k] = *(const PG8_LAS bf16x8*)(lds + PG8_SB(b, h) + boff + n * 2048 + k * 1024); } while (0)
#define PG8_MMA(ai, bj, At, Bt) do { __builtin_amdgcn_s_setprio(1); _Pragma("unroll") for (int m = 0; m < 4; ++m) _Pragma("unroll") for (int n = 0; n < 2; ++n) _Pragma("unroll") for (int k = 0; k < 2; ++k) \
        acc[ai][bj][m][n] = __builtin_amdgcn_mfma_f32_16x16x32_bf16(Bt[n][k], At[m][k], acc[ai][bj][m][n], 0, 0, 0); __builtin_amdgcn_s_setprio(0); } while (0)
#define PG8_WAIT_V(n) asm volatile("s_waitcnt vmcnt(" #n ")" ::: "memory")
#define PG8_WAIT_L(n) asm volatile("s_waitcnt lgkmcnt(" #n ")" ::: "memory")
#define PG8_BAR __builtin_amdgcn_s_barrier()
#define PG8_SCHED __builtin_amdgcn_sched_barrier(0)
    Unit cur, nxt; int ui = 0;
    if (!S.next(0, cur)) return;
    f32x4 acc[2][2][4][2];
#pragma unroll
    for (int a = 0; a < 2; ++a)
#pragma unroll
        for (int b = 0; b < 2; ++b)
#pragma unroll
            for (int m = 0; m < 4; ++m)
#pragma unroll
                for (int n = 0; n < 2; ++n) acc[a][b][m][n] = (f32x4){0.f, 0.f, 0.f, 0.f};
    bf16x8 At[4][2], B0[2][2], B1[2][2];
    const char* cA = (const char*)g.A + (size_t)cur.pm * tstep; const char* cB = (const char*)g.Bt + (size_t)cur.pn * tstep;
    S.a_ready(cur);
    PG8_STAGE(PG8_SB(0, 0), cB, voffB); PG8_STAGE(PG8_SA(0, 0), cA, voffA); PG8_STAGE(PG8_SB(0, 1), cB + hstep, voffB); PG8_STAGE(PG8_SA(0, 1), cA + hstep, voffA);
    if (wr == 1) PG8_BAR;
    PG8_WAIT_V(4); PG8_BAR;
    PG8_STAGE(PG8_SB(1, 0), cB + kstep, voffB); PG8_STAGE(PG8_SA(1, 0), cA + kstep, voffA); PG8_STAGE(PG8_SB(1, 1), cB + hstep + kstep, voffB);
    PG8_WAIT_V(6); PG8_BAR;
    PG8_STAMP();
    for (;;) {
        const bool has_next = S.next(ui + 1, nxt);
        const char* nA = has_next ? (const char*)g.A + (size_t)nxt.pm * tstep : cA; const char* nB = has_next ? (const char*)g.Bt + (size_t)nxt.pn * tstep : cB;
        for (int t = 0; t < nt; t += 2) {
            const bool last = (t == nt - 2);
            const char* a1 = cA + (size_t)(t + 1) * kstep;
            const char* a2 = last ? nA : cA + (size_t)(t + 2) * kstep; const char* b2 = last ? nB : cB + (size_t)(t + 2) * kstep;
            const char* a3 = a2 + kstep; const char* b3 = b2 + kstep;
            if (last && has_next) S.a_ready(nxt);
            PG8_LDB(B0, 0, 0); PG8_SCHED; PG8_LDA(At, 0, 0); PG8_STAGE(PG8_SA(1, 1), a1 + hstep, voffA);
            PG8_WAIT_L(8); PG8_BAR; PG8_WAIT_L(0); PG8_MMA(0, 0, At, B0); PG8_BAR; PG8_SCHED;
            PG8_LDB(B1, 0, 1); PG8_STAGE(PG8_SB(0, 0), b2, voffB);
            PG8_BAR; PG8_WAIT_L(0); PG8_MMA(0, 1, At, B1); PG8_BAR;
            PG8_LDA(At, 0, 1); PG8_STAGE(PG8_SA(0, 0), a2, voffA);
            PG8_BAR; PG8_WAIT_L(0); PG8_MMA(1, 0, At, B0); PG8_BAR; PG8_SCHED;
            PG8_STAGE(PG8_SB(0, 1), b2 + hstep, voffB);
            PG8_WAIT_V(6); PG8_BAR; PG8_MMA(1, 1, At, B1); PG8_BAR;
            PG8_LDB(B0, 1, 0); PG8_SCHED; PG8_LDA(At, 1, 0); PG8_STAGE(PG8_SA(0, 1), a2 + hstep, voffA);
            PG8_WAIT_L(8); PG8_BAR; PG8_WAIT_L(0); PG8_MMA(0, 0, At, B0); PG8_BAR; PG8_SCHED;
            PG8_LDB(B1, 1, 1); PG8_STAGE(PG8_SB(1, 0), b3, voffB);
            PG8_BAR; PG8_WAIT_L(0); PG8_MMA(0, 1, At, B1); PG8_BAR;
            PG8_LDA(At, 1, 1); PG8_STAGE(PG8_SA(1, 0), a3, voffA);
            PG8_BAR; PG8_WAIT_L(0); PG8_MMA(1, 0, At, B0); PG8_BAR; PG8_SCHED;
            PG8_STAGE(PG8_SB(1, 1), b3 + hstep, voffB);
            PG8_WAIT_V(6); PG8_BAR; PG8_MMA(1, 1, At, B1); PG8_BAR;
        }
        PG8_STAMP();
        if constexpr (!Epi::AFTER_DRAIN) { E(acc, cur, wr, wc, fr, fq); S.done(cur); }
        PG8_STAMP();
        if (!has_next) break;
        if constexpr (!Epi::KEEP_ACC) {
#pragma unroll
        for (int a = 0; a < 2; ++a)
#pragma unroll
            for (int b = 0; b < 2; ++b)
#pragma unroll
                for (int m = 0; m < 4; ++m)
#pragma unroll
                    for (int n = 0; n < 2; ++n) acc[a][b][m][n] = (f32x4){0.f, 0.f, 0.f, 0.f};
        }
        cur = nxt; cA = nA; cB = nB; ++ui;
    }
    PG8_WAIT_V(0);
    if (wr == 0) PG8_BAR;
    PG8_BAR;
    if constexpr (Epi::AFTER_DRAIN) { E.fused(acc, cur, wr, wc, fr, fq, lds, wid, lane); S.done(cur); }
    PG8_STAMP();
    if (STAMP && wid == 0) { stamps[lane] = lane < nts ? (((unsigned long long)(unsigned)ts_hi << 32) | (unsigned)ts_lo) : 0ull;
        if (lane == 62) stamps[62] = rt_entry; if (lane == 63) stamps[63] = (unsigned long long)wall_clock64(); }
#undef PG8_STAMP
#undef PG8_SA
#undef PG8_SB
#undef PG8_STAGE
#undef PG8_LDA
#undef PG8_LDB
#undef PG8_MMA
#undef PG8_WAIT_V
#undef PG8_WAIT_L
#undef PG8_BAR
#undef PG8_SCHED
}
}


struct InSched {
  int l, c;
  __device__ __forceinline__ bool next(int i, pg8::Unit& u) const {
    const int x = c >> 5, q = c & 31;
    const int e = i * 32 + q;
    if (e >= 124) return false;
    const int it = 4 * x + (e & 3), jt = e >> 2;
    const bool swapped = (jt == 4) || (jt == 5) || (jt == 10) || (jt == 11);
    if (swapped) { u.pm = l * 31 + jt; u.pn = 62 + it; } else { u.pm = 62 + it; u.pn = l * 31 + jt; }
    return true;
  }
  __device__ __forceinline__ void a_ready(const pg8::Unit&) const {}
  __device__ __forceinline__ void done(const pg8::Unit&) const {}
};

DEV void st8bf(u16* p, const pg8::f32x4& a, const pg8::f32x4& b) {
  uint4 w; w.x = pack2(a[0], a[1]); w.y = pack2(a[2], a[3]); w.z = pack2(b[0], b[1]); w.w = pack2(b[2], b[3]);
  *(uint4*)p = w;
}
template <class F> DEV pg8::f32x4 map4(const pg8::f32x4& v, F f) { pg8::f32x4 r; r[0] = f(v[0]); r[1] = f(v[1]); r[2] = f(v[2]); r[3] = f(v[3]); return r; }

struct InEpi {
  static constexpr bool PERM = true, AFTER_DRAIN = false, KEEP_ACC = false;
  char* ws; float* out; int l, s;
  __device__ __forceinline__ void operator()(const pg8::f32x4 (&acc)[2][2][4][2], const pg8::Unit& u, int wr, int wc, int fr, int fq) const {
    u16* QNA = (u16*)(ws + O_QNA); u16* KNA = (u16*)(ws + O_KNA); u16* VTNA = (u16*)(ws + O_VTNA);
    const size_t zs = (size_t)s * 8192 * 512;
    u16* ZA = (u16*)(ws + O_ZA) + zs; u16* ZB = (u16*)(ws + O_ZB) + zs; u16* ZC = (u16*)(ws + O_ZC) + zs;
    u16* GU = (u16*)(ws + O_GU); u16* GVT = (u16*)(ws + O_GVT);
    u16* DQ = (u16*)(ws + O_DQ); u16* DKV = (u16*)(ws + O_DKV); float* KRF = (float*)(ws + O_KRF);
    unsigned char* GATES = (unsigned char*)(ws + O_GATES) + (size_t)s * 8192 * 3072;
    if (u.pm >= 62) {
      const int t0 = (u.pm - 62) * 256 + wr * 64 + fr;
      const int cbase = (u.pn - l * 31) * 256;
#pragma unroll
      for (int bj = 0; bj < 2; ++bj) {
        const int seg0 = cbase + bj * 128;
        const int n = seg0 >> 7;
        const int c0 = seg0 + wc * 32 + 8 * fq;
#pragma unroll
        for (int ai = 0; ai < 2; ++ai)
#pragma unroll
          for (int m = 0; m < 4; ++m) {
            const int T = t0 + ai * 128 + m * 16;
            const pg8::f32x4 v0 = acc[ai][bj][m][0], v1 = acc[ai][bj][m][1];
            if (n < 4) {
              st8bf(QNA + (size_t)T * 512 + c0, v0, v1);
            } else if (n < 8) {
              const int col = c0 - 512;
              st8bf(KNA + (size_t)T * 512 + col, v0, v1);
              if (s == 0) {
                const int b = T >> 8, sq = T & 255;
                float* o = out + OUT_SK + ((size_t)(b * 2 + l) * 256 + sq) * 512 + col;
                *(float4*)o = make_float4(v0[0], v0[1], v0[2], v0[3]); *(float4*)(o + 4) = make_float4(v1[0], v1[1], v1[2], v1[3]);
              }
            } else if (n < 16) {
              st8bf(ZA + blk_off(T, c0 - 1536, 512), v0, v1);
            } else if (n < 20) {
              st8bf(GU + (size_t)T * 512 + c0 - 2048, v0, v1);
            } else if (n < 28) {
              st8bf(ZB + blk_off(T, c0 - 3072, 512), v0, v1);
            } else if (n < 31) {
              st8bf(DQ + (size_t)T * 384 + c0 - 3584, v0, v1);
            } else if (n < 33) {
              st8bf(DKV + (size_t)T * 256 + c0 - 3968, v0, v1);
            } else if (n < 37) {
              st8bf(ZC + blk_off(T, c0 - 4224, 512), v0, v1);
            } else if (n < 61) {
              unsigned q[8];
#pragma unroll
              for (int e = 0; e < 4; e++) { q[e] = (unsigned)(sigmoid_f(v0[e]) * 255.f + 0.5f); q[4 + e] = (unsigned)(sigmoid_f(v1[e]) * 255.f + 0.5f); }
              uint2 gw; gw.x = q[0] | (q[1] << 8) | (q[2] << 16) | (q[3] << 24); gw.y = q[4] | (q[5] << 8) | (q[6] << 16) | (q[7] << 24);
              *(uint2*)(GATES + (size_t)T * 3072 + c0 - 4736) = gw;
            } else if (c0 < 7808 + 32) {
              const int j = c0 - 7808;
              float* kp = KRF + (size_t)T * 32 + j;
              *(float4*)kp = make_float4(v0[0], v0[1], v0[2], v0[3]); *(float4*)(kp + 4) = make_float4(v1[0], v1[1], v1[2], v1[3]);
              if (s == 0) {
                const int b = T >> 8, sq = T & 255;
                float* o = out + OUT_SKR + ((size_t)(b * 2 + l) * 256 + sq) * 32 + j;
                *(float4*)o = make_float4(v0[0], v0[1], v0[2], v0[3]); *(float4*)(o + 4) = make_float4(v1[0], v1[1], v1[2], v1[3]);
              }
            }
          }
      }
    } else {
      const int jt = u.pm - l * 31;
      const int ch0 = jt * 256 + wr * 64 + fr;
      const int tk0 = (u.pn - 62) * 256 + wc * 32 + 8 * fq;
#pragma unroll
      for (int ai = 0; ai < 2; ++ai)
#pragma unroll
        for (int m = 0; m < 4; ++m) {
          const int ch = ch0 + ai * 128 + m * 16;
#pragma unroll
          for (int bj = 0; bj < 2; ++bj) {
            const int tok = tk0 + bj * 128;
            const pg8::f32x4 v0 = acc[ai][bj][m][0], v1 = acc[ai][bj][m][1];
            if (jt < 8) {
              const int dva = ch - 1024;
              if (s == 0) {
                const int b = tok >> 8, sq = tok & 255;
                st8bf(VTNA + ((size_t)(b * 512 + dva)) * 256 + sq, v0, v1);
                float* o = out + OUT_SV + ((size_t)(b * 2 + l) * 256 + sq) * 512 + dva;
                o[0] = v0[0]; o[512] = v0[1]; o[1024] = v0[2]; o[1536] = v0[3]; o[2048] = v1[0]; o[2560] = v1[1]; o[3072] = v1[2]; o[3584] = v1[3];
              } else {
                const int b = tok >> 10, nn = tok & 1023;
                st8bf(VTNA + ((size_t)(b * 512 + dva)) * 1024 + nn, v0, v1);
              }
            } else {
              const int c = ch - 2560;
              const int chunk = tok >> 7, q = tok & 127;
              st8bf(GVT + ((size_t)chunk * 512 + c) * 128 + q, v0, v1);
            }
          }
        }
    }
  }
};

DEV void phase_in8(const Params& p, int l, int s, char* smem_full, int vid) {
  pg8::Gemm g; g.A = (const pg8::bf16_t*)(p.ws + O_WIN); g.Bt = g.A; g.M = 0; g.N = 0; g.K = 1024;
  InSched S; S.l = l; S.c = vid;
  InEpi E; E.ws = p.ws; E.out = p.out; E.l = l; E.s = s;
  pg8::gemm_phase<InEpi, InSched, false>((PG8_LAS unsigned char*)smem_full, g, S, E, nullptr);
}


struct MergeSched {
  int l, c;
  __device__ __forceinline__ bool next(int i, pg8::Unit& u) const {
    const int x = c >> 5, q = c & 31;
    if (i >= 3) return false;
    const int it = 8 * x + (q & 7), jt = q >> 3;
    const size_t zo = (i == 0) ? O_ZA : (i == 1 ? O_ZB : O_ZC);
    u.pm = (int)(zo / 262144) + it;
    u.pn = (int)(O_WBR / 262144) + (l * 3 + i) * 4 + jt;
    return true;
  }
  __device__ __forceinline__ void a_ready(const pg8::Unit&) const {}
  __device__ __forceinline__ void done(const pg8::Unit&) const {}
};
struct MergeEpi {
  static constexpr bool PERM = true, AFTER_DRAIN = false, KEEP_ACC = true;
  char* ws; int l;
  __device__ __forceinline__ void operator()(pg8::f32x4 (&acc)[2][2][4][2], const pg8::Unit& u, int wr, int wc, int fr, int fq) const {
    const int wrel = u.pn - (int)(O_WBR / 262144) - l * 12;
    const int k = wrel >> 2, jt = wrel & 3;
    const size_t zo = (k == 0) ? O_ZA : (k == 1 ? O_ZB : O_ZC);
    const int it = u.pm - (int)(zo / 262144);
    const unsigned char* GATES = (const unsigned char*)(ws + O_GATES);
    u16* MG = (u16*)(ws + O_MG);
    const int t0 = it * 256 + wr * 64 + fr;
#pragma unroll
    for (int ai = 0; ai < 2; ++ai) {
      uint2 ga[4][2], gb[4][2];
#pragma unroll
      for (int m = 0; m < 4; ++m)
#pragma unroll
        for (int bj = 0; bj < 2; ++bj) {
          const int T = t0 + ai * 128 + m * 16;
          const int c0 = jt * 256 + bj * 128 + wc * 32 + 8 * fq;
          const unsigned char* gp = GATES + (size_t)T * 3072 + k * 1024 + c0;
          ga[m][bj] = *(const uint2*)gp;
          gb[m][bj] = (k < 2) ? *(const uint2*)(gp + 1024) : make_uint2(0u, 0u);
        }
      asm volatile("" ::: "memory");
#pragma unroll
      for (int m = 0; m < 4; ++m)
#pragma unroll
        for (int bj = 0; bj < 2; ++bj) {
          const int T = t0 + ai * 128 + m * 16;
          const int c0 = jt * 256 + bj * 128 + wc * 32 + 8 * fq;
          float f[8];
#pragma unroll
          for (int e = 0; e < 8; e++) {
            const float qa = fmaxf((float)((((e < 4) ? ga[m][bj].x : ga[m][bj].y) >> (8 * (e & 3))) & 0xffu), 1.f);
            if (k < 2) {
              const float qb = fmaxf((float)((((e < 4) ? gb[m][bj].x : gb[m][bj].y) >> (8 * (e & 3))) & 0xffu), 1.f);
              f[e] = qa * __builtin_amdgcn_rcpf(qb);
            } else {
              f[e] = qa * (1.f / 255.f);
            }
          }
#pragma unroll
          for (int e = 0; e < 4; e++) { acc[ai][bj][m][0][e] *= f[e]; acc[ai][bj][m][1][e] *= f[4 + e]; }
          if (k == 2) {
            uint4 o;
            o.x = pack2(acc[ai][bj][m][0][0], acc[ai][bj][m][0][1]); o.y = pack2(acc[ai][bj][m][0][2], acc[ai][bj][m][0][3]);
            o.z = pack2(acc[ai][bj][m][1][0], acc[ai][bj][m][1][1]); o.w = pack2(acc[ai][bj][m][1][2], acc[ai][bj][m][1][3]);
            *(uint4*)(MG + blk_off(T, c0, 1024)) = o;
          }
        }
    }
  }
};
DEV void phase_merge8(const Params& p, int l, char* smem_full, int vid) {
  pg8::Gemm g; g.A = (const pg8::bf16_t*)p.ws; g.Bt = g.A; g.M = 0; g.N = 0; g.K = 512;
  MergeSched S; S.l = l; S.c = vid;
  MergeEpi E; E.ws = p.ws; E.l = l;
  pg8::gemm_phase<MergeEpi, MergeSched, false>((PG8_LAS unsigned char*)smem_full, g, S, E, nullptr);
}

struct OutSched {
  int l, c;
  __device__ __forceinline__ bool next(int i, pg8::Unit& u) const {
    const int x = c >> 5, q = c & 31;
    if (i >= 1) return false;
    u.pm = (int)(O_MG / 524288) + 8 * x + (q & 7);
    u.pn = (int)(O_WOUT / 524288) + l * 4 + (q >> 3);
    return true;
  }
  __device__ __forceinline__ void a_ready(const pg8::Unit&) const {}
  __device__ __forceinline__ void done(const pg8::Unit&) const {}
};
struct OutEpi {
  static constexpr bool PERM = true, AFTER_DRAIN = false, KEEP_ACC = false;
  const float* x0; const float* x1; float* outy; const float* MOD; int l;
  __device__ __forceinline__ void operator()(const pg8::f32x4 (&acc)[2][2][4][2], const pg8::Unit& u, int wr, int wc, int fr, int fq) const {
    const int it = u.pm - (int)(O_MG / 524288), jt = u.pn - (int)(O_WOUT / 524288) - l * 4;
    const int s = it >> 5;
    const int t0 = it * 256 + wr * 64 + fr;
    const float* xin = (l == 0) ? ((s == 0) ? x0 : x1 - (size_t)8192 * 1024) : outy;
    typedef __attribute__((address_space(1))) pg8::f32x4 GF4;
    const GF4* xg = (const GF4*)(unsigned long long)xin;
    GF4* og = (GF4*)(unsigned long long)outy;
    const float* gr = MOD + (size_t)(l * 9 + cond_idx(s, t0 & 8191)) * 3072 + 2048;
    float4 gv[2][2];
#pragma unroll
    for (int bj = 0; bj < 2; ++bj)
#pragma unroll
      for (int h2 = 0; h2 < 2; ++h2) gv[bj][h2] = *(const float4*)(gr + jt * 256 + bj * 128 + wc * 32 + 8 * fq + 4 * h2);
#pragma unroll
    for (int ai = 0; ai < 2; ++ai)
#pragma unroll
      for (int mp = 0; mp < 2; ++mp) {
        pg8::f32x4 xv[2][2][2];
#pragma unroll
        for (int mm = 0; mm < 2; ++mm)
#pragma unroll
          for (int bj = 0; bj < 2; ++bj)
#pragma unroll
            for (int h2 = 0; h2 < 2; ++h2)
              xv[mm][bj][h2] = *(xg + (size_t)(t0 + ai * 128 + (mp * 2 + mm) * 16) * 256 + jt * 64 + bj * 32 + wc * 8 + 2 * fq + h2);
        asm volatile("" ::: "memory"); __builtin_amdgcn_sched_barrier(0);
#pragma unroll
        for (int mm = 0; mm < 2; ++mm)
#pragma unroll
          for (int bj = 0; bj < 2; ++bj)
#pragma unroll
            for (int h2 = 0; h2 < 2; ++h2) {
              const int m = mp * 2 + mm;
              const pg8::f32x4 x = xv[mm][bj][h2];
              const float4 g = gv[bj][h2];
              const pg8::f32x4 v = acc[ai][bj][m][h2];
              *(og + (size_t)(t0 + ai * 128 + m * 16) * 256 + jt * 64 + bj * 32 + wc * 8 + 2 * fq + h2) =
                  pg8::f32x4{x[0] + g.x * v[0], x[1] + g.y * v[1], x[2] + g.z * v[2], x[3] + g.w * v[3]};
            }
        asm volatile("" ::: "memory"); __builtin_amdgcn_sched_barrier(0);
      }
  }
};
DEV void phase_out8(const Params& p, int l, char* smem_full, int vid) {
  pg8::Gemm g; g.A = (const pg8::bf16_t*)p.ws; g.Bt = g.A; g.M = 0; g.N = 0; g.K = 1024;
  OutSched S; S.l = l; S.c = vid;
  OutEpi E; E.x0 = p.x_prompt; E.x1 = p.x_sample; E.outy = p.out + OUT_Y; E.MOD = (const float*)(p.ws + O_MOD); E.l = l;
  pg8::gemm_phase<OutEpi, OutSched, false>((PG8_LAS unsigned char*)smem_full, g, S, E, nullptr);
}


struct QSched {
  int l, c;
  __device__ __forceinline__ bool next(int i, pg8::Unit& u) const {
    const int x = c >> 5, q = c & 31;
    if (q >= 12 || i >= 1) return false;
    u.pm = (int)(O_DQN / 196608) + 4 * x + (q & 3);
    u.pn = (int)(O_WUQ / 196608) + l * 3 + (q >> 2);
    return true;
  }
  __device__ __forceinline__ void a_ready(const pg8::Unit&) const {}
  __device__ __forceinline__ void done(const pg8::Unit&) const {}
};
struct QEpi {
  static constexpr bool PERM = true, AFTER_DRAIN = false, KEEP_ACC = false;
  char* ws; int l;
  __device__ __forceinline__ void operator()(const pg8::f32x4 (&acc)[2][2][4][2], const pg8::Unit& u, int wr, int wc, int fr, int fq) const {
    const int it = u.pm - (int)(O_DQN / 196608), jt = u.pn - (int)(O_WUQ / 196608) - l * 3;
    u16* QM = (u16*)(ws + O_QM);
#pragma unroll
    for (int ai = 0; ai < 2; ++ai)
#pragma unroll
      for (int m = 0; m < 4; ++m) {
        const int T = it * 256 + ai * 128 + wr * 64 + m * 16 + fr;
#pragma unroll
        for (int bj = 0; bj < 2; ++bj)
          st8bf(QM + (size_t)T * 768 + jt * 256 + bj * 128 + wc * 32 + 8 * fq, acc[ai][bj][m][0], acc[ai][bj][m][1]);
      }
  }
};
struct KvSched {
  int l, c, nt;
  __device__ __forceinline__ bool next(int i, pg8::Unit& u) const {
    const int x = c >> 5, q = c & 31, per = nt >> 3;
    if (q >= 4 * per || i >= 1) return false;
    const int it = per * x + (q % per), jt = q / per;
    const int wt = (int)(O_WUKV / 131072) + l * 4 + jt, ct = (int)(O_CKV / 131072) + it;
    if (jt < 2) { u.pm = ct; u.pn = wt; } else { u.pm = wt; u.pn = ct; }
    return true;
  }
  __device__ __forceinline__ void a_ready(const pg8::Unit&) const {}
  __device__ __forceinline__ void done(const pg8::Unit&) const {}
};
struct KvEpi {
  static constexpr bool PERM = true, AFTER_DRAIN = false, KEEP_ACC = false;
  char* ws; int l, S;
  __device__ __forceinline__ void operator()(const pg8::f32x4 (&acc)[2][2][4][2], const pg8::Unit& u, int wr, int wc, int fr, int fq) const {
    const int c0t = (int)(O_CKV / 131072), w0t = (int)(O_WUKV / 131072) + l * 4;
    if (u.pm >= c0t) {
      const int it = u.pm - c0t, jt = u.pn - w0t;
      u16* KNOPE = (u16*)(ws + O_KNOPE);
#pragma unroll
      for (int ai = 0; ai < 2; ++ai)
#pragma unroll
        for (int m = 0; m < 4; ++m) {
          const int R = it * 256 + ai * 128 + wr * 64 + m * 16 + fr;
#pragma unroll
          for (int bj = 0; bj < 2; ++bj)
            st8bf(KNOPE + (size_t)R * 512 + jt * 256 + bj * 128 + wc * 32 + 8 * fq, acc[ai][bj][m][0], acc[ai][bj][m][1]);
        }
    } else {
      const int jt = u.pm - w0t - 2, it = u.pn - c0t;
      u16* VTM = (u16*)(ws + O_VTM);
#pragma unroll
      for (int ai = 0; ai < 2; ++ai)
#pragma unroll
        for (int m = 0; m < 4; ++m) {
          const int ch = jt * 256 + ai * 128 + wr * 64 + m * 16 + fr;
#pragma unroll
          for (int bj = 0; bj < 2; ++bj) {
            const int row = it * 256 + bj * 128 + wc * 32 + 8 * fq;
            const int b = row / S, mm = row % S;
            st8bf(VTM + ((size_t)b * 512 + ch) * S + mm, acc[ai][bj][m][0], acc[ai][bj][m][1]);
          }
        }
    }
  }
};
DEV void phase_qkv8(const Params& p, int l, int s, char* smem_full, int vid) {
  {
    pg8::Gemm g; g.A = (const pg8::bf16_t*)p.ws; g.Bt = g.A; g.M = 0; g.N = 0; g.K = 384;
    QSched S; S.l = l; S.c = vid;
    QEpi E; E.ws = p.ws; E.l = l;
    pg8::gemm_phase<QEpi, QSched, false>((PG8_LAS unsigned char*)smem_full, g, S, E, nullptr);
  }
  {
    pg8::Gemm g; g.A = (const pg8::bf16_t*)p.ws; g.Bt = g.A; g.M = 0; g.N = 0; g.K = 256;
    KvSched S; S.l = l; S.c = vid; S.nt = (s == 0) ? 32 : 40;
    KvEpi E; E.ws = p.ws; E.l = l; E.S = (s == 0) ? 256 : 1280;
    pg8::gemm_phase<KvEpi, KvSched, false>((PG8_LAS unsigned char*)smem_full, g, S, E, nullptr);
  }
}

#define XB_TMO      128
#define XB_XCNT(j)  (256  + 64 * (j))
#define XB_XSUB(j)  (1280 + 64 * (j))
#define XB_XGEN(j)  (2304 + 64 * (j))
#define XB_TOP      3328
#define XB_TOPGEN   3392
#define XCD_BAR_WORDS 3456
#define XB_SPIN_CAP (1u << 18)
#define LAS __attribute__((address_space(3)))

__device__ __forceinline__ unsigned xb_ld(unsigned* p)              { return __hip_atomic_load(p, __ATOMIC_RELAXED, __HIP_MEMORY_SCOPE_AGENT); }
__device__ __forceinline__ unsigned xb_add(unsigned* p, unsigned v) { return __hip_atomic_fetch_add(p, v, __ATOMIC_RELAXED, __HIP_MEMORY_SCOPE_AGENT); }
__device__ __forceinline__ unsigned xb_xcc_id() { return (unsigned)__builtin_amdgcn_s_getreg((3 << 11) | 20) & 0xFu; }
#define XB_SPIN(cond, bar) do { unsigned _sp = 0; while (cond) { __builtin_amdgcn_s_sleep(1); \
    if ((++_sp & 255u) == 0u) { if (xb_ld(&(bar)[XB_TMO])) break; if (_sp > XB_SPIN_CAP) { atomicAdd(&(bar)[XB_TMO], 1u); break; } } } } while (0)

struct XcdBarrier {
    unsigned* bar; unsigned x;
    volatile LAS unsigned* st;
};

__device__ __forceinline__ XcdBarrier xcd_barrier_post(unsigned* bar, volatile LAS unsigned* st) {
    XcdBarrier b; b.bar = bar; b.x = xb_xcc_id(); b.st = st;
    if ((int)threadIdx.x == 0) st[2] = xb_add(&bar[XB_XCNT(b.x)], 1u);
    return b;
}
__device__ __forceinline__ void xcd_barrier_complete(unsigned* bar, unsigned x, unsigned& nloc, unsigned& nx) {
    const unsigned G = gridDim.x * gridDim.y * gridDim.z;
    unsigned sum, cnt, mine, sp = 0u;
    for (;;) {
        sum = 0u; cnt = 0u; mine = 0u;
#pragma unroll
        for (unsigned j = 0; j < 16; ++j) { const unsigned c = xb_ld(&bar[XB_XCNT(j)]); sum += c; cnt += (c > 0u) ? 1u : 0u; mine = (j == x) ? c : mine; }
        if (sum == G) break;
        __builtin_amdgcn_s_sleep(1);
        if ((++sp & 255u) == 0u) { if (xb_ld(&bar[XB_TMO])) break; if (sp > XB_SPIN_CAP) { atomicAdd(&bar[XB_TMO], 1u); break; } }
    }
    nloc = mine > 0u ? mine : 1u; nx = cnt > 0u ? cnt : 1u;
}

__device__ __forceinline__ void xcd_barrier(const XcdBarrier& b) {
    asm volatile("s_waitcnt vmcnt(0)" ::: "memory");
    __syncthreads();
    if ((int)threadIdx.x == 0) {
        unsigned* bar = b.bar;
        __builtin_amdgcn_s_waitcnt(0);
        unsigned nloc = b.st[0], nx = b.st[1];
        if (nloc == 0u) { xcd_barrier_complete(bar, b.x, nloc, nx); b.st[0] = nloc; b.st[1] = nx; }
        const unsigned old = xb_add(&bar[XB_XSUB(b.x)], 1u);
        const unsigned gen = old / nloc;
        if (old + 1u == (gen + 1u) * nloc) {
            __builtin_amdgcn_fence(__ATOMIC_RELEASE, "agent");
            asm volatile("s_waitcnt vmcnt(0)" ::: "memory");
            const unsigned og = xb_add(&bar[XB_TOP], 1u);
            const unsigned tg = og / nx;
            if (og + 1u == (tg + 1u) * nx) xb_add(&bar[XB_TOPGEN], 1u);
            else XB_SPIN(xb_ld(&bar[XB_TOPGEN]) == tg, bar);
            __builtin_amdgcn_fence(__ATOMIC_ACQUIRE, "agent");
            xb_add(&bar[XB_XGEN(b.x)], 1u);
            asm volatile("s_waitcnt vmcnt(0)" ::: "memory");
        } else {
            XB_SPIN(xb_ld(&bar[XB_XGEN(b.x)]) == gen, bar);
            __builtin_amdgcn_fence(__ATOMIC_ACQUIRE, "agent");
            asm volatile("s_waitcnt vmcnt(0)" ::: "memory");
        }
    }
    __syncthreads();
}


DEV void run_phase(const Params& p, int ph, int l, int s, char* smem, const int vid_, const int tid_, const int vb_, const int vg_) {
  switch (ph) {
    case 0: phase_prep(p, smem, tid_, vb_, vg_); break;
    case 1: phase_h(p, l, s, tid_, vb_, vg_); break;
    case 3: phase_rows(p, l, s, smem, tid_, vb_, vg_); break;
    case 4: phase_mix(p, l, s, smem, tid_, vb_, vg_); break;
    case 5: phase_mla(p, l, s, smem, tid_, vb_, vg_); break;
    default: phase_final(p, tid_, vb_, vg_); break;
  }
}

__global__ void __launch_bounds__(512, 2) mega_kernel(Params p) {
  extern __shared__ __attribute__((aligned(16))) unsigned char dyn_lds[];
  char* smem = (char*)dyn_lds;
  uint4& xb_words = *(uint4*)(dyn_lds + 131072);
  if (threadIdx.x == 0) xb_words = make_uint4(0u, 0u, 0u, 0u);
  __syncthreads();
  XcdBarrier xb = xcd_barrier_post((unsigned*)(p.ws + O_BAR), (volatile LAS unsigned*)(dyn_lds + 131072));
  if (p.ws == nullptr) cg::this_grid().sync();
  int vid = blockIdx.x;
#pragma unroll 1
  for (int step = 0; step < 24; step++) {
    int ph, l = 0, s = 0;
    bool also_h1 = false;
    if (step == 0) ph = 0;
    else if (step == 23) ph = 8;
    else {
      const int idx = step - 1; l = idx / 11; const int r = idx % 11;
      if (r < 5) { s = 0; ph = 1 + r; also_h1 = (r == 4); }
      else if (r < 9) { s = 1; ph = 2 + (r - 5); }
      else ph = 6 + (r - 9);
    }
    {
      const int tfull = tid_opaque();
      const int team = tfull >> 8;
      Params q = p;
      size_t zoff = 0;
      asm volatile("" : "+s"(zoff));
      q.ws = p.ws + zoff;
      q.out = p.out + zoff;
      if (ph == 4) { phase_qkv8(q, l, s, smem, vid); __syncthreads(); }
      if (ph == 2) phase_in8(q, l, s, smem, vid);
      else if (ph == 6) phase_merge8(q, l, smem, vid);
      else if (ph == 7) phase_out8(q, l, smem, vid);
      else run_phase(q, ph, l, s, smem + team * 65536, vid * 2 + team, tfull & 255, blockIdx.x * 2 + team, gridDim.x * 2);
      if (also_h1) run_phase(q, 1, l, 1, smem + team * 65536, vid * 2 + team, tfull & 255, blockIdx.x * 2 + team, gridDim.x * 2);
    }
    if (step < 23) xcd_barrier(xb);
    if (step == 0) {
      if (threadIdx.x == 0) {
        unsigned base = 0;
        for (unsigned j = 0; j < 16; ++j) { const unsigned c = xb_ld(&xb.bar[XB_XCNT(j)]); if (j < xb.x) base += c; }
        unsigned v = base + xb_words.z;
        if (v >= gridDim.x) v = blockIdx.x;
        xb_words.w = v;
      }
      __syncthreads();
      vid = __builtin_amdgcn_readfirstlane((int)xb_words.w);
    }
  }
}

extern "C" void kernel_launch(void* const* d_in, const int* in_sizes, int n_in, void* d_out, int out_size, void* d_ws, size_t ws_size,
                              hipStream_t stream) {
  Params p{};
  const float** pp = (const float**)&p;
  for (int i = 0; i < 22; i++) pp[i] = (const float*)d_in[i];
  p.out = (float*)d_out;
  p.ws = (char*)d_ws;
  static int grid_blocks = 0;
  if (!grid_blocks) {
    int dev = 0, cus = 0, per_cu = 0;
    hipGetDevice(&dev);
    hipDeviceGetAttribute(&cus, hipDeviceAttributeMultiprocessorCount, dev);
    hipFuncSetAttribute((const void*)mega_kernel, hipFuncAttributeMaxDynamicSharedMemorySize, (int)DYN_LDS);
    hipOccupancyMaxActiveBlocksPerMultiprocessor(&per_cu, mega_kernel, 512, DYN_LDS);
    if (per_cu > 1) per_cu = 1;
    grid_blocks = cus * per_cu;
    grid_blocks &= ~7;
    if (grid_blocks > 256) grid_blocks = 256;
  }
  hipMemsetAsync((char*)d_ws + O_BAR, 0, BAR_BYTES, stream);
  void* args[] = {&p};
  hipError_t e = hipLaunchCooperativeKernel((void*)mega_kernel, dim3(grid_blocks), dim3(512), args, DYN_LDS, stream);
  if (e != hipSuccess) fprintf(stderr, "cooperative launch failed: %s (grid %d)\n", hipGetErrorString(e), grid_blocks);
}
```

```cpp
#include <hip/hip_runtime.h>
#include <hip/hip_cooperative_groups.h>
#include <cstdio>
namespace cg = cooperative_groups;

typedef unsigned short u16;
typedef __attribute__((ext_vector_type(8))) __bf16 bf16x8;
typedef __attribute__((ext_vector_type(16))) float f32x16;
#define DEV __device__ __forceinline__
__device__ __forceinline__ int tid_opaque() { int t = threadIdx.x; asm volatile("" : "+v"(t)); return t; }
#define TIDX tid_

constexpr size_t A256(size_t x) { return (x + 255) & ~(size_t)255; }
constexpr size_t A512K(size_t x) { return (x + 524287) & ~(size_t)524287; }
constexpr size_t AUP(size_t x, size_t a) { return (x + a - 1) / a * a; }
constexpr size_t O_WIN = 0;
constexpr size_t O_H = O_WIN + A256(2ull * 7936 * 1024 * 2);
constexpr size_t O_WUQ = AUP(O_H + A256(8192ull * 1024 * 2), 196608);
constexpr size_t O_WUKV = AUP(O_WUQ + A256(2ull * 768 * 384 * 2), 131072);
constexpr size_t O_WBR = A512K(O_WUKV + A256(2ull * 1024 * 256 * 2));
constexpr size_t O_WOUT = A512K(O_WBR + A256(2ull * 3 * 1024 * 512 * 2));
constexpr size_t O_SGUW = O_WOUT + A256(2ull * 1024 * 1024 * 2);
constexpr size_t O_KC = O_SGUW + A256(2ull * 4 * 128 * 128 * 2);
constexpr size_t O_VTC = O_KC + A256(2ull * 8 * 256 * 512 * 2);
constexpr size_t O_MOD = O_VTC + A256(2ull * 8 * 256 * 512 * 2);
constexpr size_t O_QNA = A512K(O_MOD + A256(2ull * 9 * 3072 * 4));
constexpr size_t O_KNA = O_QNA + 8192ull * 512 * 2;
constexpr size_t O_VTNA = O_KNA + 8192ull * 512 * 2;
constexpr size_t O_GU = O_VTNA + 8192ull * 512 * 2;
constexpr size_t O_MG = O_QNA;
constexpr size_t O_ZA = A512K(O_GU + 8192ull * 512 * 2);
constexpr size_t O_ZB = O_ZA + 2 * 8192ull * 512 * 2;
constexpr size_t O_ZC = O_ZB + 2 * 8192ull * 512 * 2;
constexpr size_t O_GVT = O_ZC + 2 * 8192ull * 512 * 2;
constexpr size_t O_GATES = O_GVT + A256(8192ull * 512 * 2);
constexpr size_t O_CKV = AUP(O_GATES + A256(2ull * 8192 * 3072), 131072);
constexpr size_t O_KR = O_CKV + A256(10240ull * 256 * 2);
constexpr size_t O_KNOPE = O_KR + A256(10240ull * 32 * 2);
constexpr size_t O_VTM = O_KNOPE + A256(10240ull * 512 * 2);
constexpr size_t O_END = O_VTM + A256(10240ull * 512 * 2);
constexpr size_t O_DQN = AUP(O_END, 196608);
constexpr size_t O_DQ = O_DQN + A256(8192ull * 384 * 2);
constexpr size_t O_DKV = O_DQ + A256(8192ull * 384 * 2);
constexpr size_t O_KRF = O_DKV + A256(8192ull * 256 * 2);
constexpr size_t O_QM = O_DQ;
constexpr size_t O_BAR = O_QM + A256(8192ull * 768 * 2);
constexpr size_t BAR_BYTES = 16384;
constexpr size_t DYN_LDS = 131072 + 16;
static_assert(O_H % 524288 == 0 && O_WIN == 0 && O_WOUT % 524288 == 0, "K=1024 operands must be 256-row-tile aligned");
static_assert(O_WBR % 262144 == 0 && O_ZA % 262144 == 0 && O_ZB % 262144 == 0 && O_ZC % 262144 == 0, "K=512 operands must be 256-row-tile aligned");
static_assert(O_MG % 524288 == 0, "MERGED must be tile aligned");
static_assert(O_WUQ % 196608 == 0 && O_DQN % 196608 == 0 && O_WUKV % 131072 == 0 && O_CKV % 131072 == 0, "K=384 / K=256 operands must be 256-row-tile aligned");
static_assert(O_KRF + 8192ull * 32 * 4 <= O_BAR, "QM alias region must cover DQ/DKV/KRF");
static_assert(O_BAR + BAR_BYTES <= 256ull * 1024 * 1024, "workspace too large");

constexpr size_t OUT_Y = 0;
constexpr size_t OUT_SK = 16777216;
constexpr size_t OUT_SV = 25165824;
constexpr size_t OUT_CKV = 33554432;
constexpr size_t OUT_SKR = 37748736;

struct Params {
  const float *x_prompt, *x_sample, *cache_na_k, *cache_na_v, *cache_ckv, *cache_kr, *c, *c_ctx;
  const float *norm_g, *w_mod, *b_mod, *w_in, *na_rpb, *sgu_w, *sgu_b, *q_norm, *w_uq, *kv_norm, *w_ukv, *w_branch, *w_out, *final_g;
  float* out;
  char* ws;
};

DEV u16 f2bf(float f) { unsigned u = __float_as_uint(f); u += 0x7fffu + ((u >> 16) & 1u); return (u16)(u >> 16); }
DEV float bf2f(u16 h) { return __uint_as_float(((unsigned)h) << 16); }
typedef __attribute__((ext_vector_type(2))) __bf16 bf16x2;
DEV unsigned pack2(float a, float b) { bf16x2 v; v[0] = (__bf16)a; v[1] = (__bf16)b; return __builtin_bit_cast(unsigned, v); }
DEV void st4bf(u16* p, float a, float b, float c, float d) { uint2 v; v.x = pack2(a, b); v.y = pack2(c, d); *(uint2*)p = v; }
DEV void ld4bf(const u16* p, float& a, float& b, float& c, float& d) {
  uint2 v = *(const uint2*)p;
  a = __uint_as_float(v.x << 16); b = __uint_as_float(v.x & 0xffff0000u);
  c = __uint_as_float(v.y << 16); d = __uint_as_float(v.y & 0xffff0000u);
}
DEV size_t blk_off(int row, int k, int K) { return (size_t)(row >> 8) * 256 * K + (size_t)(k >> 6) * 16384 + (size_t)(row & 255) * 64 + (k & 63); }
DEV float rows_allmax(float v) {
  const unsigned u = __float_as_uint(v);
  const auto a = __builtin_amdgcn_permlane16_swap(u, u, false, false);
  const float m1 = fmaxf(__uint_as_float(a[0]), __uint_as_float(a[1]));
  const unsigned u2 = __float_as_uint(m1);
  const auto b = __builtin_amdgcn_permlane32_swap(u2, u2, false, false);
  return fmaxf(__uint_as_float(b[0]), __uint_as_float(b[1]));
}
DEV float wave_sum(float v) {
#pragma unroll
  for (int o = 32; o > 0; o >>= 1) v += __shfl_xor(v, o);
  return v;
}
DEV float sigmoid_f(float x) { return __builtin_amdgcn_rcpf(1.f + __expf(-x)); }
DEV float silu_f(float x) { return x * __builtin_amdgcn_rcpf(1.f + __expf(-x)); }
DEV float gelu_f(float x) { float u = 0.7978845608028654f * (x + 0.044715f * x * x * x); return x * __builtin_amdgcn_rcpf(1.f + __expf(-2.f * u)); }

DEV void gemm_mainloop_d1(const u16* P, int ldp, const u16* Q, int ldq, int K, char* smem, f32x16 (&acc)[2][2], const int tid_) {
  const int t = TIDX, lane = t & 63, w = t >> 6, wm = w >> 1, wn = w & 1;
  const int lr = t >> 3, ch = t & 7;
  const u16* pg = P + (size_t)lr * ldp + ch * 8;
  const u16* qg = Q + (size_t)lr * ldq + ch * 8;
  const size_t sp = (size_t)32 * ldp, sq = (size_t)32 * ldq;
  const int soff = lr * 128 + ((ch ^ ((t >> 4) & 7)) << 4);
  const int sw = (lane >> 1) & 7;
  const int prow = (wm * 64 + (lane & 31)) * 128;
  const int qrow = (wn * 64 + (lane & 31)) * 128;
  uint4 p0, p1, p2, p3, q0, q1, q2, q3;
#define GLOAD(k0) do { p0 = *(const uint4*)(pg + (k0)); p1 = *(const uint4*)(pg + sp + (k0)); p2 = *(const uint4*)(pg + 2 * sp + (k0)); p3 = *(const uint4*)(pg + 3 * sp + (k0)); \
                       q0 = *(const uint4*)(qg + (k0)); q1 = *(const uint4*)(qg + sq + (k0)); q2 = *(const uint4*)(qg + 2 * sq + (k0)); q3 = *(const uint4*)(qg + 3 * sq + (k0)); } while (0)
#define SWRITE(base) do { char* b_ = (base) + soff; *(uint4*)(b_) = p0; *(uint4*)(b_ + 4096) = p1; *(uint4*)(b_ + 8192) = p2; *(uint4*)(b_ + 12288) = p3; \
                          *(uint4*)(b_ + 16384) = q0; *(uint4*)(b_ + 20480) = q1; *(uint4*)(b_ + 24576) = q2; *(uint4*)(b_ + 28672) = q3; } while (0)
  GLOAD(0);
  SWRITE(smem);
  __syncthreads();
  const int nk = K >> 6;
  for (int kt = 0; kt < nk; kt++) {
    const int k0 = min(kt + 1, nk - 1) << 6;
    GLOAD(k0);
    asm volatile("" ::: "memory"); __builtin_amdgcn_sched_barrier(0);
    const char* bP = smem + (kt & 1) * 32768;
    const char* bQ = bP + 16384;
#pragma unroll
    for (int s = 0; s < 4; s++) {
      const int co = ((s * 2 + (lane >> 5)) ^ sw) << 4;
      const bf16x8 pf0 = *(const bf16x8*)(bP + prow + co), pf1 = *(const bf16x8*)(bP + prow + 4096 + co);
      const bf16x8 qf0 = *(const bf16x8*)(bQ + qrow + co), qf1 = *(const bf16x8*)(bQ + qrow + 4096 + co);
      acc[0][0] = __builtin_amdgcn_mfma_f32_32x32x16_bf16(qf0, pf0, acc[0][0], 0, 0, 0);
      acc[0][1] = __builtin_amdgcn_mfma_f32_32x32x16_bf16(qf1, pf0, acc[0][1], 0, 0, 0);
      acc[1][0] = __builtin_amdgcn_mfma_f32_32x32x16_bf16(qf0, pf1, acc[1][0], 0, 0, 0);
      acc[1][1] = __builtin_amdgcn_mfma_f32_32x32x16_bf16(qf1, pf1, acc[1][1], 0, 0, 0);
    }
    asm volatile("" ::: "memory"); __builtin_amdgcn_sched_barrier(0);
    SWRITE(smem + ((kt + 1) & 1) * 32768);
    __syncthreads();
  }
#undef GLOAD
#undef SWRITE
}

DEV void acc_zero(f32x16 (&acc)[2][2]) {
#pragma unroll
  for (int a = 0; a < 2; a++)
#pragma unroll
    for (int b = 0; b < 2; b++)
#pragma unroll
      for (int r = 0; r < 16; r++) acc[a][b][r] = 0.f;
}

template <class F>
DEV void epi_foreach(const f32x16 (&acc)[2][2], const int tid_, F f) {
  const int lane = TIDX & 63, w = TIDX >> 6, wm = w >> 1, wn = w & 1;
#pragma unroll
  for (int a = 0; a < 2; a++)
#pragma unroll
    for (int b = 0; b < 2; b++)
#pragma unroll
      for (int rg = 0; rg < 4; rg++) {
        const int i = wm * 64 + a * 32 + (lane & 31);
        const int j = wn * 64 + b * 32 + rg * 8 + (lane >> 5) * 4;
        f(i, j, acc[a][b][rg * 4 + 0], acc[a][b][rg * 4 + 1], acc[a][b][rg * 4 + 2], acc[a][b][rg * 4 + 3]);
      }
}

DEV void tile_map(int li, int MPX, int xcd, int& m, int& n) {
  const int g = MPX * 8;
  const int ng = li / g, wv = li % g;
  m = xcd * MPX + (wv % MPX);
  n = ng * 8 + (wv / MPX);
}

DEV void tconv_tile(const float* __restrict__ src, int ldsrc, int k0, int n0, u16* __restrict__ dst, int lddst, int drow0, float* tile, const int tid_, const int blkK = 0) {
  const int t = TIDX;
  {
    const int n = t & 31, kk = t >> 5;
    float v[16];
#pragma unroll
    for (int p = 0; p < 16; p++) v[p] = src[(size_t)(k0 + kk + p * 8) * ldsrc + n0 + n];
#pragma unroll
    for (int p = 0; p < 16; p++) tile[(kk + p * 8) * 33 + n] = v[p];
  }
  __syncthreads();
  {
    const int k2 = (t & 63) * 2, nn = t >> 6;
#pragma unroll
    for (int p = 0; p < 8; p++) {
      const int n2 = nn + p * 4;
      u16* dp = blkK ? (dst + blk_off(drow0 + n2, k0 + k2, blkK)) : (dst + (size_t)(drow0 + n2) * lddst + k0 + k2);
      *(unsigned*)dp = pack2(tile[k2 * 33 + n2], tile[(k2 + 1) * 33 + n2]);
    }
  }
  __syncthreads();
}

DEV void phase_prep(const Params& p, char* smem, const int tid_, const int vb_, const int vg_) {
  const int t = TIDX;
  constexpr int N_MOD = 192;
  constexpr int T_IN = 1960, T_UQ = 72, T_UKV = 64, T_BR = 384, T_OUT = 256, T_CV = 256;
  constexpr int T_L = T_IN + T_UQ + T_UKV + T_BR + T_OUT + T_CV;
  constexpr int N_TC = 2 * T_L;
  constexpr int N_SG = 64, N_KC = 1024;
  constexpr int TOTAL = N_MOD + N_TC + N_SG + N_KC;
  float* MOD = (float*)(p.ws + O_MOD);
  for (int item = vb_; item < TOTAL; item += vg_) {
    if (item < N_MOD) {
      const int l = item / 96, e0 = (item % 96) * 32;
      float* sc = (float*)smem;
      {
        float cv[36];
#pragma unroll
        for (int i = 0; i < 36; i++) { const int idx = t + i * 256; const int c9 = idx >> 10, d = idx & 1023; cv[i] = (c9 == 0) ? p.c_ctx[d] : p.c[(c9 - 1) * 1024 + d]; }
#pragma unroll
        for (int i = 0; i < 36; i++) sc[t + i * 256] = silu_f(cv[i]);
      }
      __syncthreads();
      const int col = t & 31, slab = t >> 5;
      float a[9];
#pragma unroll
      for (int c9 = 0; c9 < 9; c9++) a[c9] = 0.f;
      const float* wp = p.w_mod + ((size_t)l * 1024 + slab * 128) * 3072 + e0 + col;
#pragma unroll 1
      for (int d0 = 0; d0 < 128; d0 += 16) {
        float wv[16];
#pragma unroll
        for (int j = 0; j < 16; j++) wv[j] = wp[(size_t)(d0 + j) * 3072];
#pragma unroll
        for (int j = 0; j < 16; j++) {
          const int d = slab * 128 + d0 + j;
#pragma unroll
          for (int c9 = 0; c9 < 9; c9++) a[c9] += sc[c9 * 1024 + d] * wv[j];
        }
      }
      float* red = sc + 9216;
#pragma unroll
      for (int c9 = 0; c9 < 9; c9++) red[(slab * 9 + c9) * 32 + col] = a[c9];
      __syncthreads();
      for (int idx = t; idx < 288; idx += 256) {
        const int c9 = idx >> 5, cc = idx & 31;
        float sum = 0.f;
#pragma unroll
        for (int sl = 0; sl < 8; sl++) sum += red[(sl * 9 + c9) * 32 + cc];
        MOD[(l * 9 + c9) * 3072 + e0 + cc] = sum + p.b_mod[l * 3072 + e0 + cc];
      }
      __syncthreads();
    } else if (item < N_MOD + N_TC) {
      const int ti = item - N_MOD;
      const int l = ti / T_L;
      int r = ti % T_L;
      const float* src; u16* dst; int ldsrc, lddst, k0, n0, drow, blkK = 0;
      if (r < T_IN) {
        const int nt = r >> 3, kt = r & 7;
        src = p.w_in + (size_t)l * 1024 * 7840; ldsrc = 7840; k0 = kt * 128; n0 = nt * 32;
        dst = (u16*)(p.ws + O_WIN) + (size_t)l * 7936 * 1024; lddst = 1024; blkK = 1024;
        drow = (n0 < 4224) ? n0 : (n0 == 4224 ? 7808 : n0 - 32);
      } else if ((r -= T_IN) < T_UQ) {
        const int nt = r / 3, kt = r % 3;
        src = p.w_uq + (size_t)l * 384 * 768; ldsrc = 768; k0 = kt * 128; n0 = nt * 32;
        dst = (u16*)(p.ws + O_WUQ) + (size_t)l * 768 * 384; lddst = 384; drow = n0; blkK = 384;
      } else if ((r -= T_UQ) < T_UKV) {
        const int nt = r >> 1, kt = r & 1;
        src = p.w_ukv + (size_t)l * 256 * 1024; ldsrc = 1024; k0 = kt * 128; n0 = nt * 32;
        dst = (u16*)(p.ws + O_WUKV) + (size_t)l * 1024 * 256; lddst = 256;
        const int hh = n0 >> 7, jj = n0 & 127;
        drow = (jj < 64) ? (hh * 64 + jj) : (512 + hh * 64 + jj - 64);
        blkK = 256;
      } else if ((r -= T_UKV) < T_BR) {
        const int kb = r >> 7, r2 = r & 127;
        const int nt = r2 >> 2, kt = r2 & 3;
        src = p.w_branch + (size_t)(l * 3 + kb) * 512 * 1024; ldsrc = 1024; k0 = kt * 128; n0 = nt * 32;
        dst = (u16*)(p.ws + O_WBR) + (size_t)(l * 3 + kb) * 1024 * 512; lddst = 512; drow = n0; blkK = 512;
      } else if ((r -= T_BR) < T_OUT) {
        const int nt = r >> 3, kt = r & 7;
        src = p.w_out + (size_t)l * 1024 * 1024; ldsrc = 1024; k0 = kt * 128; n0 = nt * 32;
        dst = (u16*)(p.ws + O_WOUT) + (size_t)l * 1024 * 1024; lddst = 1024; drow = n0; blkK = 1024;
      } else {
        r -= T_OUT;
        const int b = r >> 5, r2 = r & 31;
        const int nt = r2 >> 1, kt = r2 & 1;
        src = p.cache_na_v + (size_t)(b * 2 + l) * 256 * 512; ldsrc = 512; k0 = kt * 128; n0 = nt * 32;
        dst = (u16*)(p.ws + O_VTC) + (size_t)(l * 8 + b) * 512 * 256; lddst = 256; drow = n0;
      }
      tconv_tile(src, ldsrc, k0, n0, dst, lddst, drow, (float*)smem, tid_, blkK);
    } else if (item < N_MOD + N_TC + N_SG) {
      const int it = item - N_MOD - N_TC;
      const size_t e = (size_t)it * 2048 + t * 8;
      const float4 a = *(const float4*)(p.sgu_w + e), b = *(const float4*)(p.sgu_w + e + 4);
      u16* d = (u16*)(p.ws + O_SGUW) + e;
      st4bf(d, a.x, a.y, a.z, a.w); st4bf(d + 4, b.x, b.y, b.z, b.w);
    } else {
      const int it = item - N_MOD - N_TC - N_SG;
      const size_t e = (size_t)it * 2048 + t * 8;
      const int l = (int)(e >> 20), b = (int)(e >> 17) & 7; const size_t rest = e & 131071;
      const float* s = p.cache_na_k + ((size_t)(b * 2 + l) << 17) + rest;
      const float4 a = *(const float4*)s, bb = *(const float4*)(s + 4);
      u16* d = (u16*)(p.ws + O_KC) + e;
      st4bf(d, a.x, a.y, a.z, a.w); st4bf(d + 4, bb.x, bb.y, bb.z, bb.w);
    }
  }
}

DEV const float* xrow_in(const Params& p, int l, int s, int tl) {
  if (l == 0) return (s == 0 ? p.x_prompt : p.x_sample) + (size_t)tl * 1024;
  return p.out + OUT_Y + (size_t)s * 8388608 + (size_t)tl * 1024;
}
DEV int cond_idx(int s, int tl) { return s == 0 ? 0 : 1 + (tl >> 10); }

DEV void phase_h(const Params& p, int l, int s, const int tid_, const int vb_, const int vg_) {
  const int lane = TIDX & 63, wave = TIDX >> 6;
  u16* H = (u16*)(p.ws + O_H);
  const float* MOD = (const float*)(p.ws + O_MOD);
  for (int item = vb_; item < 512; item += vg_) {
    const int tl0 = item * 16 + wave * 4;
    const float* x = xrow_in(p, l, s, tl0);
    const float* mod = MOD + (size_t)(l * 9 + cond_idx(s, tl0)) * 3072;
    float4 v[4][4];
#pragma unroll
    for (int r = 0; r < 4; r++)
#pragma unroll
      for (int i = 0; i < 4; i++) v[r][i] = *(const float4*)(x + (size_t)r * 1024 + i * 256 + lane * 4);
    float4 g[4], sh[4], sc[4];
#pragma unroll
    for (int i = 0; i < 4; i++) {
      const int col = i * 256 + lane * 4;
      g[i] = *(const float4*)(p.norm_g + l * 1024 + col);
      sh[i] = *(const float4*)(mod + col);
      sc[i] = *(const float4*)(mod + 1024 + col);
    }
    asm volatile("" ::: "memory");
    float ss[4];
#pragma unroll
    for (int r = 0; r < 4; r++) {
      ss[r] = 0.f;
#pragma unroll
      for (int i = 0; i < 4; i++) ss[r] += v[r][i].x * v[r][i].x + v[r][i].y * v[r][i].y + v[r][i].z * v[r][i].z + v[r][i].w * v[r][i].w;
    }
#pragma unroll
    for (int o = 32; o > 0; o >>= 1) {
#pragma unroll
      for (int r = 0; r < 4; r++) ss[r] += __shfl_xor(ss[r], o);
    }
#pragma unroll
    for (int r = 0; r < 4; r++) {
      const float rstd = rsqrtf(ss[r] * (1.f / 1024.f) + 1e-6f);
#pragma unroll
      for (int i = 0; i < 4; i++) {
        const int col = i * 256 + lane * 4;
        st4bf(H + blk_off(tl0 + r, col, 1024), v[r][i].x * rstd * g[i].x * (1.f + sc[i].x) + sh[i].x, v[r][i].y * rstd * g[i].y * (1.f + sc[i].y) + sh[i].y,
              v[r][i].z * rstd * g[i].z * (1.f + sc[i].z) + sh[i].z, v[r][i].w * rstd * g[i].w * (1.f + sc[i].w) + sh[i].w);
      }
    }
  }
}

DEV void phase_rows(const Params& p, int l, int s, char* smem, const int tid_, const int vb_, const int vg_) {
  const int t = TIDX, lane = t & 63, wave = t >> 6;
  const u16* DQ = (const u16*)(p.ws + O_DQ); const u16* DKV = (const u16*)(p.ws + O_DKV); const float* KRF = (const float*)(p.ws + O_KRF);
  u16* CKV = (u16*)(p.ws + O_CKV); u16* KR = (u16*)(p.ws + O_KR); u16* GVT = (u16*)(p.ws + O_GVT);
  const int n_row = 512, n_ln = 256, n_cache = (s == 1) ? 512 : 0;
  const int total = n_row + n_ln + n_cache;
  for (int item = vb_; item < total; item += vg_) {
    if (item < n_row) {
      const int tl0 = item * 16 + wave * 4;
      unsigned dqw[4][3]; uint2 dkw[4]; float k1[4], k2[4];
#pragma unroll
      for (int r = 0; r < 4; r++) {
        const unsigned* rp = (const unsigned*)(DQ + (size_t)(tl0 + r) * 384) + lane * 3;
        dqw[r][0] = rp[0]; dqw[r][1] = rp[1]; dqw[r][2] = rp[2];
        dkw[r] = *(const uint2*)(DKV + (size_t)(tl0 + r) * 256 + lane * 4);
        k1[r] = KRF[(size_t)(tl0 + r) * 32 + (lane & 15)]; k2[r] = KRF[(size_t)(tl0 + r) * 32 + 16 + (lane & 15)];
      }
      const float2* gq = (const float2*)(p.q_norm + l * 384) + lane * 3;
      const float2 g0 = gq[0], g1 = gq[1], g2 = gq[2];
      const float4 gk = *(const float4*)(p.kv_norm + l * 256 + lane * 4);
      asm volatile("" ::: "memory");
      float qv[4][6], kv4[4][4], sq[4], sk[4];
#pragma unroll
      for (int r = 0; r < 4; r++) {
#pragma unroll
        for (int j = 0; j < 3; j++) { qv[r][2 * j] = __uint_as_float(dqw[r][j] << 16); qv[r][2 * j + 1] = __uint_as_float(dqw[r][j] & 0xffff0000u); }
        kv4[r][0] = __uint_as_float(dkw[r].x << 16); kv4[r][1] = __uint_as_float(dkw[r].x & 0xffff0000u);
        kv4[r][2] = __uint_as_float(dkw[r].y << 16); kv4[r][3] = __uint_as_float(dkw[r].y & 0xffff0000u);
        sq[r] = 0.f; sk[r] = 0.f;
#pragma unroll
        for (int j = 0; j < 6; j++) sq[r] += qv[r][j] * qv[r][j];
#pragma unroll
        for (int j = 0; j < 4; j++) sk[r] += kv4[r][j] * kv4[r][j];
      }
#pragma unroll
      for (int o = 32; o > 0; o >>= 1) {
#pragma unroll
        for (int r = 0; r < 4; r++) { sq[r] += __shfl_xor(sq[r], o); sk[r] += __shfl_xor(sk[r], o); }
      }
#pragma unroll
      for (int r = 0; r < 4; r++) {
        const int tl = tl0 + r;
        const float rq = rsqrtf(sq[r] * (1.f / 384.f) + 1e-6f);
        u16* dqn = (u16*)(p.ws + O_DQN);
        *(unsigned*)(dqn + blk_off(tl, lane * 6 + 0, 384)) = pack2(qv[r][0] * rq * g0.x, qv[r][1] * rq * g0.y);
        *(unsigned*)(dqn + blk_off(tl, lane * 6 + 2, 384)) = pack2(qv[r][2] * rq * g1.x, qv[r][3] * rq * g1.y);
        *(unsigned*)(dqn + blk_off(tl, lane * 6 + 4, 384)) = pack2(qv[r][4] * rq * g2.x, qv[r][5] * rq * g2.y);
        const float rk = rsqrtf(sk[r] * (1.f / 256.f) + 1e-6f);
        const float a = kv4[r][0] * rk * gk.x, b = kv4[r][1] * rk * gk.y, c = kv4[r][2] * rk * gk.z, d = kv4[r][3] * rk * gk.w;
        const int row = (s == 0) ? tl : ((tl >> 10) * 1280 + 256 + (tl & 1023));
        st4bf(CKV + blk_off(row, lane * 4, 256), a, b, c, d);
        if (s == 0) {
          const int bb = tl >> 8, sqi = tl & 255;
          *(float4*)(p.out + OUT_CKV + ((size_t)(bb * 2 + l) * 256 + sqi) * 256 + lane * 4) = make_float4(a, b, c, d);
        }
        if (lane < 16) {
          const float x1 = k1[r], x2 = k2[r];
          if (s == 0) {
            KR[(size_t)tl * 32 + lane] = f2bf(x1);
            KR[(size_t)tl * 32 + 16 + lane] = f2bf(x2);
          } else {
            const int nn = tl & 1023;
            const float pos = (lane < 8) ? (float)(nn >> 6) : (float)(nn & 63);
            const float inv = powf(10000.f, -(float)(lane & 7) * 0.125f);
            const float ang = pos * inv;
            const float cs = cosf(ang), sn = sinf(ang);
            const int row2 = (tl >> 10) * 1280 + 256 + nn;
            KR[(size_t)row2 * 32 + lane] = f2bf(x1 * cs - x2 * sn);
            KR[(size_t)row2 * 32 + 16 + lane] = f2bf(x1 * sn + x2 * cs);
          }
        }
      }
    } else if (item < n_row + n_ln) {
      const int it = item - n_row, chunk = it >> 2, slab = it & 3;
      u16* g = GVT + (size_t)chunk * 512 * 128 + slab * 32;
      const int q = t & 31, part = t >> 5;
      float v[64];
      float sum = 0.f, sq = 0.f;
#pragma unroll
      for (int c = 0; c < 64; c++) { v[c] = gelu_f(bf2f(g[(part * 64 + c) * 128 + q])); sum += v[c]; sq += v[c] * v[c]; }
      float* red = (float*)smem;
      red[(part * 2 + 0) * 32 + q] = sum; red[(part * 2 + 1) * 32 + q] = sq;
      __syncthreads();
      sum = 0.f; sq = 0.f;
#pragma unroll
      for (int pp = 0; pp < 8; pp++) { sum += red[(pp * 2 + 0) * 32 + q]; sq += red[(pp * 2 + 1) * 32 + q]; }
      const float mu = sum * (1.f / 512.f);
      const float var = fmaxf(sq * (1.f / 512.f) - mu * mu, 0.f);
      const float rstd = rsqrtf(var + 1e-6f);
#pragma unroll
      for (int c = 0; c < 64; c++) g[(part * 64 + c) * 128 + q] = f2bf((v[c] - mu) * rstd);
      __syncthreads();
    } else {
      const int rowi = (item - n_row - n_ln) * 4 + wave;
      const int b = rowi >> 8, m = rowi & 255;
      const float4 a = *(const float4*)(p.cache_ckv + ((size_t)(b * 2 + l) * 256 + m) * 256 + lane * 4);
      st4bf(CKV + blk_off(b * 1280 + m, lane * 4, 256), a.x, a.y, a.z, a.w);
      if (lane < 32) KR[(size_t)(b * 1280 + m) * 32 + lane] = f2bf(p.cache_kr[((size_t)(b * 2 + l) * 256 + m) * 32 + lane]);
    }
  }
}

typedef __attribute__((ext_vector_type(4))) float f32x4;
struct AttnSrc { const u16* k; const u16* kr; const u16* vt; int vts; };
struct AttnState { f32x4 o[4]; float mx, ls; };
constexpr int ATT_VST = 136;

struct AttnRegs { uint4 k0, k1, k2, v0, v1; };
template <int DQK>
DEV void attn_gload(const AttnSrc& src, AttnRegs& r, int t) {
  const int row = t >> 3, c8 = (t & 7) * 8;
  r.k0 = *(const uint4*)(src.k + (size_t)row * 512 + c8);
  r.k1 = *(const uint4*)(src.k + (size_t)(row + 32) * 512 + c8);
  r.v0 = *(const uint4*)(src.vt + (size_t)row * src.vts + c8);
  r.v1 = *(const uint4*)(src.vt + (size_t)(row + 32) * src.vts + c8);
  if (DQK == 96) r.k2 = *(const uint4*)(src.kr + (size_t)(t >> 2) * 32 + (t & 3) * 8);
}
template <int DQK>
DEV void attn_swrite(char* buf, const AttnRegs& r, int t) {
  constexpr int KST = DQK * 2 + 16;
  const int row = t >> 3, c16 = (t & 7) * 16;
  char* vb = buf + 64 * KST;
  *(uint4*)(buf + row * KST + c16) = make_uint4(r.k0.x, r.k0.y, r.k0.z, r.k0.w);
  *(uint4*)(buf + (row + 32) * KST + c16) = make_uint4(r.k1.x, r.k1.y, r.k1.z, r.k1.w);
  char* vp = vb + row * ATT_VST + c16;
  *(uint2*)vp = make_uint2(r.v0.x, r.v0.y);
  *(uint2*)(vp + 8) = make_uint2(r.v0.z, r.v0.w);
  vp += 32 * ATT_VST;
  *(uint2*)vp = make_uint2(r.v1.x, r.v1.y);
  *(uint2*)(vp + 8) = make_uint2(r.v1.z, r.v1.w);
  if (DQK == 96) *(uint4*)(buf + (t >> 2) * KST + 128 + (t & 3) * 16) = make_uint4(r.k2.x, r.k2.y, r.k2.z, r.k2.w);
}

template <int DQK, int NT, bool LOCAL>
DEV void attn_compute(const char* buf, const bf16x8 qf0, const bf16x8 qf1, const bf16x8 qf2, AttnState& st, float scale, int koff0, const float* biasrow, int qc, int wlo, const int tid_) {
  constexpr int KST = DQK * 2 + 16;
  const int lane = TIDX & 63, r16 = lane & 15, g = lane >> 4;
  const char* vb = buf + 64 * KST;
  f32x4 s[NT];
#pragma unroll
  for (int t = 0; t < NT; t++) {
    s[t] = f32x4{0.f, 0.f, 0.f, 0.f};
    const char* kp = buf + (koff0 + t * 16 + r16) * KST + g * 16;
    s[t] = __builtin_amdgcn_mfma_f32_16x16x32_bf16(*(const bf16x8*)(kp), qf0, s[t], 0, 0, 0);
    s[t] = __builtin_amdgcn_mfma_f32_16x16x32_bf16(*(const bf16x8*)(kp + 64), qf1, s[t], 0, 0, 0);
    if (DQK == 96) s[t] = __builtin_amdgcn_mfma_f32_16x16x32_bf16(*(const bf16x8*)(kp + 128), qf2, s[t], 0, 0, 0);
  }
  float mloc = st.mx;
#pragma unroll
  for (int t = 0; t < NT; t++)
#pragma unroll
    for (int e = 0; e < 4; e++) {
      float v = s[t][e] * scale;
      if (LOCAL) {
        const int kc = koff0 + t * 16 + 4 * g + e;
        const int bi = min(max(kc - qc + 15, 0), 30);
        const float bv = biasrow[bi] * 1.4426950408889634f;
        v = (kc >= wlo && kc < wlo + 16) ? v + bv : -1e30f;
      }
      s[t][e] = v;
      mloc = fmaxf(mloc, v);
    }
  mloc = rows_allmax(mloc);
  const float alpha = __builtin_amdgcn_exp2f(st.mx - mloc);
  st.mx = mloc;
  float psum = 0.f;
#pragma unroll
  for (int t = 0; t < NT; t++)
#pragma unroll
    for (int e = 0; e < 4; e++) {
      const float pv = __builtin_amdgcn_exp2f(s[t][e] - mloc);
      s[t][e] = pv;
      psum += pv;
    }
  st.ls = st.ls * alpha + psum;
#pragma unroll
  for (int dt = 0; dt < 4; dt++) st.o[dt] *= alpha;
#pragma unroll
  for (int kb = 0; kb < NT / 2; kb++) {
    bf16x8 pf;
#pragma unroll
    for (int e = 0; e < 4; e++) { pf[e] = (__bf16)s[2 * kb][e]; pf[4 + e] = (__bf16)s[2 * kb + 1][e]; }
#pragma unroll
    for (int dt = 0; dt < 4; dt++) {
      const char* vp = vb + (dt * 16 + r16) * ATT_VST + (koff0 + 4 * g) * 2 + kb * 64;
      const uint2 a0 = *(const uint2*)vp, a1 = *(const uint2*)(vp + 32);
      const uint4 av = make_uint4(a0.x, a0.y, a1.x, a1.y);
      st.o[dt] = __builtin_amdgcn_mfma_f32_16x16x32_bf16(__builtin_bit_cast(bf16x8, av), pf, st.o[dt], 0, 0, 0);
    }
  }
}

template <int MODE>
DEV void attn_item(const Params& p, int l, int it, char* smem, const int tid_) {
  constexpr int DQK = (MODE >= 2) ? 96 : 64;
  constexpr int KST = DQK * 2 + 16;
  constexpr int BUFSZ = 64 * KST + 64 * ATT_VST;
  const int t = TIDX, lane = t & 63, w = t >> 6, r16 = lane & 15, g = lane >> 4;
  constexpr int QB = (MODE >= 2) ? 2 : 1;
  int b, h, tl0, nst, r = 0;
  if (MODE == 0) { b = it >> 5; h = (it >> 2) & 7; tl0 = b * 256 + (it & 3) * 64; nst = 4; }
  else if (MODE == 1) { b = it >> 7; h = (it >> 4) & 7; r = it & 15; tl0 = b * 1024 + r * 64; nst = 12; }
  else if (MODE == 2) { b = it >> 4; h = (it >> 1) & 7; tl0 = b * 256 + (it & 1) * 128; nst = 4; }
  else { b = it >> 6; h = (it >> 3) & 7; tl0 = b * 1024 + (it & 7) * 128; nst = 20; }
  const int tl = tl0 + w * (16 * QB) + r16;
  const int wr0 = min(max(r - 4, 0), 8);
  const u16* KNA = (const u16*)(p.ws + O_KNA); const u16* VTNA = (const u16*)(p.ws + O_VTNA);
  const u16* KC = (const u16*)(p.ws + O_KC); const u16* VTC = (const u16*)(p.ws + O_VTC);
  const u16* KNOPE = (const u16*)(p.ws + O_KNOPE); const u16* KR = (const u16*)(p.ws + O_KR); const u16* VTM = (const u16*)(p.ws + O_VTM);
  auto get_src = [&](int st) {
    AttnSrc s;
    s.kr = nullptr;
    if (MODE == 0) {
      s.k = KNA + (size_t)(b * 256 + st * 64) * 512 + h * 64; s.vt = VTNA + (size_t)(b * 512 + h * 64) * 256 + st * 64; s.vts = 256;
    } else if (MODE == 1) {
      if (st < 8) {
        const int krow = wr0 + st;
        s.k = KNA + (size_t)(b * 1024 + krow * 64) * 512 + h * 64; s.vt = VTNA + (size_t)(b * 512 + h * 64) * 1024 + krow * 64; s.vts = 1024;
      } else {
        const int m0 = (st - 8) * 64;
        s.k = KC + ((size_t)(l * 8 + b) * 256 + m0) * 512 + h * 64; s.vt = VTC + ((size_t)(l * 8 + b) * 512 + h * 64) * 256 + m0; s.vts = 256;
      }
    } else if (MODE == 2) {
      s.k = KNOPE + (size_t)(b * 256 + st * 64) * 512 + h * 64; s.kr = KR + (size_t)(b * 256 + st * 64) * 32;
      s.vt = VTM + (size_t)(b * 512 + h * 64) * 256 + st * 64; s.vts = 256;
    } else {
      s.k = KNOPE + (size_t)(b * 1280 + st * 64) * 512 + h * 64; s.kr = KR + (size_t)(b * 1280 + st * 64) * 32;
      s.vt = VTM + (size_t)(b * 512 + h * 64) * 1280 + st * 64; s.vts = 1280;
    }
    return s;
  };
  AttnRegs rg;
  rg.k2 = make_uint4(0, 0, 0, 0);
  {
    const AttnSrc s0 = get_src(0);
    attn_gload<DQK>(s0, rg, t);
  }
  asm volatile("" ::: "memory");
  auto load_q = [&](int tl, bf16x8& qf0, bf16x8& qf1, bf16x8& qf2) {
  if (MODE < 2) {
    const u16* qp = (const u16*)(p.ws + O_QNA) + (size_t)tl * 512 + h * 64 + 8 * g;
    qf0 = *(const bf16x8*)qp; qf1 = *(const bf16x8*)(qp + 32); qf2 = qf0;
  } else {
    const u16* qp = (const u16*)(p.ws + O_QM) + (size_t)tl * 768 + h * 96;
    qf0 = *(const bf16x8*)(qp + 8 * g); qf1 = *(const bf16x8*)(qp + 32 + 8 * g);
    if (MODE == 2) {
      qf2 = *(const bf16x8*)(qp + 64 + 8 * g);
    } else {
      const uint4 own = *(const uint4*)(qp + 64 + 8 * g), oth = *(const uint4*)(qp + 64 + 8 * (g ^ 2));
      const unsigned ow[4] = {own.x, own.y, own.z, own.w}, ot[4] = {oth.x, oth.y, oth.z, oth.w};
      const int nn = tl & 1023;
      const float pos = (g & 1) ? (float)(nn & 63) : (float)(nn >> 6);
      bf16x8 qr;
#pragma unroll
      for (int e = 0; e < 8; e++) {
        const float a = __uint_as_float((e & 1) ? (ow[e >> 1] & 0xffff0000u) : (ow[e >> 1] << 16));
        const float c = __uint_as_float((e & 1) ? (ot[e >> 1] & 0xffff0000u) : (ot[e >> 1] << 16));
        const float inv = powf(10000.f, -(float)e * 0.125f);
        const float ang = pos * inv;
        const float cs = cosf(ang), sn = sinf(ang);
        const float v = (g < 2) ? (a * cs - c * sn) : (c * sn + a * cs);
        qr[e] = (__bf16)v;
      }
      qf2 = qr;
    }
  }
  };
  bf16x8 qf0, qf1, qf2, qg0, qg1, qg2;
  load_q(tl, qf0, qf1, qf2);
  if (QB == 2) load_q(tl + 16, qg0, qg1, qg2); else { qg0 = qf0; qg1 = qf1; qg2 = qf2; }
  float* biasl = (float*)(smem + 2 * BUFSZ);
  if (MODE == 1) {
    for (int i = t; i < 465; i += 256) biasl[i] = p.na_rpb[(size_t)(l * 8 + h) * 465 + i];
  }
  AttnState st, st2;
#pragma unroll
  for (int dt = 0; dt < 4; dt++) { st.o[dt] = f32x4{0.f, 0.f, 0.f, 0.f}; st2.o[dt] = f32x4{0.f, 0.f, 0.f, 0.f}; }
  st.mx = -1e30f; st.ls = 0.f; st2.mx = -1e30f; st2.ls = 0.f;
  const float scale = ((MODE >= 2) ? 0.10206207261596575f : 0.125f) * 1.4426950408889634f;
  const int qc = w * 16 + r16;
  const int wlo = min(max(qc - 8, 0), 48);
  const int wstart = min(max(16 * w - 8, 0), 32);
  asm volatile("" ::: "memory"); __builtin_amdgcn_sched_barrier(0);
  attn_swrite<DQK>(smem, rg, t);
  __syncthreads();
  for (int sidx = 0; sidx < nst; sidx++) {
    { const AttnSrc sn = get_src(min(sidx + 1, nst - 1)); attn_gload<DQK>(sn, rg, t); }
    asm volatile("" ::: "memory"); __builtin_amdgcn_sched_barrier(0);
    const char* buf = smem + (sidx & 1) * BUFSZ;
    if (MODE == 1 && sidx < 8) attn_compute<DQK, 2, true>(buf, qf0, qf1, qf2, st, scale, wstart, biasl + (wr0 + sidx - r + 7) * 31, qc, wlo, tid_);
    else {
      attn_compute<DQK, 4, false>(buf, qf0, qf1, qf2, st, scale, 0, nullptr, 0, 0, tid_);
      if (QB == 2) attn_compute<DQK, 4, false>(buf, qg0, qg1, qg2, st2, scale, 0, nullptr, 0, 0, tid_);
    }
    asm volatile("" ::: "memory"); __builtin_amdgcn_sched_barrier(0);
    attn_swrite<DQK>(smem + ((sidx + 1) & 1) * BUFSZ, rg, t);
    __syncthreads();
  }
  auto finish = [&](const AttnState& st, int tl) {
    float lt = st.ls;
    lt += __shfl_xor(lt, 16);
    lt += __shfl_xor(lt, 32);
    const float inv = 1.f / lt;
    u16* Z = (u16*)(p.ws + (MODE < 2 ? O_ZA : O_ZC)) + (size_t)(MODE & 1) * 8192 * 512 + blk_off(tl, h * 64 + 4 * g, 512);
#pragma unroll
    for (int dt = 0; dt < 4; dt++) {
      float a, bb, c, d;
      ld4bf(Z + dt * 16, a, bb, c, d);
      a = silu_f(a); bb = silu_f(bb); c = silu_f(c); d = silu_f(d);
      st4bf(Z + dt * 16, st.o[dt][0] * inv * a, st.o[dt][1] * inv * bb, st.o[dt][2] * inv * c, st.o[dt][3] * inv * d);
    }
  };
  finish(st, tl);
  if (QB == 2) finish(st2, tl + 16);
}

DEV void phase_mix(const Params& p, int l, int s, char* smem, const int tid_, const int vb_, const int vg_) {
  const int n_att = 1024;
  const int n_sgu = 256;
  const int total = n_att + n_sgu;
  for (int item = vb_; item < total; item += vg_) {
    if (item < n_att) {
      if (s == 0) attn_item<0>(p, l, item, smem, tid_); else attn_item<1>(p, l, item, smem, tid_);
    } else if (item < n_att + n_sgu) {
      const int it = item - n_att, chunk = it >> 2, g = it & 3;
      const u16* Wg = (const u16*)(p.ws + O_SGUW) + (size_t)(l * 4 + g) * 128 * 128;
      const u16* V = (const u16*)(p.ws + O_GVT) + ((size_t)chunk * 512 + g * 128) * 128;
      const u16* GU = (const u16*)(p.ws + O_GU); u16* ZB = (u16*)(p.ws + O_ZB) + (size_t)s * 8192 * 512;
      f32x16 acc[2][2];
      acc_zero(acc);
      gemm_mainloop_d1(Wg, 128, V, 128, 128, smem, acc, tid_);
      epi_foreach(acc, tid_, [&](int i, int j, float v0, float v1, float v2, float v3) {
        const float bs = p.sgu_b[(l * 4 + g) * 128 + i];
        const size_t off = (size_t)(chunk * 128 + i) * 512 + g * 128 + j;
        float u0, u1, u2, u3, z0, z1, z2, z3;
        ld4bf(GU + off, u0, u1, u2, u3);
        const size_t zoff = blk_off(chunk * 128 + i, g * 128 + j, 512);
        ld4bf(ZB + zoff, z0, z1, z2, z3);
        u0 = gelu_f(u0); u1 = gelu_f(u1); u2 = gelu_f(u2); u3 = gelu_f(u3);
        z0 = silu_f(z0); z1 = silu_f(z1); z2 = silu_f(z2); z3 = silu_f(z3);
        st4bf(ZB + zoff, u0 * (v0 + bs) * z0, u1 * (v1 + bs) * z1, u2 * (v2 + bs) * z2, u3 * (v3 + bs) * z3);
      });
    }
  }
}

DEV void phase_mla(const Params& p, int l, int s, char* smem, const int tid_, const int vb_, const int vg_) {
  for (int item = vb_; item < 512; item += vg_) {
    if (s == 0) attn_item<2>(p, l, item, smem, tid_); else attn_item<3>(p, l, item, smem, tid_);
  }
}

DEV void phase_final(const Params& p, const int tid_, const int vb_, const int vg_) {
  const int lane = TIDX & 63, wave = TIDX >> 6;
  for (int item = vb_; item < 1024; item += vg_) {
    float* x = p.out + OUT_Y + (size_t)(item * 16 + wave * 4) * 1024;
    float4 v[4][4];
#pragma unroll
    for (int r = 0; r < 4; r++)
#pragma unroll
      for (int i = 0; i < 4; i++) v[r][i] = *(const float4*)(x + (size_t)r * 1024 + i * 256 + lane * 4);
    float4 g[4];
#pragma unroll
    for (int i = 0; i < 4; i++) g[i] = *(const float4*)(p.final_g + i * 256 + lane * 4);
    asm volatile("" ::: "memory");
    float ss[4];
#pragma unroll
    for (int r = 0; r < 4; r++) {
      ss[r] = 0.f;
#pragma unroll
      for (int i = 0; i < 4; i++) ss[r] += v[r][i].x * v[r][i].x + v[r][i].y * v[r][i].y + v[r][i].z * v[r][i].z + v[r][i].w * v[r][i].w;
    }
#pragma unroll
    for (int o = 32; o > 0; o >>= 1) {
#pragma unroll
      for (int r = 0; r < 4; r++) ss[r] += __shfl_xor(ss[r], o);
    }
#pragma unroll
    for (int r = 0; r < 4; r++) {
      const float rstd = rsqrtf(ss[r] * (1.f / 1024.f) + 1e-6f);
#pragma unroll
      for (int i = 0; i < 4; i++)
        *(float4*)(x + (size_t)r * 1024 + i * 256 + lane * 4) =
            make_float4(v[r][i].x * rstd * g[i].x, v[r][i].y * rstd * g[i].y, v[r][i].z * rstd * g[i].z, v[r][i].w * rstd * g[i].w);
    }
  }
}

namespace pg8 {
#define PG8_LAS __attribute__((address_space(3)))
typedef unsigned short bf16_t;
typedef short bf16x8 __attribute__((ext_vector_type(8)));
typedef float f32x4 __attribute__((ext_vector_type(4)));
typedef unsigned u32x4 __attribute__((ext_vector_type(4)));
constexpr int BM = 256, BK = 64, HALF = 128, HTB = HALF * BK * 2  , STAGE_BYTES = 8 * HTB, NXCD = 8, WGM = 8;

__host__ __device__ __forceinline__ int lds_byte(int r, int c) { const int st = (r >> 4) * 2 + (c >> 5), rr = r & 15, cc = c & 31, ob = rr * 64 + cc * 2; return st * 1024 + (ob ^ (((ob >> 9) & 1) << 5)); }
__host__ __device__ __forceinline__ void stage_rc(int b, int& R, int& C) { const int st = b / 1024, sb = b % 1024, swz = sb ^ (((sb >> 9) & 1) << 5); R = (st >> 1) * 16 + swz / 64; C = (st & 1) * 32 + (swz % 64) / 2; }
__host__ __device__ __forceinline__ int perm32(int rho) { const int n = rho >> 4, i = rho & 15; return 8 * (i >> 2) + 4 * n + (i & 3); }

struct Unit { int pm, pn; };
struct Gemm { const bf16_t* A; const bf16_t* Bt; int M, N, K; };

template <class Epi, class Sched, bool STAMP = false>
__device__ __forceinline__ void gemm_phase(PG8_LAS unsigned char* lds, const Gemm g, const Sched& S, const Epi& E, unsigned long long* stamps) {
    const int tid = tid_opaque(), wid = __builtin_amdgcn_readfirstlane(tid >> 6), lane = tid & 63, wr = wid >> 2, wc = wid & 3, fr = lane & 15, fq = lane >> 4;
    const int K = g.K, nt = K / BK;
    int ts_lo = 0, ts_hi = 0, nts = 0; const unsigned long long rt_entry = STAMP ? (unsigned long long)wall_clock64() : 0ull;
#define PG8_STAMP() do { if (STAMP && wid == 0 && nts < 64) { const unsigned long long _c = (unsigned long long)clock64(); \
        ts_lo = (lane == nts) ? (int)(unsigned)_c : ts_lo; ts_hi = (lane == nts) ? (int)(unsigned)(_c >> 32) : ts_hi; ++nts; } } while (0)
    PG8_STAMP();
    unsigned voffA[2], voffB[2];
#pragma unroll
    for (int i = 0; i < 2; ++i) { int R, C; stage_rc(tid * 16 + i * 8192, R, C); const int Rb = Epi::PERM ? ((R & ~31) + perm32(R & 31)) : R;
        voffA[i] = (unsigned)(R * BK + C) * 2u; voffB[i] = (unsigned)(Rb * BK + C) * 2u; }
    const size_t kstep = (size_t)(BM * BK * 2);
    const size_t hstep = (size_t)HALF * BK * 2;
    const size_t tstep = (size_t)BM * K * 2;
    const unsigned ldsw = (unsigned)wid * 1024u;
    const int aoff = lds_byte(wr * 64 + fr, fq * 8), boff = lds_byte(wc * 32 + fr, fq * 8);
#define PG8_SA(b, h) (((b) * 2 + (h)) * HTB)
#define PG8_SB(b, h) ((4 + (b) * 2 + (h)) * HTB)
#define PG8_STAGE(bufoff, gbase, voff) do { _Pragma("unroll") for (int _i = 0; _i < 2; ++_i) \
        __builtin_amdgcn_global_load_lds((const unsigned*)((const char*)(gbase) + (voff)[_i]), (PG8_LAS unsigned*)(lds + (bufoff) + ldsw + _i * 8192), 16, 0, 0); } while (0)
#define PG8_LDA(dst, b, h) do { _Pragma("unroll") for (int m = 0; m < 4; ++m) _Pragma("unroll") for (int k = 0; k < 2; ++k) dst[m][k] = *(const PG8_LAS bf16x8*)(lds + PG8_SA(b, h) + aoff + m * 2048 + k * 1024); } while (0)
#define PG8_LDB(dst, b, h) do { _Pragma("unroll") for (int n = 0; n < 2; ++n) _Pragma("unroll") for (int k = 0; k < 2; ++k) dst[n][k] = *(const PG8_LAS bf16x8*)(lds + PG8_SB(b, h) + boff + n * 2048 + k * 1024); } while (0)
#define PG8_MMA(ai, bj, At, Bt) do { __builtin_amdgcn_s_setprio(1); _Pragma("unroll") for (int m = 0; m < 4; ++m) _Pragma("unroll") for (int n = 0; n < 2; ++n) _Pragma("unroll") for (int k = 0; k < 2; ++k) \
        acc[ai][bj][m][n] = __builtin_amdgcn_mfma_f32_16x16x32_bf16(Bt[n][k], At[m][k], acc[ai][bj][m][n], 0, 0, 0); __builtin_amdgcn_s_setprio(0); } while (0)
#define PG8_WAIT_V(n) asm volatile("s_waitcnt vmcnt(" #n ")" ::: "memory")
#define PG8_WAIT_L(n) asm volatile("s_waitcnt lgkmcnt(" #n ")" ::: "memory")
#define PG8_BAR __builtin_amdgcn_s_barrier()
#define PG8_SCHED __builtin_amdgcn_sched_barrier(0)
    Unit cur, nxt; int ui = 0;
    if (!S.next(0, cur)) return;
    f32x4 acc[2][2][4][2];
#pragma unroll
    for (int a = 0; a < 2; ++a)
#pragma unroll
        for (int b = 0; b < 2; ++b)
#pragma unroll
            for (int m = 0; m < 4; ++m)
#pragma unroll
                for (int n = 0; n < 2; ++n) acc[a][b][m][n] = (f32x4){0.f, 0.f, 0.f, 0.f};
    bf16x8 At[4][2], B0[2][2], B1[2][2];
    const char* cA = (const char*)g.A + (size_t)cur.pm * tstep; const char* cB = (const char*)g.Bt + (size_t)cur.pn * tstep;
    S.a_ready(cur);
    PG8_STAGE(PG8_SB(0, 0), cB, voffB); PG8_STAGE(PG8_SA(0, 0), cA, voffA); PG8_STAGE(PG8_SB(0, 1), cB + hstep, voffB); PG8_STAGE(PG8_SA(0, 1), cA + hstep, voffA);
    if (wr == 1) PG8_BAR;
    PG8_WAIT_V(4); PG8_BAR;
    PG8_STAGE(PG8_SB(1, 0), cB + kstep, voffB); PG8_STAGE(PG8_SA(1, 0), cA + kstep, voffA); PG8_STAGE(PG8_SB(1, 1), cB + hstep + kstep, voffB);
    PG8_WAIT_V(6); PG8_BAR;
    PG8_STAMP();
    for (;;) {
        const bool has_next = S.next(ui + 1, nxt);
        const char* nA = has_next ? (const char*)g.A + (size_t)nxt.pm * tstep : cA; const char* nB = has_next ? (const char*)g.Bt + (size_t)nxt.pn * tstep : cB;
        for (int t = 0; t < nt; t += 2) {
            const bool last = (t == nt - 2);
            const char* a1 = cA + (size_t)(t + 1) * kstep;
            const char* a2 = last ? nA : cA + (size_t)(t + 2) * kstep; const char* b2 = last ? nB : cB + (size_t)(t + 2) * kstep;
            const char* a3 = a2 + kstep; const char* b3 = b2 + kstep;
            if (last && has_next) S.a_ready(nxt);
            PG8_LDB(B0, 0, 0); PG8_SCHED; PG8_LDA(At, 0, 0); PG8_STAGE(PG8_SA(1, 1), a1 + hstep, voffA);
            PG8_WAIT_L(8); PG8_BAR; PG8_WAIT_L(0); PG8_MMA(0, 0, At, B0); PG8_BAR; PG8_SCHED;
            PG8_LDB(B1, 0, 1); PG8_STAGE(PG8_SB(0, 0), b2, voffB);
            PG8_BAR; PG8_WAIT_L(0); PG8_MMA(0, 1, At, B1); PG8_BAR;
            PG8_LDA(At, 0, 1); PG8_STAGE(PG8_SA(0, 0), a2, voffA);
            PG8_BAR; PG8_WAIT_L(0); PG8_MMA(1, 0, At, B0); PG8_BAR; PG8_SCHED;
            PG8_STAGE(PG8_SB(0, 1), b2 + hstep, voffB);
            PG8_WAIT_V(6); PG8_BAR; PG8_MMA(1, 1, At, B1); PG8_BAR;
            PG8_LDB(B0, 1, 0); PG8_SCHED; PG8_LDA(At, 1, 0); PG8_STAGE(PG8_SA(0, 1), a2 + hstep, voffA);
            PG8_WAIT_L(8); PG8_BAR; PG8_WAIT_L(0); PG8_MMA(0, 0, At, B0); PG8_BAR; PG8_SCHED;
            PG8_LDB(B1, 1, 1); PG8_STAGE(PG8_SB(1, 0), b3, voffB);
            PG8_BAR; PG8_WAIT_L(0); PG8_MMA(0, 1, At, B1); PG8_BAR;
            PG8_LDA(At, 1, 1); PG8_STAGE(PG8_SA(1, 0), a3, voffA);
            PG8_BAR; PG8_WAIT_L(0); PG8_MMA(1, 0, At, B0); PG8_BAR; PG8_SCHED;
            PG8_STAGE(PG8_SB(1, 1), b3 + hstep, voffB);
            PG8_WAIT_V(6); PG8_BAR; PG8_MMA(1, 1, At, B1); PG8_BAR;
        }
        PG8_STAMP();
        if constexpr (!Epi::AFTER_DRAIN) { E(acc, cur, wr, wc, fr, fq); S.done(cur); }
        PG8_STAMP();
        if (!has_next) break;
        if constexpr (!Epi::KEEP_ACC) {
#pragma unroll
        for (int a = 0; a < 2; ++a)
#pragma unroll
            for (int b = 0; b < 2; ++b)
#pragma unroll
                for (int m = 0; m < 4; ++m)
#pragma unroll
                    for (int n = 0; n < 2; ++n) acc[a][b][m][n] = (f32x4){0.f, 0.f, 0.f, 0.f};
        }
        cur = nxt; cA = nA; cB = nB; ++ui;
    }
    PG8_WAIT_V(0);
    if (wr == 0) PG8_BAR;
    PG8_BAR;
    if constexpr (Epi::AFTER_DRAIN) { E.fused(acc, cur, wr, wc, fr, fq, lds, wid, lane); S.done(cur); }
    PG8_STAMP();
    if (STAMP && wid == 0) { stamps[lane] = lane < nts ? (((unsigned long long)(unsigned)ts_hi << 32) | (unsigned)ts_lo) : 0ull;
        if (lane == 62) stamps[62] = rt_entry; if (lane == 63) stamps[63] = (unsigned long long)wall_clock64(); }
#undef PG8_STAMP
#undef PG8_SA
#undef PG8_SB
#undef PG8_STAGE
#undef PG8_LDA
#undef PG8_LDB
#undef PG8_MMA
#undef PG8_WAIT_V
#undef PG8_WAIT_L
#undef PG8_BAR
#undef PG8_SCHED
}
}


struct InSched {
  int l, c;
  __device__ __forceinline__ bool next(int i, pg8::Unit& u) const {
    const int x = c >> 5, q = c & 31;
    const int e = i * 32 + q;
    if (e >= 124) return false;
    const int it = 4 * x + (e & 3), jt = e >> 2;
    const bool swapped = (jt == 4) || (jt == 5) || (jt == 10) || (jt == 11);
    if (swapped) { u.pm = l * 31 + jt; u.pn = 62 + it; } else { u.pm = 62 + it; u.pn = l * 31 + jt; }
    return true;
  }
  __device__ __forceinline__ void a_ready(const pg8::Unit&) const {}
  __device__ __forceinline__ void done(const pg8::Unit&) const {}
};

DEV void st8bf(u16* p, const pg8::f32x4& a, const pg8::f32x4& b) {
  uint4 w; w.x = pack2(a[0], a[1]); w.y = pack2(a[2], a[3]); w.z = pack2(b[0], b[1]); w.w = pack2(b[2], b[3]);
  *(uint4*)p = w;
}
template <class F> DEV pg8::f32x4 map4(const pg8::f32x4& v, F f) { pg8::f32x4 r; r[0] = f(v[0]); r[1] = f(v[1]); r[2] = f(v[2]); r[3] = f(v[3]); return r; }

struct InEpi {
  static constexpr bool PERM = true, AFTER_DRAIN = false, KEEP_ACC = false;
  char* ws; float* out; int l, s;
  __device__ __forceinline__ void operator()(const pg8::f32x4 (&acc)[2][2][4][2], const pg8::Unit& u, int wr, int wc, int fr, int fq) const {
    u16* QNA = (u16*)(ws + O_QNA); u16* KNA = (u16*)(ws + O_KNA); u16* VTNA = (u16*)(ws + O_VTNA);
    const size_t zs = (size_t)s * 8192 * 512;
    u16* ZA = (u16*)(ws + O_ZA) + zs; u16* ZB = (u16*)(ws + O_ZB) + zs; u16* ZC = (u16*)(ws + O_ZC) + zs;
    u16* GU = (u16*)(ws + O_GU); u16* GVT = (u16*)(ws + O_GVT);
    u16* DQ = (u16*)(ws + O_DQ); u16* DKV = (u16*)(ws + O_DKV); float* KRF = (float*)(ws + O_KRF);
    unsigned char* GATES = (unsigned char*)(ws + O_GATES) + (size_t)s * 8192 * 3072;
    if (u.pm >= 62) {
      const int t0 = (u.pm - 62) * 256 + wr * 64 + fr;
      const int cbase = (u.pn - l * 31) * 256;
#pragma unroll
      for (int bj = 0; bj < 2; ++bj) {
        const int seg0 = cbase + bj * 128;
        const int n = seg0 >> 7;
        const int c0 = seg0 + wc * 32 + 8 * fq;
#pragma unroll
        for (int ai = 0; ai < 2; ++ai)
#pragma unroll
          for (int m = 0; m < 4; ++m) {
            const int T = t0 + ai * 128 + m * 16;
            const pg8::f32x4 v0 = acc[ai][bj][m][0], v1 = acc[ai][bj][m][1];
            if (n < 4) {
              st8bf(QNA + (size_t)T * 512 + c0, v0, v1);
            } else if (n < 8) {
              const int col = c0 - 512;
              st8bf(KNA + (size_t)T * 512 + col, v0, v1);
              if (s == 0) {
                const int b = T >> 8, sq = T & 255;
                float* o = out + OUT_SK + ((size_t)(b * 2 + l) * 256 + sq) * 512 + col;
                *(float4*)o = make_float4(v0[0], v0[1], v0[2], v0[3]); *(float4*)(o + 4) = make_float4(v1[0], v1[1], v1[2], v1[3]);
              }
            } else if (n < 16) {
              st8bf(ZA + blk_off(T, c0 - 1536, 512), v0, v1);
            } else if (n < 20) {
              st8bf(GU + (size_t)T * 512 + c0 - 2048, v0, v1);
            } else if (n < 28) {
              st8bf(ZB + blk_off(T, c0 - 3072, 512), v0, v1);
            } else if (n < 31) {
              st8bf(DQ + (size_t)T * 384 + c0 - 3584, v0, v1);
            } else if (n < 33) {
              st8bf(DKV + (size_t)T * 256 + c0 - 3968, v0, v1);
            } else if (n < 37) {
              st8bf(ZC + blk_off(T, c0 - 4224, 512), v0, v1);
            } else if (n < 61) {
              unsigned q[8];
#pragma unroll
              for (int e = 0; e < 4; e++) { q[e] = (unsigned)(sigmoid_f(v0[e]) * 255.f + 0.5f); q[4 + e] = (unsigned)(sigmoid_f(v1[e]) * 255.f + 0.5f); }
              uint2 gw; gw.x = q[0] | (q[1] << 8) | (q[2] << 16) | (q[3] << 24); gw.y = q[4] | (q[5] << 8) | (q[6] << 16) | (q[7] << 24);
              *(uint2*)(GATES + (size_t)T * 3072 + c0 - 4736) = gw;
            } else if (c0 < 7808 + 32) {
              const int j = c0 - 7808;
              float* kp = KRF + (size_t)T * 32 + j;
              *(float4*)kp = make_float4(v0[0], v0[1], v0[2], v0[3]); *(float4*)(kp + 4) = make_float4(v1[0], v1[1], v1[2], v1[3]);
              if (s == 0) {
                const int b = T >> 8, sq = T & 255;
                float* o = out + OUT_SKR + ((size_t)(b * 2 + l) * 256 + sq) * 32 + j;
                *(float4*)o = make_float4(v0[0], v0[1], v0[2], v0[3]); *(float4*)(o + 4) = make_float4(v1[0], v1[1], v1[2], v1[3]);
              }
            }
          }
      }
    } else {
      const int jt = u.pm - l * 31;
      const int ch0 = jt * 256 + wr * 64 + fr;
      const int tk0 = (u.pn - 62) * 256 + wc * 32 + 8 * fq;
#pragma unroll
      for (int ai = 0; ai < 2; ++ai)
#pragma unroll
        for (int m = 0; m < 4; ++m) {
          const int ch = ch0 + ai * 128 + m * 16;
#pragma unroll
          for (int bj = 0; bj < 2; ++bj) {
            const int tok = tk0 + bj * 128;
            const pg8::f32x4 v0 = acc[ai][bj][m][0], v1 = acc[ai][bj][m][1];
            if (jt < 8) {
              const int dva = ch - 1024;
              if (s == 0) {
                const int b = tok >> 8, sq = tok & 255;
                st8bf(VTNA + ((size_t)(b * 512 + dva)) * 256 + sq, v0, v1);
                float* o = out + OUT_SV + ((size_t)(b * 2 + l) * 256 + sq) * 512 + dva;
                o[0] = v0[0]; o[512] = v0[1]; o[1024] = v0[2]; o[1536] = v0[3]; o[2048] = v1[0]; o[2560] = v1[1]; o[3072] = v1[2]; o[3584] = v1[3];
              } else {
                const int b = tok >> 10, nn = tok & 1023;
                st8bf(VTNA + ((size_t)(b * 512 + dva)) * 1024 + nn, v0, v1);
              }
            } else {
              const int c = ch - 2560;
              const int chunk = tok >> 7, q = tok & 127;
              st8bf(GVT + ((size_t)chunk * 512 + c) * 128 + q, v0, v1);
            }
          }
        }
    }
  }
};

DEV void phase_in8(const Params& p, int l, int s, char* smem_full, int vid) {
  pg8::Gemm g; g.A = (const pg8::bf16_t*)(p.ws + O_WIN); g.Bt = g.A; g.M = 0; g.N = 0; g.K = 1024;
  InSched S; S.l = l; S.c = vid;
  InEpi E; E.ws = p.ws; E.out = p.out; E.l = l; E.s = s;
  pg8::gemm_phase<InEpi, InSched, false>((PG8_LAS unsigned char*)smem_full, g, S, E, nullptr);
}


struct MergeSched {
  int l, c;
  __device__ __forceinline__ bool next(int i, pg8::Unit& u) const {
    const int x = c >> 5, q = c & 31;
    if (i >= 3) return false;
    const int it = 8 * x + (q & 7), jt = q >> 3;
    const size_t zo = (i == 0) ? O_ZA : (i == 1 ? O_ZB : O_ZC);
    u.pm = (int)(zo / 262144) + it;
    u.pn = (int)(O_WBR / 262144) + (l * 3 + i) * 4 + jt;
    return true;
  }
  __device__ __forceinline__ void a_ready(const pg8::Unit&) const {}
  __device__ __forceinline__ void done(const pg8::Unit&) const {}
};
struct MergeEpi {
  static constexpr bool PERM = true, AFTER_DRAIN = false, KEEP_ACC = true;
  char* ws; int l;
  __device__ __forceinline__ void operator()(pg8::f32x4 (&acc)[2][2][4][2], const pg8::Unit& u, int wr, int wc, int fr, int fq) const {
    const int wrel = u.pn - (int)(O_WBR / 262144) - l * 12;
    const int k = wrel >> 2, jt = wrel & 3;
    const size_t zo = (k == 0) ? O_ZA : (k == 1 ? O_ZB : O_ZC);
    const int it = u.pm - (int)(zo / 262144);
    const unsigned char* GATES = (const unsigned char*)(ws + O_GATES);
    u16* MG = (u16*)(ws + O_MG);
    const int t0 = it * 256 + wr * 64 + fr;
#pragma unroll
    for (int ai = 0; ai < 2; ++ai) {
      uint2 ga[4][2], gb[4][2];
#pragma unroll
      for (int m = 0; m < 4; ++m)
#pragma unroll
        for (int bj = 0; bj < 2; ++bj) {
          const int T = t0 + ai * 128 + m * 16;
          const int c0 = jt * 256 + bj * 128 + wc * 32 + 8 * fq;
          const unsigned char* gp = GATES + (size_t)T * 3072 + k * 1024 + c0;
          ga[m][bj] = *(const uint2*)gp;
          gb[m][bj] = (k < 2) ? *(const uint2*)(gp + 1024) : make_uint2(0u, 0u);
        }
      asm volatile("" ::: "memory");
#pragma unroll
      for (int m = 0; m < 4; ++m)
#pragma unroll
        for (int bj = 0; bj < 2; ++bj) {
          const int T = t0 + ai * 128 + m * 16;
          const int c0 = jt * 256 + bj * 128 + wc * 32 + 8 * fq;
          float f[8];
#pragma unroll
          for (int e = 0; e < 8; e++) {
            const float qa = fmaxf((float)((((e < 4) ? ga[m][bj].x : ga[m][bj].y) >> (8 * (e & 3))) & 0xffu), 1.f);
            if (k < 2) {
              const float qb = fmaxf((float)((((e < 4) ? gb[m][bj].x : gb[m][bj].y) >> (8 * (e & 3))) & 0xffu), 1.f);
              f[e] = qa * __builtin_amdgcn_rcpf(qb);
            } else {
              f[e] = qa * (1.f / 255.f);
            }
          }
#pragma unroll
          for (int e = 0; e < 4; e++) { acc[ai][bj][m][0][e] *= f[e]; acc[ai][bj][m][1][e] *= f[4 + e]; }
          if (k == 2) {
            uint4 o;
            o.x = pack2(acc[ai][bj][m][0][0], acc[ai][bj][m][0][1]); o.y = pack2(acc[ai][bj][m][0][2], acc[ai][bj][m][0][3]);
            o.z = pack2(acc[ai][bj][m][1][0], acc[ai][bj][m][1][1]); o.w = pack2(acc[ai][bj][m][1][2], acc[ai][bj][m][1][3]);
            *(uint4*)(MG + blk_off(T, c0, 1024)) = o;
          }
        }
    }
  }
};
DEV void phase_merge8(const Params& p, int l, char* smem_full, int vid) {
  pg8::Gemm g; g.A = (const pg8::bf16_t*)p.ws; g.Bt = g.A; g.M = 0; g.N = 0; g.K = 512;
  MergeSched S; S.l = l; S.c = vid;
  MergeEpi E; E.ws = p.ws; E.l = l;
  pg8::gemm_phase<MergeEpi, MergeSched, false>((PG8_LAS unsigned char*)smem_full, g, S, E, nullptr);
}

struct OutSched {
  int l, c;
  __device__ __forceinline__ bool next(int i, pg8::Unit& u) const {
    const int x = c >> 5, q = c & 31;
    if (i >= 1) return false;
    u.pm = (int)(O_MG / 524288) + 8 * x + (q & 7);
    u.pn = (int)(O_WOUT / 524288) + l * 4 + (q >> 3);
    return true;
  }
  __device__ __forceinline__ void a_ready(const pg8::Unit&) const {}
  __device__ __forceinline__ void done(const pg8::Unit&) const {}
};
struct OutEpi {
  static constexpr bool PERM = true, AFTER_DRAIN = false, KEEP_ACC = false;
  const float* x0; const float* x1; float* outy; const float* MOD; int l;
  __device__ __forceinline__ void operator()(const pg8::f32x4 (&acc)[2][2][4][2], const pg8::Unit& u, int wr, int wc, int fr, int fq) const {
    const int it = u.pm - (int)(O_MG / 524288), jt = u.pn - (int)(O_WOUT / 524288) - l * 4;
    const int s = it >> 5;
    const int t0 = it * 256 + wr * 64 + fr;
    const float* xin = (l == 0) ? ((s == 0) ? x0 : x1 - (size_t)8192 * 1024) : outy;
    typedef __attribute__((address_space(1))) pg8::f32x4 GF4;
    const GF4* xg = (const GF4*)(unsigned long long)xin;
    GF4* og = (GF4*)(unsigned long long)outy;
    const float* gr = MOD + (size_t)(l * 9 + cond_idx(s, t0 & 8191)) * 3072 + 2048;
    float4 gv[2][2];
#pragma unroll
    for (int bj = 0; bj < 2; ++bj)
#pragma unroll
      for (int h2 = 0; h2 < 2; ++h2) gv[bj][h2] = *(const float4*)(gr + jt * 256 + bj * 128 + wc * 32 + 8 * fq + 4 * h2);
#pragma unroll
    for (int ai = 0; ai < 2; ++ai)
#pragma unroll
      for (int mp = 0; mp < 2; ++mp) {
        pg8::f32x4 xv[2][2][2];
#pragma unroll
        for (int mm = 0; mm < 2; ++mm)
#pragma unroll
          for (int bj = 0; bj < 2; ++bj)
#pragma unroll
            for (int h2 = 0; h2 < 2; ++h2)
              xv[mm][bj][h2] = *(xg + (size_t)(t0 + ai * 128 + (mp * 2 + mm) * 16) * 256 + jt * 64 + bj * 32 + wc * 8 + 2 * fq + h2);
        asm volatile("" ::: "memory"); __builtin_amdgcn_sched_barrier(0);
#pragma unroll
        for (int mm = 0; mm < 2; ++mm)
#pragma unroll
          for (int bj = 0; bj < 2; ++bj)
#pragma unroll
            for (int h2 = 0; h2 < 2; ++h2) {
              const int m = mp * 2 + mm;
              const pg8::f32x4 x = xv[mm][bj][h2];
              const float4 g = gv[bj][h2];
              const pg8::f32x4 v = acc[ai][bj][m][h2];
              *(og + (size_t)(t0 + ai * 128 + m * 16) * 256 + jt * 64 + bj * 32 + wc * 8 + 2 * fq + h2) =
                  pg8::f32x4{x[0] + g.x * v[0], x[1] + g.y * v[1], x[2] + g.z * v[2], x[3] + g.w * v[3]};
            }
        asm volatile("" ::: "memory"); __builtin_amdgcn_sched_barrier(0);
      }
  }
};
DEV void phase_out8(const Params& p, int l, char* smem_full, int vid) {
  pg8::Gemm g; g.A = (const pg8::bf16_t*)p.ws; g.Bt = g.A; g.M = 0; g.N = 0; g.K = 1024;
  OutSched S; S.l = l; S.c = vid;
  OutEpi E; E.x0 = p.x_prompt; E.x1 = p.x_sample; E.outy = p.out + OUT_Y; E.MOD = (const float*)(p.ws + O_MOD); E.l = l;
  pg8::gemm_phase<OutEpi, OutSched, false>((PG8_LAS unsigned char*)smem_full, g, S, E, nullptr);
}


struct QSched {
  int l, c;
  __device__ __forceinline__ bool next(int i, pg8::Unit& u) const {
    const int x = c >> 5, q = c & 31;
    if (q >= 12 || i >= 1) return false;
    u.pm = (int)(O_DQN / 196608) + 4 * x + (q & 3);
    u.pn = (int)(O_WUQ / 196608) + l * 3 + (q >> 2);
    return true;
  }
  __device__ __forceinline__ void a_ready(const pg8::Unit&) const {}
  __device__ __forceinline__ void done(const pg8::Unit&) const {}
};
struct QEpi {
  static constexpr bool PERM = true, AFTER_DRAIN = false, KEEP_ACC = false;
  char* ws; int l;
  __device__ __forceinline__ void operator()(const pg8::f32x4 (&acc)[2][2][4][2], const pg8::Unit& u, int wr, int wc, int fr, int fq) const {
    const int it = u.pm - (int)(O_DQN / 196608), jt = u.pn - (int)(O_WUQ / 196608) - l * 3;
    u16* QM = (u16*)(ws + O_QM);
#pragma unroll
    for (int ai = 0; ai < 2; ++ai)
#pragma unroll
      for (int m = 0; m < 4; ++m) {
        const int T = it * 256 + ai * 128 + wr * 64 + m * 16 + fr;
#pragma unroll
        for (int bj = 0; bj < 2; ++bj)
          st8bf(QM + (size_t)T * 768 + jt * 256 + bj * 128 + wc * 32 + 8 * fq, acc[ai][bj][m][0], acc[ai][bj][m][1]);
      }
  }
};
struct KvSched {
  int l, c, nt;
  __device__ __forceinline__ bool next(int i, pg8::Unit& u) const {
    const int x = c >> 5, q = c & 31, per = nt >> 3;
    if (q >= 4 * per || i >= 1) return false;
    const int it = per * x + (q % per), jt = q / per;
    const int wt = (int)(O_WUKV / 131072) + l * 4 + jt, ct = (int)(O_CKV / 131072) + it;
    if (jt < 2) { u.pm = ct; u.pn = wt; } else { u.pm = wt; u.pn = ct; }
    return true;
  }
  __device__ __forceinline__ void a_ready(const pg8::Unit&) const {}
  __device__ __forceinline__ void done(const pg8::Unit&) const {}
};
struct KvEpi {
  static constexpr bool PERM = true, AFTER_DRAIN = false, KEEP_ACC = false;
  char* ws; int l, S;
  __device__ __forceinline__ void operator()(const pg8::f32x4 (&acc)[2][2][4][2], const pg8::Unit& u, int wr, int wc, int fr, int fq) const {
    const int c0t = (int)(O_CKV / 131072), w0t = (int)(O_WUKV / 131072) + l * 4;
    if (u.pm >= c0t) {
      const int it = u.pm - c0t, jt = u.pn - w0t;
      u16* KNOPE = (u16*)(ws + O_KNOPE);
#pragma unroll
      for (int ai = 0; ai < 2; ++ai)
#pragma unroll
        for (int m = 0; m < 4; ++m) {
          const int R = it * 256 + ai * 128 + wr * 64 + m * 16 + fr;
#pragma unroll
          for (int bj = 0; bj < 2; ++bj)
            st8bf(KNOPE + (size_t)R * 512 + jt * 256 + bj * 128 + wc * 32 + 8 * fq, acc[ai][bj][m][0], acc[ai][bj][m][1]);
        }
    } else {
      const int jt = u.pm - w0t - 2, it = u.pn - c0t;
      u16* VTM = (u16*)(ws + O_VTM);
#pragma unroll
      for (int ai = 0; ai < 2; ++ai)
#pragma unroll
        for (int m = 0; m < 4; ++m) {
          const int ch = jt * 256 + ai * 128 + wr * 64 + m * 16 + fr;
#pragma unroll
          for (int bj = 0; bj < 2; ++bj) {
            const int row = it * 256 + bj * 128 + wc * 32 + 8 * fq;
            const int b = row / S, mm = row % S;
            st8bf(VTM + ((size_t)b * 512 + ch) * S + mm, acc[ai][bj][m][0], acc[ai][bj][m][1]);
          }
        }
    }
  }
};
DEV void phase_qkv8(const Params& p, int l, int s, char* smem_full, int vid) {
  {
    pg8::Gemm g; g.A = (const pg8::bf16_t*)p.ws; g.Bt = g.A; g.M = 0; g.N = 0; g.K = 384;
    QSched S; S.l = l; S.c = vid;
    QEpi E; E.ws = p.ws; E.l = l;
    pg8::gemm_phase<QEpi, QSched, false>((PG8_LAS unsigned char*)smem_full, g, S, E, nullptr);
  }
  {
    pg8::Gemm g; g.A = (const pg8::bf16_t*)p.ws; g.Bt = g.A; g.M = 0; g.N = 0; g.K = 256;
    KvSched S; S.l = l; S.c = vid; S.nt = (s == 0) ? 32 : 40;
    KvEpi E; E.ws = p.ws; E.l = l; E.S = (s == 0) ? 256 : 1280;
    pg8::gemm_phase<KvEpi, KvSched, false>((PG8_LAS unsigned char*)smem_full, g, S, E, nullptr);
  }
}

#define XB_TMO      128
#define XB_XCNT(j)  (256  + 64 * (j))
#define XB_XSUB(j)  (1280 + 64 * (j))
#define XB_XGEN(j)  (2304 + 64 * (j))
#define XB_TOP      3328
#define XB_TOPGEN   3392
#define XCD_BAR_WORDS 3456
#define XB_SPIN_CAP (1u << 18)
#define LAS __attribute__((address_space(3)))

__device__ __forceinline__ unsigned xb_ld(unsigned* p)              { return __hip_atomic_load(p, __ATOMIC_RELAXED, __HIP_MEMORY_SCOPE_AGENT); }
__device__ __forceinline__ unsigned xb_add(unsigned* p, unsigned v) { return __hip_atomic_fetch_add(p, v, __ATOMIC_RELAXED, __HIP_MEMORY_SCOPE_AGENT); }
__device__ __forceinline__ unsigned xb_xcc_id() { return (unsigned)__builtin_amdgcn_s_getreg((3 << 11) | 20) & 0xFu; }
#define XB_SPIN(cond, bar) do { unsigned _sp = 0; while (cond) { __builtin_amdgcn_s_sleep(1); \
    if ((++_sp & 255u) == 0u) { if (xb_ld(&(bar)[XB_TMO])) break; if (_sp > XB_SPIN_CAP) { atomicAdd(&(bar)[XB_TMO], 1u); break; } } } } while (0)

struct XcdBarrier {
    unsigned* bar; unsigned x;
    volatile LAS unsigned* st;
};

__device__ __forceinline__ XcdBarrier xcd_barrier_post(unsigned* bar, volatile LAS unsigned* st) {
    XcdBarrier b; b.bar = bar; b.x = xb_xcc_id(); b.st = st;
    if ((int)threadIdx.x == 0) st[2] = xb_add(&bar[XB_XCNT(b.x)], 1u);
    return b;
}
__device__ __forceinline__ void xcd_barrier_complete(unsigned* bar, unsigned x, unsigned& nloc, unsigned& nx) {
    const unsigned G = gridDim.x * gridDim.y * gridDim.z;
    unsigned sum, cnt, mine, sp = 0u;
    for (;;) {
        sum = 0u; cnt = 0u; mine = 0u;
#pragma unroll
        for (unsigned j = 0; j < 16; ++j) { const unsigned c = xb_ld(&bar[XB_XCNT(j)]); sum += c; cnt += (c > 0u) ? 1u : 0u; mine = (j == x) ? c : mine; }
        if (sum == G) break;
        __builtin_amdgcn_s_sleep(1);
        if ((++sp & 255u) == 0u) { if (xb_ld(&bar[XB_TMO])) break; if (sp > XB_SPIN_CAP) { atomicAdd(&bar[XB_TMO], 1u); break; } }
    }
    nloc = mine > 0u ? mine : 1u; nx = cnt > 0u ? cnt : 1u;
}

__device__ __forceinline__ void xcd_barrier(const XcdBarrier& b) {
    asm volatile("s_waitcnt vmcnt(0)" ::: "memory");
    __syncthreads();
    if ((int)threadIdx.x == 0) {
        unsigned* bar = b.bar;
        __builtin_amdgcn_s_waitcnt(0);
        unsigned nloc = b.st[0], nx = b.st[1];
        if (nloc == 0u) { xcd_barrier_complete(bar, b.x, nloc, nx); b.st[0] = nloc; b.st[1] = nx; }
        const unsigned old = xb_add(&bar[XB_XSUB(b.x)], 1u);
        const unsigned gen = old / nloc;
        if (old + 1u == (gen + 1u) * nloc) {
            __builtin_amdgcn_fence(__ATOMIC_RELEASE, "agent");
            asm volatile("s_waitcnt vmcnt(0)" ::: "memory");
            const unsigned og = xb_add(&bar[XB_TOP], 1u);
            const unsigned tg = og / nx;
            if (og + 1u == (tg + 1u) * nx) xb_add(&bar[XB_TOPGEN], 1u);
            else XB_SPIN(xb_ld(&bar[XB_TOPGEN]) == tg, bar);
            __builtin_amdgcn_fence(__ATOMIC_ACQUIRE, "agent");
            xb_add(&bar[XB_XGEN(b.x)], 1u);
            asm volatile("s_waitcnt vmcnt(0)" ::: "memory");
        } else {
            XB_SPIN(xb_ld(&bar[XB_XGEN(b.x)]) == gen, bar);
            __builtin_amdgcn_fence(__ATOMIC_ACQUIRE, "agent");
            asm volatile("s_waitcnt vmcnt(0)" ::: "memory");
        }
    }
    __syncthreads();
}


DEV void run_phase(const Params& p, int ph, int l, int s, char* smem, const int vid_, const int tid_, const int vb_, const int vg_) {
  switch (ph) {
    case 0: phase_prep(p, smem, tid_, vb_, vg_); break;
    case 1: phase_h(p, l, s, tid_, vb_, vg_); break;
    case 3: phase_rows(p, l, s, smem, tid_, vb_, vg_); break;
    case 4: phase_mix(p, l, s, smem, tid_, vb_, vg_); break;
    case 5: phase_mla(p, l, s, smem, tid_, vb_, vg_); break;
    default: phase_final(p, tid_, vb_, vg_); break;
  }
}

__global__ void __launch_bounds__(512, 2) mega_kernel(Params p) {
  extern __shared__ __attribute__((aligned(16))) unsigned char dyn_lds[];
  char* smem = (char*)dyn_lds;
  uint4& xb_words = *(uint4*)(dyn_lds + 131072);
  if (threadIdx.x == 0) xb_words = make_uint4(0u, 0u, 0u, 0u);
  __syncthreads();
  XcdBarrier xb = xcd_barrier_post((unsigned*)(p.ws + O_BAR), (volatile LAS unsigned*)(dyn_lds + 131072));
  if (p.ws == nullptr) cg::this_grid().sync();
  int vid = blockIdx.x;
#pragma unroll 1
  for (int step = 0; step < 24; step++) {
    int ph, l = 0, s = 0;
    bool also_h1 = false;
    if (step == 0) ph = 0;
    else if (step == 23) ph = 8;
    else {
      const int idx = step - 1; l = idx / 11; const int r = idx % 11;
      if (r < 5) { s = 0; ph = 1 + r; also_h1 = (r == 4); }
      else if (r < 9) { s = 1; ph = 2 + (r - 5); }
      else ph = 6 + (r - 9);
    }
    {
      const int tfull = tid_opaque();
      const int team = tfull >> 8;
      Params q = p;
      size_t zoff = 0;
      asm volatile("" : "+s"(zoff));
      q.ws = p.ws + zoff;
      q.out = p.out + zoff;
      if (ph == 4) { phase_qkv8(q, l, s, smem, vid); __syncthreads(); }
      if (ph == 2) phase_in8(q, l, s, smem, vid);
      else if (ph == 6) phase_merge8(q, l, smem, vid);
      else if (ph == 7) phase_out8(q, l, smem, vid);
      else run_phase(q, ph, l, s, smem + team * 65536, vid * 2 + team, tfull & 255, blockIdx.x * 2 + team, gridDim.x * 2);
      if (also_h1) run_phase(q, 1, l, 1, smem + team * 65536, vid * 2 + team, tfull & 255, blockIdx.x * 2 + team, gridDim.x * 2);
    }
    if (step < 23) xcd_barrier(xb);
    if (step == 0) {
      if (threadIdx.x == 0) {
        unsigned base = 0;
        for (unsigned j = 0; j < 16; ++j) { const unsigned c = xb_ld(&xb.bar[XB_XCNT(j)]); if (j < xb.x) base += c; }
        unsigned v = base + xb_words.z;
        if (v >= gridDim.x) v = blockIdx.x;
        xb_words.w = v;
      }
      __syncthreads();
      vid = __builtin_amdgcn_readfirstlane((int)xb_words.w);
    }
  }
}

extern "C" void kernel_launch(void* const* d_in, const int* in_sizes, int n_in, void* d_out, int out_size, void* d_ws, size_t ws_size,
                              hipStream_t stream) {
  Params p{};
  const float** pp = (const float**)&p;
  for (int i = 0; i < 22; i++) pp[i] = (const float*)d_in[i];
  p.out = (float*)d_out;
  p.ws = (char*)d_ws;
  static int grid_blocks = 0;
  if (!grid_blocks) {
    int dev = 0, cus = 0, per_cu = 0;
    hipGetDevice(&dev);
    hipDeviceGetAttribute(&cus, hipDeviceAttributeMultiprocessorCount, dev);
    hipFuncSetAttribute((const void*)mega_kernel, hipFuncAttributeMaxDynamicSharedMemorySize, (int)DYN_LDS);
    hipOccupancyMaxActiveBlocksPerMultiprocessor(&per_cu, mega_kernel, 512, DYN_LDS);
    if (per_cu > 1) per_cu = 1;
    grid_blocks = cus * per_cu;
    grid_blocks &= ~7;
    if (grid_blocks > 256) grid_blocks = 256;
  }
  hipMemsetAsync((char*)d_ws + O_BAR, 0, BAR_BYTES, stream);
  void* args[] = {&p};
  hipError_t e = hipLaunchCooperativeKernel((void*)mega_kernel, dim3(grid_blocks), dim3(512), args, DYN_LDS, stream);
  if (e != hipSuccess) fprintf(stderr, "cooperative launch failed: %s (grid %d)\n", hipGetErrorString(e), grid_blocks);
}
```

```cpp
#include <hip/hip_runtime.h>
#include <hip/hip_cooperative_groups.h>
#include <cstdio>
namespace cg = cooperative_groups;

typedef unsigned short u16;
typedef __attribute__((ext_vector_type(8))) __bf16 bf16x8;
typedef __attribute__((ext_vector_type(16))) float f32x16;
#define DEV __device__ __forceinline__
__device__ __forceinline__ int tid_opaque() { int t = threadIdx.x; asm volatile("" : "+v"(t)); return t; }
#define TIDX tid_

constexpr size_t A256(size_t x) { return (x + 255) & ~(size_t)255; }
constexpr size_t A512K(size_t x) { return (x + 524287) & ~(size_t)524287; }
constexpr size_t AUP(size_t x, size_t a) { return (x + a - 1) / a * a; }
constexpr size_t O_WIN = 0;
constexpr size_t O_H = O_WIN + A256(2ull * 7936 * 1024 * 2);
constexpr size_t O_WUQ = AUP(O_H + A256(8192ull * 1024 * 2), 196608);
constexpr size_t O_WUKV = AUP(O_WUQ + A256(2ull * 768 * 384 * 2), 131072);
constexpr size_t O_WBR = A512K(O_WUKV + A256(2ull * 1024 * 256 * 2));
constexpr size_t O_WOUT = A512K(O_WBR + A256(2ull * 3 * 1024 * 512 * 2));
constexpr size_t O_SGUW = O_WOUT + A256(2ull * 1024 * 1024 * 2);
constexpr size_t O_KC = O_SGUW + A256(2ull * 4 * 128 * 128 * 2);
constexpr size_t O_VTC = O_KC + A256(2ull * 8 * 256 * 512 * 2);
constexpr size_t O_MOD = O_VTC + A256(2ull * 8 * 256 * 512 * 2);
constexpr size_t O_QNA = A512K(O_MOD + A256(2ull * 9 * 3072 * 4));
constexpr size_t O_KNA = O_QNA + 8192ull * 512 * 2;
constexpr size_t O_VTNA = O_KNA + 8192ull * 512 * 2;
constexpr size_t O_GU = O_VTNA + 8192ull * 512 * 2;
constexpr size_t O_MG = O_QNA;
constexpr size_t O_ZA = A512K(O_GU + 8192ull * 512 * 2);
constexpr size_t O_ZB = O_ZA + 2 * 8192ull * 512 * 2;
constexpr size_t O_ZC = O_ZB + 2 * 8192ull * 512 * 2;
constexpr size_t O_GVT = O_ZC + 2 * 8192ull * 512 * 2;
constexpr size_t O_GATES = O_GVT + A256(8192ull * 512 * 2);
constexpr size_t O_CKV = AUP(O_GATES + A256(2ull * 8192 * 3072), 131072);
constexpr size_t O_KR = O_CKV + A256(10240ull * 256 * 2);
constexpr size_t O_KNOPE = O_KR + A256(10240ull * 32 * 2);
constexpr size_t O_VTM = O_KNOPE + A256(10240ull * 512 * 2);
constexpr size_t O_END = O_VTM + A256(10240ull * 512 * 2);
constexpr size_t O_DQN = AUP(O_END, 196608);
constexpr size_t O_DQ = O_DQN + A256(8192ull * 384 * 2);
constexpr size_t O_DKV = O_DQ + A256(8192ull * 384 * 2);
constexpr size_t O_KRF = O_DKV + A256(8192ull * 256 * 2);
constexpr size_t O_QM = O_DQ;
constexpr size_t O_BAR = O_QM + A256(8192ull * 768 * 2);
constexpr size_t BAR_BYTES = 16384;
constexpr size_t DYN_LDS = 131072 + 16;
static_assert(O_H % 524288 == 0 && O_WIN == 0 && O_WOUT % 524288 == 0, "K=1024 operands must be 256-row-tile aligned");
static_assert(O_WBR % 262144 == 0 && O_ZA % 262144 == 0 && O_ZB % 262144 == 0 && O_ZC % 262144 == 0, "K=512 operands must be 256-row-tile aligned");
static_assert(O_MG % 524288 == 0, "MERGED must be tile aligned");
static_assert(O_WUQ % 196608 == 0 && O_DQN % 196608 == 0 && O_WUKV % 131072 == 0 && O_CKV % 131072 == 0, "K=384 / K=256 operands must be 256-row-tile aligned");
static_assert(O_KRF + 8192ull * 32 * 4 <= O_BAR, "QM alias region must cover DQ/DKV/KRF");
static_assert(O_BAR + BAR_BYTES <= 256ull * 1024 * 1024, "workspace too large");

constexpr size_t OUT_Y = 0;
constexpr size_t OUT_SK = 16777216;
constexpr size_t OUT_SV = 25165824;
constexpr size_t OUT_CKV = 33554432;
constexpr size_t OUT_SKR = 37748736;

struct Params {
  const float *x_prompt, *x_sample, *cache_na_k, *cache_na_v, *cache_ckv, *cache_kr, *c, *c_ctx;
  const float *norm_g, *w_mod, *b_mod, *w_in, *na_rpb, *sgu_w, *sgu_b, *q_norm, *w_uq, *kv_norm, *w_ukv, *w_branch, *w_out, *final_g;
  float* out;
  char* ws;
};

DEV u16 f2bf(float f) { unsigned u = __float_as_uint(f); u += 0x7fffu + ((u >> 16) & 1u); return (u16)(u >> 16); }
DEV float bf2f(u16 h) { return __uint_as_float(((unsigned)h) << 16); }
typedef __attribute__((ext_vector_type(2))) __bf16 bf16x2;
DEV unsigned pack2(float a, float b) { bf16x2 v; v[0] = (__bf16)a; v[1] = (__bf16)b; return __builtin_bit_cast(unsigned, v); }
DEV void st4bf(u16* p, float a, float b, float c, float d) { uint2 v; v.x = pack2(a, b); v.y = pack2(c, d); *(uint2*)p = v; }
DEV void ld4bf(const u16* p, float& a, float& b, float& c, float& d) {
  uint2 v = *(const uint2*)p;
  a = __uint_as_float(v.x << 16); b = __uint_as_float(v.x & 0xffff0000u);
  c = __uint_as_float(v.y << 16); d = __uint_as_float(v.y & 0xffff0000u);
}
DEV size_t blk_off(int row, int k, int K) { return (size_t)(row >> 8) * 256 * K + (size_t)(k >> 6) * 16384 + (size_t)(row & 255) * 64 + (k & 63); }
DEV float rows_allmax(float v) {
  const unsigned u = __float_as_uint(v);
  const auto a = __builtin_amdgcn_permlane16_swap(u, u, false, false);
  const float m1 = fmaxf(__uint_as_float(a[0]), __uint_as_float(a[1]));
  const unsigned u2 = __float_as_uint(m1);
  const auto b = __builtin_amdgcn_permlane32_swap(u2, u2, false, false);
  return fmaxf(__uint_as_float(b[0]), __uint_as_float(b[1]));
}
DEV float wave_sum(float v) {
#pragma unroll
  for (int o = 32; o > 0; o >>= 1) v += __shfl_xor(v, o);
  return v;
}
DEV float sigmoid_f(float x) { return __builtin_amdgcn_rcpf(1.f + __expf(-x)); }
DEV float silu_f(float x) { return x * __builtin_amdgcn_rcpf(1.f + __expf(-x)); }
DEV float gelu_f(float x) { float u = 0.7978845608028654f * (x + 0.044715f * x * x * x); return x * __builtin_amdgcn_rcpf(1.f + __expf(-2.f * u)); }

DEV void gemm_mainloop_d1(const u16* P, int ldp, const u16* Q, int ldq, int K, char* smem, f32x16 (&acc)[2][2], const int tid_) {
  const int t = TIDX, lane = t & 63, w = t >> 6, wm = w >> 1, wn = w & 1;
  const int lr = t >> 3, ch = t & 7;
  const u16* pg = P + (size_t)lr * ldp + ch * 8;
  const u16* qg = Q + (size_t)lr * ldq + ch * 8;
  const size_t sp = (size_t)32 * ldp, sq = (size_t)32 * ldq;
  const int soff = lr * 128 + ((ch ^ ((t >> 4) & 7)) << 4);
  const int sw = (lane >> 1) & 7;
  const int prow = (wm * 64 + (lane & 31)) * 128;
  const int qrow = (wn * 64 + (lane & 31)) * 128;
  uint4 p0, p1, p2, p3, q0, q1, q2, q3;
#define GLOAD(k0) do { p0 = *(const uint4*)(pg + (k0)); p1 = *(const uint4*)(pg + sp + (k0)); p2 = *(const uint4*)(pg + 2 * sp + (k0)); p3 = *(const uint4*)(pg + 3 * sp + (k0)); \
                       q0 = *(const uint4*)(qg + (k0)); q1 = *(const uint4*)(qg + sq + (k0)); q2 = *(const uint4*)(qg + 2 * sq + (k0)); q3 = *(const uint4*)(qg + 3 * sq + (k0)); } while (0)
#define SWRITE(base) do { char* b_ = (base) + soff; *(uint4*)(b_) = p0; *(uint4*)(b_ + 4096) = p1; *(uint4*)(b_ + 8192) = p2; *(uint4*)(b_ + 12288) = p3; \
                          *(uint4*)(b_ + 16384) = q0; *(uint4*)(b_ + 20480) = q1; *(uint4*)(b_ + 24576) = q2; *(uint4*)(b_ + 28672) = q3; } while (0)
  GLOAD(0);
  SWRITE(smem);
  __syncthreads();
  const int nk = K >> 6;
  for (int kt = 0; kt < nk; kt++) {
    const int k0 = min(kt + 1, nk - 1) << 6;
    GLOAD(k0);
    asm volatile("" ::: "memory"); __builtin_amdgcn_sched_barrier(0);
    const char* bP = smem + (kt & 1) * 32768;
    const char* bQ = bP + 16384;
#pragma unroll
    for (int s = 0; s < 4; s++) {
      const int co = ((s * 2 + (lane >> 5)) ^ sw) << 4;
      const bf16x8 pf0 = *(const bf16x8*)(bP + prow + co), pf1 = *(const bf16x8*)(bP + prow + 4096 + co);
      const bf16x8 qf0 = *(const bf16x8*)(bQ + qrow + co), qf1 = *(const bf16x8*)(bQ + qrow + 4096 + co);
      acc[0][0] = __builtin_amdgcn_mfma_f32_32x32x16_bf16(qf0, pf0, acc[0][0], 0, 0, 0);
      acc[0][1] = __builtin_amdgcn_mfma_f32_32x32x16_bf16(qf1, pf0, acc[0][1], 0, 0, 0);
      acc[1][0] = __builtin_amdgcn_mfma_f32_32x32x16_bf16(qf0, pf1, acc[1][0], 0, 0, 0);
      acc[1][1] = __builtin_amdgcn_mfma_f32_32x32x16_bf16(qf1, pf1, acc[1][1], 0, 0, 0);
    }
    asm volatile("" ::: "memory"); __builtin_amdgcn_sched_barrier(0);
    SWRITE(smem + ((kt + 1) & 1) * 32768);
    __syncthreads();
  }
#undef GLOAD
#undef SWRITE
}

DEV void acc_zero(f32x16 (&acc)[2][2]) {
#pragma unroll
  for (int a = 0; a < 2; a++)
#pragma unroll
    for (int b = 0; b < 2; b++)
#pragma unroll
      for (int r = 0; r < 16; r++) acc[a][b][r] = 0.f;
}

template <class F>
DEV void epi_foreach(const f32x16 (&acc)[2][2], const int tid_, F f) {
  const int lane = TIDX & 63, w = TIDX >> 6, wm = w >> 1, wn = w & 1;
#pragma unroll
  for (int a = 0; a < 2; a++)
#pragma unroll
    for (int b = 0; b < 2; b++)
#pragma unroll
      for (int rg = 0; rg < 4; rg++) {
        const int i = wm * 64 + a * 32 + (lane & 31);
        const int j = wn * 64 + b * 32 + rg * 8 + (lane >> 5) * 4;
        f(i, j, acc[a][b][rg * 4 + 0], acc[a][b][rg * 4 + 1], acc[a][b][rg * 4 + 2], acc[a][b][rg * 4 + 3]);
      }
}

DEV void tile_map(int li, int MPX, int xcd, int& m, int& n) {
  const int g = MPX * 8;
  const int ng = li / g, wv = li % g;
  m = xcd * MPX + (wv % MPX);
  n = ng * 8 + (wv / MPX);
}

DEV void tconv_tile(const float* __restrict__ src, int ldsrc, int k0, int n0, u16* __restrict__ dst, int lddst, int drow0, float* tile, const int tid_, const int blkK = 0) {
  const int t = TIDX;
  {
    const int n = t & 31, kk = t >> 5;
    float v[16];
#pragma unroll
    for (int p = 0; p < 16; p++) v[p] = src[(size_t)(k0 + kk + p * 8) * ldsrc + n0 + n];
#pragma unroll
    for (int p = 0; p < 16; p++) tile[(kk + p * 8) * 33 + n] = v[p];
  }
  __syncthreads();
  {
    const int k2 = (t & 63) * 2, nn = t >> 6;
#pragma unroll
    for (int p = 0; p < 8; p++) {
      const int n2 = nn + p * 4;
      u16* dp = blkK ? (dst + blk_off(drow0 + n2, k0 + k2, blkK)) : (dst + (size_t)(drow0 + n2) * lddst + k0 + k2);
      *(unsigned*)dp = pack2(tile[k2 * 33 + n2], tile[(k2 + 1) * 33 + n2]);
    }
  }
  __syncthreads();
}

DEV void phase_prep(const Params& p, char* smem, const int tid_, const int vb_, const int vg_) {
  const int t = TIDX;
  constexpr int N_MOD = 192;
  constexpr int T_IN = 1960, T_UQ = 72, T_UKV = 64, T_BR = 384, T_OUT = 256, T_CV = 256;
  constexpr int T_L = T_IN + T_UQ + T_UKV + T_BR + T_OUT + T_CV;
  constexpr int N_TC = 2 * T_L;
  constexpr int N_SG = 64, N_KC = 1024;
  constexpr int TOTAL = N_MOD + N_TC + N_SG + N_KC;
  float* MOD = (float*)(p.ws + O_MOD);
  for (int item = vb_; item < TOTAL; item += vg_) {
    if (item < N_MOD) {
      const int l = item / 96, e0 = (item % 96) * 32;
      float* sc = (float*)smem;
      {
        float cv[36];
#pragma unroll
        for (int i = 0; i < 36; i++) { const int idx = t + i * 256; const int c9 = idx >> 10, d = idx & 1023; cv[i] = (c9 == 0) ? p.c_ctx[d] : p.c[(c9 - 1) * 1024 + d]; }
#pragma unroll
        for (int i = 0; i < 36; i++) sc[t + i * 256] = silu_f(cv[i]);
      }
      __syncthreads();
      const int col = t & 31, slab = t >> 5;
      float a[9];
#pragma unroll
      for (int c9 = 0; c9 < 9; c9++) a[c9] = 0.f;
      const float* wp = p.w_mod + ((size_t)l * 1024 + slab * 128) * 3072 + e0 + col;
#pragma unroll 1
      for (int d0 = 0; d0 < 128; d0 += 16) {
        float wv[16];
#pragma unroll
        for (int j = 0; j < 16; j++) wv[j] = wp[(size_t)(d0 + j) * 3072];
#pragma unroll
        for (int j = 0; j < 16; j++) {
          const int d = slab * 128 + d0 + j;
#pragma unroll
          for (int c9 = 0; c9 < 9; c9++) a[c9] += sc[c9 * 1024 + d] * wv[j];
        }
      }
      float* red = sc + 9216;
#pragma unroll
      for (int c9 = 0; c9 < 9; c9++) red[(slab * 9 + c9) * 32 + col] = a[c9];
      __syncthreads();
      for (int idx = t; idx < 288; idx += 256) {
        const int c9 = idx >> 5, cc = idx & 31;
        float sum = 0.f;
#pragma unroll
        for (int sl = 0; sl < 8; sl++) sum += red[(sl * 9 + c9) * 32 + cc];
        MOD[(l * 9 + c9) * 3072 + e0 + cc] = sum + p.b_mod[l * 3072 + e0 + cc];
      }
      __syncthreads();
    } else if (item < N_MOD + N_TC) {
      const int ti = item - N_MOD;
      const int l = ti / T_L;
      int r = ti % T_L;
      const float* src; u16* dst; int ldsrc, lddst, k0, n0, drow, blkK = 0;
      if (r < T_IN) {
        const int nt = r >> 3, kt = r & 7;
        src = p.w_in + (size_t)l * 1024 * 7840; ldsrc = 7840; k0 = kt * 128; n0 = nt * 32;
        dst = (u16*)(p.ws + O_WIN) + (size_t)l * 7936 * 1024; lddst = 1024; blkK = 1024;
        drow = (n0 < 4224) ? n0 : (n0 == 4224 ? 7808 : n0 - 32);
      } else if ((r -= T_IN) < T_UQ) {
        const int nt = r / 3, kt = r % 3;
        src = p.w_uq + (size_t)l * 384 * 768; ldsrc = 768; k0 = kt * 128; n0 = nt * 32;
        dst = (u16*)(p.ws + O_WUQ) + (size_t)l * 768 * 384; lddst = 384; drow = n0; blkK = 384;
      } else if ((r -= T_UQ) < T_UKV) {
        const int nt = r >> 1, kt = r & 1;
        src = p.w_ukv + (size_t)l * 256 * 1024; ldsrc = 1024; k0 = kt * 128; n0 = nt * 32;
        dst = (u16*)(p.ws + O_WUKV) + (size_t)l * 1024 * 256; lddst = 256;
        const int hh = n0 >> 7, jj = n0 & 127;
        drow = (jj < 64) ? (hh * 64 + jj) : (512 + hh * 64 + jj - 64);
        blkK = 256;
      } else if ((r -= T_UKV) < T_BR) {
        const int kb = r >> 7, r2 = r & 127;
        const int nt = r2 >> 2, kt = r2 & 3;
        src = p.w_branch + (size_t)(l * 3 + kb) * 512 * 1024; ldsrc = 1024; k0 = kt * 128; n0 = nt * 32;
        dst = (u16*)(p.ws + O_WBR) + (size_t)(l * 3 + kb) * 1024 * 512; lddst = 512; drow = n0; blkK = 512;
      } else if ((r -= T_BR) < T_OUT) {
        const int nt = r >> 3, kt = r & 7;
        src = p.w_out + (size_t)l * 1024 * 1024; ldsrc = 1024; k0 = kt * 128; n0 = nt * 32;
        dst = (u16*)(p.ws + O_WOUT) + (size_t)l * 1024 * 1024; lddst = 1024; drow = n0; blkK = 1024;
      } else {
        r -= T_OUT;
        const int b = r >> 5, r2 = r & 31;
        const int nt = r2 >> 1, kt = r2 & 1;
        src = p.cache_na_v + (size_t)(b * 2 + l) * 256 * 512; ldsrc = 512; k0 = kt * 128; n0 = nt * 32;
        dst = (u16*)(p.ws + O_VTC) + (size_t)(l * 8 + b) * 512 * 256; lddst = 256; drow = n0;
      }
      tconv_tile(src, ldsrc, k0, n0, dst, lddst, drow, (float*)smem, tid_, blkK);
    } else if (item < N_MOD + N_TC + N_SG) {
      const int it = item - N_MOD - N_TC;
      const size_t e = (size_t)it * 2048 + t * 8;
      const float4 a = *(const float4*)(p.sgu_w + e), b = *(const float4*)(p.sgu_w + e + 4);
      u16* d = (u16*)(p.ws + O_SGUW) + e;
      st4bf(d, a.x, a.y, a.z, a.w); st4bf(d + 4, b.x, b.y, b.z, b.w);
    } else {
      const int it = item - N_MOD - N_TC - N_SG;
      const size_t e = (size_t)it * 2048 + t * 8;
      const int l = (int)(e >> 20), b = (int)(e >> 17) & 7; const size_t rest = e & 131071;
      const float* s = p.cache_na_k + ((size_t)(b * 2 + l) << 17) + rest;
      const float4 a = *(const float4*)s, bb = *(const float4*)(s + 4);
      u16* d = (u16*)(p.ws + O_KC) + e;
      st4bf(d, a.x, a.y, a.z, a.w); st4bf(d + 4, bb.x, bb.y, bb.z, bb.w);
    }
  }
}

DEV const float* xrow_in(const Params& p, int l, int s, int tl) {
  if (l == 0) return (s == 0 ? p.x_prompt : p.x_sample) + (size_t)tl * 1024;
  return p.out + OUT_Y + (size_t)s * 8388608 + (size_t)tl * 1024;
}
DEV int cond_idx(int s, int tl) { return s == 0 ? 0 : 1 + (tl >> 10); }

DEV void phase_h(const Params& p, int l, int s, const int tid_, const int vb_, const int vg_) {
  const int lane = TIDX & 63, wave = TIDX >> 6;
  u16* H = (u16*)(p.ws + O_H);
  const float* MOD = (const float*)(p.ws + O_MOD);
  for (int item = vb_; item < 512; item += vg_) {
    const int tl0 = item * 16 + wave * 4;
    const float* x = xrow_in(p, l, s, tl0);
    const float* mod = MOD + (size_t)(l * 9 + cond_idx(s, tl0)) * 3072;
    float4 v[4][4];
#pragma unroll
    for (int r = 0; r < 4; r++)
#pragma unroll
      for (int i = 0; i < 4; i++) v[r][i] = *(const float4*)(x + (size_t)r * 1024 + i * 256 + lane * 4);
    float4 g[4], sh[4], sc[4];
#pragma unroll
    for (int i = 0; i < 4; i++) {
      const int col = i * 256 + lane * 4;
      g[i] = *(const float4*)(p.norm_g + l * 1024 + col);
      sh[i] = *(const float4*)(mod + col);
      sc[i] = *(const float4*)(mod + 1024 + col);
    }
    asm volatile("" ::: "memory");
    float ss[4];
#pragma unroll
    for (int r = 0; r < 4; r++) {
      ss[r] = 0.f;
#pragma unroll
      for (int i = 0; i < 4; i++) ss[r] += v[r][i].x * v[r][i].x + v[r][i].y * v[r][i].y + v[r][i].z * v[r][i].z + v[r][i].w * v[r][i].w;
    }
#pragma unroll
    for (int o = 32; o > 0; o >>= 1) {
#pragma unroll
      for (int r = 0; r < 4; r++) ss[r] += __shfl_xor(ss[r], o);
    }
#pragma unroll
    for (int r = 0; r < 4; r++) {
      const float rstd = rsqrtf(ss[r] * (1.f / 1024.f) + 1e-6f);
#pragma unroll
      for (int i = 0; i < 4; i++) {
        const int col = i * 256 + lane * 4;
        st4bf(H + blk_off(tl0 + r, col, 1024), v[r][i].x * rstd * g[i].x * (1.f + sc[i].x) + sh[i].x, v[r][i].y * rstd * g[i].y * (1.f + sc[i].y) + sh[i].y,
              v[r][i].z * rstd * g[i].z * (1.f + sc[i].z) + sh[i].z, v[r][i].w * rstd * g[i].w * (1.f + sc[i].w) + sh[i].w);
      }
    }
  }
}

DEV void phase_rows(const Params& p, int l, int s, char* smem, const int tid_, const int vb_, const int vg_) {
  const int t = TIDX, lane = t & 63, wave = t >> 6;
  const u16* DQ = (const u16*)(p.ws + O_DQ); const u16* DKV = (const u16*)(p.ws + O_DKV); const float* KRF = (const float*)(p.ws + O_KRF);
  u16* CKV = (u16*)(p.ws + O_CKV); u16* KR = (u16*)(p.ws + O_KR); u16* GVT = (u16*)(p.ws + O_GVT);
  const int n_row = 512, n_ln = 256, n_cache = (s == 1) ? 512 : 0;
  const int total = n_row + n_ln + n_cache;
  for (int item = vb_; item < total; item += vg_) {
    if (item < n_row) {
      const int tl0 = item * 16 + wave * 4;
      unsigned dqw[4][3]; uint2 dkw[4]; float k1[4], k2[4];
#pragma unroll
      for (int r = 0; r < 4; r++) {
        const unsigned* rp = (const unsigned*)(DQ + (size_t)(tl0 + r) * 384) + lane * 3;
        dqw[r][0] = rp[0]; dqw[r][1] = rp[1]; dqw[r][2] = rp[2];
        dkw[r] = *(const uint2*)(DKV + (size_t)(tl0 + r) * 256 + lane * 4);
        k1[r] = KRF[(size_t)(tl0 + r) * 32 + (lane & 15)]; k2[r] = KRF[(size_t)(tl0 + r) * 32 + 16 + (lane & 15)];
      }
      const float2* gq = (const float2*)(p.q_norm + l * 384) + lane * 3;
      const float2 g0 = gq[0], g1 = gq[1], g2 = gq[2];
      const float4 gk = *(const float4*)(p.kv_norm + l * 256 + lane * 4);
      asm volatile("" ::: "memory");
      float qv[4][6], kv4[4][4], sq[4], sk[4];
#pragma unroll
      for (int r = 0; r < 4; r++) {
#pragma unroll
        for (int j = 0; j < 3; j++) { qv[r][2 * j] = __uint_as_float(dqw[r][j] << 16); qv[r][2 * j + 1] = __uint_as_float(dqw[r][j] & 0xffff0000u); }
        kv4[r][0] = __uint_as_float(dkw[r].x << 16); kv4[r][1] = __uint_as_float(dkw[r].x & 0xffff0000u);
        kv4[r][2] = __uint_as_float(dkw[r].y << 16); kv4[r][3] = __uint_as_float(dkw[r].y & 0xffff0000u);
        sq[r] = 0.f; sk[r] = 0.f;
#pragma unroll
        for (int j = 0; j < 6; j++) sq[r] += qv[r][j] * qv[r][j];
#pragma unroll
        for (int j = 0; j < 4; j++) sk[r] += kv4[r][j] * kv4[r][j];
      }
#pragma unroll
      for (int o = 32; o > 0; o >>= 1) {
#pragma unroll
        for (int r = 0; r < 4; r++) { sq[r] += __shfl_xor(sq[r], o); sk[r] += __shfl_xor(sk[r], o); }
      }
#pragma unroll
      for (int r = 0; r < 4; r++) {
        const int tl = tl0 + r;
        const float rq = rsqrtf(sq[r] * (1.f / 384.f) + 1e-6f);
        u16* dqn = (u16*)(p.ws + O_DQN);
        *(unsigned*)(dqn + blk_off(tl, lane * 6 + 0, 384)) = pack2(qv[r][0] * rq * g0.x, qv[r][1] * rq * g0.y);
        *(unsigned*)(dqn + blk_off(tl, lane * 6 + 2, 384)) = pack2(qv[r][2] * rq * g1.x, qv[r][3] * rq * g1.y);
        *(unsigned*)(dqn + blk_off(tl, lane * 6 + 4, 384)) = pack2(qv[r][4] * rq * g2.x, qv[r][5] * rq * g2.y);
        const float rk = rsqrtf(sk[r] * (1.f / 256.f) + 1e-6f);
        const float a = kv4[r][0] * rk * gk.x, b = kv4[r][1] * rk * gk.y, c = kv4[r][2] * rk * gk.z, d = kv4[r][3] * rk * gk.w;
        const int row = (s == 0) ? tl : ((tl >> 10) * 1280 + 256 + (tl & 1023));
        st4bf(CKV + blk_off(row, lane * 4, 256), a, b, c, d);
        if (s == 0) {
          const int bb = tl >> 8, sqi = tl & 255;
          *(float4*)(p.out + OUT_CKV + ((size_t)(bb * 2 + l) * 256 + sqi) * 256 + lane * 4) = make_float4(a, b, c, d);
        }
        if (lane < 16) {
          const float x1 = k1[r], x2 = k2[r];
          if (s == 0) {
            KR[(size_t)tl * 32 + lane] = f2bf(x1);
            KR[(size_t)tl * 32 + 16 + lane] = f2bf(x2);
          } else {
            const int nn = tl & 1023;
            const float pos = (lane < 8) ? (float)(nn >> 6) : (float)(nn & 63);
            const float inv = powf(10000.f, -(float)(lane & 7) * 0.125f);
            const float ang = pos * inv;
            const float cs = cosf(ang), sn = sinf(ang);
            const int row2 = (tl >> 10) * 1280 + 256 + nn;
            KR[(size_t)row2 * 32 + lane] = f2bf(x1 * cs - x2 * sn);
            KR[(size_t)row2 * 32 + 16 + lane] = f2bf(x1 * sn + x2 * cs);
          }
        }
      }
    } else if (item < n_row + n_ln) {
      const int it = item - n_row, chunk = it >> 2, slab = it & 3;
      u16* g = GVT + (size_t)chunk * 512 * 128 + slab * 32;
      const int q = t & 31, part = t >> 5;
      float v[64];
      float sum = 0.f, sq = 0.f;
#pragma unroll
      for (int c = 0; c < 64; c++) { v[c] = gelu_f(bf2f(g[(part * 64 + c) * 128 + q])); sum += v[c]; sq += v[c] * v[c]; }
      float* red = (float*)smem;
      red[(part * 2 + 0) * 32 + q] = sum; red[(part * 2 + 1) * 32 + q] = sq;
      __syncthreads();
      sum = 0.f; sq = 0.f;
#pragma unroll
      for (int pp = 0; pp < 8; pp++) { sum += red[(pp * 2 + 0) * 32 + q]; sq += red[(pp * 2 + 1) * 32 + q]; }
      const float mu = sum * (1.f / 512.f);
      const float var = fmaxf(sq * (1.f / 512.f) - mu * mu, 0.f);
      const float rstd = rsqrtf(var + 1e-6f);
#pragma unroll
      for (int c = 0; c < 64; c++) g[(part * 64 + c) * 128 + q] = f2bf((v[c] - mu) * rstd);
      __syncthreads();
    } else {
      const int rowi = (item - n_row - n_ln) * 4 + wave;
      const int b = rowi >> 8, m = rowi & 255;
      const float4 a = *(const float4*)(p.cache_ckv + ((size_t)(b * 2 + l) * 256 + m) * 256 + lane * 4);
      st4bf(CKV + blk_off(b * 1280 + m, lane * 4, 256), a.x, a.y, a.z, a.w);
      if (lane < 32) KR[(size_t)(b * 1280 + m) * 32 + lane] = f2bf(p.cache_kr[((size_t)(b * 2 + l) * 256 + m) * 32 + lane]);
    }
  }
}

typedef __attribute__((ext_vector_type(4))) float f32x4;
struct AttnSrc { const u16* k; const u16* kr; const u16* vt; int vts; };
struct AttnState { f32x4 o[4]; float mx, ls; };
constexpr int ATT_VST = 136;

struct AttnRegs { uint4 k0, k1, k2, v0, v1; };
template <int DQK>
DEV void attn_gload(const AttnSrc& src, AttnRegs& r, int t) {
  const int row = t >> 3, c8 = (t & 7) * 8;
  r.k0 = *(const uint4*)(src.k + (size_t)row * 512 + c8);
  r.k1 = *(const uint4*)(src.k + (size_t)(row + 32) * 512 + c8);
  r.v0 = *(const uint4*)(src.vt + (size_t)row * src.vts + c8);
  r.v1 = *(const uint4*)(src.vt + (size_t)(row + 32) * src.vts + c8);
  if (DQK == 96) r.k2 = *(const uint4*)(src.kr + (size_t)(t >> 2) * 32 + (t & 3) * 8);
}
template <int DQK>
DEV void attn_swrite(char* buf, const AttnRegs& r, int t) {
  constexpr int KST = DQK * 2 + 16;
  const int row = t >> 3, c16 = (t & 7) * 16;
  char* vb = buf + 64 * KST;
  *(uint4*)(buf + row * KST + c16) = make_uint4(r.k0.x, r.k0.y, r.k0.z, r.k0.w);
  *(uint4*)(buf + (row + 32) * KST + c16) = make_uint4(r.k1.x, r.k1.y, r.k1.z, r.k1.w);
  char* vp = vb + row * ATT_VST + c16;
  *(uint2*)vp = make_uint2(r.v0.x, r.v0.y);
  *(uint2*)(vp + 8) = make_uint2(r.v0.z, r.v0.w);
  vp += 32 * ATT_VST;
  *(uint2*)vp = make_uint2(r.v1.x, r.v1.y);
  *(uint2*)(vp + 8) = make_uint2(r.v1.z, r.v1.w);
  if (DQK == 96) *(uint4*)(buf + (t >> 2) * KST + 128 + (t & 3) * 16) = make_uint4(r.k2.x, r.k2.y, r.k2.z, r.k2.w);
}

template <int DQK, int NT, bool LOCAL>
DEV void attn_compute(const char* buf, const bf16x8 qf0, const bf16x8 qf1, const bf16x8 qf2, AttnState& st, float scale, int koff0, const float* biasrow, int qc, int wlo, const int tid_) {
  constexpr int KST = DQK * 2 + 16;
  const int lane = TIDX & 63, r16 = lane & 15, g = lane >> 4;
  const char* vb = buf + 64 * KST;
  f32x4 s[NT];
#pragma unroll
  for (int t = 0; t < NT; t++) {
    s[t] = f32x4{0.f, 0.f, 0.f, 0.f};
    const char* kp = buf + (koff0 + t * 16 + r16) * KST + g * 16;
    s[t] = __builtin_amdgcn_mfma_f32_16x16x32_bf16(*(const bf16x8*)(kp), qf0, s[t], 0, 0, 0);
    s[t] = __builtin_amdgcn_mfma_f32_16x16x32_bf16(*(const bf16x8*)(kp + 64), qf1, s[t], 0, 0, 0);
    if (DQK == 96) s[t] = __builtin_amdgcn_mfma_f32_16x16x32_bf16(*(const bf16x8*)(kp + 128), qf2, s[t], 0, 0, 0);
  }
  float mloc = st.mx;
#pragma unroll
  for (int t = 0; t < NT; t++)
#pragma unroll
    for (int e = 0; e < 4; e++) {
      float v = s[t][e] * scale;
      if (LOCAL) {
        const int kc = koff0 + t * 16 + 4 * g + e;
        const int bi = min(max(kc - qc + 15, 0), 30);
        const float bv = biasrow[bi] * 1.4426950408889634f;
        v = (kc >= wlo && kc < wlo + 16) ? v + bv : -1e30f;
      }
      s[t][e] = v;
      mloc = fmaxf(mloc, v);
    }
  mloc = rows_allmax(mloc);
  const float alpha = __builtin_amdgcn_exp2f(st.mx - mloc);
  st.mx = mloc;
  float psum = 0.f;
#pragma unroll
  for (int t = 0; t < NT; t++)
#pragma unroll
    for (int e = 0; e < 4; e++) {
      const float pv = __builtin_amdgcn_exp2f(s[t][e] - mloc);
      s[t][e] = pv;
      psum += pv;
    }
  st.ls = st.ls * alpha + psum;
#pragma unroll
  for (int dt = 0; dt < 4; dt++) st.o[dt] *= alpha;
#pragma unroll
  for (int kb = 0; kb < NT / 2; kb++) {
    bf16x8 pf;
#pragma unroll
    for (int e = 0; e < 4; e++) { pf[e] = (__bf16)s[2 * kb][e]; pf[4 + e] = (__bf16)s[2 * kb + 1][e]; }
#pragma unroll
    for (int dt = 0; dt < 4; dt++) {
      const char* vp = vb + (dt * 16 + r16) * ATT_VST + (koff0 + 4 * g) * 2 + kb * 64;
      const uint2 a0 = *(const uint2*)vp, a1 = *(const uint2*)(vp + 32);
      const uint4 av = make_uint4(a0.x, a0.y, a1.x, a1.y);
      st.o[dt] = __builtin_amdgcn_mfma_f32_16x16x32_bf16(__builtin_bit_cast(bf16x8, av), pf, st.o[dt], 0, 0, 0);
    }
  }
}

template <int MODE>
DEV void attn_item(const Params& p, int l, int it, char* smem, const int tid_) {
  constexpr int DQK = (MODE >= 2) ? 96 : 64;
  constexpr int KST = DQK * 2 + 16;
  constexpr int BUFSZ = 64 * KST + 64 * ATT_VST;
  const int t = TIDX, lane = t & 63, w = t >> 6, r16 = lane & 15, g = lane >> 4;
  constexpr int QB = (MODE >= 2) ? 2 : 1;
  int b, h, tl0, nst, r = 0;
  if (MODE == 0) { b = it >> 5; h = (it >> 2) & 7; tl0 = b * 256 + (it & 3) * 64; nst = 4; }
  else if (MODE == 1) { b = it >> 7; h = (it >> 4) & 7; r = it & 15; tl0 = b * 1024 + r * 64; nst = 12; }
  else if (MODE == 2) { b = it >> 4; h = (it >> 1) & 7; tl0 = b * 256 + (it & 1) * 128; nst = 4; }
  else { b = it >> 6; h = (it >> 3) & 7; tl0 = b * 1024 + (it & 7) * 128; nst = 20; }
  const int tl = tl0 + w * (16 * QB) + r16;
  const int wr0 = min(max(r - 4, 0), 8);
  const u16* KNA = (const u16*)(p.ws + O_KNA); const u16* VTNA = (const u16*)(p.ws + O_VTNA);
  const u16* KC = (const u16*)(p.ws + O_KC); const u16* VTC = (const u16*)(p.ws + O_VTC);
  const u16* KNOPE = (const u16*)(p.ws + O_KNOPE); const u16* KR = (const u16*)(p.ws + O_KR); const u16* VTM = (const u16*)(p.ws + O_VTM);
  auto get_src = [&](int st) {
    AttnSrc s;
    s.kr = nullptr;
    if (MODE == 0) {
      s.k = KNA + (size_t)(b * 256 + st * 64) * 512 + h * 64; s.vt = VTNA + (size_t)(b * 512 + h * 64) * 256 + st * 64; s.vts = 256;
    } else if (MODE == 1) {
      if (st < 8) {
        const int krow = wr0 + st;
        s.k = KNA + (size_t)(b * 1024 + krow * 64) * 512 + h * 64; s.vt = VTNA + (size_t)(b * 512 + h * 64) * 1024 + krow * 64; s.vts = 1024;
      } else {
        const int m0 = (st - 8) * 64;
        s.k = KC + ((size_t)(l * 8 + b) * 256 + m0) * 512 + h * 64; s.vt = VTC + ((size_t)(l * 8 + b) * 512 + h * 64) * 256 + m0; s.vts = 256;
      }
    } else if (MODE == 2) {
      s.k = KNOPE + (size_t)(b * 256 + st * 64) * 512 + h * 64; s.kr = KR + (size_t)(b * 256 + st * 64) * 32;
      s.vt = VTM + (size_t)(b * 512 + h * 64) * 256 + st * 64; s.vts = 256;
    } else {
      s.k = KNOPE + (size_t)(b * 1280 + st * 64) * 512 + h * 64; s.kr = KR + (size_t)(b * 1280 + st * 64) * 32;
      s.vt = VTM + (size_t)(b * 512 + h * 64) * 1280 + st * 64; s.vts = 1280;
    }
    return s;
  };
  AttnRegs rg;
  rg.k2 = make_uint4(0, 0, 0, 0);
  {
    const AttnSrc s0 = get_src(0);
    attn_gload<DQK>(s0, rg, t);
  }
  asm volatile("" ::: "memory");
  auto load_q = [&](int tl, bf16x8& qf0, bf16x8& qf1, bf16x8& qf2) {
  if (MODE < 2) {
    const u16* qp = (const u16*)(p.ws + O_QNA) + (size_t)tl * 512 + h * 64 + 8 * g;
    qf0 = *(const bf16x8*)qp; qf1 = *(const bf16x8*)(qp + 32); qf2 = qf0;
  } else {
    const u16* qp = (const u16*)(p.ws + O_QM) + (size_t)tl * 768 + h * 96;
    qf0 = *(const bf16x8*)(qp + 8 * g); qf1 = *(const bf16x8*)(qp + 32 + 8 * g);
    if (MODE == 2) {
      qf2 = *(const bf16x8*)(qp + 64 + 8 * g);
    } else {
      const uint4 own = *(const uint4*)(qp + 64 + 8 * g), oth = *(const uint4*)(qp + 64 + 8 * (g ^ 2));
      const unsigned ow[4] = {own.x, own.y, own.z, own.w}, ot[4] = {oth.x, oth.y, oth.z, oth.w};
      const int nn = tl & 1023;
      const float pos = (g & 1) ? (float)(nn & 63) : (float)(nn >> 6);
      bf16x8 qr;
#pragma unroll
      for (int e = 0; e < 8; e++) {
        const float a = __uint_as_float((e & 1) ? (ow[e >> 1] & 0xffff0000u) : (ow[e >> 1] << 16));
        const float c = __uint_as_float((e & 1) ? (ot[e >> 1] & 0xffff0000u) : (ot[e >> 1] << 16));
        const float inv = powf(10000.f, -(float)e * 0.125f);
        const float ang = pos * inv;
        const float cs = cosf(ang), sn = sinf(ang);
        const float v = (g < 2) ? (a * cs - c * sn) : (c * sn + a * cs);
        qr[e] = (__bf16)v;
      }
      qf2 = qr;
    }
  }
  };
  bf16x8 qf0, qf1, qf2, qg0, qg1, qg2;
  load_q(tl, qf0, qf1, qf2);
  if (QB == 2) load_q(tl + 16, qg0, qg1, qg2); else { qg0 = qf0; qg1 = qf1; qg2 = qf2; }
  float* biasl = (float*)(smem + 2 * BUFSZ);
  if (MODE == 1) {
    for (int i = t; i < 465; i += 256) biasl[i] = p.na_rpb[(size_t)(l * 8 + h) * 465 + i];
  }
  AttnState st, st2;
#pragma unroll
  for (int dt = 0; dt < 4; dt++) { st.o[dt] = f32x4{0.f, 0.f, 0.f, 0.f}; st2.o[dt] = f32x4{0.f, 0.f, 0.f, 0.f}; }
  st.mx = -1e30f; st.ls = 0.f; st2.mx = -1e30f; st2.ls = 0.f;
  const float scale = ((MODE >= 2) ? 0.10206207261596575f : 0.125f) * 1.4426950408889634f;
  const int qc = w * 16 + r16;
  const int wlo = min(max(qc - 8, 0), 48);
  const int wstart = min(max(16 * w - 8, 0), 32);
  asm volatile("" ::: "memory"); __builtin_amdgcn_sched_barrier(0);
  attn_swrite<DQK>(smem, rg, t);
  __syncthreads();
  for (int sidx = 0; sidx < nst; sidx++) {
    { const AttnSrc sn = get_src(min(sidx + 1, nst - 1)); attn_gload<DQK>(sn, rg, t); }
    asm volatile("" ::: "memory"); __builtin_amdgcn_sched_barrier(0);
    const char* buf = smem + (sidx & 1) * BUFSZ;
    if (MODE == 1 && sidx < 8) attn_compute<DQK, 2, true>(buf, qf0, qf1, qf2, st, scale, wstart, biasl + (wr0 + sidx - r + 7) * 31, qc, wlo, tid_);
    else {
      attn_compute<DQK, 4, false>(buf, qf0, qf1, qf2, st, scale, 0, nullptr, 0, 0, tid_);
      if (QB == 2) attn_compute<DQK, 4, false>(buf, qg0, qg1, qg2, st2, scale, 0, nullptr, 0, 0, tid_);
    }
    asm volatile("" ::: "memory"); __builtin_amdgcn_sched_barrier(0);
    attn_swrite<DQK>(smem + ((sidx + 1) & 1) * BUFSZ, rg, t);
    __syncthreads();
  }
  auto finish = [&](const AttnState& st, int tl) {
    float lt = st.ls;
    lt += __shfl_xor(lt, 16);
    lt += __shfl_xor(lt, 32);
    const float inv = 1.f / lt;
    u16* Z = (u16*)(p.ws + (MODE < 2 ? O_ZA : O_ZC)) + (size_t)(MODE & 1) * 8192 * 512 + blk_off(tl, h * 64 + 4 * g, 512);
#pragma unroll
    for (int dt = 0; dt < 4; dt++) {
      float a, bb, c, d;
      ld4bf(Z + dt * 16, a, bb, c, d);
      a = silu_f(a); bb = silu_f(bb); c = silu_f(c); d = silu_f(d);
      st4bf(Z + dt * 16, st.o[dt][0] * inv * a, st.o[dt][1] * inv * bb, st.o[dt][2] * inv * c, st.o[dt][3] * inv * d);
    }
  };
  finish(st, tl);
  if (QB == 2) finish(st2, tl + 16);
}

DEV void phase_mix(const Params& p, int l, int s, char* smem, const int tid_, const int vb_, const int vg_, const int vid_) {
  for (int item = vb_; item < 1024; item += vg_) {
    if (s == 0) attn_item<0>(p, l, item, smem, tid_); else attn_item<1>(p, l, item, smem, tid_);
  }
  {
    const int vblk = vid_ >> 1, team = vid_ & 1, bq = vblk & 31;
    if (bq >= 16) {
      const int it = (vblk >> 5) * 32 + (bq - 16) * 2 + team, chunk = it >> 2, g = it & 3;
      const u16* Wg = (const u16*)(p.ws + O_SGUW) + (size_t)(l * 4 + g) * 128 * 128;
      const u16* V = (const u16*)(p.ws + O_GVT) + ((size_t)chunk * 512 + g * 128) * 128;
      const u16* GU = (const u16*)(p.ws + O_GU); u16* ZB = (u16*)(p.ws + O_ZB) + (size_t)s * 8192 * 512;
      f32x16 acc[2][2];
      acc_zero(acc);
      gemm_mainloop_d1(Wg, 128, V, 128, 128, smem, acc, tid_);
      epi_foreach(acc, tid_, [&](int i, int j, float v0, float v1, float v2, float v3) {
        const float bs = p.sgu_b[(l * 4 + g) * 128 + i];
        const size_t off = (size_t)(chunk * 128 + i) * 512 + g * 128 + j;
        float u0, u1, u2, u3, z0, z1, z2, z3;
        ld4bf(GU + off, u0, u1, u2, u3);
        const size_t zoff = blk_off(chunk * 128 + i, g * 128 + j, 512);
        ld4bf(ZB + zoff, z0, z1, z2, z3);
        u0 = gelu_f(u0); u1 = gelu_f(u1); u2 = gelu_f(u2); u3 = gelu_f(u3);
        z0 = silu_f(z0); z1 = silu_f(z1); z2 = silu_f(z2); z3 = silu_f(z3);
        st4bf(ZB + zoff, u0 * (v0 + bs) * z0, u1 * (v1 + bs) * z1, u2 * (v2 + bs) * z2, u3 * (v3 + bs) * z3);
      });
    }
  }
}

DEV void phase_mla(const Params& p, int l, int s, char* smem, const int tid_, const int vb_, const int vg_) {
  for (int item = vb_; item < 512; item += vg_) {
    if (s == 0) attn_item<2>(p, l, item, smem, tid_); else attn_item<3>(p, l, item, smem, tid_);
  }
}

DEV void phase_final(const Params& p, const int tid_, const int vb_, const int vg_) {
  const int lane = TIDX & 63, wave = TIDX >> 6;
  for (int item = vb_; item < 1024; item += vg_) {
    float* x = p.out + OUT_Y + (size_t)(item * 16 + wave * 4) * 1024;
    float4 v[4][4];
#pragma unroll
    for (int r = 0; r < 4; r++)
#pragma unroll
      for (int i = 0; i < 4; i++) v[r][i] = *(const float4*)(x + (size_t)r * 1024 + i * 256 + lane * 4);
    float4 g[4];
#pragma unroll
    for (int i = 0; i < 4; i++) g[i] = *(const float4*)(p.final_g + i * 256 + lane * 4);
    asm volatile("" ::: "memory");
    float ss[4];
#pragma unroll
    for (int r = 0; r < 4; r++) {
      ss[r] = 0.f;
#pragma unroll
      for (int i = 0; i < 4; i++) ss[r] += v[r][i].x * v[r][i].x + v[r][i].y * v[r][i].y + v[r][i].z * v[r][i].z + v[r][i].w * v[r][i].w;
    }
#pragma unroll
    for (int o = 32; o > 0; o >>= 1) {
#pragma unroll
      for (int r = 0; r < 4; r++) ss[r] += __shfl_xor(ss[r], o);
    }
#pragma unroll
    for (int r = 0; r < 4; r++) {
      const float rstd = rsqrtf(ss[r] * (1.f / 1024.f) + 1e-6f);
#pragma unroll
      for (int i = 0; i < 4; i++)
        *(float4*)(x + (size_t)r * 1024 + i * 256 + lane * 4) =
            make_float4(v[r][i].x * rstd * g[i].x, v[r][i].y * rstd * g[i].y, v[r][i].z * rstd * g[i].z, v[r][i].w * rstd * g[i].w);
    }
  }
}

namespace pg8 {
#define PG8_LAS __attribute__((address_space(3)))
typedef unsigned short bf16_t;
typedef short bf16x8 __attribute__((ext_vector_type(8)));
typedef float f32x4 __attribute__((ext_vector_type(4)));
typedef unsigned u32x4 __attribute__((ext_vector_type(4)));
constexpr int BM = 256, BK = 64, HALF = 128, HTB = HALF * BK * 2  , STAGE_BYTES = 8 * HTB, NXCD = 8, WGM = 8;

__host__ __device__ __forceinline__ int lds_byte(int r, int c) { const int st = (r >> 4) * 2 + (c >> 5), rr = r & 15, cc = c & 31, ob = rr * 64 + cc * 2; return st * 1024 + (ob ^ (((ob >> 9) & 1) << 5)); }
__host__ __device__ __forceinline__ void stage_rc(int b, int& R, int& C) { const int st = b / 1024, sb = b % 1024, swz = sb ^ (((sb >> 9) & 1) << 5); R = (st >> 1) * 16 + swz / 64; C = (st & 1) * 32 + (swz % 64) / 2; }
__host__ __device__ __forceinline__ int perm32(int rho) { const int n = rho >> 4, i = rho & 15; return 8 * (i >> 2) + 4 * n + (i & 3); }

struct Unit { int pm, pn; };
struct Gemm { const bf16_t* A; const bf16_t* Bt; int M, N, K; };

template <class Epi, class Sched, bool STAMP = false>
__device__ __forceinline__ void gemm_phase(PG8_LAS unsigned char* lds, const Gemm g, const Sched& S, const Epi& E, unsigned long long* stamps) {
    const int tid = tid_opaque(), wid = __builtin_amdgcn_readfirstlane(tid >> 6), lane = tid & 63, wr = wid >> 2, wc = wid & 3, fr = lane & 15, fq = lane >> 4;
    const int K = g.K, nt = K / BK;
    int ts_lo = 0, ts_hi = 0, nts = 0; const unsigned long long rt_entry = STAMP ? (unsigned long long)wall_clock64() : 0ull;
#define PG8_STAMP() do { if (STAMP && wid == 0 && nts < 64) { const unsigned long long _c = (unsigned long long)clock64(); \
        ts_lo = (lane == nts) ? (int)(unsigned)_c : ts_lo; ts_hi = (lane == nts) ? (int)(unsigned)(_c >> 32) : ts_hi; ++nts; } } while (0)
    PG8_STAMP();
    unsigned voffA[2], voffB[2];
#pragma unroll
    for (int i = 0; i < 2; ++i) { int R, C; stage_rc(tid * 16 + i * 8192, R, C); const int Rb = Epi::PERM ? ((R & ~31) + perm32(R & 31)) : R;
        voffA[i] = (unsigned)(R * BK + C) * 2u; voffB[i] = (unsigned)(Rb * BK + C) * 2u; }
    const size_t kstep = (size_t)(BM * BK * 2);
    const size_t hstep = (size_t)HALF * BK * 2;
    const size_t tstep = (size_t)BM * K * 2;
    const unsigned ldsw = (unsigned)wid * 1024u;
    const int aoff = lds_byte(wr * 64 + fr, fq * 8), boff = lds_byte(wc * 32 + fr, fq * 8);
#define PG8_SA(b, h) (((b) * 2 + (h)) * HTB)
#define PG8_SB(b, h) ((4 + (b) * 2 + (h)) * HTB)
#define PG8_STAGE(bufoff, gbase, voff) do { _Pragma("unroll") for (int _i = 0; _i < 2; ++_i) \
        __builtin_amdgcn_global_load_lds((const unsigned*)((const char*)(gbase) + (voff)[_i]), (PG8_LAS unsigned*)(lds + (bufoff) + ldsw + _i * 8192), 16, 0, 0); } while (0)
#define PG8_LDA(dst, b, h) do { _Pragma("unroll") for (int m = 0; m < 4; ++m) _Pragma("unroll") for (int k = 0; k < 2; ++k) dst[m][k] = *(const PG8_LAS bf16x8*)(lds + PG8_SA(b, h) + aoff + m * 2048 + k * 1024); } while (0)
#define PG8_LDB(dst, b, h) do { _Pragma("unroll") for (int n = 0; n < 2; ++n) _Pragma("unroll") for (int k = 0; k < 2; ++k) dst[n][k] = *(const PG8_LAS bf16x8*)(lds + PG8_SB(b, h) + boff + n * 2048 + k * 1024); } while (0)
#define PG8_MMA(ai, bj, At, Bt) do { __builtin_amdgcn_s_setprio(1); _Pragma("unroll") for (int m = 0; m < 4; ++m) _Pragma("unroll") for (int n = 0; n < 2; ++n) _Pragma("unroll") for (int k = 0; k < 2; ++k) \
        acc[ai][bj][m][n] = __builtin_amdgcn_mfma_f32_16x16x32_bf16(Bt[n][k], At[m][k], acc[ai][bj][m][n], 0, 0, 0); __builtin_amdgcn_s_setprio(0); } while (0)
#define PG8_WAIT_V(n) asm volatile("s_waitcnt vmcnt(" #n ")" ::: "memory")
#define PG8_WAIT_L(n) asm volatile("s_waitcnt lgkmcnt(" #n ")" ::: "memory")
#define PG8_BAR __builtin_amdgcn_s_barrier()
#define PG8_SCHED __builtin_amdgcn_sched_barrier(0)
    Unit cur, nxt; int ui = 0;
    if (!S.next(0, cur)) return;
    f32x4 acc[2][2][4][2];
#pragma unroll
    for (int a = 0; a < 2; ++a)
#pragma unroll
        for (int b = 0; b < 2; ++b)
#pragma unroll
            for (int m = 0; m < 4; ++m)
#pragma unroll
                for (int n = 0; n < 2; ++n) acc[a][b][m][n] = (f32x4){0.f, 0.f, 0.f, 0.f};
    bf16x8 At[4][2], B0[2][2], B1[2][2];
    const char* cA = (const char*)g.A + (size_t)cur.pm * tstep; const char* cB = (const char*)g.Bt + (size_t)cur.pn * tstep;
    S.a_ready(cur);
    PG8_STAGE(PG8_SB(0, 0), cB, voffB); PG8_STAGE(PG8_SA(0, 0), cA, voffA); PG8_STAGE(PG8_SB(0, 1), cB + hstep, voffB); PG8_STAGE(PG8_SA(0, 1), cA + hstep, voffA);
    if (wr == 1) PG8_BAR;
    PG8_WAIT_V(4); PG8_BAR;
    PG8_STAGE(PG8_SB(1, 0), cB + kstep, voffB); PG8_STAGE(PG8_SA(1, 0), cA + kstep, voffA); PG8_STAGE(PG8_SB(1, 1), cB + hstep + kstep, voffB);
    PG8_WAIT_V(6); PG8_BAR;
    PG8_STAMP();
    for (;;) {
        const bool has_next = S.next(ui + 1, nxt);
        const char* nA = has_next ? (const char*)g.A + (size_t)nxt.pm * tstep : cA; const char* nB = has_next ? (const char*)g.Bt + (size_t)nxt.pn * tstep : cB;
        for (int t = 0; t < nt; t += 2) {
            const bool last = (t == nt - 2);
            const char* a1 = cA + (size_t)(t + 1) * kstep;
            const char* a2 = last ? nA : cA + (size_t)(t + 2) * kstep; const char* b2 = last ? nB : cB + (size_t)(t + 2) * kstep;
            const char* a3 = a2 + kstep; const char* b3 = b2 + kstep;
            if (last && has_next) S.a_ready(nxt);
            PG8_LDB(B0, 0, 0); PG8_SCHED; PG8_LDA(At, 0, 0); PG8_STAGE(PG8_SA(1, 1), a1 + hstep, voffA);
            PG8_WAIT_L(8); PG8_BAR; PG8_WAIT_L(0); PG8_MMA(0, 0, At, B0); PG8_BAR; PG8_SCHED;
            PG8_LDB(B1, 0, 1); PG8_STAGE(PG8_SB(0, 0), b2, voffB);
            PG8_BAR; PG8_WAIT_L(0); PG8_MMA(0, 1, At, B1); PG8_BAR;
            PG8_LDA(At, 0, 1); PG8_STAGE(PG8_SA(0, 0), a2, voffA);
            PG8_BAR; PG8_WAIT_L(0); PG8_MMA(1, 0, At, B0); PG8_BAR; PG8_SCHED;
            PG8_STAGE(PG8_SB(0, 1), b2 + hstep, voffB);
            PG8_WAIT_V(6); PG8_BAR; PG8_MMA(1, 1, At, B1); PG8_BAR;
            PG8_LDB(B0, 1, 0); PG8_SCHED; PG8_LDA(At, 1, 0); PG8_STAGE(PG8_SA(0, 1), a2 + hstep, voffA);
            PG8_WAIT_L(8); PG8_BAR; PG8_WAIT_L(0); PG8_MMA(0, 0, At, B0); PG8_BAR; PG8_SCHED;
            PG8_LDB(B1, 1, 1); PG8_STAGE(PG8_SB(1, 0), b3, voffB);
            PG8_BAR; PG8_WAIT_L(0); PG8_MMA(0, 1, At, B1); PG8_BAR;
            PG8_LDA(At, 1, 1); PG8_STAGE(PG8_SA(1, 0), a3, voffA);
            PG8_BAR; PG8_WAIT_L(0); PG8_MMA(1, 0, At, B0); PG8_BAR; PG8_SCHED;
            PG8_STAGE(PG8_SB(1, 1), b3 + hstep, voffB);
            PG8_WAIT_V(6); PG8_BAR; PG8_MMA(1, 1, At, B1); PG8_BAR;
        }
        PG8_STAMP();
        if constexpr (!Epi::AFTER_DRAIN) { E(acc, cur, wr, wc, fr, fq); S.done(cur); }
        PG8_STAMP();
        if (!has_next) break;
        if constexpr (!Epi::KEEP_ACC) {
#pragma unroll
        for (int a = 0; a < 2; ++a)
#pragma unroll
            for (int b = 0; b < 2; ++b)
#pragma unroll
                for (int m = 0; m < 4; ++m)
#pragma unroll
                    for (int n = 0; n < 2; ++n) acc[a][b][m][n] = (f32x4){0.f, 0.f, 0.f, 0.f};
        }
        cur = nxt; cA = nA; cB = nB; ++ui;
    }
    PG8_WAIT_V(0);
    if (wr == 0) PG8_BAR;
    PG8_BAR;
    if constexpr (Epi::AFTER_DRAIN) { E.fused(acc, cur, wr, wc, fr, fq, lds, wid, lane); S.done(cur); }
    PG8_STAMP();
    if (STAMP && wid == 0) { stamps[lane] = lane < nts ? (((unsigned long long)(unsigned)ts_hi << 32) | (unsigned)ts_lo) : 0ull;
        if (lane == 62) stamps[62] = rt_entry; if (lane == 63) stamps[63] = (unsigned long long)wall_clock64(); }
#undef PG8_STAMP
#undef PG8_SA
#undef PG8_SB
#undef PG8_STAGE
#undef PG8_LDA
#undef PG8_LDB
#undef PG8_MMA
#undef PG8_WAIT_V
#undef PG8_WAIT_L
#undef PG8_BAR
#undef PG8_SCHED
}
}


struct InSched {
  int l, c;
  __device__ __forceinline__ bool next(int i, pg8::Unit& u) const {
    const int x = c >> 5, q = c & 31;
    const int e = i * 32 + q;
    if (e >= 124) return false;
    const int it = 4 * x + (e & 3), jt = e >> 2;
    const bool swapped = (jt == 4) || (jt == 5) || (jt == 10) || (jt == 11);
    if (swapped) { u.pm = l * 31 + jt; u.pn = 62 + it; } else { u.pm = 62 + it; u.pn = l * 31 + jt; }
    return true;
  }
  __device__ __forceinline__ void a_ready(const pg8::Unit&) const {}
  __device__ __forceinline__ void done(const pg8::Unit&) const {}
};

DEV void st8bf(u16* p, const pg8::f32x4& a, const pg8::f32x4& b) {
  uint4 w; w.x = pack2(a[0], a[1]); w.y = pack2(a[2], a[3]); w.z = pack2(b[0], b[1]); w.w = pack2(b[2], b[3]);
  *(uint4*)p = w;
}
template <class F> DEV pg8::f32x4 map4(const pg8::f32x4& v, F f) { pg8::f32x4 r; r[0] = f(v[0]); r[1] = f(v[1]); r[2] = f(v[2]); r[3] = f(v[3]); return r; }

struct InEpi {
  static constexpr bool PERM = true, AFTER_DRAIN = false, KEEP_ACC = false;
  char* ws; float* out; int l, s;
  __device__ __forceinline__ void operator()(const pg8::f32x4 (&acc)[2][2][4][2], const pg8::Unit& u, int wr, int wc, int fr, int fq) const {
    u16* QNA = (u16*)(ws + O_QNA); u16* KNA = (u16*)(ws + O_KNA); u16* VTNA = (u16*)(ws + O_VTNA);
    const size_t zs = (size_t)s * 8192 * 512;
    u16* ZA = (u16*)(ws + O_ZA) + zs; u16* ZB = (u16*)(ws + O_ZB) + zs; u16* ZC = (u16*)(ws + O_ZC) + zs;
    u16* GU = (u16*)(ws + O_GU); u16* GVT = (u16*)(ws + O_GVT);
    u16* DQ = (u16*)(ws + O_DQ); u16* DKV = (u16*)(ws + O_DKV); float* KRF = (float*)(ws + O_KRF);
    unsigned char* GATES = (unsigned char*)(ws + O_GATES) + (size_t)s * 8192 * 3072;
    if (u.pm >= 62) {
      const int t0 = (u.pm - 62) * 256 + wr * 64 + fr;
      const int cbase = (u.pn - l * 31) * 256;
#pragma unroll
      for (int bj = 0; bj < 2; ++bj) {
        const int seg0 = cbase + bj * 128;
        const int n = seg0 >> 7;
        const int c0 = seg0 + wc * 32 + 8 * fq;
#pragma unroll
        for (int ai = 0; ai < 2; ++ai)
#pragma unroll
          for (int m = 0; m < 4; ++m) {
            const int T = t0 + ai * 128 + m * 16;
            const pg8::f32x4 v0 = acc[ai][bj][m][0], v1 = acc[ai][bj][m][1];
            if (n < 4) {
              st8bf(QNA + (size_t)T * 512 + c0, v0, v1);
            } else if (n < 8) {
              const int col = c0 - 512;
              st8bf(KNA + (size_t)T * 512 + col, v0, v1);
              if (s == 0) {
                const int b = T >> 8, sq = T & 255;
                float* o = out + OUT_SK + ((size_t)(b * 2 + l) * 256 + sq) * 512 + col;
                *(float4*)o = make_float4(v0[0], v0[1], v0[2], v0[3]); *(float4*)(o + 4) = make_float4(v1[0], v1[1], v1[2], v1[3]);
              }
            } else if (n < 16) {
              st8bf(ZA + blk_off(T, c0 - 1536, 512), v0, v1);
            } else if (n < 20) {
              st8bf(GU + (size_t)T * 512 + c0 - 2048, v0, v1);
            } else if (n < 28) {
              st8bf(ZB + blk_off(T, c0 - 3072, 512), v0, v1);
            } else if (n < 31) {
              st8bf(DQ + (size_t)T * 384 + c0 - 3584, v0, v1);
            } else if (n < 33) {
              st8bf(DKV + (size_t)T * 256 + c0 - 3968, v0, v1);
            } else if (n < 37) {
              st8bf(ZC + blk_off(T, c0 - 4224, 512), v0, v1);
            } else if (n < 61) {
              unsigned q[8];
#pragma unroll
              for (int e = 0; e < 4; e++) { q[e] = (unsigned)(sigmoid_f(v0[e]) * 255.f + 0.5f); q[4 + e] = (unsigned)(sigmoid_f(v1[e]) * 255.f + 0.5f); }
              uint2 gw; gw.x = q[0] | (q[1] << 8) | (q[2] << 16) | (q[3] << 24); gw.y = q[4] | (q[5] << 8) | (q[6] << 16) | (q[7] << 24);
              *(uint2*)(GATES + (size_t)T * 3072 + c0 - 4736) = gw;
            } else if (c0 < 7808 + 32) {
              const int j = c0 - 7808;
              float* kp = KRF + (size_t)T * 32 + j;
              *(float4*)kp = make_float4(v0[0], v0[1], v0[2], v0[3]); *(float4*)(kp + 4) = make_float4(v1[0], v1[1], v1[2], v1[3]);
              if (s == 0) {
                const int b = T >> 8, sq = T & 255;
                float* o = out + OUT_SKR + ((size_t)(b * 2 + l) * 256 + sq) * 32 + j;
                *(float4*)o = make_float4(v0[0], v0[1], v0[2], v0[3]); *(float4*)(o + 4) = make_float4(v1[0], v1[1], v1[2], v1[3]);
              }
            }
          }
      }
    } else {
      const int jt = u.pm - l * 31;
      const int ch0 = jt * 256 + wr * 64 + fr;
      const int tk0 = (u.pn - 62) * 256 + wc * 32 + 8 * fq;
#pragma unroll
      for (int ai = 0; ai < 2; ++ai)
#pragma unroll
        for (int m = 0; m < 4; ++m) {
          const int ch = ch0 + ai * 128 + m * 16;
#pragma unroll
          for (int bj = 0; bj < 2; ++bj) {
            const int tok = tk0 + bj * 128;
            const pg8::f32x4 v0 = acc[ai][bj][m][0], v1 = acc[ai][bj][m][1];
            if (jt < 8) {
              const int dva = ch - 1024;
              if (s == 0) {
                const int b = tok >> 8, sq = tok & 255;
                st8bf(VTNA + ((size_t)(b * 512 + dva)) * 256 + sq, v0, v1);
                float* o = out + OUT_SV + ((size_t)(b * 2 + l) * 256 + sq) * 512 + dva;
                o[0] = v0[0]; o[512] = v0[1]; o[1024] = v0[2]; o[1536] = v0[3]; o[2048] = v1[0]; o[2560] = v1[1]; o[3072] = v1[2]; o[3584] = v1[3];
              } else {
                const int b = tok >> 10, nn = tok & 1023;
                st8bf(VTNA + ((size_t)(b * 512 + dva)) * 1024 + nn, v0, v1);
              }
            } else {
              const int c = ch - 2560;
              const int chunk = tok >> 7, q = tok & 127;
              st8bf(GVT + ((size_t)chunk * 512 + c) * 128 + q, v0, v1);
            }
          }
        }
    }
  }
};

DEV void phase_in8(const Params& p, int l, int s, char* smem_full, int vid) {
  pg8::Gemm g; g.A = (const pg8::bf16_t*)(p.ws + O_WIN); g.Bt = g.A; g.M = 0; g.N = 0; g.K = 1024;
  InSched S; S.l = l; S.c = vid;
  InEpi E; E.ws = p.ws; E.out = p.out; E.l = l; E.s = s;
  pg8::gemm_phase<InEpi, InSched, false>((PG8_LAS unsigned char*)smem_full, g, S, E, nullptr);
}


struct MergeSched {
  int l, c;
  __device__ __forceinline__ bool next(int i, pg8::Unit& u) const {
    const int x = c >> 5, q = c & 31;
    if (i >= 3) return false;
    const int it = 8 * x + (q & 7), jt = q >> 3;
    const size_t zo = (i == 0) ? O_ZA : (i == 1 ? O_ZB : O_ZC);
    u.pm = (int)(zo / 262144) + it;
    u.pn = (int)(O_WBR / 262144) + (l * 3 + i) * 4 + jt;
    return true;
  }
  __device__ __forceinline__ void a_ready(const pg8::Unit&) const {}
  __device__ __forceinline__ void done(const pg8::Unit&) const {}
};
struct MergeEpi {
  static constexpr bool PERM = true, AFTER_DRAIN = false, KEEP_ACC = true;
  char* ws; int l;
  __device__ __forceinline__ void operator()(pg8::f32x4 (&acc)[2][2][4][2], const pg8::Unit& u, int wr, int wc, int fr, int fq) const {
    const int wrel = u.pn - (int)(O_WBR / 262144) - l * 12;
    const int k = wrel >> 2, jt = wrel & 3;
    const size_t zo = (k == 0) ? O_ZA : (k == 1 ? O_ZB : O_ZC);
    const int it = u.pm - (int)(zo / 262144);
    const unsigned char* GATES = (const unsigned char*)(ws + O_GATES);
    u16* MG = (u16*)(ws + O_MG);
    const int t0 = it * 256 + wr * 64 + fr;
#pragma unroll
    for (int ai = 0; ai < 2; ++ai) {
      uint2 ga[4][2], gb[4][2];
#pragma unroll
      for (int m = 0; m < 4; ++m)
#pragma unroll
        for (int bj = 0; bj < 2; ++bj) {
          const int T = t0 + ai * 128 + m * 16;
          const int c0 = jt * 256 + bj * 128 + wc * 32 + 8 * fq;
          const unsigned char* gp = GATES + (size_t)T * 3072 + k * 1024 + c0;
          ga[m][bj] = *(const uint2*)gp;
          gb[m][bj] = (k < 2) ? *(const uint2*)(gp + 1024) : make_uint2(0u, 0u);
        }
      asm volatile("" ::: "memory");
#pragma unroll
      for (int m = 0; m < 4; ++m)
#pragma unroll
        for (int bj = 0; bj < 2; ++bj) {
          const int T = t0 + ai * 128 + m * 16;
          const int c0 = jt * 256 + bj * 128 + wc * 32 + 8 * fq;
          float f[8];
#pragma unroll
          for (int e = 0; e < 8; e++) {
            const float qa = fmaxf((float)((((e < 4) ? ga[m][bj].x : ga[m][bj].y) >> (8 * (e & 3))) & 0xffu), 1.f);
            if (k < 2) {
              const float qb = fmaxf((float)((((e < 4) ? gb[m][bj].x : gb[m][bj].y) >> (8 * (e & 3))) & 0xffu), 1.f);
              f[e] = qa * __builtin_amdgcn_rcpf(qb);
            } else {
              f[e] = qa * (1.f / 255.f);
            }
          }
#pragma unroll
          for (int e = 0; e < 4; e++) { acc[ai][bj][m][0][e] *= f[e]; acc[ai][bj][m][1][e] *= f[4 + e]; }
          if (k == 2) {
            uint4 o;
            o.x = pack2(acc[ai][bj][m][0][0], acc[ai][bj][m][0][1]); o.y = pack2(acc[ai][bj][m][0][2], acc[ai][bj][m][0][3]);
            o.z = pack2(acc[ai][bj][m][1][0], acc[ai][bj][m][1][1]); o.w = pack2(acc[ai][bj][m][1][2], acc[ai][bj][m][1][3]);
            *(uint4*)(MG + blk_off(T, c0, 1024)) = o;
          }
        }
    }
  }
};
DEV void phase_merge8(const Params& p, int l, char* smem_full, int vid) {
  pg8::Gemm g; g.A = (const pg8::bf16_t*)p.ws; g.Bt = g.A; g.M = 0; g.N = 0; g.K = 512;
  MergeSched S; S.l = l; S.c = vid;
  MergeEpi E; E.ws = p.ws; E.l = l;
  pg8::gemm_phase<MergeEpi, MergeSched, false>((PG8_LAS unsigned char*)smem_full, g, S, E, nullptr);
}

struct OutSched {
  int l, c;
  __device__ __forceinline__ bool next(int i, pg8::Unit& u) const {
    const int x = c >> 5, q = c & 31;
    if (i >= 1) return false;
    u.pm = (int)(O_MG / 524288) + 8 * x + (q & 7);
    u.pn = (int)(O_WOUT / 524288) + l * 4 + (q >> 3);
    return true;
  }
  __device__ __forceinline__ void a_ready(const pg8::Unit&) const {}
  __device__ __forceinline__ void done(const pg8::Unit&) const {}
};
struct OutEpi {
  static constexpr bool PERM = true, AFTER_DRAIN = false, KEEP_ACC = false;
  const float* x0; const float* x1; float* outy; const float* MOD; int l;
  __device__ __forceinline__ void operator()(const pg8::f32x4 (&acc)[2][2][4][2], const pg8::Unit& u, int wr, int wc, int fr, int fq) const {
    const int it = u.pm - (int)(O_MG / 524288), jt = u.pn - (int)(O_WOUT / 524288) - l * 4;
    const int s = it >> 5;
    const int t0 = it * 256 + wr * 64 + fr;
    const float* xin = (l == 0) ? ((s == 0) ? x0 : x1 - (size_t)8192 * 1024) : outy;
    typedef __attribute__((address_space(1))) pg8::f32x4 GF4;
    const GF4* xg = (const GF4*)(unsigned long long)xin;
    GF4* og = (GF4*)(unsigned long long)outy;
    const float* gr = MOD + (size_t)(l * 9 + cond_idx(s, t0 & 8191)) * 3072 + 2048;
    float4 gv[2][2];
#pragma unroll
    for (int bj = 0; bj < 2; ++bj)
#pragma unroll
      for (int h2 = 0; h2 < 2; ++h2) gv[bj][h2] = *(const float4*)(gr + jt * 256 + bj * 128 + wc * 32 + 8 * fq + 4 * h2);
#pragma unroll
    for (int ai = 0; ai < 2; ++ai)
#pragma unroll
      for (int mp = 0; mp < 2; ++mp) {
        pg8::f32x4 xv[2][2][2];
#pragma unroll
        for (int mm = 0; mm < 2; ++mm)
#pragma unroll
          for (int bj = 0; bj < 2; ++bj)
#pragma unroll
            for (int h2 = 0; h2 < 2; ++h2)
              xv[mm][bj][h2] = *(xg + (size_t)(t0 + ai * 128 + (mp * 2 + mm) * 16) * 256 + jt * 64 + bj * 32 + wc * 8 + 2 * fq + h2);
        asm volatile("" ::: "memory"); __builtin_amdgcn_sched_barrier(0);
#pragma unroll
        for (int mm = 0; mm < 2; ++mm)
#pragma unroll
          for (int bj = 0; bj < 2; ++bj)
#pragma unroll
            for (int h2 = 0; h2 < 2; ++h2) {
              const int m = mp * 2 + mm;
              const pg8::f32x4 x = xv[mm][bj][h2];
              const float4 g = gv[bj][h2];
              const pg8::f32x4 v = acc[ai][bj][m][h2];
              *(og + (size_t)(t0 + ai * 128 + m * 16) * 256 + jt * 64 + bj * 32 + wc * 8 + 2 * fq + h2) =
                  pg8::f32x4{x[0] + g.x * v[0], x[1] + g.y * v[1], x[2] + g.z * v[2], x[3] + g.w * v[3]};
            }
        asm volatile("" ::: "memory"); __builtin_amdgcn_sched_barrier(0);
      }
  }
};
DEV void phase_out8(const Params& p, int l, char* smem_full, int vid) {
  pg8::Gemm g; g.A = (const pg8::bf16_t*)p.ws; g.Bt = g.A; g.M = 0; g.N = 0; g.K = 1024;
  OutSched S; S.l = l; S.c = vid;
  OutEpi E; E.x0 = p.x_prompt; E.x1 = p.x_sample; E.outy = p.out + OUT_Y; E.MOD = (const float*)(p.ws + O_MOD); E.l = l;
  pg8::gemm_phase<OutEpi, OutSched, false>((PG8_LAS unsigned char*)smem_full, g, S, E, nullptr);
}


struct QSched {
  int l, c;
  __device__ __forceinline__ bool next(int i, pg8::Unit& u) const {
    const int x = c >> 5, q = c & 31;
    if (q >= 12 || i >= 1) return false;
    u.pm = (int)(O_DQN / 196608) + 4 * x + (q & 3);
    u.pn = (int)(O_WUQ / 196608) + l * 3 + (q >> 2);
    return true;
  }
  __device__ __forceinline__ void a_ready(const pg8::Unit&) const {}
  __device__ __forceinline__ void done(const pg8::Unit&) const {}
};
struct QEpi {
  static constexpr bool PERM = true, AFTER_DRAIN = false, KEEP_ACC = false;
  char* ws; int l;
  __device__ __forceinline__ void operator()(const pg8::f32x4 (&acc)[2][2][4][2], const pg8::Unit& u, int wr, int wc, int fr, int fq) const {
    const int it = u.pm - (int)(O_DQN / 196608), jt = u.pn - (int)(O_WUQ / 196608) - l * 3;
    u16* QM = (u16*)(ws + O_QM);
#pragma unroll
    for (int ai = 0; ai < 2; ++ai)
#pragma unroll
      for (int m = 0; m < 4; ++m) {
        const int T = it * 256 + ai * 128 + wr * 64 + m * 16 + fr;
#pragma unroll
        for (int bj = 0; bj < 2; ++bj)
          st8bf(QM + (size_t)T * 768 + jt * 256 + bj * 128 + wc * 32 + 8 * fq, acc[ai][bj][m][0], acc[ai][bj][m][1]);
      }
  }
};
struct KvSched {
  int l, c, nt;
  __device__ __forceinline__ bool next(int i, pg8::Unit& u) const {
    const int x = c >> 5, q = c & 31, per = nt >> 3;
    if (q >= 4 * per || i >= 1) return false;
    const int it = per * x + (q % per), jt = q / per;
    const int wt = (int)(O_WUKV / 131072) + l * 4 + jt, ct = (int)(O_CKV / 131072) + it;
    if (jt < 2) { u.pm = ct; u.pn = wt; } else { u.pm = wt; u.pn = ct; }
    return true;
  }
  __device__ __forceinline__ void a_ready(const pg8::Unit&) const {}
  __device__ __forceinline__ void done(const pg8::Unit&) const {}
};
struct KvEpi {
  static constexpr bool PERM = true, AFTER_DRAIN = false, KEEP_ACC = false;
  char* ws; int l, S;
  __device__ __forceinline__ void operator()(const pg8::f32x4 (&acc)[2][2][4][2], const pg8::Unit& u, int wr, int wc, int fr, int fq) const {
    const int c0t = (int)(O_CKV / 131072), w0t = (int)(O_WUKV / 131072) + l * 4;
    if (u.pm >= c0t) {
      const int it = u.pm - c0t, jt = u.pn - w0t;
      u16* KNOPE = (u16*)(ws + O_KNOPE);
#pragma unroll
      for (int ai = 0; ai < 2; ++ai)
#pragma unroll
        for (int m = 0; m < 4; ++m) {
          const int R = it * 256 + ai * 128 + wr * 64 + m * 16 + fr;
#pragma unroll
          for (int bj = 0; bj < 2; ++bj)
            st8bf(KNOPE + (size_t)R * 512 + jt * 256 + bj * 128 + wc * 32 + 8 * fq, acc[ai][bj][m][0], acc[ai][bj][m][1]);
        }
    } else {
      const int jt = u.pm - w0t - 2, it = u.pn - c0t;
      u16* VTM = (u16*)(ws + O_VTM);
#pragma unroll
      for (int ai = 0; ai < 2; ++ai)
#pragma unroll
        for (int m = 0; m < 4; ++m) {
          const int ch = jt * 256 + ai * 128 + wr * 64 + m * 16 + fr;
#pragma unroll
          for (int bj = 0; bj < 2; ++bj) {
            const int row = it * 256 + bj * 128 + wc * 32 + 8 * fq;
            const int b = row / S, mm = row % S;
            st8bf(VTM + ((size_t)b * 512 + ch) * S + mm, acc[ai][bj][m][0], acc[ai][bj][m][1]);
          }
        }
    }
  }
};
DEV void phase_qkv8(const Params& p, int l, int s, char* smem_full, int vid) {
  {
    pg8::Gemm g; g.A = (const pg8::bf16_t*)p.ws; g.Bt = g.A; g.M = 0; g.N = 0; g.K = 384;
    QSched S; S.l = l; S.c = vid;
    QEpi E; E.ws = p.ws; E.l = l;
    pg8::gemm_phase<QEpi, QSched, false>((PG8_LAS unsigned char*)smem_full, g, S, E, nullptr);
  }
  {
    pg8::Gemm g; g.A = (const pg8::bf16_t*)p.ws; g.Bt = g.A; g.M = 0; g.N = 0; g.K = 256;
    KvSched S; S.l = l; S.c = vid; S.nt = (s == 0) ? 32 : 40;
    KvEpi E; E.ws = p.ws; E.l = l; E.S = (s == 0) ? 256 : 1280;
    pg8::gemm_phase<KvEpi, KvSched, false>((PG8_LAS unsigned char*)smem_full, g, S, E, nullptr);
  }
}

#define XB_TMO      128
#define XB_XCNT(j)  (256  + 64 * (j))
#define XB_XSUB(j)  (1280 + 64 * (j))
#define XB_XGEN(j)  (2304 + 64 * (j))
#define XB_TOP      3328
#define XB_TOPGEN   3392
#define XCD_BAR_WORDS 3456
#define XB_SPIN_CAP (1u << 18)
#define LAS __attribute__((address_space(3)))

__device__ __forceinline__ unsigned xb_ld(unsigned* p)              { return __hip_atomic_load(p, __ATOMIC_RELAXED, __HIP_MEMORY_SCOPE_AGENT); }
__device__ __forceinline__ unsigned xb_add(unsigned* p, unsigned v) { return __hip_atomic_fetch_add(p, v, __ATOMIC_RELAXED, __HIP_MEMORY_SCOPE_AGENT); }
__device__ __forceinline__ unsigned xb_xcc_id() { return (unsigned)__builtin_amdgcn_s_getreg((3 << 11) | 20) & 0xFu; }
#define XB_SPIN(cond, bar) do { unsigned _sp = 0; while (cond) { __builtin_amdgcn_s_sleep(1); \
    if ((++_sp & 255u) == 0u) { if (xb_ld(&(bar)[XB_TMO])) break; if (_sp > XB_SPIN_CAP) { atomicAdd(&(bar)[XB_TMO], 1u); break; } } } } while (0)

struct XcdBarrier {
    unsigned* bar; unsigned x;
    volatile LAS unsigned* st;
};

__device__ __forceinline__ XcdBarrier xcd_barrier_post(unsigned* bar, volatile LAS unsigned* st) {
    XcdBarrier b; b.bar = bar; b.x = xb_xcc_id(); b.st = st;
    if ((int)threadIdx.x == 0) st[2] = xb_add(&bar[XB_XCNT(b.x)], 1u);
    return b;
}
__device__ __forceinline__ void xcd_barrier_complete(unsigned* bar, unsigned x, unsigned& nloc, unsigned& nx) {
    const unsigned G = gridDim.x * gridDim.y * gridDim.z;
    unsigned sum, cnt, mine, sp = 0u;
    for (;;) {
        sum = 0u; cnt = 0u; mine = 0u;
#pragma unroll
        for (unsigned j = 0; j < 16; ++j) { const unsigned c = xb_ld(&bar[XB_XCNT(j)]); sum += c; cnt += (c > 0u) ? 1u : 0u; mine = (j == x) ? c : mine; }
        if (sum == G) break;
        __builtin_amdgcn_s_sleep(1);
        if ((++sp & 255u) == 0u) { if (xb_ld(&bar[XB_TMO])) break; if (sp > XB_SPIN_CAP) { atomicAdd(&bar[XB_TMO], 1u); break; } }
    }
    nloc = mine > 0u ? mine : 1u; nx = cnt > 0u ? cnt : 1u;
}

__device__ __forceinline__ void xcd_barrier(const XcdBarrier& b) {
    asm volatile("s_waitcnt vmcnt(0)" ::: "memory");
    __syncthreads();
    if ((int)threadIdx.x == 0) {
        unsigned* bar = b.bar;
        __builtin_amdgcn_s_waitcnt(0);
        unsigned nloc = b.st[0], nx = b.st[1];
        if (nloc == 0u) { xcd_barrier_complete(bar, b.x, nloc, nx); b.st[0] = nloc; b.st[1] = nx; }
        const unsigned old = xb_add(&bar[XB_XSUB(b.x)], 1u);
        const unsigned gen = old / nloc;
        if (old + 1u == (gen + 1u) * nloc) {
            __builtin_amdgcn_fence(__ATOMIC_RELEASE, "agent");
            asm volatile("s_waitcnt vmcnt(0)" ::: "memory");
            const unsigned og = xb_add(&bar[XB_TOP], 1u);
            const unsigned tg = og / nx;
            if (og + 1u == (tg + 1u) * nx) xb_add(&bar[XB_TOPGEN], 1u);
            else XB_SPIN(xb_ld(&bar[XB_TOPGEN]) == tg, bar);
            __builtin_amdgcn_fence(__ATOMIC_ACQUIRE, "agent");
            xb_add(&bar[XB_XGEN(b.x)], 1u);
            asm volatile("s_waitcnt vmcnt(0)" ::: "memory");
        } else {
            XB_SPIN(xb_ld(&bar[XB_XGEN(b.x)]) == gen, bar);
            __builtin_amdgcn_fence(__ATOMIC_ACQUIRE, "agent");
            asm volatile("s_waitcnt vmcnt(0)" ::: "memory");
        }
    }
    __syncthreads();
}


DEV void run_phase(const Params& p, int ph, int l, int s, char* smem, const int vid_, const int tid_, const int vb_, const int vg_) {
  switch (ph) {
    case 0: phase_prep(p, smem, tid_, vb_, vg_); break;
    case 1: phase_h(p, l, s, tid_, vb_, vg_); break;
    case 3: phase_rows(p, l, s, smem, tid_, vb_, vg_); break;
    case 4: phase_mix(p, l, s, smem, tid_, vb_, vg_, vid_); break;
    case 5: phase_mla(p, l, s, smem, tid_, vb_, vg_); break;
    default: phase_final(p, tid_, vb_, vg_); break;
  }
}

__global__ void __launch_bounds__(512, 2) mega_kernel(Params p) {
  extern __shared__ __attribute__((aligned(16))) unsigned char dyn_lds[];
  char* smem = (char*)dyn_lds;
  uint4& xb_words = *(uint4*)(dyn_lds + 131072);
  if (threadIdx.x == 0) xb_words = make_uint4(0u, 0u, 0u, 0u);
  __syncthreads();
  XcdBarrier xb = xcd_barrier_post((unsigned*)(p.ws + O_BAR), (volatile LAS unsigned*)(dyn_lds + 131072));
  if (p.ws == nullptr) cg::this_grid().sync();
  int vid = blockIdx.x;
#pragma unroll 1
  for (int step = 0; step < 24; step++) {
    int ph, l = 0, s = 0;
    bool also_h1 = false;
    if (step == 0) ph = 0;
    else if (step == 23) ph = 8;
    else {
      const int idx = step - 1; l = idx / 11; const int r = idx % 11;
      if (r < 5) { s = 0; ph = 1 + r; also_h1 = (r == 4); }
      else if (r < 9) { s = 1; ph = 2 + (r - 5); }
      else ph = 6 + (r - 9);
    }
    {
      const int tfull = tid_opaque();
      const int team = tfull >> 8;
      Params q = p;
      size_t zoff = 0;
      asm volatile("" : "+s"(zoff));
      q.ws = p.ws + zoff;
      q.out = p.out + zoff;
      if (ph == 4) { phase_qkv8(q, l, s, smem, vid); __syncthreads(); }
      if (ph == 2) phase_in8(q, l, s, smem, vid);
      else if (ph == 6) phase_merge8(q, l, smem, vid);
      else if (ph == 7) phase_out8(q, l, smem, vid);
      else run_phase(q, ph, l, s, smem + team * 65536, vid * 2 + team, tfull & 255, blockIdx.x * 2 + team, gridDim.x * 2);
      if (also_h1) run_phase(q, 1, l, 1, smem + team * 65536, vid * 2 + team, tfull & 255, blockIdx.x * 2 + team, gridDim.x * 2);
    }
    if (step < 23) xcd_barrier(xb);
    if (step == 0) {
      if (threadIdx.x == 0) {
        unsigned base = 0;
        for (unsigned j = 0; j < 16; ++j) { const unsigned c = xb_ld(&xb.bar[XB_XCNT(j)]); if (j < xb.x) base += c; }
        unsigned v = base + xb_words.z;
        if (v >= gridDim.x) v = blockIdx.x;
        xb_words.w = v;
      }
      __syncthreads();
      vid = __builtin_amdgcn_readfirstlane((int)xb_words.w);
    }
  }
}

extern "C" void kernel_launch(void* const* d_in, const int* in_sizes, int n_in, void* d_out, int out_size, void* d_ws, size_t ws_size,
                              hipStream_t stream) {
  Params p{};
  const float** pp = (const float**)&p;
  for (int i = 0; i < 22; i++) pp[i] = (const float*)d_in[i];
  p.out = (float*)d_out;
  p.ws = (char*)d_ws;
  static int grid_blocks = 0;
  if (!grid_blocks) {
    int dev = 0, cus = 0, per_cu = 0;
    hipGetDevice(&dev);
    hipDeviceGetAttribute(&cus, hipDeviceAttributeMultiprocessorCount, dev);
    hipFuncSetAttribute((const void*)mega_kernel, hipFuncAttributeMaxDynamicSharedMemorySize, (int)DYN_LDS);
    hipOccupancyMaxActiveBlocksPerMultiprocessor(&per_cu, mega_kernel, 512, DYN_LDS);
    if (per_cu > 1) per_cu = 1;
    grid_blocks = cus * per_cu;
    grid_blocks &= ~7;
    if (grid_blocks > 256) grid_blocks = 256;
  }
  hipMemsetAsync((char*)d_ws + O_BAR, 0, BAR_BYTES, stream);
  void* args[] = {&p};
  hipError_t e = hipLaunchCooperativeKernel((void*)mega_kernel, dim3(grid_blocks), dim3(512), args, DYN_LDS, stream);
  if (e != hipSuccess) fprintf(stderr, "cooperative launch failed: %s (grid %d)\n", hipGetErrorString(e), grid_blocks);
}
```

```cpp
#include <hip/hip_runtime.h>
#include <hip/hip_cooperative_groups.h>
#include <cstdio>
namespace cg = cooperative_groups;

typedef unsigned short u16;
typedef __attribute__((ext_vector_type(8))) __bf16 bf16x8;
typedef __attribute__((ext_vector_type(16))) float f32x16;
#define DEV __device__ __forceinline__
__device__ __forceinline__ int tid_opaque() { int t = threadIdx.x; asm volatile("" : "+v"(t)); return t; }
#define TIDX tid_

constexpr size_t A256(size_t x) { return (x + 255) & ~(size_t)255; }
constexpr size_t A512K(size_t x) { return (x + 524287) & ~(size_t)524287; }
constexpr size_t AUP(size_t x, size_t a) { return (x + a - 1) / a * a; }
constexpr size_t O_WIN = 0;
constexpr size_t O_H = O_WIN + A256(2ull * 7936 * 1024 * 2);
constexpr size_t O_WUQ = AUP(O_H + A256(8192ull * 1024 * 2), 196608);
constexpr size_t O_WUKV = AUP(O_WUQ + A256(2ull * 768 * 384 * 2), 131072);
constexpr size_t O_WBR = A512K(O_WUKV + A256(2ull * 1024 * 256 * 2));
constexpr size_t O_WOUT = A512K(O_WBR + A256(2ull * 3 * 1024 * 512 * 2));
constexpr size_t O_SGUW = O_WOUT + A256(2ull * 1024 * 1024 * 2);
constexpr size_t O_KC = O_SGUW + A256(2ull * 4 * 128 * 128 * 2);
constexpr size_t O_VTC = O_KC + A256(2ull * 8 * 256 * 512 * 2);
constexpr size_t O_MOD = O_VTC + A256(2ull * 8 * 256 * 512 * 2);
constexpr size_t O_QNA = A512K(O_MOD + A256(2ull * 9 * 3072 * 4));
constexpr size_t O_KNA = O_QNA + 8192ull * 512 * 2;
constexpr size_t O_VTNA = O_KNA + 8192ull * 512 * 2;
constexpr size_t O_GU = O_VTNA + 8192ull * 512 * 2;
constexpr size_t O_MG = O_QNA;
constexpr size_t O_ZA = A512K(O_GU + 8192ull * 512 * 2);
constexpr size_t O_ZB = O_ZA + 2 * 8192ull * 512 * 2;
constexpr size_t O_ZC = O_ZB + 2 * 8192ull * 512 * 2;
constexpr size_t O_GVT = O_ZC + 2 * 8192ull * 512 * 2;
constexpr size_t O_GATES = O_GVT + A256(8192ull * 512 * 2);
constexpr size_t O_CKV = AUP(O_GATES + A256(2ull * 8192 * 3072), 131072);
constexpr size_t O_KR = O_CKV + A256(10240ull * 256 * 2);
constexpr size_t O_KNOPE = O_KR + A256(10240ull * 32 * 2);
constexpr size_t O_VTM = O_KNOPE + A256(10240ull * 512 * 2);
constexpr size_t O_END = O_VTM + A256(10240ull * 512 * 2);
constexpr size_t O_DQN = AUP(O_END, 196608);
constexpr size_t O_DQ = O_DQN + A256(8192ull * 384 * 2);
constexpr size_t O_DKV = O_DQ + A256(8192ull * 384 * 2);
constexpr size_t O_KRF = O_DKV + A256(8192ull * 256 * 2);
constexpr size_t O_QM = O_DQ;
constexpr size_t O_BAR = O_QM + A256(8192ull * 768 * 2);
constexpr size_t BAR_BYTES = 16384;
constexpr size_t DYN_LDS = 131072 + 16;
static_assert(O_H % 524288 == 0 && O_WIN == 0 && O_WOUT % 524288 == 0, "K=1024 operands must be 256-row-tile aligned");
static_assert(O_WBR % 262144 == 0 && O_ZA % 262144 == 0 && O_ZB % 262144 == 0 && O_ZC % 262144 == 0, "K=512 operands must be 256-row-tile aligned");
static_assert(O_MG % 524288 == 0, "MERGED must be tile aligned");
static_assert(O_WUQ % 196608 == 0 && O_DQN % 196608 == 0 && O_WUKV % 131072 == 0 && O_CKV % 131072 == 0, "K=384 / K=256 operands must be 256-row-tile aligned");
static_assert(O_KRF + 8192ull * 32 * 4 <= O_BAR, "QM alias region must cover DQ/DKV/KRF");
static_assert(O_BAR + BAR_BYTES <= 256ull * 1024 * 1024, "workspace too large");

constexpr size_t OUT_Y = 0;
constexpr size_t OUT_SK = 16777216;
constexpr size_t OUT_SV = 25165824;
constexpr size_t OUT_CKV = 33554432;
constexpr size_t OUT_SKR = 37748736;

struct Params {
  const float *x_prompt, *x_sample, *cache_na_k, *cache_na_v, *cache_ckv, *cache_kr, *c, *c_ctx;
  const float *norm_g, *w_mod, *b_mod, *w_in, *na_rpb, *sgu_w, *sgu_b, *q_norm, *w_uq, *kv_norm, *w_ukv, *w_branch, *w_out, *final_g;
  float* out;
  char* ws;
};

DEV u16 f2bf(float f) { unsigned u = __float_as_uint(f); u += 0x7fffu + ((u >> 16) & 1u); return (u16)(u >> 16); }
DEV float bf2f(u16 h) { return __uint_as_float(((unsigned)h) << 16); }
typedef __attribute__((ext_vector_type(2))) __bf16 bf16x2;
DEV unsigned pack2(float a, float b) { bf16x2 v; v[0] = (__bf16)a; v[1] = (__bf16)b; return __builtin_bit_cast(unsigned, v); }
DEV void st4bf(u16* p, float a, float b, float c, float d) { uint2 v; v.x = pack2(a, b); v.y = pack2(c, d); *(uint2*)p = v; }
DEV void ld4bf(const u16* p, float& a, float& b, float& c, float& d) {
  uint2 v = *(const uint2*)p;
  a = __uint_as_float(v.x << 16); b = __uint_as_float(v.x & 0xffff0000u);
  c = __uint_as_float(v.y << 16); d = __uint_as_float(v.y & 0xffff0000u);
}
DEV size_t blk_off(int row, int k, int K) { return (size_t)(row >> 8) * 256 * K + (size_t)(k >> 6) * 16384 + (size_t)(row & 255) * 64 + (k & 63); }
DEV float rows_allmax(float v) {
  const unsigned u = __float_as_uint(v);
  const auto a = __builtin_amdgcn_permlane16_swap(u, u, false, false);
  const float m1 = fmaxf(__uint_as_float(a[0]), __uint_as_float(a[1]));
  const unsigned u2 = __float_as_uint(m1);
  const auto b = __builtin_amdgcn_permlane32_swap(u2, u2, false, false);
  return fmaxf(__uint_as_float(b[0]), __uint_as_float(b[1]));
}
DEV float wave_sum(float v) {
#pragma unroll
  for (int o = 32; o > 0; o >>= 1) v += __shfl_xor(v, o);
  return v;
}
DEV float sigmoid_f(float x) { return __builtin_amdgcn_rcpf(1.f + __expf(-x)); }
DEV float silu_f(float x) { return x * __builtin_amdgcn_rcpf(1.f + __expf(-x)); }
DEV float gelu_f(float x) { float u = 0.7978845608028654f * (x + 0.044715f * x * x * x); return x * __builtin_amdgcn_rcpf(1.f + __expf(-2.f * u)); }

DEV void gemm_mainloop_d1(const u16* P, int ldp, const u16* Q, int ldq, int K, char* smem, f32x16 (&acc)[2][2], const int tid_) {
  const int t = TIDX, lane = t & 63, w = t >> 6, wm = w >> 1, wn = w & 1;
  const int lr = t >> 3, ch = t & 7;
  const u16* pg = P + (size_t)lr * ldp + ch * 8;
  const u16* qg = Q + (size_t)lr * ldq + ch * 8;
  const size_t sp = (size_t)32 * ldp, sq = (size_t)32 * ldq;
  const int soff = lr * 128 + ((ch ^ ((t >> 4) & 7)) << 4);
  const int sw = (lane >> 1) & 7;
  const int prow = (wm * 64 + (lane & 31)) * 128;
  const int qrow = (wn * 64 + (lane & 31)) * 128;
  uint4 p0, p1, p2, p3, q0, q1, q2, q3;
#define GLOAD(k0) do { p0 = *(const uint4*)(pg + (k0)); p1 = *(const uint4*)(pg + sp + (k0)); p2 = *(const uint4*)(pg + 2 * sp + (k0)); p3 = *(const uint4*)(pg + 3 * sp + (k0)); \
                       q0 = *(const uint4*)(qg + (k0)); q1 = *(const uint4*)(qg + sq + (k0)); q2 = *(const uint4*)(qg + 2 * sq + (k0)); q3 = *(const uint4*)(qg + 3 * sq + (k0)); } while (0)
#define SWRITE(base) do { char* b_ = (base) + soff; *(uint4*)(b_) = p0; *(uint4*)(b_ + 4096) = p1; *(uint4*)(b_ + 8192) = p2; *(uint4*)(b_ + 12288) = p3; \
                          *(uint4*)(b_ + 16384) = q0; *(uint4*)(b_ + 20480) = q1; *(uint4*)(b_ + 24576) = q2; *(uint4*)(b_ + 28672) = q3; } while (0)
  GLOAD(0);
  SWRITE(smem);
  __syncthreads();
  const int nk = K >> 6;
  for (int kt = 0; kt < nk; kt++) {
    const int k0 = min(kt + 1, nk - 1) << 6;
    GLOAD(k0);
    asm volatile("" ::: "memory"); __builtin_amdgcn_sched_barrier(0);
    const char* bP = smem + (kt & 1) * 32768;
    const char* bQ = bP + 16384;
#pragma unroll
    for (int s = 0; s < 4; s++) {
      const int co = ((s * 2 + (lane >> 5)) ^ sw) << 4;
      const bf16x8 pf0 = *(const bf16x8*)(bP + prow + co), pf1 = *(const bf16x8*)(bP + prow + 4096 + co);
      const bf16x8 qf0 = *(const bf16x8*)(bQ + qrow + co), qf1 = *(const bf16x8*)(bQ + qrow + 4096 + co);
      acc[0][0] = __builtin_amdgcn_mfma_f32_32x32x16_bf16(qf0, pf0, acc[0][0], 0, 0, 0);
      acc[0][1] = __builtin_amdgcn_mfma_f32_32x32x16_bf16(qf1, pf0, acc[0][1], 0, 0, 0);
      acc[1][0] = __builtin_amdgcn_mfma_f32_32x32x16_bf16(qf0, pf1, acc[1][0], 0, 0, 0);
      acc[1][1] = __builtin_amdgcn_mfma_f32_32x32x16_bf16(qf1, pf1, acc[1][1], 0, 0, 0);
    }
    asm volatile("" ::: "memory"); __builtin_amdgcn_sched_barrier(0);
    SWRITE(smem + ((kt + 1) & 1) * 32768);
    __syncthreads();
  }
#undef GLOAD
#undef SWRITE
}

DEV void acc_zero(f32x16 (&acc)[2][2]) {
#pragma unroll
  for (int a = 0; a < 2; a++)
#pragma unroll
    for (int b = 0; b < 2; b++)
#pragma unroll
      for (int r = 0; r < 16; r++) acc[a][b][r] = 0.f;
}

template <class F>
DEV void epi_foreach(const f32x16 (&acc)[2][2], const int tid_, F f) {
  const int lane = TIDX & 63, w = TIDX >> 6, wm = w >> 1, wn = w & 1;
#pragma unroll
  for (int a = 0; a < 2; a++)
#pragma unroll
    for (int b = 0; b < 2; b++)
#pragma unroll
      for (int rg = 0; rg < 4; rg++) {
        const int i = wm * 64 + a * 32 + (lane & 31);
        const int j = wn * 64 + b * 32 + rg * 8 + (lane >> 5) * 4;
        f(i, j, acc[a][b][rg * 4 + 0], acc[a][b][rg * 4 + 1], acc[a][b][rg * 4 + 2], acc[a][b][rg * 4 + 3]);
      }
}

DEV void tile_map(int li, int MPX, int xcd, int& m, int& n) {
  const int g = MPX * 8;
  const int ng = li / g, wv = li % g;
  m = xcd * MPX + (wv % MPX);
  n = ng * 8 + (wv / MPX);
}

DEV void tconv_tile(const float* __restrict__ src, int ldsrc, int k0, int n0, u16* __restrict__ dst, int lddst, int drow0, float* tile, const int tid_, const int blkK = 0) {
  const int t = TIDX;
  {
    const int n = t & 31, kk = t >> 5;
    float v[16];
#pragma unroll
    for (int p = 0; p < 16; p++) v[p] = src[(size_t)(k0 + kk + p * 8) * ldsrc + n0 + n];
#pragma unroll
    for (int p = 0; p < 16; p++) tile[(kk + p * 8) * 33 + n] = v[p];
  }
  __syncthreads();
  {
    const int k2 = (t & 63) * 2, nn = t >> 6;
#pragma unroll
    for (int p = 0; p < 8; p++) {
      const int n2 = nn + p * 4;
      u16* dp = blkK ? (dst + blk_off(drow0 + n2, k0 + k2, blkK)) : (dst + (size_t)(drow0 + n2) * lddst + k0 + k2);
      *(unsigned*)dp = pack2(tile[k2 * 33 + n2], tile[(k2 + 1) * 33 + n2]);
    }
  }
  __syncthreads();
}

DEV void phase_prep(const Params& p, char* smem, const int tid_, const int vb_, const int vg_) {
  const int t = TIDX;
  constexpr int N_MOD = 192;
  constexpr int T_IN = 1960, T_UQ = 72, T_UKV = 64, T_BR = 384, T_OUT = 256, T_CV = 256;
  constexpr int T_L = T_IN + T_UQ + T_UKV + T_BR + T_OUT + T_CV;
  constexpr int N_TC = 2 * T_L;
  constexpr int N_SG = 64, N_KC = 1024;
  constexpr int TOTAL = N_MOD + N_TC + N_SG + N_KC;
  float* MOD = (float*)(p.ws + O_MOD);
  for (int item = vb_; item < TOTAL; item += vg_) {
    if (item < N_MOD) {
      const int l = item / 96, e0 = (item % 96) * 32;
      float* sc = (float*)smem;
      {
        float cv[36];
#pragma unroll
        for (int i = 0; i < 36; i++) { const int idx = t + i * 256; const int c9 = idx >> 10, d = idx & 1023; cv[i] = (c9 == 0) ? p.c_ctx[d] : p.c[(c9 - 1) * 1024 + d]; }
#pragma unroll
        for (int i = 0; i < 36; i++) sc[t + i * 256] = silu_f(cv[i]);
      }
      __syncthreads();
      const int col = t & 31, slab = t >> 5;
      float a[9];
#pragma unroll
      for (int c9 = 0; c9 < 9; c9++) a[c9] = 0.f;
      const float* wp = p.w_mod + ((size_t)l * 1024 + slab * 128) * 3072 + e0 + col;
#pragma unroll 1
      for (int d0 = 0; d0 < 128; d0 += 16) {
        float wv[16];
#pragma unroll
        for (int j = 0; j < 16; j++) wv[j] = wp[(size_t)(d0 + j) * 3072];
#pragma unroll
        for (int j = 0; j < 16; j++) {
          const int d = slab * 128 + d0 + j;
#pragma unroll
          for (int c9 = 0; c9 < 9; c9++) a[c9] += sc[c9 * 1024 + d] * wv[j];
        }
      }
      float* red = sc + 9216;
#pragma unroll
      for (int c9 = 0; c9 < 9; c9++) red[(slab * 9 + c9) * 32 + col] = a[c9];
      __syncthreads();
      for (int idx = t; idx < 288; idx += 256) {
        const int c9 = idx >> 5, cc = idx & 31;
        float sum = 0.f;
#pragma unroll
        for (int sl = 0; sl < 8; sl++) sum += red[(sl * 9 + c9) * 32 + cc];
        MOD[(l * 9 + c9) * 3072 + e0 + cc] = sum + p.b_mod[l * 3072 + e0 + cc];
      }
      __syncthreads();
    } else if (item < N_MOD + N_TC) {
      const int ti = item - N_MOD;
      const int l = ti / T_L;
      int r = ti % T_L;
      const float* src; u16* dst; int ldsrc, lddst, k0, n0, drow, blkK = 0;
      if (r < T_IN) {
        const int nt = r >> 3, kt = r & 7;
        src = p.w_in + (size_t)l * 1024 * 7840; ldsrc = 7840; k0 = kt * 128; n0 = nt * 32;
        dst = (u16*)(p.ws + O_WIN) + (size_t)l * 7936 * 1024; lddst = 1024; blkK = 1024;
        drow = (n0 < 4224) ? n0 : (n0 == 4224 ? 7808 : n0 - 32);
      } else if ((r -= T_IN) < T_UQ) {
        const int nt = r / 3, kt = r % 3;
        src = p.w_uq + (size_t)l * 384 * 768; ldsrc = 768; k0 = kt * 128; n0 = nt * 32;
        dst = (u16*)(p.ws + O_WUQ) + (size_t)l * 768 * 384; lddst = 384; drow = n0; blkK = 384;
      } else if ((r -= T_UQ) < T_UKV) {
        const int nt = r >> 1, kt = r & 1;
        src = p.w_ukv + (size_t)l * 256 * 1024; ldsrc = 1024; k0 = kt * 128; n0 = nt * 32;
        dst = (u16*)(p.ws + O_WUKV) + (size_t)l * 1024 * 256; lddst = 256;
        const int hh = n0 >> 7, jj = n0 & 127;
        drow = (jj < 64) ? (hh * 64 + jj) : (512 + hh * 64 + jj - 64);
        blkK = 256;
      } else if ((r -= T_UKV) < T_BR) {
        const int kb = r >> 7, r2 = r & 127;
        const int nt = r2 >> 2, kt = r2 & 3;
        src = p.w_branch + (size_t)(l * 3 + kb) * 512 * 1024; ldsrc = 1024; k0 = kt * 128; n0 = nt * 32;
        dst = (u16*)(p.ws + O_WBR) + (size_t)(l * 3 + kb) * 1024 * 512; lddst = 512; drow = n0; blkK = 512;
      } else if ((r -= T_BR) < T_OUT) {
        const int nt = r >> 3, kt = r & 7;
        src = p.w_out + (size_t)l * 1024 * 1024; ldsrc = 1024; k0 = kt * 128; n0 = nt * 32;
        dst = (u16*)(p.ws + O_WOUT) + (size_t)l * 1024 * 1024; lddst = 1024; drow = n0; blkK = 1024;
      } else {
        r -= T_OUT;
        const int b = r >> 5, r2 = r & 31;
        const int nt = r2 >> 1, kt = r2 & 1;
        src = p.cache_na_v + (size_t)(b * 2 + l) * 256 * 512; ldsrc = 512; k0 = kt * 128; n0 = nt * 32;
        dst = (u16*)(p.ws + O_VTC) + (size_t)(l * 8 + b) * 512 * 256; lddst = 256; drow = n0;
      }
      tconv_tile(src, ldsrc, k0, n0, dst, lddst, drow, (float*)smem, tid_, blkK);
    } else if (item < N_MOD + N_TC + N_SG) {
      const int it = item - N_MOD - N_TC;
      const size_t e = (size_t)it * 2048 + t * 8;
      const float4 a = *(const float4*)(p.sgu_w + e), b = *(const float4*)(p.sgu_w + e + 4);
      u16* d = (u16*)(p.ws + O_SGUW) + e;
      st4bf(d, a.x, a.y, a.z, a.w); st4bf(d + 4, b.x, b.y, b.z, b.w);
    } else {
      const int it = item - N_MOD - N_TC - N_SG;
      const size_t e = (size_t)it * 2048 + t * 8;
      const int l = (int)(e >> 20), b = (int)(e >> 17) & 7; const size_t rest = e & 131071;
      const float* s = p.cache_na_k + ((size_t)(b * 2 + l) << 17) + rest;
      const float4 a = *(const float4*)s, bb = *(const float4*)(s + 4);
      u16* d = (u16*)(p.ws + O_KC) + e;
      st4bf(d, a.x, a.y, a.z, a.w); st4bf(d + 4, bb.x, bb.y, bb.z, bb.w);
    }
  }
}

DEV const float* xrow_in(const Params& p, int l, int s, int tl) {
  if (l == 0) return (s == 0 ? p.x_prompt : p.x_sample) + (size_t)tl * 1024;
  return p.out + OUT_Y + (size_t)s * 8388608 + (size_t)tl * 1024;
}
DEV int cond_idx(int s, int tl) { return s == 0 ? 0 : 1 + (tl >> 10); }

DEV void phase_h(const Params& p, int l, int s, const int tid_, const int vb_, const int vg_) {
  const int lane = TIDX & 63, wave = TIDX >> 6;
  u16* H = (u16*)(p.ws + O_H);
  const float* MOD = (const float*)(p.ws + O_MOD);
  for (int item = vb_; item < 512; item += vg_) {
    const int tl0 = item * 16 + wave * 4;
    const float* x = xrow_in(p, l, s, tl0);
    const float* mod = MOD + (size_t)(l * 9 + cond_idx(s, tl0)) * 3072;
    float4 v[4][4];
#pragma unroll
    for (int r = 0; r < 4; r++)
#pragma unroll
      for (int i = 0; i < 4; i++) {
        if (l == 0) v[r][i] = *(const float4*)(x + (size_t)r * 1024 + i * 256 + lane * 4);
        else {
          const uint2 w = *(const uint2*)((const u16*)(p.out + OUT_Y) + (size_t)(s * 8192 + tl0 + r) * 1024 + i * 256 + lane * 4);
          v[r][i] = make_float4(__uint_as_float(w.x << 16), __uint_as_float(w.x & 0xffff0000u), __uint_as_float(w.y << 16), __uint_as_float(w.y & 0xffff0000u));
        }
      }
    float4 g[4], sh[4], sc[4];
#pragma unroll
    for (int i = 0; i < 4; i++) {
      const int col = i * 256 + lane * 4;
      g[i] = *(const float4*)(p.norm_g + l * 1024 + col);
      sh[i] = *(const float4*)(mod + col);
      sc[i] = *(const float4*)(mod + 1024 + col);
    }
    asm volatile("" ::: "memory");
    float ss[4];
#pragma unroll
    for (int r = 0; r < 4; r++) {
      ss[r] = 0.f;
#pragma unroll
      for (int i = 0; i < 4; i++) ss[r] += v[r][i].x * v[r][i].x + v[r][i].y * v[r][i].y + v[r][i].z * v[r][i].z + v[r][i].w * v[r][i].w;
    }
#pragma unroll
    for (int o = 32; o > 0; o >>= 1) {
#pragma unroll
      for (int r = 0; r < 4; r++) ss[r] += __shfl_xor(ss[r], o);
    }
#pragma unroll
    for (int r = 0; r < 4; r++) {
      const float rstd = rsqrtf(ss[r] * (1.f / 1024.f) + 1e-6f);
#pragma unroll
      for (int i = 0; i < 4; i++) {
        const int col = i * 256 + lane * 4;
        st4bf(H + blk_off(tl0 + r, col, 1024), v[r][i].x * rstd * g[i].x * (1.f + sc[i].x) + sh[i].x, v[r][i].y * rstd * g[i].y * (1.f + sc[i].y) + sh[i].y,
              v[r][i].z * rstd * g[i].z * (1.f + sc[i].z) + sh[i].z, v[r][i].w * rstd * g[i].w * (1.f + sc[i].w) + sh[i].w);
      }
    }
  }
}

DEV void phase_rows(const Params& p, int l, int s, char* smem, const int tid_, const int vb_, const int vg_) {
  const int t = TIDX, lane = t & 63, wave = t >> 6;
  const u16* DQ = (const u16*)(p.ws + O_DQ); const u16* DKV = (const u16*)(p.ws + O_DKV); const float* KRF = (const float*)(p.ws + O_KRF);
  u16* CKV = (u16*)(p.ws + O_CKV); u16* KR = (u16*)(p.ws + O_KR); u16* GVT = (u16*)(p.ws + O_GVT);
  const int n_row = 512, n_ln = 256, n_cache = (s == 1) ? 512 : 0;
  const int total = n_row + n_ln + n_cache;
  for (int item = vb_; item < total; item += vg_) {
    if (item < n_row) {
      const int tl0 = item * 16 + wave * 4;
      unsigned dqw[4][3]; uint2 dkw[4]; float k1[4], k2[4];
#pragma unroll
      for (int r = 0; r < 4; r++) {
        const unsigned* rp = (const unsigned*)(DQ + (size_t)(tl0 + r) * 384) + lane * 3;
        dqw[r][0] = rp[0]; dqw[r][1] = rp[1]; dqw[r][2] = rp[2];
        dkw[r] = *(const uint2*)(DKV + (size_t)(tl0 + r) * 256 + lane * 4);
        k1[r] = KRF[(size_t)(tl0 + r) * 32 + (lane & 15)]; k2[r] = KRF[(size_t)(tl0 + r) * 32 + 16 + (lane & 15)];
      }
      const float2* gq = (const float2*)(p.q_norm + l * 384) + lane * 3;
      const float2 g0 = gq[0], g1 = gq[1], g2 = gq[2];
      const float4 gk = *(const float4*)(p.kv_norm + l * 256 + lane * 4);
      asm volatile("" ::: "memory");
      float qv[4][6], kv4[4][4], sq[4], sk[4];
#pragma unroll
      for (int r = 0; r < 4; r++) {
#pragma unroll
        for (int j = 0; j < 3; j++) { qv[r][2 * j] = __uint_as_float(dqw[r][j] << 16); qv[r][2 * j + 1] = __uint_as_float(dqw[r][j] & 0xffff0000u); }
        kv4[r][0] = __uint_as_float(dkw[r].x << 16); kv4[r][1] = __uint_as_float(dkw[r].x & 0xffff0000u);
        kv4[r][2] = __uint_as_float(dkw[r].y << 16); kv4[r][3] = __uint_as_float(dkw[r].y & 0xffff0000u);
        sq[r] = 0.f; sk[r] = 0.f;
#pragma unroll
        for (int j = 0; j < 6; j++) sq[r] += qv[r][j] * qv[r][j];
#pragma unroll
        for (int j = 0; j < 4; j++) sk[r] += kv4[r][j] * kv4[r][j];
      }
#pragma unroll
      for (int o = 32; o > 0; o >>= 1) {
#pragma unroll
        for (int r = 0; r < 4; r++) { sq[r] += __shfl_xor(sq[r], o); sk[r] += __shfl_xor(sk[r], o); }
      }
#pragma unroll
      for (int r = 0; r < 4; r++) {
        const int tl = tl0 + r;
        const float rq = rsqrtf(sq[r] * (1.f / 384.f) + 1e-6f);
        u16* dqn = (u16*)(p.ws + O_DQN);
        *(unsigned*)(dqn + blk_off(tl, lane * 6 + 0, 384)) = pack2(qv[r][0] * rq * g0.x, qv[r][1] * rq * g0.y);
        *(unsigned*)(dqn + blk_off(tl, lane * 6 + 2, 384)) = pack2(qv[r][2] * rq * g1.x, qv[r][3] * rq * g1.y);
        *(unsigned*)(dqn + blk_off(tl, lane * 6 + 4, 384)) = pack2(qv[r][4] * rq * g2.x, qv[r][5] * rq * g2.y);
        const float rk = rsqrtf(sk[r] * (1.f / 256.f) + 1e-6f);
        const float a = kv4[r][0] * rk * gk.x, b = kv4[r][1] * rk * gk.y, c = kv4[r][2] * rk * gk.z, d = kv4[r][3] * rk * gk.w;
        const int row = (s == 0) ? tl : ((tl >> 10) * 1280 + 256 + (tl & 1023));
        st4bf(CKV + blk_off(row, lane * 4, 256), a, b, c, d);
        if (s == 0) {
          const int bb = tl >> 8, sqi = tl & 255;
          *(float4*)(p.out + OUT_CKV + ((size_t)(bb * 2 + l) * 256 + sqi) * 256 + lane * 4) = make_float4(a, b, c, d);
        }
        if (lane < 16) {
          const float x1 = k1[r], x2 = k2[r];
          if (s == 0) {
            KR[(size_t)tl * 32 + lane] = f2bf(x1);
            KR[(size_t)tl * 32 + 16 + lane] = f2bf(x2);
          } else {
            const int nn = tl & 1023;
            const float pos = (lane < 8) ? (float)(nn >> 6) : (float)(nn & 63);
            const float inv = powf(10000.f, -(float)(lane & 7) * 0.125f);
            const float ang = pos * inv;
            const float cs = cosf(ang), sn = sinf(ang);
            const int row2 = (tl >> 10) * 1280 + 256 + nn;
            KR[(size_t)row2 * 32 + lane] = f2bf(x1 * cs - x2 * sn);
            KR[(size_t)row2 * 32 + 16 + lane] = f2bf(x1 * sn + x2 * cs);
          }
        }
      }
    } else if (item < n_row + n_ln) {
      const int it = item - n_row, chunk = it >> 2, slab = it & 3;
      u16* g = GVT + (size_t)chunk * 512 * 128 + slab * 32;
      const int q = t & 31, part = t >> 5;
      float v[64];
      float sum = 0.f, sq = 0.f;
#pragma unroll
      for (int c = 0; c < 64; c++) { v[c] = gelu_f(bf2f(g[(part * 64 + c) * 128 + q])); sum += v[c]; sq += v[c] * v[c]; }
      float* red = (float*)smem;
      red[(part * 2 + 0) * 32 + q] = sum; red[(part * 2 + 1) * 32 + q] = sq;
      __syncthreads();
      sum = 0.f; sq = 0.f;
#pragma unroll
      for (int pp = 0; pp < 8; pp++) { sum += red[(pp * 2 + 0) * 32 + q]; sq += red[(pp * 2 + 1) * 32 + q]; }
      const float mu = sum * (1.f / 512.f);
      const float var = fmaxf(sq * (1.f / 512.f) - mu * mu, 0.f);
      const float rstd = rsqrtf(var + 1e-6f);
#pragma unroll
      for (int c = 0; c < 64; c++) g[(part * 64 + c) * 128 + q] = f2bf((v[c] - mu) * rstd);
      __syncthreads();
    } else {
      const int rowi = (item - n_row - n_ln) * 4 + wave;
      const int b = rowi >> 8, m = rowi & 255;
      const float4 a = *(const float4*)(p.cache_ckv + ((size_t)(b * 2 + l) * 256 + m) * 256 + lane * 4);
      st4bf(CKV + blk_off(b * 1280 + m, lane * 4, 256), a.x, a.y, a.z, a.w);
      if (lane < 32) KR[(size_t)(b * 1280 + m) * 32 + lane] = f2bf(p.cache_kr[((size_t)(b * 2 + l) * 256 + m) * 32 + lane]);
    }
  }
}

typedef __attribute__((ext_vector_type(4))) float f32x4;
struct AttnSrc { const u16* k; const u16* kr; const u16* vt; int vts; };
struct AttnState { f32x4 o[4]; float mx, ls; };
constexpr int ATT_VST = 136;

struct AttnRegs { uint4 k0, k1, k2, v0, v1; };
template <int DQK>
DEV void attn_gload(const AttnSrc& src, AttnRegs& r, int t) {
  const int row = t >> 3, c8 = (t & 7) * 8;
  r.k0 = *(const uint4*)(src.k + (size_t)row * 512 + c8);
  r.k1 = *(const uint4*)(src.k + (size_t)(row + 32) * 512 + c8);
  r.v0 = *(const uint4*)(src.vt + (size_t)row * src.vts + c8);
  r.v1 = *(const uint4*)(src.vt + (size_t)(row + 32) * src.vts + c8);
  if (DQK == 96) r.k2 = *(const uint4*)(src.kr + (size_t)(t >> 2) * 32 + (t & 3) * 8);
}
template <int DQK>
DEV void attn_swrite(char* buf, const AttnRegs& r, int t) {
  constexpr int KST = DQK * 2 + 16;
  const int row = t >> 3, c16 = (t & 7) * 16;
  char* vb = buf + 64 * KST;
  *(uint4*)(buf + row * KST + c16) = make_uint4(r.k0.x, r.k0.y, r.k0.z, r.k0.w);
  *(uint4*)(buf + (row + 32) * KST + c16) = make_uint4(r.k1.x, r.k1.y, r.k1.z, r.k1.w);
  char* vp = vb + row * ATT_VST + c16;
  *(uint2*)vp = make_uint2(r.v0.x, r.v0.y);
  *(uint2*)(vp + 8) = make_uint2(r.v0.z, r.v0.w);
  vp += 32 * ATT_VST;
  *(uint2*)vp = make_uint2(r.v1.x, r.v1.y);
  *(uint2*)(vp + 8) = make_uint2(r.v1.z, r.v1.w);
  if (DQK == 96) *(uint4*)(buf + (t >> 2) * KST + 128 + (t & 3) * 16) = make_uint4(r.k2.x, r.k2.y, r.k2.z, r.k2.w);
}

template <int DQK, int NT, bool LOCAL>
DEV void attn_compute(const char* buf, const bf16x8 qf0, const bf16x8 qf1, const bf16x8 qf2, AttnState& st, float scale, int koff0, const float* biasrow, int qc, int wlo, const int tid_) {
  constexpr int KST = DQK * 2 + 16;
  const int lane = TIDX & 63, r16 = lane & 15, g = lane >> 4;
  const char* vb = buf + 64 * KST;
  f32x4 s[NT];
#pragma unroll
  for (int t = 0; t < NT; t++) {
    s[t] = f32x4{0.f, 0.f, 0.f, 0.f};
    const char* kp = buf + (koff0 + t * 16 + r16) * KST + g * 16;
    s[t] = __builtin_amdgcn_mfma_f32_16x16x32_bf16(*(const bf16x8*)(kp), qf0, s[t], 0, 0, 0);
    s[t] = __builtin_amdgcn_mfma_f32_16x16x32_bf16(*(const bf16x8*)(kp + 64), qf1, s[t], 0, 0, 0);
    if (DQK == 96) s[t] = __builtin_amdgcn_mfma_f32_16x16x32_bf16(*(const bf16x8*)(kp + 128), qf2, s[t], 0, 0, 0);
  }
  float mloc = st.mx;
#pragma unroll
  for (int t = 0; t < NT; t++)
#pragma unroll
    for (int e = 0; e < 4; e++) {
      float v = s[t][e] * scale;
      if (LOCAL) {
        const int kc = koff0 + t * 16 + 4 * g + e;
        const int bi = min(max(kc - qc + 15, 0), 30);
        const float bv = biasrow[bi] * 1.4426950408889634f;
        v = (kc >= wlo && kc < wlo + 16) ? v + bv : -1e30f;
      }
      s[t][e] = v;
      mloc = fmaxf(mloc, v);
    }
  mloc = rows_allmax(mloc);
  const float alpha = __builtin_amdgcn_exp2f(st.mx - mloc);
  st.mx = mloc;
  float psum = 0.f;
#pragma unroll
  for (int t = 0; t < NT; t++)
#pragma unroll
    for (int e = 0; e < 4; e++) {
      const float pv = __builtin_amdgcn_exp2f(s[t][e] - mloc);
      s[t][e] = pv;
      psum += pv;
    }
  st.ls = st.ls * alpha + psum;
#pragma unroll
  for (int dt = 0; dt < 4; dt++) st.o[dt] *= alpha;
#pragma unroll
  for (int kb = 0; kb < NT / 2; kb++) {
    bf16x8 pf;
#pragma unroll
    for (int e = 0; e < 4; e++) { pf[e] = (__bf16)s[2 * kb][e]; pf[4 + e] = (__bf16)s[2 * kb + 1][e]; }
#pragma unroll
    for (int dt = 0; dt < 4; dt++) {
      const char* vp = vb + (dt * 16 + r16) * ATT_VST + (koff0 + 4 * g) * 2 + kb * 64;
      const uint2 a0 = *(const uint2*)vp, a1 = *(const uint2*)(vp + 32);
      const uint4 av = make_uint4(a0.x, a0.y, a1.x, a1.y);
      st.o[dt] = __builtin_amdgcn_mfma_f32_16x16x32_bf16(__builtin_bit_cast(bf16x8, av), pf, st.o[dt], 0, 0, 0);
    }
  }
}

template <int MODE>
DEV void attn_item(const Params& p, int l, int it, char* smem, const int tid_) {
  constexpr int DQK = (MODE >= 2) ? 96 : 64;
  constexpr int KST = DQK * 2 + 16;
  constexpr int BUFSZ = 64 * KST + 64 * ATT_VST;
  const int t = TIDX, lane = t & 63, w = t >> 6, r16 = lane & 15, g = lane >> 4;
  constexpr int QB = (MODE >= 2) ? 2 : 1;
  int b, h, tl0, nst, r = 0;
  if (MODE == 0) { b = it >> 5; h = (it >> 2) & 7; tl0 = b * 256 + (it & 3) * 64; nst = 4; }
  else if (MODE == 1) { b = it >> 7; h = (it >> 4) & 7; r = it & 15; tl0 = b * 1024 + r * 64; nst = 12; }
  else if (MODE == 2) { b = it >> 4; h = (it >> 1) & 7; tl0 = b * 256 + (it & 1) * 128; nst = 4; }
  else { b = it >> 6; h = (it >> 3) & 7; tl0 = b * 1024 + (it & 7) * 128; nst = 20; }
  const int tl = tl0 + w * (16 * QB) + r16;
  const int wr0 = min(max(r - 4, 0), 8);
  const u16* KNA = (const u16*)(p.ws + O_KNA); const u16* VTNA = (const u16*)(p.ws + O_VTNA);
  const u16* KC = (const u16*)(p.ws + O_KC); const u16* VTC = (const u16*)(p.ws + O_VTC);
  const u16* KNOPE = (const u16*)(p.ws + O_KNOPE); const u16* KR = (const u16*)(p.ws + O_KR); const u16* VTM = (const u16*)(p.ws + O_VTM);
  auto get_src = [&](int st) {
    AttnSrc s;
    s.kr = nullptr;
    if (MODE == 0) {
      s.k = KNA + (size_t)(b * 256 + st * 64) * 512 + h * 64; s.vt = VTNA + (size_t)(b * 512 + h * 64) * 256 + st * 64; s.vts = 256;
    } else if (MODE == 1) {
      if (st < 8) {
        const int krow = wr0 + st;
        s.k = KNA + (size_t)(b * 1024 + krow * 64) * 512 + h * 64; s.vt = VTNA + (size_t)(b * 512 + h * 64) * 1024 + krow * 64; s.vts = 1024;
      } else {
        const int m0 = (st - 8) * 64;
        s.k = KC + ((size_t)(l * 8 + b) * 256 + m0) * 512 + h * 64; s.vt = VTC + ((size_t)(l * 8 + b) * 512 + h * 64) * 256 + m0; s.vts = 256;
      }
    } else if (MODE == 2) {
      s.k = KNOPE + (size_t)(b * 256 + st * 64) * 512 + h * 64; s.kr = KR + (size_t)(b * 256 + st * 64) * 32;
      s.vt = VTM + (size_t)(b * 512 + h * 64) * 256 + st * 64; s.vts = 256;
    } else {
      s.k = KNOPE + (size_t)(b * 1280 + st * 64) * 512 + h * 64; s.kr = KR + (size_t)(b * 1280 + st * 64) * 32;
      s.vt = VTM + (size_t)(b * 512 + h * 64) * 1280 + st * 64; s.vts = 1280;
    }
    return s;
  };
  AttnRegs rg;
  rg.k2 = make_uint4(0, 0, 0, 0);
  {
    const AttnSrc s0 = get_src(0);
    attn_gload<DQK>(s0, rg, t);
  }
  asm volatile("" ::: "memory");
  auto load_q = [&](int tl, bf16x8& qf0, bf16x8& qf1, bf16x8& qf2) {
  if (MODE < 2) {
    const u16* qp = (const u16*)(p.ws + O_QNA) + (size_t)tl * 512 + h * 64 + 8 * g;
    qf0 = *(const bf16x8*)qp; qf1 = *(const bf16x8*)(qp + 32); qf2 = qf0;
  } else {
    const u16* qp = (const u16*)(p.ws + O_QM) + (size_t)tl * 768 + h * 96;
    qf0 = *(const bf16x8*)(qp + 8 * g); qf1 = *(const bf16x8*)(qp + 32 + 8 * g);
    if (MODE == 2) {
      qf2 = *(const bf16x8*)(qp + 64 + 8 * g);
    } else {
      const uint4 own = *(const uint4*)(qp + 64 + 8 * g), oth = *(const uint4*)(qp + 64 + 8 * (g ^ 2));
      const unsigned ow[4] = {own.x, own.y, own.z, own.w}, ot[4] = {oth.x, oth.y, oth.z, oth.w};
      const int nn = tl & 1023;
      const float pos = (g & 1) ? (float)(nn & 63) : (float)(nn >> 6);
      bf16x8 qr;
#pragma unroll
      for (int e = 0; e < 8; e++) {
        const float a = __uint_as_float((e & 1) ? (ow[e >> 1] & 0xffff0000u) : (ow[e >> 1] << 16));
        const float c = __uint_as_float((e & 1) ? (ot[e >> 1] & 0xffff0000u) : (ot[e >> 1] << 16));
        const float inv = powf(10000.f, -(float)e * 0.125f);
        const float ang = pos * inv;
        const float cs = cosf(ang), sn = sinf(ang);
        const float v = (g < 2) ? (a * cs - c * sn) : (c * sn + a * cs);
        qr[e] = (__bf16)v;
      }
      qf2 = qr;
    }
  }
  };
  bf16x8 qf0, qf1, qf2, qg0, qg1, qg2;
  load_q(tl, qf0, qf1, qf2);
  if (QB == 2) load_q(tl + 16, qg0, qg1, qg2); else { qg0 = qf0; qg1 = qf1; qg2 = qf2; }
  float* biasl = (float*)(smem + 2 * BUFSZ);
  if (MODE == 1) {
    for (int i = t; i < 465; i += 256) biasl[i] = p.na_rpb[(size_t)(l * 8 + h) * 465 + i];
  }
  AttnState st, st2;
#pragma unroll
  for (int dt = 0; dt < 4; dt++) { st.o[dt] = f32x4{0.f, 0.f, 0.f, 0.f}; st2.o[dt] = f32x4{0.f, 0.f, 0.f, 0.f}; }
  st.mx = -1e30f; st.ls = 0.f; st2.mx = -1e30f; st2.ls = 0.f;
  const float scale = ((MODE >= 2) ? 0.10206207261596575f : 0.125f) * 1.4426950408889634f;
  const int qc = w * 16 + r16;
  const int wlo = min(max(qc - 8, 0), 48);
  const int wstart = min(max(16 * w - 8, 0), 32);
  asm volatile("" ::: "memory"); __builtin_amdgcn_sched_barrier(0);
  attn_swrite<DQK>(smem, rg, t);
  __syncthreads();
  for (int sidx = 0; sidx < nst; sidx++) {
    { const AttnSrc sn = get_src(min(sidx + 1, nst - 1)); attn_gload<DQK>(sn, rg, t); }
    asm volatile("" ::: "memory"); __builtin_amdgcn_sched_barrier(0);
    const char* buf = smem + (sidx & 1) * BUFSZ;
    if (MODE == 1 && sidx < 8) attn_compute<DQK, 2, true>(buf, qf0, qf1, qf2, st, scale, wstart, biasl + (wr0 + sidx - r + 7) * 31, qc, wlo, tid_);
    else {
      attn_compute<DQK, 4, false>(buf, qf0, qf1, qf2, st, scale, 0, nullptr, 0, 0, tid_);
      if (QB == 2) attn_compute<DQK, 4, false>(buf, qg0, qg1, qg2, st2, scale, 0, nullptr, 0, 0, tid_);
    }
    asm volatile("" ::: "memory"); __builtin_amdgcn_sched_barrier(0);
    attn_swrite<DQK>(smem + ((sidx + 1) & 1) * BUFSZ, rg, t);
    __syncthreads();
  }
  auto finish = [&](const AttnState& st, int tl) {
    float lt = st.ls;
    lt += __shfl_xor(lt, 16);
    lt += __shfl_xor(lt, 32);
    const float inv = 1.f / lt;
    u16* Z = (u16*)(p.ws + (MODE < 2 ? O_ZA : O_ZC)) + (size_t)(MODE & 1) * 8192 * 512 + blk_off(tl, h * 64 + 4 * g, 512);
#pragma unroll
    for (int dt = 0; dt < 4; dt++) {
      float a, bb, c, d;
      ld4bf(Z + dt * 16, a, bb, c, d);
      a = silu_f(a); bb = silu_f(bb); c = silu_f(c); d = silu_f(d);
      st4bf(Z + dt * 16, st.o[dt][0] * inv * a, st.o[dt][1] * inv * bb, st.o[dt][2] * inv * c, st.o[dt][3] * inv * d);
    }
  };
  finish(st, tl);
  if (QB == 2) finish(st2, tl + 16);
}

DEV void phase_mix(const Params& p, int l, int s, char* smem, const int tid_, const int vb_, const int vg_, const int vid_) {
  for (int item = vb_; item < 1024; item += vg_) {
    if (s == 0) attn_item<0>(p, l, item, smem, tid_); else attn_item<1>(p, l, item, smem, tid_);
  }
  {
    const int vblk = vid_ >> 1, team = vid_ & 1, bq = vblk & 31;
    if (bq >= 16) {
      const int it = (vblk >> 5) * 32 + (bq - 16) * 2 + team, chunk = it >> 2, g = it & 3;
      const u16* Wg = (const u16*)(p.ws + O_SGUW) + (size_t)(l * 4 + g) * 128 * 128;
      const u16* V = (const u16*)(p.ws + O_GVT) + ((size_t)chunk * 512 + g * 128) * 128;
      const u16* GU = (const u16*)(p.ws + O_GU); u16* ZB = (u16*)(p.ws + O_ZB) + (size_t)s * 8192 * 512;
      f32x16 acc[2][2];
      acc_zero(acc);
      gemm_mainloop_d1(Wg, 128, V, 128, 128, smem, acc, tid_);
      epi_foreach(acc, tid_, [&](int i, int j, float v0, float v1, float v2, float v3) {
        const float bs = p.sgu_b[(l * 4 + g) * 128 + i];
        const size_t off = (size_t)(chunk * 128 + i) * 512 + g * 128 + j;
        float u0, u1, u2, u3, z0, z1, z2, z3;
        ld4bf(GU + off, u0, u1, u2, u3);
        const size_t zoff = blk_off(chunk * 128 + i, g * 128 + j, 512);
        ld4bf(ZB + zoff, z0, z1, z2, z3);
        u0 = gelu_f(u0); u1 = gelu_f(u1); u2 = gelu_f(u2); u3 = gelu_f(u3);
        z0 = silu_f(z0); z1 = silu_f(z1); z2 = silu_f(z2); z3 = silu_f(z3);
        st4bf(ZB + zoff, u0 * (v0 + bs) * z0, u1 * (v1 + bs) * z1, u2 * (v2 + bs) * z2, u3 * (v3 + bs) * z3);
      });
    }
  }
}

DEV void phase_mla(const Params& p, int l, int s, char* smem, const int tid_, const int vb_, const int vg_) {
  for (int item = vb_; item < 512; item += vg_) {
    if (s == 0) attn_item<2>(p, l, item, smem, tid_); else attn_item<3>(p, l, item, smem, tid_);
  }
}

DEV void phase_final(const Params& p, const int tid_, const int vb_, const int vg_) {
  const int lane = TIDX & 63, wave = TIDX >> 6;
  for (int item = vb_; item < 1024; item += vg_) {
    float* x = p.out + OUT_Y + (size_t)(item * 16 + wave * 4) * 1024;
    const u16* xb = (const u16*)(p.ws + O_ZA) + (size_t)(item * 16 + wave * 4) * 1024;
    float4 v[4][4];
#pragma unroll
    for (int r = 0; r < 4; r++)
#pragma unroll
      for (int i = 0; i < 4; i++) {
        const uint2 w = *(const uint2*)(xb + (size_t)r * 1024 + i * 256 + lane * 4);
        v[r][i] = make_float4(__uint_as_float(w.x << 16), __uint_as_float(w.x & 0xffff0000u), __uint_as_float(w.y << 16), __uint_as_float(w.y & 0xffff0000u));
      }
    float4 g[4];
#pragma unroll
    for (int i = 0; i < 4; i++) g[i] = *(const float4*)(p.final_g + i * 256 + lane * 4);
    asm volatile("" ::: "memory");
    float ss[4];
#pragma unroll
    for (int r = 0; r < 4; r++) {
      ss[r] = 0.f;
#pragma unroll
      for (int i = 0; i < 4; i++) ss[r] += v[r][i].x * v[r][i].x + v[r][i].y * v[r][i].y + v[r][i].z * v[r][i].z + v[r][i].w * v[r][i].w;
    }
#pragma unroll
    for (int o = 32; o > 0; o >>= 1) {
#pragma unroll
      for (int r = 0; r < 4; r++) ss[r] += __shfl_xor(ss[r], o);
    }
#pragma unroll
    for (int r = 0; r < 4; r++) {
      const float rstd = rsqrtf(ss[r] * (1.f / 1024.f) + 1e-6f);
#pragma unroll
      for (int i = 0; i < 4; i++)
        *(float4*)(x + (size_t)r * 1024 + i * 256 + lane * 4) =
            make_float4(v[r][i].x * rstd * g[i].x, v[r][i].y * rstd * g[i].y, v[r][i].z * rstd * g[i].z, v[r][i].w * rstd * g[i].w);
    }
  }
}

namespace pg8 {
#define PG8_LAS __attribute__((address_space(3)))
typedef unsigned short bf16_t;
typedef short bf16x8 __attribute__((ext_vector_type(8)));
typedef float f32x4 __attribute__((ext_vector_type(4)));
typedef unsigned u32x4 __attribute__((ext_vector_type(4)));
constexpr int BM = 256, BK = 64, HALF = 128, HTB = HALF * BK * 2  , STAGE_BYTES = 8 * HTB, NXCD = 8, WGM = 8;

__host__ __device__ __forceinline__ int lds_byte(int r, int c) { const int st = (r >> 4) * 2 + (c >> 5), rr = r & 15, cc = c & 31, ob = rr * 64 + cc * 2; return st * 1024 + (ob ^ (((ob >> 9) & 1) << 5)); }
__host__ __device__ __forceinline__ void stage_rc(int b, int& R, int& C) { const int st = b / 1024, sb = b % 1024, swz = sb ^ (((sb >> 9) & 1) << 5); R = (st >> 1) * 16 + swz / 64; C = (st & 1) * 32 + (swz % 64) / 2; }
__host__ __device__ __forceinline__ int perm32(int rho) { const int n = rho >> 4, i = rho & 15; return 8 * (i >> 2) + 4 * n + (i & 3); }

struct Unit { int pm, pn; };
struct Gemm { const bf16_t* A; const bf16_t* Bt; int M, N, K; };

template <class Epi, class Sched, bool STAMP = false>
__device__ __forceinline__ void gemm_phase(PG8_LAS unsigned char* lds, const Gemm g, const Sched& S, const Epi& E, unsigned long long* stamps) {
    const int tid = tid_opaque(), wid = __builtin_amdgcn_readfirstlane(tid >> 6), lane = tid & 63, wr = wid >> 2, wc = wid & 3, fr = lane & 15, fq = lane >> 4;
    const int K = g.K, nt = K / BK;
    int ts_lo = 0, ts_hi = 0, nts = 0; const unsigned long long rt_entry = STAMP ? (unsigned long long)wall_clock64() : 0ull;
#define PG8_STAMP() do { if (STAMP && wid == 0 && nts < 64) { const unsigned long long _c = (unsigned long long)clock64(); \
        ts_lo = (lane == nts) ? (int)(unsigned)_c : ts_lo; ts_hi = (lane == nts) ? (int)(unsigned)(_c >> 32) : ts_hi; ++nts; } } while (0)
    PG8_STAMP();
    unsigned voffA[2], voffB[2];
#pragma unroll
    for (int i = 0; i < 2; ++i) { int R, C; stage_rc(tid * 16 + i * 8192, R, C); const int Rb = Epi::PERM ? ((R & ~31) + perm32(R & 31)) : R;
        voffA[i] = (unsigned)(R * BK + C) * 2u; voffB[i] = (unsigned)(Rb * BK + C) * 2u; }
    const size_t kstep = (size_t)(BM * BK * 2);
    const size_t hstep = (size_t)HALF * BK * 2;
    const size_t tstep = (size_t)BM * K * 2;
    const unsigned ldsw = (unsigned)wid * 1024u;
    const int aoff = lds_byte(wr * 64 + fr, fq * 8), boff = lds_byte(wc * 32 + fr, fq * 8);
#define PG8_SA(b, h) (((b) * 2 + (h)) * HTB)
#define PG8_SB(b, h) ((4 + (b) * 2 + (h)) * HTB)
#define PG8_STAGE(bufoff, gbase, voff) do { _Pragma("unroll") for (int _i = 0; _i < 2; ++_i) \
        __builtin_amdgcn_global_load_lds((const unsigned*)((const char*)(gbase) + (voff)[_i]), (PG8_LAS unsigned*)(lds + (bufoff) + ldsw + _i * 8192), 16, 0, 0); } while (0)
#define PG8_LDA(dst, b, h) do { _Pragma("unroll") for (int m = 0; m < 4; ++m) _Pragma("unroll") for (int k = 0; k < 2; ++k) dst[m][k] = *(const PG8_LAS bf16x8*)(lds + PG8_SA(b, h) + aoff + m * 2048 + k * 1024); } while (0)
#define PG8_LDB(dst, b, h) do { _Pragma("unroll") for (int n = 0; n < 2; ++n) _Pragma("unroll") for (int k = 0; k < 2; ++k) dst[n][k] = *(const PG8_LAS bf16x8*)(lds + PG8_SB(b, h) + boff + n * 2048 + k * 1024); } while (0)
#define PG8_MMA(ai, bj, At, Bt) do { __builtin_amdgcn_s_setprio(1); _Pragma("unroll") for (int m = 0; m < 4; ++m) _Pragma("unroll") for (int n = 0; n < 2; ++n) _Pragma("unroll") for (int k = 0; k < 2; ++k) \
        acc[ai][bj][m][n] = __builtin_amdgcn_mfma_f32_16x16x32_bf16(Bt[n][k], At[m][k], acc[ai][bj][m][n], 0, 0, 0); __builtin_amdgcn_s_setprio(0); } while (0)
#define PG8_WAIT_V(n) asm volatile("s_waitcnt vmcnt(" #n ")" ::: "memory")
#define PG8_WAIT_L(n) asm volatile("s_waitcnt lgkmcnt(" #n ")" ::: "memory")
#define PG8_BAR __builtin_amdgcn_s_barrier()
#define PG8_SCHED __builtin_amdgcn_sched_barrier(0)
    Unit cur, nxt; int ui = 0;
    if (!S.next(0, cur)) return;
    f32x4 acc[2][2][4][2];
#pragma unroll
    for (int a = 0; a < 2; ++a)
#pragma unroll
        for (int b = 0; b < 2; ++b)
#pragma unroll
            for (int m = 0; m < 4; ++m)
#pragma unroll
                for (int n = 0; n < 2; ++n) acc[a][b][m][n] = (f32x4){0.f, 0.f, 0.f, 0.f};
    bf16x8 At[4][2], B0[2][2], B1[2][2];
    const char* cA = (const char*)g.A + (size_t)cur.pm * tstep; const char* cB = (const char*)g.Bt + (size_t)cur.pn * tstep;
    S.a_ready(cur);
    PG8_STAGE(PG8_SB(0, 0), cB, voffB); PG8_STAGE(PG8_SA(0, 0), cA, voffA); PG8_STAGE(PG8_SB(0, 1), cB + hstep, voffB); PG8_STAGE(PG8_SA(0, 1), cA + hstep, voffA);
    if (wr == 1) PG8_BAR;
    PG8_WAIT_V(4); PG8_BAR;
    PG8_STAGE(PG8_SB(1, 0), cB + kstep, voffB); PG8_STAGE(PG8_SA(1, 0), cA + kstep, voffA); PG8_STAGE(PG8_SB(1, 1), cB + hstep + kstep, voffB);
    PG8_WAIT_V(6); PG8_BAR;
    PG8_STAMP();
    for (;;) {
        const bool has_next = S.next(ui + 1, nxt);
        const char* nA = has_next ? (const char*)g.A + (size_t)nxt.pm * tstep : cA; const char* nB = has_next ? (const char*)g.Bt + (size_t)nxt.pn * tstep : cB;
        for (int t = 0; t < nt; t += 2) {
            const bool last = (t == nt - 2);
            const char* a1 = cA + (size_t)(t + 1) * kstep;
            const char* a2 = last ? nA : cA + (size_t)(t + 2) * kstep; const char* b2 = last ? nB : cB + (size_t)(t + 2) * kstep;
            const char* a3 = a2 + kstep; const char* b3 = b2 + kstep;
            if (last && has_next) S.a_ready(nxt);
            PG8_LDB(B0, 0, 0); PG8_SCHED; PG8_LDA(At, 0, 0); PG8_STAGE(PG8_SA(1, 1), a1 + hstep, voffA);
            PG8_WAIT_L(8); PG8_BAR; PG8_WAIT_L(0); PG8_MMA(0, 0, At, B0); PG8_BAR; PG8_SCHED;
            PG8_LDB(B1, 0, 1); PG8_STAGE(PG8_SB(0, 0), b2, voffB);
            PG8_BAR; PG8_WAIT_L(0); PG8_MMA(0, 1, At, B1); PG8_BAR;
            PG8_LDA(At, 0, 1); PG8_STAGE(PG8_SA(0, 0), a2, voffA);
            PG8_BAR; PG8_WAIT_L(0); PG8_MMA(1, 0, At, B0); PG8_BAR; PG8_SCHED;
            PG8_STAGE(PG8_SB(0, 1), b2 + hstep, voffB);
            PG8_WAIT_V(6); PG8_BAR; PG8_MMA(1, 1, At, B1); PG8_BAR;
            PG8_LDB(B0, 1, 0); PG8_SCHED; PG8_LDA(At, 1, 0); PG8_STAGE(PG8_SA(0, 1), a2 + hstep, voffA);
            PG8_WAIT_L(8); PG8_BAR; PG8_WAIT_L(0); PG8_MMA(0, 0, At, B0); PG8_BAR; PG8_SCHED;
            PG8_LDB(B1, 1, 1); PG8_STAGE(PG8_SB(1, 0), b3, voffB);
            PG8_BAR; PG8_WAIT_L(0); PG8_MMA(0, 1, At, B1); PG8_BAR;
            PG8_LDA(At, 1, 1); PG8_STAGE(PG8_SA(1, 0), a3, voffA);
            PG8_BAR; PG8_WAIT_L(0); PG8_MMA(1, 0, At, B0); PG8_BAR; PG8_SCHED;
            PG8_STAGE(PG8_SB(1, 1), b3 + hstep, voffB);
            PG8_WAIT_V(6); PG8_BAR; PG8_MMA(1, 1, At, B1); PG8_BAR;
        }
        PG8_STAMP();
        if constexpr (!Epi::AFTER_DRAIN) { E(acc, cur, wr, wc, fr, fq); S.done(cur); }
        PG8_STAMP();
        if (!has_next) break;
        if constexpr (!Epi::KEEP_ACC) {
#pragma unroll
        for (int a = 0; a < 2; ++a)
#pragma unroll
            for (int b = 0; b < 2; ++b)
#pragma unroll
                for (int m = 0; m < 4; ++m)
#pragma unroll
                    for (int n = 0; n < 2; ++n) acc[a][b][m][n] = (f32x4){0.f, 0.f, 0.f, 0.f};
        }
        cur = nxt; cA = nA; cB = nB; ++ui;
    }
    PG8_WAIT_V(0);
    if (wr == 0) PG8_BAR;
    PG8_BAR;
    if constexpr (Epi::AFTER_DRAIN) { E.fused(acc, cur, wr, wc, fr, fq, lds, wid, lane); S.done(cur); }
    PG8_STAMP();
    if (STAMP && wid == 0) { stamps[lane] = lane < nts ? (((unsigned long long)(unsigned)ts_hi << 32) | (unsigned)ts_lo) : 0ull;
        if (lane == 62) stamps[62] = rt_entry; if (lane == 63) stamps[63] = (unsigned long long)wall_clock64(); }
#undef PG8_STAMP
#undef PG8_SA
#undef PG8_SB
#undef PG8_STAGE
#undef PG8_LDA
#undef PG8_LDB
#undef PG8_MMA
#undef PG8_WAIT_V
#undef PG8_WAIT_L
#undef PG8_BAR
#undef PG8_SCHED
}
}


struct InSched {
  int l, c;
  __device__ __forceinline__ bool next(int i, pg8::Unit& u) const {
    const int x = c >> 5, q = c & 31;
    const int e = i * 32 + q;
    if (e >= 124) return false;
    const int it = 4 * x + (e & 3), jt = e >> 2;
    const bool swapped = (jt == 4) || (jt == 5) || (jt == 10) || (jt == 11);
    if (swapped) { u.pm = l * 31 + jt; u.pn = 62 + it; } else { u.pm = 62 + it; u.pn = l * 31 + jt; }
    return true;
  }
  __device__ __forceinline__ void a_ready(const pg8::Unit&) const {}
  __device__ __forceinline__ void done(const pg8::Unit&) const {}
};

DEV void st8bf(u16* p, const pg8::f32x4& a, const pg8::f32x4& b) {
  uint4 w; w.x = pack2(a[0], a[1]); w.y = pack2(a[2], a[3]); w.z = pack2(b[0], b[1]); w.w = pack2(b[2], b[3]);
  *(uint4*)p = w;
}
template <class F> DEV pg8::f32x4 map4(const pg8::f32x4& v, F f) { pg8::f32x4 r; r[0] = f(v[0]); r[1] = f(v[1]); r[2] = f(v[2]); r[3] = f(v[3]); return r; }

struct InEpi {
  static constexpr bool PERM = true, AFTER_DRAIN = false, KEEP_ACC = false;
  char* ws; float* out; int l, s;
  __device__ __forceinline__ void operator()(const pg8::f32x4 (&acc)[2][2][4][2], const pg8::Unit& u, int wr, int wc, int fr, int fq) const {
    u16* QNA = (u16*)(ws + O_QNA); u16* KNA = (u16*)(ws + O_KNA); u16* VTNA = (u16*)(ws + O_VTNA);
    const size_t zs = (size_t)s * 8192 * 512;
    u16* ZA = (u16*)(ws + O_ZA) + zs; u16* ZB = (u16*)(ws + O_ZB) + zs; u16* ZC = (u16*)(ws + O_ZC) + zs;
    u16* GU = (u16*)(ws + O_GU); u16* GVT = (u16*)(ws + O_GVT);
    u16* DQ = (u16*)(ws + O_DQ); u16* DKV = (u16*)(ws + O_DKV); float* KRF = (float*)(ws + O_KRF);
    unsigned char* GATES = (unsigned char*)(ws + O_GATES) + (size_t)s * 8192 * 3072;
    if (u.pm >= 62) {
      const int t0 = (u.pm - 62) * 256 + wr * 64 + fr;
      const int cbase = (u.pn - l * 31) * 256;
#pragma unroll
      for (int bj = 0; bj < 2; ++bj) {
        const int seg0 = cbase + bj * 128;
        const int n = seg0 >> 7;
        const int c0 = seg0 + wc * 32 + 8 * fq;
#pragma unroll
        for (int ai = 0; ai < 2; ++ai)
#pragma unroll
          for (int m = 0; m < 4; ++m) {
            const int T = t0 + ai * 128 + m * 16;
            const pg8::f32x4 v0 = acc[ai][bj][m][0], v1 = acc[ai][bj][m][1];
            if (n < 4) {
              st8bf(QNA + (size_t)T * 512 + c0, v0, v1);
            } else if (n < 8) {
              const int col = c0 - 512;
              st8bf(KNA + (size_t)T * 512 + col, v0, v1);
              if (s == 0) {
                const int b = T >> 8, sq = T & 255;
                float* o = out + OUT_SK + ((size_t)(b * 2 + l) * 256 + sq) * 512 + col;
                *(float4*)o = make_float4(v0[0], v0[1], v0[2], v0[3]); *(float4*)(o + 4) = make_float4(v1[0], v1[1], v1[2], v1[3]);
              }
            } else if (n < 16) {
              st8bf(ZA + blk_off(T, c0 - 1536, 512), v0, v1);
            } else if (n < 20) {
              st8bf(GU + (size_t)T * 512 + c0 - 2048, v0, v1);
            } else if (n < 28) {
              st8bf(ZB + blk_off(T, c0 - 3072, 512), v0, v1);
            } else if (n < 31) {
              st8bf(DQ + (size_t)T * 384 + c0 - 3584, v0, v1);
            } else if (n < 33) {
              st8bf(DKV + (size_t)T * 256 + c0 - 3968, v0, v1);
            } else if (n < 37) {
              st8bf(ZC + blk_off(T, c0 - 4224, 512), v0, v1);
            } else if (n < 61) {
              unsigned q[8];
#pragma unroll
              for (int e = 0; e < 4; e++) { q[e] = (unsigned)(sigmoid_f(v0[e]) * 255.f + 0.5f); q[4 + e] = (unsigned)(sigmoid_f(v1[e]) * 255.f + 0.5f); }
              uint2 gw; gw.x = q[0] | (q[1] << 8) | (q[2] << 16) | (q[3] << 24); gw.y = q[4] | (q[5] << 8) | (q[6] << 16) | (q[7] << 24);
              *(uint2*)(GATES + (size_t)T * 3072 + c0 - 4736) = gw;
            } else if (c0 < 7808 + 32) {
              const int j = c0 - 7808;
              float* kp = KRF + (size_t)T * 32 + j;
              *(float4*)kp = make_float4(v0[0], v0[1], v0[2], v0[3]); *(float4*)(kp + 4) = make_float4(v1[0], v1[1], v1[2], v1[3]);
              if (s == 0) {
                const int b = T >> 8, sq = T & 255;
                float* o = out + OUT_SKR + ((size_t)(b * 2 + l) * 256 + sq) * 32 + j;
                *(float4*)o = make_float4(v0[0], v0[1], v0[2], v0[3]); *(float4*)(o + 4) = make_float4(v1[0], v1[1], v1[2], v1[3]);
              }
            }
          }
      }
    } else {
      const int jt = u.pm - l * 31;
      const int ch0 = jt * 256 + wr * 64 + fr;
      const int tk0 = (u.pn - 62) * 256 + wc * 32 + 8 * fq;
#pragma unroll
      for (int ai = 0; ai < 2; ++ai)
#pragma unroll
        for (int m = 0; m < 4; ++m) {
          const int ch = ch0 + ai * 128 + m * 16;
#pragma unroll
          for (int bj = 0; bj < 2; ++bj) {
            const int tok = tk0 + bj * 128;
            const pg8::f32x4 v0 = acc[ai][bj][m][0], v1 = acc[ai][bj][m][1];
            if (jt < 8) {
              const int dva = ch - 1024;
              if (s == 0) {
                const int b = tok >> 8, sq = tok & 255;
                st8bf(VTNA + ((size_t)(b * 512 + dva)) * 256 + sq, v0, v1);
                float* o = out + OUT_SV + ((size_t)(b * 2 + l) * 256 + sq) * 512 + dva;
                o[0] = v0[0]; o[512] = v0[1]; o[1024] = v0[2]; o[1536] = v0[3]; o[2048] = v1[0]; o[2560] = v1[1]; o[3072] = v1[2]; o[3584] = v1[3];
              } else {
                const int b = tok >> 10, nn = tok & 1023;
                st8bf(VTNA + ((size_t)(b * 512 + dva)) * 1024 + nn, v0, v1);
              }
            } else {
              const int c = ch - 2560;
              const int chunk = tok >> 7, q = tok & 127;
              st8bf(GVT + ((size_t)chunk * 512 + c) * 128 + q, v0, v1);
            }
          }
        }
    }
  }
};

DEV void phase_in8(const Params& p, int l, int s, char* smem_full, int vid) {
  pg8::Gemm g; g.A = (const pg8::bf16_t*)(p.ws + O_WIN); g.Bt = g.A; g.M = 0; g.N = 0; g.K = 1024;
  InSched S; S.l = l; S.c = vid;
  InEpi E; E.ws = p.ws; E.out = p.out; E.l = l; E.s = s;
  pg8::gemm_phase<InEpi, InSched, false>((PG8_LAS unsigned char*)smem_full, g, S, E, nullptr);
}


struct MergeSched {
  int l, c;
  __device__ __forceinline__ bool next(int i, pg8::Unit& u) const {
    const int x = c >> 5, q = c & 31;
    if (i >= 3) return false;
    const int it = 8 * x + (q & 7), jt = q >> 3;
    const size_t zo = (i == 0) ? O_ZA : (i == 1 ? O_ZB : O_ZC);
    u.pm = (int)(zo / 262144) + it;
    u.pn = (int)(O_WBR / 262144) + (l * 3 + i) * 4 + jt;
    return true;
  }
  __device__ __forceinline__ void a_ready(const pg8::Unit&) const {}
  __device__ __forceinline__ void done(const pg8::Unit&) const {}
};
struct MergeEpi {
  static constexpr bool PERM = true, AFTER_DRAIN = false, KEEP_ACC = true;
  char* ws; int l;
  __device__ __forceinline__ void operator()(pg8::f32x4 (&acc)[2][2][4][2], const pg8::Unit& u, int wr, int wc, int fr, int fq) const {
    const int wrel = u.pn - (int)(O_WBR / 262144) - l * 12;
    const int k = wrel >> 2, jt = wrel & 3;
    const size_t zo = (k == 0) ? O_ZA : (k == 1 ? O_ZB : O_ZC);
    const int it = u.pm - (int)(zo / 262144);
    const unsigned char* GATES = (const unsigned char*)(ws + O_GATES);
    u16* MG = (u16*)(ws + O_MG);
    const int t0 = it * 256 + wr * 64 + fr;
#pragma unroll
    for (int ai = 0; ai < 2; ++ai) {
      uint2 ga[4][2], gb[4][2];
#pragma unroll
      for (int m = 0; m < 4; ++m)
#pragma unroll
        for (int bj = 0; bj < 2; ++bj) {
          const int T = t0 + ai * 128 + m * 16;
          const int c0 = jt * 256 + bj * 128 + wc * 32 + 8 * fq;
          const unsigned char* gp = GATES + (size_t)T * 3072 + k * 1024 + c0;
          ga[m][bj] = *(const uint2*)gp;
          gb[m][bj] = (k < 2) ? *(const uint2*)(gp + 1024) : make_uint2(0u, 0u);
        }
      asm volatile("" ::: "memory");
#pragma unroll
      for (int m = 0; m < 4; ++m)
#pragma unroll
        for (int bj = 0; bj < 2; ++bj) {
          const int T = t0 + ai * 128 + m * 16;
          const int c0 = jt * 256 + bj * 128 + wc * 32 + 8 * fq;
          float f[8];
#pragma unroll
          for (int e = 0; e < 8; e++) {
            const float qa = fmaxf((float)((((e < 4) ? ga[m][bj].x : ga[m][bj].y) >> (8 * (e & 3))) & 0xffu), 1.f);
            if (k < 2) {
              const float qb = fmaxf((float)((((e < 4) ? gb[m][bj].x : gb[m][bj].y) >> (8 * (e & 3))) & 0xffu), 1.f);
              f[e] = qa * __builtin_amdgcn_rcpf(qb);
            } else {
              f[e] = qa * (1.f / 255.f);
            }
          }
#pragma unroll
          for (int e = 0; e < 4; e++) { acc[ai][bj][m][0][e] *= f[e]; acc[ai][bj][m][1][e] *= f[4 + e]; }
          if (k == 2) {
            uint4 o;
            o.x = pack2(acc[ai][bj][m][0][0], acc[ai][bj][m][0][1]); o.y = pack2(acc[ai][bj][m][0][2], acc[ai][bj][m][0][3]);
            o.z = pack2(acc[ai][bj][m][1][0], acc[ai][bj][m][1][1]); o.w = pack2(acc[ai][bj][m][1][2], acc[ai][bj][m][1][3]);
            *(uint4*)(MG + blk_off(T, c0, 1024)) = o;
          }
        }
    }
  }
};
DEV void phase_merge8(const Params& p, int l, char* smem_full, int vid) {
  pg8::Gemm g; g.A = (const pg8::bf16_t*)p.ws; g.Bt = g.A; g.M = 0; g.N = 0; g.K = 512;
  MergeSched S; S.l = l; S.c = vid;
  MergeEpi E; E.ws = p.ws; E.l = l;
  pg8::gemm_phase<MergeEpi, MergeSched, false>((PG8_LAS unsigned char*)smem_full, g, S, E, nullptr);
}

struct OutSched {
  int l, c;
  __device__ __forceinline__ bool next(int i, pg8::Unit& u) const {
    const int x = c >> 5, q = c & 31;
    if (i >= 1) return false;
    u.pm = (int)(O_MG / 524288) + 8 * x + (q & 7);
    u.pn = (int)(O_WOUT / 524288) + l * 4 + (q >> 3);
    return true;
  }
  __device__ __forceinline__ void a_ready(const pg8::Unit&) const {}
  __device__ __forceinline__ void done(const pg8::Unit&) const {}
};
struct OutEpi {
  static constexpr bool PERM = true, AFTER_DRAIN = false, KEEP_ACC = false;
  const float* x0; const float* x1; const u16* xb_in; u16* xb_out; const float* MOD; int l;
  __device__ __forceinline__ void operator()(const pg8::f32x4 (&acc)[2][2][4][2], const pg8::Unit& u, int wr, int wc, int fr, int fq) const {
    const int it = u.pm - (int)(O_MG / 524288), jt = u.pn - (int)(O_WOUT / 524288) - l * 4;
    const int s = it >> 5;
    const int t0 = it * 256 + wr * 64 + fr;
    typedef __attribute__((address_space(1))) pg8::f32x4 GF4;
    typedef __attribute__((address_space(1))) pg8::u32x4 GU4;
    const GF4* xg = (const GF4*)(unsigned long long)((s == 0) ? x0 : x1 - (size_t)8192 * 1024);
    const GU4* xbg = (const GU4*)(unsigned long long)xb_in;
    GU4* og = (GU4*)(unsigned long long)xb_out;
    const float* gr = MOD + (size_t)(l * 9 + cond_idx(s, t0 & 8191)) * 3072 + 2048;
    float4 gv[2][2];
#pragma unroll
    for (int bj = 0; bj < 2; ++bj)
#pragma unroll
      for (int h2 = 0; h2 < 2; ++h2) gv[bj][h2] = *(const float4*)(gr + jt * 256 + bj * 128 + wc * 32 + 8 * fq + 4 * h2);
#pragma unroll
    for (int ai = 0; ai < 2; ++ai)
#pragma unroll
      for (int mp = 0; mp < 2; ++mp) {
        float xr[2][2][8];
        if (l == 0) {
          pg8::f32x4 xv[2][2][2];
#pragma unroll
          for (int mm = 0; mm < 2; ++mm)
#pragma unroll
            for (int bj = 0; bj < 2; ++bj)
#pragma unroll
              for (int h2 = 0; h2 < 2; ++h2)
                xv[mm][bj][h2] = *(xg + (size_t)(t0 + ai * 128 + (mp * 2 + mm) * 16) * 256 + jt * 64 + bj * 32 + wc * 8 + 2 * fq + h2);
          asm volatile("" ::: "memory"); __builtin_amdgcn_sched_barrier(0);
#pragma unroll
          for (int mm = 0; mm < 2; ++mm)
#pragma unroll
            for (int bj = 0; bj < 2; ++bj)
#pragma unroll
              for (int e = 0; e < 8; ++e) xr[mm][bj][e] = xv[mm][bj][e >> 2][e & 3];
        } else {
          pg8::u32x4 xw[2][2];
#pragma unroll
          for (int mm = 0; mm < 2; ++mm)
#pragma unroll
            for (int bj = 0; bj < 2; ++bj)
              xw[mm][bj] = *(xbg + (size_t)(t0 + ai * 128 + (mp * 2 + mm) * 16) * 128 + jt * 32 + bj * 16 + wc * 4 + fq);
          asm volatile("" ::: "memory"); __builtin_amdgcn_sched_barrier(0);
#pragma unroll
          for (int mm = 0; mm < 2; ++mm)
#pragma unroll
            for (int bj = 0; bj < 2; ++bj)
#pragma unroll
              for (int e = 0; e < 8; ++e) { const unsigned w = xw[mm][bj][e >> 1]; xr[mm][bj][e] = __uint_as_float((e & 1) ? (w & 0xffff0000u) : (w << 16)); }
        }
#pragma unroll
        for (int mm = 0; mm < 2; ++mm)
#pragma unroll
          for (int bj = 0; bj < 2; ++bj) {
            const int m = mp * 2 + mm;
            const pg8::f32x4 v0 = acc[ai][bj][m][0], v1 = acc[ai][bj][m][1];
            const float4 g0 = gv[bj][0], g1 = gv[bj][1];
            pg8::u32x4 o;
            o[0] = pack2(xr[mm][bj][0] + g0.x * v0[0], xr[mm][bj][1] + g0.y * v0[1]);
            o[1] = pack2(xr[mm][bj][2] + g0.z * v0[2], xr[mm][bj][3] + g0.w * v0[3]);
            o[2] = pack2(xr[mm][bj][4] + g1.x * v1[0], xr[mm][bj][5] + g1.y * v1[1]);
            o[3] = pack2(xr[mm][bj][6] + g1.z * v1[2], xr[mm][bj][7] + g1.w * v1[3]);
            *(og + (size_t)(t0 + ai * 128 + m * 16) * 128 + jt * 32 + bj * 16 + wc * 4 + fq) = o;
          }
        asm volatile("" ::: "memory"); __builtin_amdgcn_sched_barrier(0);
      }
  }
};
DEV void phase_out8(const Params& p, int l, char* smem_full, int vid) {
  pg8::Gemm g; g.A = (const pg8::bf16_t*)p.ws; g.Bt = g.A; g.M = 0; g.N = 0; g.K = 1024;
  OutSched S; S.l = l; S.c = vid;
  OutEpi E; E.x0 = p.x_prompt; E.x1 = p.x_sample; E.xb_in = (const u16*)(p.out + OUT_Y);
  E.xb_out = (l == 0) ? (u16*)(p.out + OUT_Y) : (u16*)(p.ws + O_ZA);
  E.MOD = (const float*)(p.ws + O_MOD); E.l = l;
  pg8::gemm_phase<OutEpi, OutSched, false>((PG8_LAS unsigned char*)smem_full, g, S, E, nullptr);
}


struct QSched {
  int l, c;
  __device__ __forceinline__ bool next(int i, pg8::Unit& u) const {
    const int x = c >> 5, q = c & 31;
    if (q >= 12 || i >= 1) return false;
    u.pm = (int)(O_DQN / 196608) + 4 * x + (q & 3);
    u.pn = (int)(O_WUQ / 196608) + l * 3 + (q >> 2);
    return true;
  }
  __device__ __forceinline__ void a_ready(const pg8::Unit&) const {}
  __device__ __forceinline__ void done(const pg8::Unit&) const {}
};
struct QEpi {
  static constexpr bool PERM = true, AFTER_DRAIN = false, KEEP_ACC = false;
  char* ws; int l;
  __device__ __forceinline__ void operator()(const pg8::f32x4 (&acc)[2][2][4][2], const pg8::Unit& u, int wr, int wc, int fr, int fq) const {
    const int it = u.pm - (int)(O_DQN / 196608), jt = u.pn - (int)(O_WUQ / 196608) - l * 3;
    u16* QM = (u16*)(ws + O_QM);
#pragma unroll
    for (int ai = 0; ai < 2; ++ai)
#pragma unroll
      for (int m = 0; m < 4; ++m) {
        const int T = it * 256 + ai * 128 + wr * 64 + m * 16 + fr;
#pragma unroll
        for (int bj = 0; bj < 2; ++bj)
          st8bf(QM + (size_t)T * 768 + jt * 256 + bj * 128 + wc * 32 + 8 * fq, acc[ai][bj][m][0], acc[ai][bj][m][1]);
      }
  }
};
struct KvSched {
  int l, c, nt;
  __device__ __forceinline__ bool next(int i, pg8::Unit& u) const {
    const int x = c >> 5, q = c & 31, per = nt >> 3;
    if (q >= 4 * per || i >= 1) return false;
    const int it = per * x + (q % per), jt = q / per;
    const int wt = (int)(O_WUKV / 131072) + l * 4 + jt, ct = (int)(O_CKV / 131072) + it;
    if (jt < 2) { u.pm = ct; u.pn = wt; } else { u.pm = wt; u.pn = ct; }
    return true;
  }
  __device__ __forceinline__ void a_ready(const pg8::Unit&) const {}
  __device__ __forceinline__ void done(const pg8::Unit&) const {}
};
struct KvEpi {
  static constexpr bool PERM = true, AFTER_DRAIN = false, KEEP_ACC = false;
  char* ws; int l, S;
  __device__ __forceinline__ void operator()(const pg8::f32x4 (&acc)[2][2][4][2], const pg8::Unit& u, int wr, int wc, int fr, int fq) const {
    const int c0t = (int)(O_CKV / 131072), w0t = (int)(O_WUKV / 131072) + l * 4;
    if (u.pm >= c0t) {
      const int it = u.pm - c0t, jt = u.pn - w0t;
      u16* KNOPE = (u16*)(ws + O_KNOPE);
#pragma unroll
      for (int ai = 0; ai < 2; ++ai)
#pragma unroll
        for (int m = 0; m < 4; ++m) {
          const int R = it * 256 + ai * 128 + wr * 64 + m * 16 + fr;
#pragma unroll
          for (int bj = 0; bj < 2; ++bj)
            st8bf(KNOPE + (size_t)R * 512 + jt * 256 + bj * 128 + wc * 32 + 8 * fq, acc[ai][bj][m][0], acc[ai][bj][m][1]);
        }
    } else {
      const int jt = u.pm - w0t - 2, it = u.pn - c0t;
      u16* VTM = (u16*)(ws + O_VTM);
#pragma unroll
      for (int ai = 0; ai < 2; ++ai)
#pragma unroll
        for (int m = 0; m < 4; ++m) {
          const int ch = jt * 256 + ai * 128 + wr * 64 + m * 16 + fr;
#pragma unroll
          for (int bj = 0; bj < 2; ++bj) {
            const int row = it * 256 + bj * 128 + wc * 32 + 8 * fq;
            const int b = row / S, mm = row % S;
            st8bf(VTM + ((size_t)b * 512 + ch) * S + mm, acc[ai][bj][m][0], acc[ai][bj][m][1]);
          }
        }
    }
  }
};
DEV void phase_qkv8(const Params& p, int l, int s, char* smem_full, int vid) {
  {
    pg8::Gemm g; g.A = (const pg8::bf16_t*)p.ws; g.Bt = g.A; g.M = 0; g.N = 0; g.K = 384;
    QSched S; S.l = l; S.c = vid;
    QEpi E; E.ws = p.ws; E.l = l;
    pg8::gemm_phase<QEpi, QSched, false>((PG8_LAS unsigned char*)smem_full, g, S, E, nullptr);
  }
  {
    pg8::Gemm g; g.A = (const pg8::bf16_t*)p.ws; g.Bt = g.A; g.M = 0; g.N = 0; g.K = 256;
    KvSched S; S.l = l; S.c = vid; S.nt = (s == 0) ? 32 : 40;
    KvEpi E; E.ws = p.ws; E.l = l; E.S = (s == 0) ? 256 : 1280;
    pg8::gemm_phase<KvEpi, KvSched, false>((PG8_LAS unsigned char*)smem_full, g, S, E, nullptr);
  }
}

#define XB_TMO      128
#define XB_XCNT(j)  (256  + 64 * (j))
#define XB_XSUB(j)  (1280 + 64 * (j))
#define XB_XGEN(j)  (2304 + 64 * (j))
#define XB_TOP      3328
#define XB_TOPGEN   3392
#define XCD_BAR_WORDS 3456
#define XB_SPIN_CAP (1u << 18)
#define LAS __attribute__((address_space(3)))

__device__ __forceinline__ unsigned xb_ld(unsigned* p)              { return __hip_atomic_load(p, __ATOMIC_RELAXED, __HIP_MEMORY_SCOPE_AGENT); }
__device__ __forceinline__ unsigned xb_add(unsigned* p, unsigned v) { return __hip_atomic_fetch_add(p, v, __ATOMIC_RELAXED, __HIP_MEMORY_SCOPE_AGENT); }
__device__ __forceinline__ unsigned xb_xcc_id() { return (unsigned)__builtin_amdgcn_s_getreg((3 << 11) | 20) & 0xFu; }
#define XB_SPIN(cond, bar) do { unsigned _sp = 0; while (cond) { __builtin_amdgcn_s_sleep(1); \
    if ((++_sp & 255u) == 0u) { if (xb_ld(&(bar)[XB_TMO])) break; if (_sp > XB_SPIN_CAP) { atomicAdd(&(bar)[XB_TMO], 1u); break; } } } } while (0)

struct XcdBarrier {
    unsigned* bar; unsigned x;
    volatile LAS unsigned* st;
};

__device__ __forceinline__ XcdBarrier xcd_barrier_post(unsigned* bar, volatile LAS unsigned* st) {
    XcdBarrier b; b.bar = bar; b.x = xb_xcc_id(); b.st = st;
    if ((int)threadIdx.x == 0) st[2] = xb_add(&bar[XB_XCNT(b.x)], 1u);
    return b;
}
__device__ __forceinline__ void xcd_barrier_complete(unsigned* bar, unsigned x, unsigned& nloc, unsigned& nx) {
    const unsigned G = gridDim.x * gridDim.y * gridDim.z;
    unsigned sum, cnt, mine, sp = 0u;
    for (;;) {
        sum = 0u; cnt = 0u; mine = 0u;
#pragma unroll
        for (unsigned j = 0; j < 16; ++j) { const unsigned c = xb_ld(&bar[XB_XCNT(j)]); sum += c; cnt += (c > 0u) ? 1u : 0u; mine = (j == x) ? c : mine; }
        if (sum == G) break;
        __builtin_amdgcn_s_sleep(1);
        if ((++sp & 255u) == 0u) { if (xb_ld(&bar[XB_TMO])) break; if (sp > XB_SPIN_CAP) { atomicAdd(&bar[XB_TMO], 1u); break; } }
    }
    nloc = mine > 0u ? mine : 1u; nx = cnt > 0u ? cnt : 1u;
}

__device__ __forceinline__ void xcd_barrier(const XcdBarrier& b) {
    asm volatile("s_waitcnt vmcnt(0)" ::: "memory");
    __syncthreads();
    if ((int)threadIdx.x == 0) {
        unsigned* bar = b.bar;
        __builtin_amdgcn_s_waitcnt(0);
        unsigned nloc = b.st[0], nx = b.st[1];
        if (nloc == 0u) { xcd_barrier_complete(bar, b.x, nloc, nx); b.st[0] = nloc; b.st[1] = nx; }
        const unsigned old = xb_add(&bar[XB_XSUB(b.x)], 1u);
        const unsigned gen = old / nloc;
        if (old + 1u == (gen + 1u) * nloc) {
            __builtin_amdgcn_fence(__ATOMIC_RELEASE, "agent");
            asm volatile("s_waitcnt vmcnt(0)" ::: "memory");
            const unsigned og = xb_add(&bar[XB_TOP], 1u);
            const unsigned tg = og / nx;
            if (og + 1u == (tg + 1u) * nx) xb_add(&bar[XB_TOPGEN], 1u);
            else XB_SPIN(xb_ld(&bar[XB_TOPGEN]) == tg, bar);
            __builtin_amdgcn_fence(__ATOMIC_ACQUIRE, "agent");
            xb_add(&bar[XB_XGEN(b.x)], 1u);
            asm volatile("s_waitcnt vmcnt(0)" ::: "memory");
        } else {
            XB_SPIN(xb_ld(&bar[XB_XGEN(b.x)]) == gen, bar);
            __builtin_amdgcn_fence(__ATOMIC_ACQUIRE, "agent");
            asm volatile("s_waitcnt vmcnt(0)" ::: "memory");
        }
    }
    __syncthreads();
}


DEV void run_phase(const Params& p, int ph, int l, int s, char* smem, const int vid_, const int tid_, const int vb_, const int vg_) {
  switch (ph) {
    case 0: phase_prep(p, smem, tid_, vb_, vg_); break;
    case 1: phase_h(p, l, s, tid_, vb_, vg_); break;
    case 3: phase_rows(p, l, s, smem, tid_, vb_, vg_); break;
    case 4: phase_mix(p, l, s, smem, tid_, vb_, vg_, vid_); break;
    case 5: phase_mla(p, l, s, smem, tid_, vb_, vg_); break;
    default: phase_final(p, tid_, vb_, vg_); break;
  }
}

__global__ void __launch_bounds__(512, 2) mega_kernel(Params p) {
  extern __shared__ __attribute__((aligned(16))) unsigned char dyn_lds[];
  char* smem = (char*)dyn_lds;
  uint4& xb_words = *(uint4*)(dyn_lds + 131072);
  if (threadIdx.x == 0) xb_words = make_uint4(0u, 0u, 0u, 0u);
  __syncthreads();
  XcdBarrier xb = xcd_barrier_post((unsigned*)(p.ws + O_BAR), (volatile LAS unsigned*)(dyn_lds + 131072));
  if (p.ws == nullptr) cg::this_grid().sync();
  int vid = blockIdx.x;
#pragma unroll 1
  for (int step = 0; step < 24; step++) {
    int ph, l = 0, s = 0;
    bool also_h1 = false;
    if (step == 0) ph = 0;
    else if (step == 23) ph = 8;
    else {
      const int idx = step - 1; l = idx / 11; const int r = idx % 11;
      if (r < 5) { s = 0; ph = 1 + r; also_h1 = (r == 4); }
      else if (r < 9) { s = 1; ph = 2 + (r - 5); }
      else ph = 6 + (r - 9);
    }
    {
      const int tfull = tid_opaque();
      const int team = tfull >> 8;
      Params q = p;
      size_t zoff = 0;
      asm volatile("" : "+s"(zoff));
      q.ws = p.ws + zoff;
      q.out = p.out + zoff;
      if (ph == 4) { phase_qkv8(q, l, s, smem, vid); __syncthreads(); }
      if (ph == 2) phase_in8(q, l, s, smem, vid);
      else if (ph == 6) phase_merge8(q, l, smem, vid);
      else if (ph == 7) phase_out8(q, l, smem, vid);
      else run_phase(q, ph, l, s, smem + team * 65536, vid * 2 + team, tfull & 255, blockIdx.x * 2 + team, gridDim.x * 2);
      if (also_h1) run_phase(q, 1, l, 1, smem + team * 65536, vid * 2 + team, tfull & 255, blockIdx.x * 2 + team, gridDim.x * 2);
    }
    if (step < 23) xcd_barrier(xb);
    if (step == 0) {
      if (threadIdx.x == 0) {
        unsigned base = 0;
        for (unsigned j = 0; j < 16; ++j) { const unsigned c = xb_ld(&xb.bar[XB_XCNT(j)]); if (j < xb.x) base += c; }
        unsigned v = base + xb_words.z;
        if (v >= gridDim.x) v = blockIdx.x;
        xb_words.w = v;
      }
      __syncthreads();
      vid = __builtin_amdgcn_readfirstlane((int)xb_words.w);
    }
  }
}

extern "C" void kernel_launch(void* const* d_in, const int* in_sizes, int n_in, void* d_out, int out_size, void* d_ws, size_t ws_size,
                              hipStream_t stream) {
  Params p{};
  const float** pp = (const float**)&p;
  for (int i = 0; i < 22; i++) pp[i] = (const float*)d_in[i];
  p.out = (float*)d_out;
  p.ws = (char*)d_ws;
  static int grid_blocks = 0;
  if (!grid_blocks) {
    int dev = 0, cus = 0, per_cu = 0;
    hipGetDevice(&dev);
    hipDeviceGetAttribute(&cus, hipDeviceAttributeMultiprocessorCount, dev);
    hipFuncSetAttribute((const void*)mega_kernel, hipFuncAttributeMaxDynamicSharedMemorySize, (int)DYN_LDS);
    hipOccupancyMaxActiveBlocksPerMultiprocessor(&per_cu, mega_kernel, 512, DYN_LDS);
    if (per_cu > 1) per_cu = 1;
    grid_blocks = cus * per_cu;
    grid_blocks &= ~7;
    if (grid_blocks > 256) grid_blocks = 256;
  }
  hipMemsetAsync((char*)d_ws + O_BAR, 0, BAR_BYTES, stream);
  void* args[] = {&p};
  hipError_t e = hipLaunchCooperativeKernel((void*)mega_kernel, dim3(grid_blocks), dim3(512), args, DYN_LDS, stream);
  if (e != hipSuccess) fprintf(stderr, "cooperative launch failed: %s (grid %d)\n", hipGetErrorString(e), grid_blocks);
}
```

```cpp
#include <hip/hip_runtime.h>
#include <hip/hip_cooperative_groups.h>
#include <cstdio>
namespace cg = cooperative_groups;

typedef unsigned short u16;
typedef __attribute__((ext_vector_type(8))) __bf16 bf16x8;
typedef __attribute__((ext_vector_type(16))) float f32x16;
#define DEV __device__ __forceinline__
__device__ __forceinline__ int tid_opaque() { int t = threadIdx.x; asm volatile("" : "+v"(t)); return t; }
#define TIDX tid_

constexpr size_t A256(size_t x) { return (x + 255) & ~(size_t)255; }
constexpr size_t A512K(size_t x) { return (x + 524287) & ~(size_t)524287; }
constexpr size_t AUP(size_t x, size_t a) { return (x + a - 1) / a * a; }
constexpr size_t O_WIN = 0;
constexpr size_t O_H = O_WIN + A256(2ull * 7936 * 1024 * 2);
constexpr size_t O_WUQ = AUP(O_H + A256(8192ull * 1024 * 2), 196608);
constexpr size_t O_WUKV = AUP(O_WUQ + A256(2ull * 768 * 384 * 2), 131072);
constexpr size_t O_WBR = A512K(O_WUKV + A256(2ull * 1024 * 256 * 2));
constexpr size_t O_WOUT = A512K(O_WBR + A256(2ull * 3 * 1024 * 512 * 2));
constexpr size_t O_SGUW = O_WOUT + A256(2ull * 1024 * 1024 * 2);
constexpr size_t O_KC = O_SGUW + A256(2ull * 4 * 128 * 128 * 2);
constexpr size_t O_VTC = O_KC + A256(2ull * 8 * 256 * 512 * 2);
constexpr size_t O_MOD = O_VTC + A256(2ull * 8 * 256 * 512 * 2);
constexpr size_t O_QNA = A512K(O_MOD + A256(2ull * 9 * 3072 * 4));
constexpr size_t O_KNA = O_QNA + 8192ull * 512 * 2;
constexpr size_t O_VTNA = O_KNA + 8192ull * 512 * 2;
constexpr size_t O_GU = O_VTNA + 8192ull * 512 * 2;
constexpr size_t O_MG = O_QNA;
constexpr size_t O_ZA = A512K(O_GU + 8192ull * 512 * 2);
constexpr size_t O_ZB = O_ZA + 2 * 8192ull * 512 * 2;
constexpr size_t O_ZC = O_ZB + 2 * 8192ull * 512 * 2;
constexpr size_t O_GVT = O_ZC + 2 * 8192ull * 512 * 2;
constexpr size_t O_GATES = O_GVT + A256(8192ull * 512 * 2);
constexpr size_t O_CKV = AUP(O_GATES + A256(2ull * 8192 * 3072), 131072);
constexpr size_t O_KR = O_CKV + A256(10240ull * 256 * 2);
constexpr size_t O_KNOPE = O_KR + A256(10240ull * 32 * 2);
constexpr size_t O_VTM = O_KNOPE + A256(10240ull * 512 * 2);
constexpr size_t O_END = O_VTM + A256(10240ull * 512 * 2);
constexpr size_t O_DQN = AUP(O_END, 196608);
constexpr size_t O_DQ = O_DQN + A256(8192ull * 384 * 2);
constexpr size_t O_DKV = O_DQ + A256(8192ull * 384 * 2);
constexpr size_t O_KRF = O_DKV + A256(8192ull * 256 * 2);
constexpr size_t O_QM = O_DQ;
constexpr size_t O_BAR = O_QM + A256(8192ull * 768 * 2);
constexpr size_t BAR_BYTES = 16384;
constexpr size_t DYN_LDS = 131072 + 16;
static_assert(O_H % 524288 == 0 && O_WIN == 0 && O_WOUT % 524288 == 0, "K=1024 operands must be 256-row-tile aligned");
static_assert(O_WBR % 262144 == 0 && O_ZA % 262144 == 0 && O_ZB % 262144 == 0 && O_ZC % 262144 == 0, "K=512 operands must be 256-row-tile aligned");
static_assert(O_MG % 524288 == 0, "MERGED must be tile aligned");
static_assert(O_WUQ % 196608 == 0 && O_DQN % 196608 == 0 && O_WUKV % 131072 == 0 && O_CKV % 131072 == 0, "K=384 / K=256 operands must be 256-row-tile aligned");
static_assert(O_KRF + 8192ull * 32 * 4 <= O_BAR, "QM alias region must cover DQ/DKV/KRF");
static_assert(O_BAR + BAR_BYTES <= 256ull * 1024 * 1024, "workspace too large");

constexpr size_t OUT_Y = 0;
constexpr size_t OUT_SK = 16777216;
constexpr size_t OUT_SV = 25165824;
constexpr size_t OUT_CKV = 33554432;
constexpr size_t OUT_SKR = 37748736;

struct Params {
  const float *x_prompt, *x_sample, *cache_na_k, *cache_na_v, *cache_ckv, *cache_kr, *c, *c_ctx;
  const float *norm_g, *w_mod, *b_mod, *w_in, *na_rpb, *sgu_w, *sgu_b, *q_norm, *w_uq, *kv_norm, *w_ukv, *w_branch, *w_out, *final_g;
  float* out;
  char* ws;
};

DEV u16 f2bf(float f) { unsigned u = __float_as_uint(f); u += 0x7fffu + ((u >> 16) & 1u); return (u16)(u >> 16); }
DEV float bf2f(u16 h) { return __uint_as_float(((unsigned)h) << 16); }
typedef __attribute__((ext_vector_type(2))) __bf16 bf16x2;
DEV unsigned pack2(float a, float b) { bf16x2 v; v[0] = (__bf16)a; v[1] = (__bf16)b; return __builtin_bit_cast(unsigned, v); }
DEV void st4bf(u16* p, float a, float b, float c, float d) { uint2 v; v.x = pack2(a, b); v.y = pack2(c, d); *(uint2*)p = v; }
DEV void ld4bf(const u16* p, float& a, float& b, float& c, float& d) {
  uint2 v = *(const uint2*)p;
  a = __uint_as_float(v.x << 16); b = __uint_as_float(v.x & 0xffff0000u);
  c = __uint_as_float(v.y << 16); d = __uint_as_float(v.y & 0xffff0000u);
}
DEV size_t blk_off(int row, int k, int K) { return (size_t)(row >> 8) * 256 * K + (size_t)(k >> 6) * 16384 + (size_t)(row & 255) * 64 + (k & 63); }
DEV float rows_allmax(float v) {
  const unsigned u = __float_as_uint(v);
  const auto a = __builtin_amdgcn_permlane16_swap(u, u, false, false);
  const float m1 = fmaxf(__uint_as_float(a[0]), __uint_as_float(a[1]));
  const unsigned u2 = __float_as_uint(m1);
  const auto b = __builtin_amdgcn_permlane32_swap(u2, u2, false, false);
  return fmaxf(__uint_as_float(b[0]), __uint_as_float(b[1]));
}
DEV float wave_sum(float v) {
#pragma unroll
  for (int o = 32; o > 0; o >>= 1) v += __shfl_xor(v, o);
  return v;
}
DEV float sigmoid_f(float x) { return __builtin_amdgcn_rcpf(1.f + __expf(-x)); }
DEV float silu_f(float x) { return x * __builtin_amdgcn_rcpf(1.f + __expf(-x)); }
DEV float gelu_f(float x) { float u = 0.7978845608028654f * (x + 0.044715f * x * x * x); return x * __builtin_amdgcn_rcpf(1.f + __expf(-2.f * u)); }

DEV void gemm_mainloop_d1(const u16* P, int ldp, const u16* Q, int ldq, int K, char* smem, f32x16 (&acc)[2][2], const int tid_) {
  const int t = TIDX, lane = t & 63, w = t >> 6, wm = w >> 1, wn = w & 1;
  const int lr = t >> 3, ch = t & 7;
  const u16* pg = P + (size_t)lr * ldp + ch * 8;
  const u16* qg = Q + (size_t)lr * ldq + ch * 8;
  const size_t sp = (size_t)32 * ldp, sq = (size_t)32 * ldq;
  const int soff = lr * 128 + ((ch ^ ((t >> 4) & 7)) << 4);
  const int sw = (lane >> 1) & 7;
  const int prow = (wm * 64 + (lane & 31)) * 128;
  const int qrow = (wn * 64 + (lane & 31)) * 128;
  uint4 p0, p1, p2, p3, q0, q1, q2, q3;
#define GLOAD(k0) do { p0 = *(const uint4*)(pg + (k0)); p1 = *(const uint4*)(pg + sp + (k0)); p2 = *(const uint4*)(pg + 2 * sp + (k0)); p3 = *(const uint4*)(pg + 3 * sp + (k0)); \
                       q0 = *(const uint4*)(qg + (k0)); q1 = *(const uint4*)(qg + sq + (k0)); q2 = *(const uint4*)(qg + 2 * sq + (k0)); q3 = *(const uint4*)(qg + 3 * sq + (k0)); } while (0)
#define SWRITE(base) do { char* b_ = (base) + soff; *(uint4*)(b_) = p0; *(uint4*)(b_ + 4096) = p1; *(uint4*)(b_ + 8192) = p2; *(uint4*)(b_ + 12288) = p3; \
                          *(uint4*)(b_ + 16384) = q0; *(uint4*)(b_ + 20480) = q1; *(uint4*)(b_ + 24576) = q2; *(uint4*)(b_ + 28672) = q3; } while (0)
  GLOAD(0);
  SWRITE(smem);
  __syncthreads();
  const int nk = K >> 6;
  for (int kt = 0; kt < nk; kt++) {
    const int k0 = min(kt + 1, nk - 1) << 6;
    GLOAD(k0);
    asm volatile("" ::: "memory"); __builtin_amdgcn_sched_barrier(0);
    const char* bP = smem + (kt & 1) * 32768;
    const char* bQ = bP + 16384;
#pragma unroll
    for (int s = 0; s < 4; s++) {
      const int co = ((s * 2 + (lane >> 5)) ^ sw) << 4;
      const bf16x8 pf0 = *(const bf16x8*)(bP + prow + co), pf1 = *(const bf16x8*)(bP + prow + 4096 + co);
      const bf16x8 qf0 = *(const bf16x8*)(bQ + qrow + co), qf1 = *(const bf16x8*)(bQ + qrow + 4096 + co);
      acc[0][0] = __builtin_amdgcn_mfma_f32_32x32x16_bf16(qf0, pf0, acc[0][0], 0, 0, 0);
      acc[0][1] = __builtin_amdgcn_mfma_f32_32x32x16_bf16(qf1, pf0, acc[0][1], 0, 0, 0);
      acc[1][0] = __builtin_amdgcn_mfma_f32_32x32x16_bf16(qf0, pf1, acc[1][0], 0, 0, 0);
      acc[1][1] = __builtin_amdgcn_mfma_f32_32x32x16_bf16(qf1, pf1, acc[1][1], 0, 0, 0);
    }
    asm volatile("" ::: "memory"); __builtin_amdgcn_sched_barrier(0);
    SWRITE(smem + ((kt + 1) & 1) * 32768);
    __syncthreads();
  }
#undef GLOAD
#undef SWRITE
}

DEV void acc_zero(f32x16 (&acc)[2][2]) {
#pragma unroll
  for (int a = 0; a < 2; a++)
#pragma unroll
    for (int b = 0; b < 2; b++)
#pragma unroll
      for (int r = 0; r < 16; r++) acc[a][b][r] = 0.f;
}

template <class F>
DEV void epi_foreach(const f32x16 (&acc)[2][2], const int tid_, F f) {
  const int lane = TIDX & 63, w = TIDX >> 6, wm = w >> 1, wn = w & 1;
#pragma unroll
  for (int a = 0; a < 2; a++)
#pragma unroll
    for (int b = 0; b < 2; b++)
#pragma unroll
      for (int rg = 0; rg < 4; rg++) {
        const int i = wm * 64 + a * 32 + (lane & 31);
        const int j = wn * 64 + b * 32 + rg * 8 + (lane >> 5) * 4;
        f(i, j, acc[a][b][rg * 4 + 0], acc[a][b][rg * 4 + 1], acc[a][b][rg * 4 + 2], acc[a][b][rg * 4 + 3]);
      }
}

DEV void tile_map(int li, int MPX, int xcd, int& m, int& n) {
  const int g = MPX * 8;
  const int ng = li / g, wv = li % g;
  m = xcd * MPX + (wv % MPX);
  n = ng * 8 + (wv / MPX);
}

DEV void tconv_tile(const float* __restrict__ src, int ldsrc, int k0, int n0, u16* __restrict__ dst, int lddst, int drow0, float* tile, const int tid_, const int blkK = 0) {
  const int t = TIDX;
  {
    const int n = t & 31, kk = t >> 5;
    float v[16];
#pragma unroll
    for (int p = 0; p < 16; p++) v[p] = src[(size_t)(k0 + kk + p * 8) * ldsrc + n0 + n];
#pragma unroll
    for (int p = 0; p < 16; p++) tile[(kk + p * 8) * 33 + n] = v[p];
  }
  __syncthreads();
  {
    const int k2 = (t & 63) * 2, nn = t >> 6;
#pragma unroll
    for (int p = 0; p < 8; p++) {
      const int n2 = nn + p * 4;
      u16* dp = blkK ? (dst + blk_off(drow0 + n2, k0 + k2, blkK)) : (dst + (size_t)(drow0 + n2) * lddst + k0 + k2);
      *(unsigned*)dp = pack2(tile[k2 * 33 + n2], tile[(k2 + 1) * 33 + n2]);
    }
  }
  __syncthreads();
}

DEV void phase_prep(const Params& p, char* smem, const int tid_, const int vb_, const int vg_) {
  const int t = TIDX;
  constexpr int N_MOD = 192;
  constexpr int T_IN = 1960, T_UQ = 72, T_UKV = 64, T_BR = 384, T_OUT = 256, T_CV = 256;
  constexpr int T_L = T_IN + T_UQ + T_UKV + T_BR + T_OUT + T_CV;
  constexpr int N_TC = 2 * T_L;
  constexpr int N_SG = 64, N_KC = 1024;
  constexpr int TOTAL = N_MOD + N_TC + N_SG + N_KC;
  float* MOD = (float*)(p.ws + O_MOD);
  for (int item = vb_; item < TOTAL; item += vg_) {
    if (item < N_MOD) {
      const int l = item / 96, e0 = (item % 96) * 32;
      float* sc = (float*)smem;
      {
        float cv[36];
#pragma unroll
        for (int i = 0; i < 36; i++) { const int idx = t + i * 256; const int c9 = idx >> 10, d = idx & 1023; cv[i] = (c9 == 0) ? p.c_ctx[d] : p.c[(c9 - 1) * 1024 + d]; }
#pragma unroll
        for (int i = 0; i < 36; i++) sc[t + i * 256] = silu_f(cv[i]);
      }
      __syncthreads();
      const int col = t & 31, slab = t >> 5;
      float a[9];
#pragma unroll
      for (int c9 = 0; c9 < 9; c9++) a[c9] = 0.f;
      const float* wp = p.w_mod + ((size_t)l * 1024 + slab * 128) * 3072 + e0 + col;
#pragma unroll 1
      for (int d0 = 0; d0 < 128; d0 += 16) {
        float wv[16];
#pragma unroll
        for (int j = 0; j < 16; j++) wv[j] = wp[(size_t)(d0 + j) * 3072];
#pragma unroll
        for (int j = 0; j < 16; j++) {
          const int d = slab * 128 + d0 + j;
#pragma unroll
          for (int c9 = 0; c9 < 9; c9++) a[c9] += sc[c9 * 1024 + d] * wv[j];
        }
      }
      float* red = sc + 9216;
#pragma unroll
      for (int c9 = 0; c9 < 9; c9++) red[(slab * 9 + c9) * 32 + col] = a[c9];
      __syncthreads();
      for (int idx = t; idx < 288; idx += 256) {
        const int c9 = idx >> 5, cc = idx & 31;
        float sum = 0.f;
#pragma unroll
        for (int sl = 0; sl < 8; sl++) sum += red[(sl * 9 + c9) * 32 + cc];
        MOD[(l * 9 + c9) * 3072 + e0 + cc] = sum + p.b_mod[l * 3072 + e0 + cc];
      }
      __syncthreads();
    } else if (item < N_MOD + N_TC) {
      const int ti = item - N_MOD;
      const int l = ti / T_L;
      int r = ti % T_L;
      const float* src; u16* dst; int ldsrc, lddst, k0, n0, drow, blkK = 0;
      if (r < T_IN) {
        const int nt = r >> 3, kt = r & 7;
        src = p.w_in + (size_t)l * 1024 * 7840; ldsrc = 7840; k0 = kt * 128; n0 = nt * 32;
        dst = (u16*)(p.ws + O_WIN) + (size_t)l * 7936 * 1024; lddst = 1024; blkK = 1024;
        drow = (n0 < 4224) ? n0 : (n0 == 4224 ? 7808 : n0 - 32);
      } else if ((r -= T_IN) < T_UQ) {
        const int nt = r / 3, kt = r % 3;
        src = p.w_uq + (size_t)l * 384 * 768; ldsrc = 768; k0 = kt * 128; n0 = nt * 32;
        dst = (u16*)(p.ws + O_WUQ) + (size_t)l * 768 * 384; lddst = 384; drow = n0; blkK = 384;
      } else if ((r -= T_UQ) < T_UKV) {
        const int nt = r >> 1, kt = r & 1;
        src = p.w_ukv + (size_t)l * 256 * 1024; ldsrc = 1024; k0 = kt * 128; n0 = nt * 32;
        dst = (u16*)(p.ws + O_WUKV) + (size_t)l * 1024 * 256; lddst = 256;
        const int hh = n0 >> 7, jj = n0 & 127;
        drow = (jj < 64) ? (hh * 64 + jj) : (512 + hh * 64 + jj - 64);
        blkK = 256;
      } else if ((r -= T_UKV) < T_BR) {
        const int kb = r >> 7, r2 = r & 127;
        const int nt = r2 >> 2, kt = r2 & 3;
        src = p.w_branch + (size_t)(l * 3 + kb) * 512 * 1024; ldsrc = 1024; k0 = kt * 128; n0 = nt * 32;
        dst = (u16*)(p.ws + O_WBR) + (size_t)(l * 3 + kb) * 1024 * 512; lddst = 512; drow = n0; blkK = 512;
      } else if ((r -= T_BR) < T_OUT) {
        const int nt = r >> 3, kt = r & 7;
        src = p.w_out + (size_t)l * 1024 * 1024; ldsrc = 1024; k0 = kt * 128; n0 = nt * 32;
        dst = (u16*)(p.ws + O_WOUT) + (size_t)l * 1024 * 1024; lddst = 1024; drow = n0; blkK = 1024;
      } else {
        r -= T_OUT;
        const int b = r >> 5, r2 = r & 31;
        const int nt = r2 >> 1, kt = r2 & 1;
        src = p.cache_na_v + (size_t)(b * 2 + l) * 256 * 512; ldsrc = 512; k0 = kt * 128; n0 = nt * 32;
        dst = (u16*)(p.ws + O_VTC) + (size_t)(l * 8 + b) * 512 * 256; lddst = 256; drow = n0;
      }
      tconv_tile(src, ldsrc, k0, n0, dst, lddst, drow, (float*)smem, tid_, blkK);
    } else if (item < N_MOD + N_TC + N_SG) {
      const int it = item - N_MOD - N_TC;
      const size_t e = (size_t)it * 2048 + t * 8;
      const float4 a = *(const float4*)(p.sgu_w + e), b = *(const float4*)(p.sgu_w + e + 4);
      u16* d = (u16*)(p.ws + O_SGUW) + e;
      st4bf(d, a.x, a.y, a.z, a.w); st4bf(d + 4, b.x, b.y, b.z, b.w);
    } else {
      const int it = item - N_MOD - N_TC - N_SG;
      const size_t e = (size_t)it * 2048 + t * 8;
      const int l = (int)(e >> 20), b = (int)(e >> 17) & 7; const size_t rest = e & 131071;
      const float* s = p.cache_na_k + ((size_t)(b * 2 + l) << 17) + rest;
      const float4 a = *(const float4*)s, bb = *(const float4*)(s + 4);
      u16* d = (u16*)(p.ws + O_KC) + e;
      st4bf(d, a.x, a.y, a.z, a.w); st4bf(d + 4, bb.x, bb.y, bb.z, bb.w);
    }
  }
}

DEV const float* xrow_in(const Params& p, int l, int s, int tl) {
  if (l == 0) return (s == 0 ? p.x_prompt : p.x_sample) + (size_t)tl * 1024;
  return p.out + OUT_Y + (size_t)s * 8388608 + (size_t)tl * 1024;
}
DEV int cond_idx(int s, int tl) { return s == 0 ? 0 : 1 + (tl >> 10); }

DEV void phase_h(const Params& p, int l, int s, const int tid_, const int vb_, const int vg_) {
  const int lane = TIDX & 63, wave = TIDX >> 6;
  u16* H = (u16*)(p.ws + O_H);
  const float* MOD = (const float*)(p.ws + O_MOD);
  for (int item = vb_; item < 512; item += vg_) {
    const int tl0 = item * 16 + wave * 4;
    const float* x = xrow_in(p, l, s, tl0);
    const float* mod = MOD + (size_t)(l * 9 + cond_idx(s, tl0)) * 3072;
    float4 v[4][4];
#pragma unroll
    for (int r = 0; r < 4; r++)
#pragma unroll
      for (int i = 0; i < 4; i++) {
        if (l == 0) v[r][i] = *(const float4*)(x + (size_t)r * 1024 + i * 256 + lane * 4);
        else {
          const uint2 w = *(const uint2*)((const u16*)(p.out + OUT_Y) + (size_t)(s * 8192 + tl0 + r) * 1024 + i * 256 + lane * 4);
          v[r][i] = make_float4(__uint_as_float(w.x << 16), __uint_as_float(w.x & 0xffff0000u), __uint_as_float(w.y << 16), __uint_as_float(w.y & 0xffff0000u));
        }
      }
    float4 g[4], sh[4], sc[4];
#pragma unroll
    for (int i = 0; i < 4; i++) {
      const int col = i * 256 + lane * 4;
      g[i] = *(const float4*)(p.norm_g + l * 1024 + col);
      sh[i] = *(const float4*)(mod + col);
      sc[i] = *(const float4*)(mod + 1024 + col);
    }
    asm volatile("" ::: "memory");
    float ss[4];
#pragma unroll
    for (int r = 0; r < 4; r++) {
      ss[r] = 0.f;
#pragma unroll
      for (int i = 0; i < 4; i++) ss[r] += v[r][i].x * v[r][i].x + v[r][i].y * v[r][i].y + v[r][i].z * v[r][i].z + v[r][i].w * v[r][i].w;
    }
#pragma unroll
    for (int o = 32; o > 0; o >>= 1) {
#pragma unroll
      for (int r = 0; r < 4; r++) ss[r] += __shfl_xor(ss[r], o);
    }
#pragma unroll
    for (int r = 0; r < 4; r++) {
      const float rstd = rsqrtf(ss[r] * (1.f / 1024.f) + 1e-6f);
#pragma unroll
      for (int i = 0; i < 4; i++) {
        const int col = i * 256 + lane * 4;
        st4bf(H + blk_off(tl0 + r, col, 1024), v[r][i].x * rstd * g[i].x * (1.f + sc[i].x) + sh[i].x, v[r][i].y * rstd * g[i].y * (1.f + sc[i].y) + sh[i].y,
              v[r][i].z * rstd * g[i].z * (1.f + sc[i].z) + sh[i].z, v[r][i].w * rstd * g[i].w * (1.f + sc[i].w) + sh[i].w);
      }
    }
  }
}

DEV void phase_rows(const Params& p, int l, int s, char* smem, const int tid_, const int vb_, const int vg_) {
  const int t = TIDX, lane = t & 63, wave = t >> 6;
  const u16* DQ = (const u16*)(p.ws + O_DQ); const u16* DKV = (const u16*)(p.ws + O_DKV); const float* KRF = (const float*)(p.ws + O_KRF);
  u16* CKV = (u16*)(p.ws + O_CKV); u16* KR = (u16*)(p.ws + O_KR); u16* GVT = (u16*)(p.ws + O_GVT);
  const int n_row = 512, n_ln = 256, n_cache = (s == 1) ? 512 : 0;
  const int total = n_row + n_ln + n_cache;
  for (int item = vb_; item < total; item += vg_) {
    if (item < n_row) {
      const int tl0 = item * 16 + wave * 4;
      unsigned dqw[4][3]; uint2 dkw[4]; float k1[4], k2[4];
#pragma unroll
      for (int r = 0; r < 4; r++) {
        const unsigned* rp = (const unsigned*)(DQ + (size_t)(tl0 + r) * 384) + lane * 3;
        dqw[r][0] = rp[0]; dqw[r][1] = rp[1]; dqw[r][2] = rp[2];
        dkw[r] = *(const uint2*)(DKV + (size_t)(tl0 + r) * 256 + lane * 4);
        k1[r] = KRF[(size_t)(tl0 + r) * 32 + (lane & 15)]; k2[r] = KRF[(size_t)(tl0 + r) * 32 + 16 + (lane & 15)];
      }
      const float2* gq = (const float2*)(p.q_norm + l * 384) + lane * 3;
      const float2 g0 = gq[0], g1 = gq[1], g2 = gq[2];
      const float4 gk = *(const float4*)(p.kv_norm + l * 256 + lane * 4);
      asm volatile("" ::: "memory");
      float qv[4][6], kv4[4][4], sq[4], sk[4];
#pragma unroll
      for (int r = 0; r < 4; r++) {
#pragma unroll
        for (int j = 0; j < 3; j++) { qv[r][2 * j] = __uint_as_float(dqw[r][j] << 16); qv[r][2 * j + 1] = __uint_as_float(dqw[r][j] & 0xffff0000u); }
        kv4[r][0] = __uint_as_float(dkw[r].x << 16); kv4[r][1] = __uint_as_float(dkw[r].x & 0xffff0000u);
        kv4[r][2] = __uint_as_float(dkw[r].y << 16); kv4[r][3] = __uint_as_float(dkw[r].y & 0xffff0000u);
        sq[r] = 0.f; sk[r] = 0.f;
#pragma unroll
        for (int j = 0; j < 6; j++) sq[r] += qv[r][j] * qv[r][j];
#pragma unroll
        for (int j = 0; j < 4; j++) sk[r] += kv4[r][j] * kv4[r][j];
      }
#pragma unroll
      for (int o = 32; o > 0; o >>= 1) {
#pragma unroll
        for (int r = 0; r < 4; r++) { sq[r] += __shfl_xor(sq[r], o); sk[r] += __shfl_xor(sk[r], o); }
      }
#pragma unroll
      for (int r = 0; r < 4; r++) {
        const int tl = tl0 + r;
        const float rq = rsqrtf(sq[r] * (1.f / 384.f) + 1e-6f);
        u16* dqn = (u16*)(p.ws + O_DQN);
        *(unsigned*)(dqn + blk_off(tl, lane * 6 + 0, 384)) = pack2(qv[r][0] * rq * g0.x, qv[r][1] * rq * g0.y);
        *(unsigned*)(dqn + blk_off(tl, lane * 6 + 2, 384)) = pack2(qv[r][2] * rq * g1.x, qv[r][3] * rq * g1.y);
        *(unsigned*)(dqn + blk_off(tl, lane * 6 + 4, 384)) = pack2(qv[r][4] * rq * g2.x, qv[r][5] * rq * g2.y);
        const float rk = rsqrtf(sk[r] * (1.f / 256.f) + 1e-6f);
        const float a = kv4[r][0] * rk * gk.x, b = kv4[r][1] * rk * gk.y, c = kv4[r][2] * rk * gk.z, d = kv4[r][3] * rk * gk.w;
        const int row = (s == 0) ? tl : ((tl >> 10) * 1280 + 256 + (tl & 1023));
        st4bf(CKV + blk_off(row, lane * 4, 256), a, b, c, d);
        if (s == 0) {
          const int bb = tl >> 8, sqi = tl & 255;
          *(float4*)(p.out + OUT_CKV + ((size_t)(bb * 2 + l) * 256 + sqi) * 256 + lane * 4) = make_float4(a, b, c, d);
        }
        if (lane < 16) {
          const float x1 = k1[r], x2 = k2[r];
          if (s == 0) {
            KR[(size_t)tl * 32 + lane] = f2bf(x1);
            KR[(size_t)tl * 32 + 16 + lane] = f2bf(x2);
          } else {
            const int nn = tl & 1023;
            const float pos = (lane < 8) ? (float)(nn >> 6) : (float)(nn & 63);
            const float inv = __builtin_amdgcn_exp2f(-(float)(lane & 7) * (0.125f * 13.287712379549449f));
            const float ang = pos * inv;
            const float cs = __cosf(ang), sn = __sinf(ang);
            const int row2 = (tl >> 10) * 1280 + 256 + nn;
            KR[(size_t)row2 * 32 + lane] = f2bf(x1 * cs - x2 * sn);
            KR[(size_t)row2 * 32 + 16 + lane] = f2bf(x1 * sn + x2 * cs);
          }
        }
      }
    } else if (item < n_row + n_ln) {
      const int it = item - n_row, chunk = it >> 2, slab = it & 3;
      u16* g = GVT + (size_t)chunk * 512 * 128 + slab * 32;
      const int q = t & 31, part = t >> 5;
      float v[64];
      float sum = 0.f, sq = 0.f;
#pragma unroll
      for (int c = 0; c < 64; c++) { v[c] = gelu_f(bf2f(g[(part * 64 + c) * 128 + q])); sum += v[c]; sq += v[c] * v[c]; }
      float* red = (float*)smem;
      red[(part * 2 + 0) * 32 + q] = sum; red[(part * 2 + 1) * 32 + q] = sq;
      __syncthreads();
      sum = 0.f; sq = 0.f;
#pragma unroll
      for (int pp = 0; pp < 8; pp++) { sum += red[(pp * 2 + 0) * 32 + q]; sq += red[(pp * 2 + 1) * 32 + q]; }
      const float mu = sum * (1.f / 512.f);
      const float var = fmaxf(sq * (1.f / 512.f) - mu * mu, 0.f);
      const float rstd = rsqrtf(var + 1e-6f);
#pragma unroll
      for (int c = 0; c < 64; c++) g[(part * 64 + c) * 128 + q] = f2bf((v[c] - mu) * rstd);
      __syncthreads();
    } else {
      const int rowi = (item - n_row - n_ln) * 4 + wave;
      const int b = rowi >> 8, m = rowi & 255;
      const float4 a = *(const float4*)(p.cache_ckv + ((size_t)(b * 2 + l) * 256 + m) * 256 + lane * 4);
      st4bf(CKV + blk_off(b * 1280 + m, lane * 4, 256), a.x, a.y, a.z, a.w);
      if (lane < 32) KR[(size_t)(b * 1280 + m) * 32 + lane] = f2bf(p.cache_kr[((size_t)(b * 2 + l) * 256 + m) * 32 + lane]);
    }
  }
}

typedef __attribute__((ext_vector_type(4))) float f32x4;
struct AttnSrc { const u16* k; const u16* kr; const u16* vt; int vts; };
struct AttnState { f32x4 o[4]; float mx, ls; };
constexpr int ATT_VST = 136;

struct AttnRegs { uint4 k0, k1, k2, v0, v1; };
template <int DQK>
DEV void attn_gload(const AttnSrc& src, AttnRegs& r, int t) {
  const int row = t >> 3, c8 = (t & 7) * 8;
  r.k0 = *(const uint4*)(src.k + (size_t)row * 512 + c8);
  r.k1 = *(const uint4*)(src.k + (size_t)(row + 32) * 512 + c8);
  r.v0 = *(const uint4*)(src.vt + (size_t)row * src.vts + c8);
  r.v1 = *(const uint4*)(src.vt + (size_t)(row + 32) * src.vts + c8);
  if (DQK == 96) r.k2 = *(const uint4*)(src.kr + (size_t)(t >> 2) * 32 + (t & 3) * 8);
}
template <int DQK>
DEV void attn_swrite(char* buf, const AttnRegs& r, int t) {
  constexpr int KST = DQK * 2 + 16;
  const int row = t >> 3, c16 = (t & 7) * 16;
  char* vb = buf + 64 * KST;
  *(uint4*)(buf + row * KST + c16) = make_uint4(r.k0.x, r.k0.y, r.k0.z, r.k0.w);
  *(uint4*)(buf + (row + 32) * KST + c16) = make_uint4(r.k1.x, r.k1.y, r.k1.z, r.k1.w);
  char* vp = vb + row * ATT_VST + c16;
  *(uint2*)vp = make_uint2(r.v0.x, r.v0.y);
  *(uint2*)(vp + 8) = make_uint2(r.v0.z, r.v0.w);
  vp += 32 * ATT_VST;
  *(uint2*)vp = make_uint2(r.v1.x, r.v1.y);
  *(uint2*)(vp + 8) = make_uint2(r.v1.z, r.v1.w);
  if (DQK == 96) *(uint4*)(buf + (t >> 2) * KST + 128 + (t & 3) * 16) = make_uint4(r.k2.x, r.k2.y, r.k2.z, r.k2.w);
}

template <int DQK, int NT, bool LOCAL>
DEV void attn_compute(const char* buf, const bf16x8 qf0, const bf16x8 qf1, const bf16x8 qf2, AttnState& st, float scale, int koff0, const float* biasrow, int qc, int wlo, const int tid_) {
  constexpr int KST = DQK * 2 + 16;
  const int lane = TIDX & 63, r16 = lane & 15, g = lane >> 4;
  const char* vb = buf + 64 * KST;
  f32x4 s[NT];
#pragma unroll
  for (int t = 0; t < NT; t++) {
    s[t] = f32x4{0.f, 0.f, 0.f, 0.f};
    const char* kp = buf + (koff0 + t * 16 + r16) * KST + g * 16;
    s[t] = __builtin_amdgcn_mfma_f32_16x16x32_bf16(*(const bf16x8*)(kp), qf0, s[t], 0, 0, 0);
    s[t] = __builtin_amdgcn_mfma_f32_16x16x32_bf16(*(const bf16x8*)(kp + 64), qf1, s[t], 0, 0, 0);
    if (DQK == 96) s[t] = __builtin_amdgcn_mfma_f32_16x16x32_bf16(*(const bf16x8*)(kp + 128), qf2, s[t], 0, 0, 0);
  }
  float mloc = st.mx;
#pragma unroll
  for (int t = 0; t < NT; t++)
#pragma unroll
    for (int e = 0; e < 4; e++) {
      float v = s[t][e] * scale;
      if (LOCAL) {
        const int kc = koff0 + t * 16 + 4 * g + e;
        const int bi = min(max(kc - qc + 15, 0), 30);
        const float bv = biasrow[bi] * 1.4426950408889634f;
        v = (kc >= wlo && kc < wlo + 16) ? v + bv : -1e30f;
      }
      s[t][e] = v;
      mloc = fmaxf(mloc, v);
    }
  mloc = rows_allmax(mloc);
  const float alpha = __builtin_amdgcn_exp2f(st.mx - mloc);
  st.mx = mloc;
  float psum = 0.f;
#pragma unroll
  for (int t = 0; t < NT; t++)
#pragma unroll
    for (int e = 0; e < 4; e++) {
      const float pv = __builtin_amdgcn_exp2f(s[t][e] - mloc);
      s[t][e] = pv;
      psum += pv;
    }
  st.ls = st.ls * alpha + psum;
#pragma unroll
  for (int dt = 0; dt < 4; dt++) st.o[dt] *= alpha;
#pragma unroll
  for (int kb = 0; kb < NT / 2; kb++) {
    bf16x8 pf;
#pragma unroll
    for (int e = 0; e < 4; e++) { pf[e] = (__bf16)s[2 * kb][e]; pf[4 + e] = (__bf16)s[2 * kb + 1][e]; }
#pragma unroll
    for (int dt = 0; dt < 4; dt++) {
      const char* vp = vb + (dt * 16 + r16) * ATT_VST + (koff0 + 4 * g) * 2 + kb * 64;
      const uint2 a0 = *(const uint2*)vp, a1 = *(const uint2*)(vp + 32);
      const uint4 av = make_uint4(a0.x, a0.y, a1.x, a1.y);
      st.o[dt] = __builtin_amdgcn_mfma_f32_16x16x32_bf16(__builtin_bit_cast(bf16x8, av), pf, st.o[dt], 0, 0, 0);
    }
  }
}

template <int MODE>
DEV void attn_item(const Params& p, int l, int it, char* smem, const int tid_) {
  constexpr int DQK = (MODE >= 2) ? 96 : 64;
  constexpr int KST = DQK * 2 + 16;
  constexpr int BUFSZ = 64 * KST + 64 * ATT_VST;
  const int t = TIDX, lane = t & 63, w = t >> 6, r16 = lane & 15, g = lane >> 4;
  constexpr int QB = (MODE >= 2) ? 2 : 1;
  int b, h, tl0, nst, r = 0;
  if (MODE == 0) { b = it >> 5; h = (it >> 2) & 7; tl0 = b * 256 + (it & 3) * 64; nst = 4; }
  else if (MODE == 1) { b = it >> 7; h = (it >> 4) & 7; r = it & 15; tl0 = b * 1024 + r * 64; nst = 12; }
  else if (MODE == 2) { b = it >> 4; h = (it >> 1) & 7; tl0 = b * 256 + (it & 1) * 128; nst = 4; }
  else { b = it >> 6; h = (it >> 3) & 7; tl0 = b * 1024 + (it & 7) * 128; nst = 20; }
  const int tl = tl0 + w * (16 * QB) + r16;
  const int wr0 = min(max(r - 4, 0), 8);
  const u16* KNA = (const u16*)(p.ws + O_KNA); const u16* VTNA = (const u16*)(p.ws + O_VTNA);
  const u16* KC = (const u16*)(p.ws + O_KC); const u16* VTC = (const u16*)(p.ws + O_VTC);
  const u16* KNOPE = (const u16*)(p.ws + O_KNOPE); const u16* KR = (const u16*)(p.ws + O_KR); const u16* VTM = (const u16*)(p.ws + O_VTM);
  auto get_src = [&](int st) {
    AttnSrc s;
    s.kr = nullptr;
    if (MODE == 0) {
      s.k = KNA + (size_t)(b * 256 + st * 64) * 512 + h * 64; s.vt = VTNA + (size_t)(b * 512 + h * 64) * 256 + st * 64; s.vts = 256;
    } else if (MODE == 1) {
      if (st < 8) {
        const int krow = wr0 + st;
        s.k = KNA + (size_t)(b * 1024 + krow * 64) * 512 + h * 64; s.vt = VTNA + (size_t)(b * 512 + h * 64) * 1024 + krow * 64; s.vts = 1024;
      } else {
        const int m0 = (st - 8) * 64;
        s.k = KC + ((size_t)(l * 8 + b) * 256 + m0) * 512 + h * 64; s.vt = VTC + ((size_t)(l * 8 + b) * 512 + h * 64) * 256 + m0; s.vts = 256;
      }
    } else if (MODE == 2) {
      s.k = KNOPE + (size_t)(b * 256 + st * 64) * 512 + h * 64; s.kr = KR + (size_t)(b * 256 + st * 64) * 32;
      s.vt = VTM + (size_t)(b * 512 + h * 64) * 256 + st * 64; s.vts = 256;
    } else {
      s.k = KNOPE + (size_t)(b * 1280 + st * 64) * 512 + h * 64; s.kr = KR + (size_t)(b * 1280 + st * 64) * 32;
      s.vt = VTM + (size_t)(b * 512 + h * 64) * 1280 + st * 64; s.vts = 1280;
    }
    return s;
  };
  AttnRegs rg;
  rg.k2 = make_uint4(0, 0, 0, 0);
  {
    const AttnSrc s0 = get_src(0);
    attn_gload<DQK>(s0, rg, t);
  }
  asm volatile("" ::: "memory");
  auto load_q = [&](int tl, bf16x8& qf0, bf16x8& qf1, bf16x8& qf2) {
  if (MODE < 2) {
    const u16* qp = (const u16*)(p.ws + O_QNA) + (size_t)tl * 512 + h * 64 + 8 * g;
    qf0 = *(const bf16x8*)qp; qf1 = *(const bf16x8*)(qp + 32); qf2 = qf0;
  } else {
    const u16* qp = (const u16*)(p.ws + O_QM) + (size_t)tl * 768 + h * 96;
    qf0 = *(const bf16x8*)(qp + 8 * g); qf1 = *(const bf16x8*)(qp + 32 + 8 * g);
    if (MODE == 2) {
      qf2 = *(const bf16x8*)(qp + 64 + 8 * g);
    } else {
      const uint4 own = *(const uint4*)(qp + 64 + 8 * g), oth = *(const uint4*)(qp + 64 + 8 * (g ^ 2));
      const unsigned ow[4] = {own.x, own.y, own.z, own.w}, ot[4] = {oth.x, oth.y, oth.z, oth.w};
      const int nn = tl & 1023;
      const float pos = (g & 1) ? (float)(nn & 63) : (float)(nn >> 6);
      bf16x8 qr;
#pragma unroll
      for (int e = 0; e < 8; e++) {
        const float a = __uint_as_float((e & 1) ? (ow[e >> 1] & 0xffff0000u) : (ow[e >> 1] << 16));
        const float c = __uint_as_float((e & 1) ? (ot[e >> 1] & 0xffff0000u) : (ot[e >> 1] << 16));
        const float inv = powf(10000.f, -(float)e * 0.125f);
        const float ang = pos * inv;
        const float cs = __cosf(ang), sn = __sinf(ang);
        const float v = (g < 2) ? (a * cs - c * sn) : (c * sn + a * cs);
        qr[e] = (__bf16)v;
      }
      qf2 = qr;
    }
  }
  };
  bf16x8 qf0, qf1, qf2, qg0, qg1, qg2;
  load_q(tl, qf0, qf1, qf2);
  if (QB == 2) load_q(tl + 16, qg0, qg1, qg2); else { qg0 = qf0; qg1 = qf1; qg2 = qf2; }
  float* biasl = (float*)(smem + 2 * BUFSZ);
  if (MODE == 1) {
    for (int i = t; i < 465; i += 256) biasl[i] = p.na_rpb[(size_t)(l * 8 + h) * 465 + i];
  }
  AttnState st, st2;
#pragma unroll
  for (int dt = 0; dt < 4; dt++) { st.o[dt] = f32x4{0.f, 0.f, 0.f, 0.f}; st2.o[dt] = f32x4{0.f, 0.f, 0.f, 0.f}; }
  st.mx = -1e30f; st.ls = 0.f; st2.mx = -1e30f; st2.ls = 0.f;
  const float scale = ((MODE >= 2) ? 0.10206207261596575f : 0.125f) * 1.4426950408889634f;
  const int qc = w * 16 + r16;
  const int wlo = min(max(qc - 8, 0), 48);
  const int wstart = min(max(16 * w - 8, 0), 32);
  asm volatile("" ::: "memory"); __builtin_amdgcn_sched_barrier(0);
  attn_swrite<DQK>(smem, rg, t);
  __syncthreads();
  for (int sidx = 0; sidx < nst; sidx++) {
    { const AttnSrc sn = get_src(min(sidx + 1, nst - 1)); attn_gload<DQK>(sn, rg, t); }
    asm volatile("" ::: "memory"); __builtin_amdgcn_sched_barrier(0);
    const char* buf = smem + (sidx & 1) * BUFSZ;
    if (MODE == 1 && sidx < 8) attn_compute<DQK, 2, true>(buf, qf0, qf1, qf2, st, scale, wstart, biasl + (wr0 + sidx - r + 7) * 31, qc, wlo, tid_);
    else {
      attn_compute<DQK, 4, false>(buf, qf0, qf1, qf2, st, scale, 0, nullptr, 0, 0, tid_);
      if (QB == 2) attn_compute<DQK, 4, false>(buf, qg0, qg1, qg2, st2, scale, 0, nullptr, 0, 0, tid_);
    }
    asm volatile("" ::: "memory"); __builtin_amdgcn_sched_barrier(0);
    attn_swrite<DQK>(smem + ((sidx + 1) & 1) * BUFSZ, rg, t);
    __syncthreads();
  }
  auto finish = [&](const AttnState& st, int tl) {
    float lt = st.ls;
    lt += __shfl_xor(lt, 16);
    lt += __shfl_xor(lt, 32);
    const float inv = 1.f / lt;
    u16* Z = (u16*)(p.ws + (MODE < 2 ? O_ZA : O_ZC)) + (size_t)(MODE & 1) * 8192 * 512 + blk_off(tl, h * 64 + 4 * g, 512);
#pragma unroll
    for (int dt = 0; dt < 4; dt++) {
      float a, bb, c, d;
      ld4bf(Z + dt * 16, a, bb, c, d);
      a = silu_f(a); bb = silu_f(bb); c = silu_f(c); d = silu_f(d);
      st4bf(Z + dt * 16, st.o[dt][0] * inv * a, st.o[dt][1] * inv * bb, st.o[dt][2] * inv * c, st.o[dt][3] * inv * d);
    }
  };
  finish(st, tl);
  if (QB == 2) finish(st2, tl + 16);
}

DEV void phase_mix(const Params& p, int l, int s, char* smem, const int tid_, const int vb_, const int vg_, const int vid_) {
  for (int item = vb_; item < 1024; item += vg_) {
    if (s == 0) attn_item<0>(p, l, item, smem, tid_); else attn_item<1>(p, l, item, smem, tid_);
  }
  {
    const int vblk = vid_ >> 1, team = vid_ & 1, bq = vblk & 31;
    if (bq >= 16) {
      const int it = (vblk >> 5) * 32 + (bq - 16) * 2 + team, chunk = it >> 2, g = it & 3;
      const u16* Wg = (const u16*)(p.ws + O_SGUW) + (size_t)(l * 4 + g) * 128 * 128;
      const u16* V = (const u16*)(p.ws + O_GVT) + ((size_t)chunk * 512 + g * 128) * 128;
      const u16* GU = (const u16*)(p.ws + O_GU); u16* ZB = (u16*)(p.ws + O_ZB) + (size_t)s * 8192 * 512;
      f32x16 acc[2][2];
      acc_zero(acc);
      gemm_mainloop_d1(Wg, 128, V, 128, 128, smem, acc, tid_);
      epi_foreach(acc, tid_, [&](int i, int j, float v0, float v1, float v2, float v3) {
        const float bs = p.sgu_b[(l * 4 + g) * 128 + i];
        const size_t off = (size_t)(chunk * 128 + i) * 512 + g * 128 + j;
        float u0, u1, u2, u3, z0, z1, z2, z3;
        ld4bf(GU + off, u0, u1, u2, u3);
        const size_t zoff = blk_off(chunk * 128 + i, g * 128 + j, 512);
        ld4bf(ZB + zoff, z0, z1, z2, z3);
        u0 = gelu_f(u0); u1 = gelu_f(u1); u2 = gelu_f(u2); u3 = gelu_f(u3);
        z0 = silu_f(z0); z1 = silu_f(z1); z2 = silu_f(z2); z3 = silu_f(z3);
        st4bf(ZB + zoff, u0 * (v0 + bs) * z0, u1 * (v1 + bs) * z1, u2 * (v2 + bs) * z2, u3 * (v3 + bs) * z3);
      });
    }
  }
}

DEV void phase_mla(const Params& p, int l, int s, char* smem, const int tid_, const int vb_, const int vg_) {
  for (int item = vb_; item < 512; item += vg_) {
    if (s == 0) attn_item<2>(p, l, item, smem, tid_); else attn_item<3>(p, l, item, smem, tid_);
  }
}

DEV void phase_final(const Params& p, const int tid_, const int vb_, const int vg_) {
  const int lane = TIDX & 63, wave = TIDX >> 6;
  for (int item = vb_; item < 1024; item += vg_) {
    float* x = p.out + OUT_Y + (size_t)(item * 16 + wave * 4) * 1024;
    const u16* xb = (const u16*)(p.ws + O_ZA) + (size_t)(item * 16 + wave * 4) * 1024;
    float4 v[4][4];
#pragma unroll
    for (int r = 0; r < 4; r++)
#pragma unroll
      for (int i = 0; i < 4; i++) {
        const uint2 w = *(const uint2*)(xb + (size_t)r * 1024 + i * 256 + lane * 4);
        v[r][i] = make_float4(__uint_as_float(w.x << 16), __uint_as_float(w.x & 0xffff0000u), __uint_as_float(w.y << 16), __uint_as_float(w.y & 0xffff0000u));
      }
    float4 g[4];
#pragma unroll
    for (int i = 0; i < 4; i++) g[i] = *(const float4*)(p.final_g + i * 256 + lane * 4);
    asm volatile("" ::: "memory");
    float ss[4];
#pragma unroll
    for (int r = 0; r < 4; r++) {
      ss[r] = 0.f;
#pragma unroll
      for (int i = 0; i < 4; i++) ss[r] += v[r][i].x * v[r][i].x + v[r][i].y * v[r][i].y + v[r][i].z * v[r][i].z + v[r][i].w * v[r][i].w;
    }
#pragma unroll
    for (int o = 32; o > 0; o >>= 1) {
#pragma unroll
      for (int r = 0; r < 4; r++) ss[r] += __shfl_xor(ss[r], o);
    }
#pragma unroll
    for (int r = 0; r < 4; r++) {
      const float rstd = rsqrtf(ss[r] * (1.f / 1024.f) + 1e-6f);
#pragma unroll
      for (int i = 0; i < 4; i++)
        *(float4*)(x + (size_t)r * 1024 + i * 256 + lane * 4) =
            make_float4(v[r][i].x * rstd * g[i].x, v[r][i].y * rstd * g[i].y, v[r][i].z * rstd * g[i].z, v[r][i].w * rstd * g[i].w);
    }
  }
}

namespace pg8 {
#define PG8_LAS __attribute__((address_space(3)))
typedef unsigned short bf16_t;
typedef short bf16x8 __attribute__((ext_vector_type(8)));
typedef float f32x4 __attribute__((ext_vector_type(4)));
typedef unsigned u32x4 __attribute__((ext_vector_type(4)));
constexpr int BM = 256, BK = 64, HALF = 128, HTB = HALF * BK * 2  , STAGE_BYTES = 8 * HTB, NXCD = 8, WGM = 8;

__host__ __device__ __forceinline__ int lds_byte(int r, int c) { const int st = (r >> 4) * 2 + (c >> 5), rr = r & 15, cc = c & 31, ob = rr * 64 + cc * 2; return st * 1024 + (ob ^ (((ob >> 9) & 1) << 5)); }
__host__ __device__ __forceinline__ void stage_rc(int b, int& R, int& C) { const int st = b / 1024, sb = b % 1024, swz = sb ^ (((sb >> 9) & 1) << 5); R = (st >> 1) * 16 + swz / 64; C = (st & 1) * 32 + (swz % 64) / 2; }
__host__ __device__ __forceinline__ int perm32(int rho) { const int n = rho >> 4, i = rho & 15; return 8 * (i >> 2) + 4 * n + (i & 3); }

struct Unit { int pm, pn; };
struct Gemm { const bf16_t* A; const bf16_t* Bt; int M, N, K; };

template <class Epi, class Sched, bool STAMP = false>
__device__ __forceinline__ void gemm_phase(PG8_LAS unsigned char* lds, const Gemm g, const Sched& S, const Epi& E, unsigned long long* stamps) {
    const int tid = tid_opaque(), wid = __builtin_amdgcn_readfirstlane(tid >> 6), lane = tid & 63, wr = wid >> 2, wc = wid & 3, fr = lane & 15, fq = lane >> 4;
    const int K = g.K, nt = K / BK;
    int ts_lo = 0, ts_hi = 0, nts = 0; const unsigned long long rt_entry = STAMP ? (unsigned long long)wall_clock64() : 0ull;
#define PG8_STAMP() do { if (STAMP && wid == 0 && nts < 64) { const unsigned long long _c = (unsigned long long)clock64(); \
        ts_lo = (lane == nts) ? (int)(unsigned)_c : ts_lo; ts_hi = (lane == nts) ? (int)(unsigned)(_c >> 32) : ts_hi; ++nts; } } while (0)
    PG8_STAMP();
    unsigned voffA[2], voffB[2];
#pragma unroll
    for (int i = 0; i < 2; ++i) { int R, C; stage_rc(tid * 16 + i * 8192, R, C); const int Rb = Epi::PERM ? ((R & ~31) + perm32(R & 31)) : R;
        voffA[i] = (unsigned)(R * BK + C) * 2u; voffB[i] = (unsigned)(Rb * BK + C) * 2u; }
    const size_t kstep = (size_t)(BM * BK * 2);
    const size_t hstep = (size_t)HALF * BK * 2;
    const size_t tstep = (size_t)BM * K * 2;
    const unsigned ldsw = (unsigned)wid * 1024u;
    const int aoff = lds_byte(wr * 64 + fr, fq * 8), boff = lds_byte(wc * 32 + fr, fq * 8);
#define PG8_SA(b, h) (((b) * 2 + (h)) * HTB)
#define PG8_SB(b, h) ((4 + (b) * 2 + (h)) * HTB)
#define PG8_STAGE(bufoff, gbase, voff) do { _Pragma("unroll") for (int _i = 0; _i < 2; ++_i) \
        __builtin_amdgcn_global_load_lds((const unsigned*)((const char*)(gbase) + (voff)[_i]), (PG8_LAS unsigned*)(lds + (bufoff) + ldsw + _i * 8192), 16, 0, 0); } while (0)
#define PG8_LDA(dst, b, h) do { _Pragma("unroll") for (int m = 0; m < 4; ++m) _Pragma("unroll") for (int k = 0; k < 2; ++k) dst[m][k] = *(const PG8_LAS bf16x8*)(lds + PG8_SA(b, h) + aoff + m * 2048 + k * 1024); } while (0)
#define PG8_LDB(dst, b, h) do { _Pragma("unroll") for (int n = 0; n < 2; ++n) _Pragma("unroll") for (int k = 0; k < 2; ++k) dst[n][k] = *(const PG8_LAS bf16x8*)(lds + PG8_SB(b, h) + boff + n * 2048 + k * 1024); } while (0)
#define PG8_MMA(ai, bj, At, Bt) do { __builtin_amdgcn_s_setprio(1); _Pragma("unroll") for (int m = 0; m < 4; ++m) _Pragma("unroll") for (int n = 0; n < 2; ++n) _Pragma("unroll") for (int k = 0; k < 2; ++k) \
        acc[ai][bj][m][n] = __builtin_amdgcn_mfma_f32_16x16x32_bf16(Bt[n][k], At[m][k], acc[ai][bj][m][n], 0, 0, 0); __builtin_amdgcn_s_setprio(0); } while (0)
#define PG8_WAIT_V(n) asm volatile("s_waitcnt vmcnt(" #n ")" ::: "memory")
#define PG8_WAIT_L(n) asm volatile("s_waitcnt lgkmcnt(" #n ")" ::: "memory")
#define PG8_BAR __builtin_amdgcn_s_barrier()
#define PG8_SCHED __builtin_amdgcn_sched_barrier(0)
    Unit cur, nxt; int ui = 0;
    if (!S.next(0, cur)) return;
    f32x4 acc[2][2][4][2];
#pragma unroll
    for (int a = 0; a < 2; ++a)
#pragma unroll
        for (int b = 0; b < 2; ++b)
#pragma unroll
            for (int m = 0; m < 4; ++m)
#pragma unroll
                for (int n = 0; n < 2; ++n) acc[a][b][m][n] = (f32x4){0.f, 0.f, 0.f, 0.f};
    bf16x8 At[4][2], B0[2][2], B1[2][2];
    const char* cA = (const char*)g.A + (size_t)cur.pm * tstep; const char* cB = (const char*)g.Bt + (size_t)cur.pn * tstep;
    S.a_ready(cur);
    PG8_STAGE(PG8_SB(0, 0), cB, voffB); PG8_STAGE(PG8_SA(0, 0), cA, voffA); PG8_STAGE(PG8_SB(0, 1), cB + hstep, voffB); PG8_STAGE(PG8_SA(0, 1), cA + hstep, voffA);
    if (wr == 1) PG8_BAR;
    PG8_WAIT_V(4); PG8_BAR;
    PG8_STAGE(PG8_SB(1, 0), cB + kstep, voffB); PG8_STAGE(PG8_SA(1, 0), cA + kstep, voffA); PG8_STAGE(PG8_SB(1, 1), cB + hstep + kstep, voffB);
    PG8_WAIT_V(6); PG8_BAR;
    PG8_STAMP();
    for (;;) {
        const bool has_next = S.next(ui + 1, nxt);
        const char* nA = has_next ? (const char*)g.A + (size_t)nxt.pm * tstep : cA; const char* nB = has_next ? (const char*)g.Bt + (size_t)nxt.pn * tstep : cB;
        for (int t = 0; t < nt; t += 2) {
            const bool last = (t == nt - 2);
            const char* a1 = cA + (size_t)(t + 1) * kstep;
            const char* a2 = last ? nA : cA + (size_t)(t + 2) * kstep; const char* b2 = last ? nB : cB + (size_t)(t + 2) * kstep;
            const char* a3 = a2 + kstep; const char* b3 = b2 + kstep;
            if (last && has_next) S.a_ready(nxt);
            PG8_LDB(B0, 0, 0); PG8_SCHED; PG8_LDA(At, 0, 0); PG8_STAGE(PG8_SA(1, 1), a1 + hstep, voffA);
            PG8_WAIT_L(8); PG8_BAR; PG8_WAIT_L(0); PG8_MMA(0, 0, At, B0); PG8_BAR; PG8_SCHED;
            PG8_LDB(B1, 0, 1); PG8_STAGE(PG8_SB(0, 0), b2, voffB);
            PG8_BAR; PG8_WAIT_L(0); PG8_MMA(0, 1, At, B1); PG8_BAR;
            PG8_LDA(At, 0, 1); PG8_STAGE(PG8_SA(0, 0), a2, voffA);
            PG8_BAR; PG8_WAIT_L(0); PG8_MMA(1, 0, At, B0); PG8_BAR; PG8_SCHED;
            PG8_STAGE(PG8_SB(0, 1), b2 + hstep, voffB);
            PG8_WAIT_V(6); PG8_BAR; PG8_MMA(1, 1, At, B1); PG8_BAR;
            PG8_LDB(B0, 1, 0); PG8_SCHED; PG8_LDA(At, 1, 0); PG8_STAGE(PG8_SA(0, 1), a2 + hstep, voffA);
            PG8_WAIT_L(8); PG8_BAR; PG8_WAIT_L(0); PG8_MMA(0, 0, At, B0); PG8_BAR; PG8_SCHED;
            PG8_LDB(B1, 1, 1); PG8_STAGE(PG8_SB(1, 0), b3, voffB);
            PG8_BAR; PG8_WAIT_L(0); PG8_MMA(0, 1, At, B1); PG8_BAR;
            PG8_LDA(At, 1, 1); PG8_STAGE(PG8_SA(1, 0), a3, voffA);
            PG8_BAR; PG8_WAIT_L(0); PG8_MMA(1, 0, At, B0); PG8_BAR; PG8_SCHED;
            PG8_STAGE(PG8_SB(1, 1), b3 + hstep, voffB);
            PG8_WAIT_V(6); PG8_BAR; PG8_MMA(1, 1, At, B1); PG8_BAR;
        }
        PG8_STAMP();
        if constexpr (!Epi::AFTER_DRAIN) { E(acc, cur, wr, wc, fr, fq); S.done(cur); }
        PG8_STAMP();
        if (!has_next) break;
        if constexpr (!Epi::KEEP_ACC) {
#pragma unroll
        for (int a = 0; a < 2; ++a)
#pragma unroll
            for (int b = 0; b < 2; ++b)
#pragma unroll
                for (int m = 0; m < 4; ++m)
#pragma unroll
                    for (int n = 0; n < 2; ++n) acc[a][b][m][n] = (f32x4){0.f, 0.f, 0.f, 0.f};
        }
        cur = nxt; cA = nA; cB = nB; ++ui;
    }
    PG8_WAIT_V(0);
    if (wr == 0) PG8_BAR;
    PG8_BAR;
    if constexpr (Epi::AFTER_DRAIN) { E.fused(acc, cur, wr, wc, fr, fq, lds, wid, lane); S.done(cur); }
    PG8_STAMP();
    if (STAMP && wid == 0) { stamps[lane] = lane < nts ? (((unsigned long long)(unsigned)ts_hi << 32) | (unsigned)ts_lo) : 0ull;
        if (lane == 62) stamps[62] = rt_entry; if (lane == 63) stamps[63] = (unsigned long long)wall_clock64(); }
#undef PG8_STAMP
#undef PG8_SA
#undef PG8_SB
#undef PG8_STAGE
#undef PG8_LDA
#undef PG8_LDB
#undef PG8_MMA
#undef PG8_WAIT_V
#undef PG8_WAIT_L
#undef PG8_BAR
#undef PG8_SCHED
}
}


struct InSched {
  int l, c;
  __device__ __forceinline__ bool next(int i, pg8::Unit& u) const {
    const int x = c >> 5, q = c & 31;
    const int e = i * 32 + q;
    if (e >= 124) return false;
    const int it = 4 * x + (e & 3), jt = e >> 2;
    const bool swapped = (jt == 4) || (jt == 5) || (jt == 10) || (jt == 11);
    if (swapped) { u.pm = l * 31 + jt; u.pn = 62 + it; } else { u.pm = 62 + it; u.pn = l * 31 + jt; }
    return true;
  }
  __device__ __forceinline__ void a_ready(const pg8::Unit&) const {}
  __device__ __forceinline__ void done(const pg8::Unit&) const {}
};

DEV void st8bf(u16* p, const pg8::f32x4& a, const pg8::f32x4& b) {
  uint4 w; w.x = pack2(a[0], a[1]); w.y = pack2(a[2], a[3]); w.z = pack2(b[0], b[1]); w.w = pack2(b[2], b[3]);
  *(uint4*)p = w;
}
template <class F> DEV pg8::f32x4 map4(const pg8::f32x4& v, F f) { pg8::f32x4 r; r[0] = f(v[0]); r[1] = f(v[1]); r[2] = f(v[2]); r[3] = f(v[3]); return r; }

struct InEpi {
  static constexpr bool PERM = true, AFTER_DRAIN = false, KEEP_ACC = false;
  char* ws; float* out; int l, s;
  __device__ __forceinline__ void operator()(const pg8::f32x4 (&acc)[2][2][4][2], const pg8::Unit& u, int wr, int wc, int fr, int fq) const {
    u16* QNA = (u16*)(ws + O_QNA); u16* KNA = (u16*)(ws + O_KNA); u16* VTNA = (u16*)(ws + O_VTNA);
    const size_t zs = (size_t)s * 8192 * 512;
    u16* ZA = (u16*)(ws + O_ZA) + zs; u16* ZB = (u16*)(ws + O_ZB) + zs; u16* ZC = (u16*)(ws + O_ZC) + zs;
    u16* GU = (u16*)(ws + O_GU); u16* GVT = (u16*)(ws + O_GVT);
    u16* DQ = (u16*)(ws + O_DQ); u16* DKV = (u16*)(ws + O_DKV); float* KRF = (float*)(ws + O_KRF);
    unsigned char* GATES = (unsigned char*)(ws + O_GATES) + (size_t)s * 8192 * 3072;
    if (u.pm >= 62) {
      const int t0 = (u.pm - 62) * 256 + wr * 64 + fr;
      const int cbase = (u.pn - l * 31) * 256;
#pragma unroll
      for (int bj = 0; bj < 2; ++bj) {
        const int seg0 = cbase + bj * 128;
        const int n = seg0 >> 7;
        const int c0 = seg0 + wc * 32 + 8 * fq;
#pragma unroll
        for (int ai = 0; ai < 2; ++ai)
#pragma unroll
          for (int m = 0; m < 4; ++m) {
            const int T = t0 + ai * 128 + m * 16;
            const pg8::f32x4 v0 = acc[ai][bj][m][0], v1 = acc[ai][bj][m][1];
            if (n < 4) {
              st8bf(QNA + (size_t)T * 512 + c0, v0, v1);
            } else if (n < 8) {
              const int col = c0 - 512;
              st8bf(KNA + (size_t)T * 512 + col, v0, v1);
              if (s == 0) {
                const int b = T >> 8, sq = T & 255;
                float* o = out + OUT_SK + ((size_t)(b * 2 + l) * 256 + sq) * 512 + col;
                *(float4*)o = make_float4(v0[0], v0[1], v0[2], v0[3]); *(float4*)(o + 4) = make_float4(v1[0], v1[1], v1[2], v1[3]);
              }
            } else if (n < 16) {
              st8bf(ZA + blk_off(T, c0 - 1536, 512), v0, v1);
            } else if (n < 20) {
              st8bf(GU + (size_t)T * 512 + c0 - 2048, v0, v1);
            } else if (n < 28) {
              st8bf(ZB + blk_off(T, c0 - 3072, 512), v0, v1);
            } else if (n < 31) {
              st8bf(DQ + (size_t)T * 384 + c0 - 3584, v0, v1);
            } else if (n < 33) {
              st8bf(DKV + (size_t)T * 256 + c0 - 3968, v0, v1);
            } else if (n < 37) {
              st8bf(ZC + blk_off(T, c0 - 4224, 512), v0, v1);
            } else if (n < 61) {
              unsigned q[8];
#pragma unroll
              for (int e = 0; e < 4; e++) { q[e] = (unsigned)(sigmoid_f(v0[e]) * 255.f + 0.5f); q[4 + e] = (unsigned)(sigmoid_f(v1[e]) * 255.f + 0.5f); }
              uint2 gw; gw.x = q[0] | (q[1] << 8) | (q[2] << 16) | (q[3] << 24); gw.y = q[4] | (q[5] << 8) | (q[6] << 16) | (q[7] << 24);
              *(uint2*)(GATES + (size_t)T * 3072 + c0 - 4736) = gw;
            } else if (c0 < 7808 + 32) {
              const int j = c0 - 7808;
              float* kp = KRF + (size_t)T * 32 + j;
              *(float4*)kp = make_float4(v0[0], v0[1], v0[2], v0[3]); *(float4*)(kp + 4) = make_float4(v1[0], v1[1], v1[2], v1[3]);
              if (s == 0) {
                const int b = T >> 8, sq = T & 255;
                float* o = out + OUT_SKR + ((size_t)(b * 2 + l) * 256 + sq) * 32 + j;
                *(float4*)o = make_float4(v0[0], v0[1], v0[2], v0[3]); *(float4*)(o + 4) = make_float4(v1[0], v1[1], v1[2], v1[3]);
              }
            }
          }
      }
    } else {
      const int jt = u.pm - l * 31;
      const int ch0 = jt * 256 + wr * 64 + fr;
      const int tk0 = (u.pn - 62) * 256 + wc * 32 + 8 * fq;
#pragma unroll
      for (int ai = 0; ai < 2; ++ai)
#pragma unroll
        for (int m = 0; m < 4; ++m) {
          const int ch = ch0 + ai * 128 + m * 16;
#pragma unroll
          for (int bj = 0; bj < 2; ++bj) {
            const int tok = tk0 + bj * 128;
            const pg8::f32x4 v0 = acc[ai][bj][m][0], v1 = acc[ai][bj][m][1];
            if (jt < 8) {
              const int dva = ch - 1024;
              if (s == 0) {
                const int b = tok >> 8, sq = tok & 255;
                st8bf(VTNA + ((size_t)(b * 512 + dva)) * 256 + sq, v0, v1);
                float* o = out + OUT_SV + ((size_t)(b * 2 + l) * 256 + sq) * 512 + dva;
                o[0] = v0[0]; o[512] = v0[1]; o[1024] = v0[2]; o[1536] = v0[3]; o[2048] = v1[0]; o[2560] = v1[1]; o[3072] = v1[2]; o[3584] = v1[3];
              } else {
                const int b = tok >> 10, nn = tok & 1023;
                st8bf(VTNA + ((size_t)(b * 512 + dva)) * 1024 + nn, v0, v1);
              }
            } else {
              const int c = ch - 2560;
              const int chunk = tok >> 7, q = tok & 127;
              st8bf(GVT + ((size_t)chunk * 512 + c) * 128 + q, v0, v1);
            }
          }
        }
    }
  }
};

DEV void phase_in8(const Params& p, int l, int s, char* smem_full, int vid) {
  pg8::Gemm g; g.A = (const pg8::bf16_t*)(p.ws + O_WIN); g.Bt = g.A; g.M = 0; g.N = 0; g.K = 1024;
  InSched S; S.l = l; S.c = vid;
  InEpi E; E.ws = p.ws; E.out = p.out; E.l = l; E.s = s;
  pg8::gemm_phase<InEpi, InSched, false>((PG8_LAS unsigned char*)smem_full, g, S, E, nullptr);
}


struct MergeSched {
  int l, c;
  __device__ __forceinline__ bool next(int i, pg8::Unit& u) const {
    const int x = c >> 5, q = c & 31;
    if (i >= 3) return false;
    const int it = 8 * x + (q & 7), jt = q >> 3;
    const size_t zo = (i == 0) ? O_ZA : (i == 1 ? O_ZB : O_ZC);
    u.pm = (int)(zo / 262144) + it;
    u.pn = (int)(O_WBR / 262144) + (l * 3 + i) * 4 + jt;
    return true;
  }
  __device__ __forceinline__ void a_ready(const pg8::Unit&) const {}
  __device__ __forceinline__ void done(const pg8::Unit&) const {}
};
struct MergeEpi {
  static constexpr bool PERM = true, AFTER_DRAIN = false, KEEP_ACC = true;
  char* ws; int l;
  __device__ __forceinline__ void operator()(pg8::f32x4 (&acc)[2][2][4][2], const pg8::Unit& u, int wr, int wc, int fr, int fq) const {
    const int wrel = u.pn - (int)(O_WBR / 262144) - l * 12;
    const int k = wrel >> 2, jt = wrel & 3;
    const size_t zo = (k == 0) ? O_ZA : (k == 1 ? O_ZB : O_ZC);
    const int it = u.pm - (int)(zo / 262144);
    const unsigned char* GATES = (const unsigned char*)(ws + O_GATES);
    u16* MG = (u16*)(ws + O_MG);
    const int t0 = it * 256 + wr * 64 + fr;
#pragma unroll
    for (int ai = 0; ai < 2; ++ai) {
      uint2 ga[4][2], gb[4][2];
#pragma unroll
      for (int m = 0; m < 4; ++m)
#pragma unroll
        for (int bj = 0; bj < 2; ++bj) {
          const int T = t0 + ai * 128 + m * 16;
          const int c0 = jt * 256 + bj * 128 + wc * 32 + 8 * fq;
          const unsigned char* gp = GATES + (size_t)T * 3072 + k * 1024 + c0;
          ga[m][bj] = *(const uint2*)gp;
          gb[m][bj] = (k < 2) ? *(const uint2*)(gp + 1024) : make_uint2(0u, 0u);
        }
      asm volatile("" ::: "memory");
#pragma unroll
      for (int m = 0; m < 4; ++m)
#pragma unroll
        for (int bj = 0; bj < 2; ++bj) {
          const int T = t0 + ai * 128 + m * 16;
          const int c0 = jt * 256 + bj * 128 + wc * 32 + 8 * fq;
          float f[8];
#pragma unroll
          for (int e = 0; e < 8; e++) {
            const float qa = fmaxf((float)((((e < 4) ? ga[m][bj].x : ga[m][bj].y) >> (8 * (e & 3))) & 0xffu), 1.f);
            if (k < 2) {
              const float qb = fmaxf((float)((((e < 4) ? gb[m][bj].x : gb[m][bj].y) >> (8 * (e & 3))) & 0xffu), 1.f);
              f[e] = qa * __builtin_amdgcn_rcpf(qb);
            } else {
              f[e] = qa * (1.f / 255.f);
            }
          }
#pragma unroll
          for (int e = 0; e < 4; e++) { acc[ai][bj][m][0][e] *= f[e]; acc[ai][bj][m][1][e] *= f[4 + e]; }
          if (k == 2) {
            uint4 o;
            o.x = pack2(acc[ai][bj][m][0][0], acc[ai][bj][m][0][1]); o.y = pack2(acc[ai][bj][m][0][2], acc[ai][bj][m][0][3]);
            o.z = pack2(acc[ai][bj][m][1][0], acc[ai][bj][m][1][1]); o.w = pack2(acc[ai][bj][m][1][2], acc[ai][bj][m][1][3]);
            *(uint4*)(MG + blk_off(T, c0, 1024)) = o;
          }
        }
    }
  }
};
DEV void phase_merge8(const Params& p, int l, char* smem_full, int vid) {
  pg8::Gemm g; g.A = (const pg8::bf16_t*)p.ws; g.Bt = g.A; g.M = 0; g.N = 0; g.K = 512;
  MergeSched S; S.l = l; S.c = vid;
  MergeEpi E; E.ws = p.ws; E.l = l;
  pg8::gemm_phase<MergeEpi, MergeSched, false>((PG8_LAS unsigned char*)smem_full, g, S, E, nullptr);
}

struct OutSched {
  int l, c;
  __device__ __forceinline__ bool next(int i, pg8::Unit& u) const {
    const int x = c >> 5, q = c & 31;
    if (i >= 1) return false;
    u.pm = (int)(O_MG / 524288) + 8 * x + (q & 7);
    u.pn = (int)(O_WOUT / 524288) + l * 4 + (q >> 3);
    return true;
  }
  __device__ __forceinline__ void a_ready(const pg8::Unit&) const {}
  __device__ __forceinline__ void done(const pg8::Unit&) const {}
};
struct OutEpi {
  static constexpr bool PERM = true, AFTER_DRAIN = false, KEEP_ACC = false;
  const float* x0; const float* x1; const u16* xb_in; u16* xb_out; const float* MOD; int l;
  __device__ __forceinline__ void operator()(const pg8::f32x4 (&acc)[2][2][4][2], const pg8::Unit& u, int wr, int wc, int fr, int fq) const {
    const int it = u.pm - (int)(O_MG / 524288), jt = u.pn - (int)(O_WOUT / 524288) - l * 4;
    const int s = it >> 5;
    const int t0 = it * 256 + wr * 64 + fr;
    typedef __attribute__((address_space(1))) pg8::f32x4 GF4;
    typedef __attribute__((address_space(1))) pg8::u32x4 GU4;
    const GF4* xg = (const GF4*)(unsigned long long)((s == 0) ? x0 : x1 - (size_t)8192 * 1024);
    const GU4* xbg = (const GU4*)(unsigned long long)xb_in;
    GU4* og = (GU4*)(unsigned long long)xb_out;
    const float* gr = MOD + (size_t)(l * 9 + cond_idx(s, t0 & 8191)) * 3072 + 2048;
    float4 gv[2][2];
#pragma unroll
    for (int bj = 0; bj < 2; ++bj)
#pragma unroll
      for (int h2 = 0; h2 < 2; ++h2) gv[bj][h2] = *(const float4*)(gr + jt * 256 + bj * 128 + wc * 32 + 8 * fq + 4 * h2);
#pragma unroll
    for (int ai = 0; ai < 2; ++ai)
#pragma unroll
      for (int mp = 0; mp < 2; ++mp) {
        float xr[2][2][8];
        if (l == 0) {
          pg8::f32x4 xv[2][2][2];
#pragma unroll
          for (int mm = 0; mm < 2; ++mm)
#pragma unroll
            for (int bj = 0; bj < 2; ++bj)
#pragma unroll
              for (int h2 = 0; h2 < 2; ++h2)
                xv[mm][bj][h2] = *(xg + (size_t)(t0 + ai * 128 + (mp * 2 + mm) * 16) * 256 + jt * 64 + bj * 32 + wc * 8 + 2 * fq + h2);
          asm volatile("" ::: "memory"); __builtin_amdgcn_sched_barrier(0);
#pragma unroll
          for (int mm = 0; mm < 2; ++mm)
#pragma unroll
            for (int bj = 0; bj < 2; ++bj)
#pragma unroll
              for (int e = 0; e < 8; ++e) xr[mm][bj][e] = xv[mm][bj][e >> 2][e & 3];
        } else {
          pg8::u32x4 xw[2][2];
#pragma unroll
          for (int mm = 0; mm < 2; ++mm)
#pragma unroll
            for (int bj = 0; bj < 2; ++bj)
              xw[mm][bj] = *(xbg + (size_t)(t0 + ai * 128 + (mp * 2 + mm) * 16) * 128 + jt * 32 + bj * 16 + wc * 4 + fq);
          asm volatile("" ::: "memory"); __builtin_amdgcn_sched_barrier(0);
#pragma unroll
          for (int mm = 0; mm < 2; ++mm)
#pragma unroll
            for (int bj = 0; bj < 2; ++bj)
#pragma unroll
              for (int e = 0; e < 8; ++e) { const unsigned w = xw[mm][bj][e >> 1]; xr[mm][bj][e] = __uint_as_float((e & 1) ? (w & 0xffff0000u) : (w << 16)); }
        }
#pragma unroll
        for (int mm = 0; mm < 2; ++mm)
#pragma unroll
          for (int bj = 0; bj < 2; ++bj) {
            const int m = mp * 2 + mm;
            const pg8::f32x4 v0 = acc[ai][bj][m][0], v1 = acc[ai][bj][m][1];
            const float4 g0 = gv[bj][0], g1 = gv[bj][1];
            pg8::u32x4 o;
            o[0] = pack2(xr[mm][bj][0] + g0.x * v0[0], xr[mm][bj][1] + g0.y * v0[1]);
            o[1] = pack2(xr[mm][bj][2] + g0.z * v0[2], xr[mm][bj][3] + g0.w * v0[3]);
            o[2] = pack2(xr[mm][bj][4] + g1.x * v1[0], xr[mm][bj][5] + g1.y * v1[1]);
            o[3] = pack2(xr[mm][bj][6] + g1.z * v1[2], xr[mm][bj][7] + g1.w * v1[3]);
            *(og + (size_t)(t0 + ai * 128 + m * 16) * 128 + jt * 32 + bj * 16 + wc * 4 + fq) = o;
          }
        asm volatile("" ::: "memory"); __builtin_amdgcn_sched_barrier(0);
      }
  }
};
DEV void phase_out8(const Params& p, int l, char* smem_full, int vid) {
  pg8::Gemm g; g.A = (const pg8::bf16_t*)p.ws; g.Bt = g.A; g.M = 0; g.N = 0; g.K = 1024;
  OutSched S; S.l = l; S.c = vid;
  OutEpi E; E.x0 = p.x_prompt; E.x1 = p.x_sample; E.xb_in = (const u16*)(p.out + OUT_Y);
  E.xb_out = (l == 0) ? (u16*)(p.out + OUT_Y) : (u16*)(p.ws + O_ZA);
  E.MOD = (const float*)(p.ws + O_MOD); E.l = l;
  pg8::gemm_phase<OutEpi, OutSched, false>((PG8_LAS unsigned char*)smem_full, g, S, E, nullptr);
}


struct QSched {
  int l, c;
  __device__ __forceinline__ bool next(int i, pg8::Unit& u) const {
    const int x = c >> 5, q = c & 31;
    if (q >= 12 || i >= 1) return false;
    u.pm = (int)(O_DQN / 196608) + 4 * x + (q & 3);
    u.pn = (int)(O_WUQ / 196608) + l * 3 + (q >> 2);
    return true;
  }
  __device__ __forceinline__ void a_ready(const pg8::Unit&) const {}
  __device__ __forceinline__ void done(const pg8::Unit&) const {}
};
struct QEpi {
  static constexpr bool PERM = true, AFTER_DRAIN = false, KEEP_ACC = false;
  char* ws; int l;
  __device__ __forceinline__ void operator()(const pg8::f32x4 (&acc)[2][2][4][2], const pg8::Unit& u, int wr, int wc, int fr, int fq) const {
    const int it = u.pm - (int)(O_DQN / 196608), jt = u.pn - (int)(O_WUQ / 196608) - l * 3;
    u16* QM = (u16*)(ws + O_QM);
#pragma unroll
    for (int ai = 0; ai < 2; ++ai)
#pragma unroll
      for (int m = 0; m < 4; ++m) {
        const int T = it * 256 + ai * 128 + wr * 64 + m * 16 + fr;
#pragma unroll
        for (int bj = 0; bj < 2; ++bj)
          st8bf(QM + (size_t)T * 768 + jt * 256 + bj * 128 + wc * 32 + 8 * fq, acc[ai][bj][m][0], acc[ai][bj][m][1]);
      }
  }
};
struct KvSched {
  int l, c, nt;
  __device__ __forceinline__ bool next(int i, pg8::Unit& u) const {
    const int x = c >> 5, q = c & 31, per = nt >> 3;
    if (q >= 4 * per || i >= 1) return false;
    const int it = per * x + (q % per), jt = q / per;
    const int wt = (int)(O_WUKV / 131072) + l * 4 + jt, ct = (int)(O_CKV / 131072) + it;
    if (jt < 2) { u.pm = ct; u.pn = wt; } else { u.pm = wt; u.pn = ct; }
    return true;
  }
  __device__ __forceinline__ void a_ready(const pg8::Unit&) const {}
  __device__ __forceinline__ void done(const pg8::Unit&) const {}
};
struct KvEpi {
  static constexpr bool PERM = true, AFTER_DRAIN = false, KEEP_ACC = false;
  char* ws; int l, S;
  __device__ __forceinline__ void operator()(const pg8::f32x4 (&acc)[2][2][4][2], const pg8::Unit& u, int wr, int wc, int fr, int fq) const {
    const int c0t = (int)(O_CKV / 131072), w0t = (int)(O_WUKV / 131072) + l * 4;
    if (u.pm >= c0t) {
      const int it = u.pm - c0t, jt = u.pn - w0t;
      u16* KNOPE = (u16*)(ws + O_KNOPE);
#pragma unroll
      for (int ai = 0; ai < 2; ++ai)
#pragma unroll
        for (int m = 0; m < 4; ++m) {
          const int R = it * 256 + ai * 128 + wr * 64 + m * 16 + fr;
#pragma unroll
          for (int bj = 0; bj < 2; ++bj)
            st8bf(KNOPE + (size_t)R * 512 + jt * 256 + bj * 128 + wc * 32 + 8 * fq, acc[ai][bj][m][0], acc[ai][bj][m][1]);
        }
    } else {
      const int jt = u.pm - w0t - 2, it = u.pn - c0t;
      u16* VTM = (u16*)(ws + O_VTM);
#pragma unroll
      for (int ai = 0; ai < 2; ++ai)
#pragma unroll
        for (int m = 0; m < 4; ++m) {
          const int ch = jt * 256 + ai * 128 + wr * 64 + m * 16 + fr;
#pragma unroll
          for (int bj = 0; bj < 2; ++bj) {
            const int row = it * 256 + bj * 128 + wc * 32 + 8 * fq;
            const int b = row / S, mm = row % S;
            st8bf(VTM + ((size_t)b * 512 + ch) * S + mm, acc[ai][bj][m][0], acc[ai][bj][m][1]);
          }
        }
    }
  }
};
DEV void phase_qkv8(const Params& p, int l, int s, char* smem_full, int vid) {
  {
    pg8::Gemm g; g.A = (const pg8::bf16_t*)p.ws; g.Bt = g.A; g.M = 0; g.N = 0; g.K = 384;
    QSched S; S.l = l; S.c = vid;
    QEpi E; E.ws = p.ws; E.l = l;
    pg8::gemm_phase<QEpi, QSched, false>((PG8_LAS unsigned char*)smem_full, g, S, E, nullptr);
  }
  {
    pg8::Gemm g; g.A = (const pg8::bf16_t*)p.ws; g.Bt = g.A; g.M = 0; g.N = 0; g.K = 256;
    KvSched S; S.l = l; S.c = vid; S.nt = (s == 0) ? 32 : 40;
    KvEpi E; E.ws = p.ws; E.l = l; E.S = (s == 0) ? 256 : 1280;
    pg8::gemm_phase<KvEpi, KvSched, false>((PG8_LAS unsigned char*)smem_full, g, S, E, nullptr);
  }
}

#define XB_TMO      128
#define XB_XCNT(j)  (256  + 64 * (j))
#define XB_XSUB(j)  (1280 + 64 * (j))
#define XB_XGEN(j)  (2304 + 64 * (j))
#define XB_TOP      3328
#define XB_TOPGEN   3392
#define XCD_BAR_WORDS 3456
#define XB_SPIN_CAP (1u << 18)
#define LAS __attribute__((address_space(3)))

__device__ __forceinline__ unsigned xb_ld(unsigned* p)              { return __hip_atomic_load(p, __ATOMIC_RELAXED, __HIP_MEMORY_SCOPE_AGENT); }
__device__ __forceinline__ unsigned xb_add(unsigned* p, unsigned v) { return __hip_atomic_fetch_add(p, v, __ATOMIC_RELAXED, __HIP_MEMORY_SCOPE_AGENT); }
__device__ __forceinline__ unsigned xb_xcc_id() { return (unsigned)__builtin_amdgcn_s_getreg((3 << 11) | 20) & 0xFu; }
#define XB_SPIN(cond, bar) do { unsigned _sp = 0; while (cond) { __builtin_amdgcn_s_sleep(1); \
    if ((++_sp & 255u) == 0u) { if (xb_ld(&(bar)[XB_TMO])) break; if (_sp > XB_SPIN_CAP) { atomicAdd(&(bar)[XB_TMO], 1u); break; } } } } while (0)

struct XcdBarrier {
    unsigned* bar; unsigned x;
    volatile LAS unsigned* st;
};

__device__ __forceinline__ XcdBarrier xcd_barrier_post(unsigned* bar, volatile LAS unsigned* st) {
    XcdBarrier b; b.bar = bar; b.x = xb_xcc_id(); b.st = st;
    if ((int)threadIdx.x == 0) st[2] = xb_add(&bar[XB_XCNT(b.x)], 1u);
    return b;
}
__device__ __forceinline__ void xcd_barrier_complete(unsigned* bar, unsigned x, unsigned& nloc, unsigned& nx) {
    const unsigned G = gridDim.x * gridDim.y * gridDim.z;
    unsigned sum, cnt, mine, sp = 0u;
    for (;;) {
        sum = 0u; cnt = 0u; mine = 0u;
#pragma unroll
        for (unsigned j = 0; j < 16; ++j) { const unsigned c = xb_ld(&bar[XB_XCNT(j)]); sum += c; cnt += (c > 0u) ? 1u : 0u; mine = (j == x) ? c : mine; }
        if (sum == G) break;
        __builtin_amdgcn_s_sleep(1);
        if ((++sp & 255u) == 0u) { if (xb_ld(&bar[XB_TMO])) break; if (sp > XB_SPIN_CAP) { atomicAdd(&bar[XB_TMO], 1u); break; } }
    }
    nloc = mine > 0u ? mine : 1u; nx = cnt > 0u ? cnt : 1u;
}

__device__ __forceinline__ void xcd_barrier(const XcdBarrier& b) {
    asm volatile("s_waitcnt vmcnt(0)" ::: "memory");
    __syncthreads();
    if ((int)threadIdx.x == 0) {
        unsigned* bar = b.bar;
        __builtin_amdgcn_s_waitcnt(0);
        unsigned nloc = b.st[0], nx = b.st[1];
        if (nloc == 0u) { xcd_barrier_complete(bar, b.x, nloc, nx); b.st[0] = nloc; b.st[1] = nx; }
        const unsigned old = xb_add(&bar[XB_XSUB(b.x)], 1u);
        const unsigned gen = old / nloc;
        if (old + 1u == (gen + 1u) * nloc) {
            __builtin_amdgcn_fence(__ATOMIC_RELEASE, "agent");
            asm volatile("s_waitcnt vmcnt(0)" ::: "memory");
            const unsigned og = xb_add(&bar[XB_TOP], 1u);
            const unsigned tg = og / nx;
            if (og + 1u == (tg + 1u) * nx) xb_add(&bar[XB_TOPGEN], 1u);
            else XB_SPIN(xb_ld(&bar[XB_TOPGEN]) == tg, bar);
            __builtin_amdgcn_fence(__ATOMIC_ACQUIRE, "agent");
            xb_add(&bar[XB_XGEN(b.x)], 1u);
            asm volatile("s_waitcnt vmcnt(0)" ::: "memory");
        } else {
            XB_SPIN(xb_ld(&bar[XB_XGEN(b.x)]) == gen, bar);
            __builtin_amdgcn_fence(__ATOMIC_ACQUIRE, "agent");
            asm volatile("s_waitcnt vmcnt(0)" ::: "memory");
        }
    }
    __syncthreads();
}


DEV void run_phase(const Params& p, int ph, int l, int s, char* smem, const int vid_, const int tid_, const int vb_, const int vg_) {
  switch (ph) {
    case 0: phase_prep(p, smem, tid_, vb_, vg_); break;
    case 1: phase_h(p, l, s, tid_, vb_, vg_); break;
    case 3: phase_rows(p, l, s, smem, tid_, vb_, vg_); break;
    case 4: phase_mix(p, l, s, smem, tid_, vb_, vg_, vid_); break;
    case 5: phase_mla(p, l, s, smem, tid_, vb_, vg_); break;
    default: phase_final(p, tid_, vb_, vg_); break;
  }
}

__global__ void __launch_bounds__(512, 2) mega_kernel(Params p) {
  extern __shared__ __attribute__((aligned(16))) unsigned char dyn_lds[];
  char* smem = (char*)dyn_lds;
  uint4& xb_words = *(uint4*)(dyn_lds + 131072);
  if (threadIdx.x == 0) xb_words = make_uint4(0u, 0u, 0u, 0u);
  __syncthreads();
  XcdBarrier xb = xcd_barrier_post((unsigned*)(p.ws + O_BAR), (volatile LAS unsigned*)(dyn_lds + 131072));
  if (p.ws == nullptr) cg::this_grid().sync();
  int vid = blockIdx.x;
#pragma unroll 1
  for (int step = 0; step < 24; step++) {
    int ph, l = 0, s = 0;
    bool also_h1 = false;
    if (step == 0) ph = 0;
    else if (step == 23) ph = 8;
    else {
      const int idx = step - 1; l = idx / 11; const int r = idx % 11;
      if (r < 5) { s = 0; ph = 1 + r; also_h1 = (r == 4); }
      else if (r < 9) { s = 1; ph = 2 + (r - 5); }
      else ph = 6 + (r - 9);
    }
    {
      const int tfull = tid_opaque();
      const int team = tfull >> 8;
      Params q = p;
      size_t zoff = 0;
      asm volatile("" : "+s"(zoff));
      q.ws = p.ws + zoff;
      q.out = p.out + zoff;
      if (ph == 4) { phase_qkv8(q, l, s, smem, vid); __syncthreads(); }
      if (ph == 2) phase_in8(q, l, s, smem, vid);
      else if (ph == 6) phase_merge8(q, l, smem, vid);
      else if (ph == 7) phase_out8(q, l, smem, vid);
      else run_phase(q, ph, l, s, smem + team * 65536, vid * 2 + team, tfull & 255, blockIdx.x * 2 + team, gridDim.x * 2);
      if (also_h1) run_phase(q, 1, l, 1, smem + team * 65536, vid * 2 + team, tfull & 255, blockIdx.x * 2 + team, gridDim.x * 2);
    }
    if (step < 23) xcd_barrier(xb);
    if (step == 0) {
      if (threadIdx.x == 0) {
        unsigned base = 0;
        for (unsigned j = 0; j < 16; ++j) { const unsigned c = xb_ld(&xb.bar[XB_XCNT(j)]); if (j < xb.x) base += c; }
        unsigned v = base + xb_words.z;
        if (v >= gridDim.x) v = blockIdx.x;
        xb_words.w = v;
      }
      __syncthreads();
      vid = __builtin_amdgcn_readfirstlane((int)xb_words.w);
    }
  }
}

extern "C" void kernel_launch(void* const* d_in, const int* in_sizes, int n_in, void* d_out, int out_size, void* d_ws, size_t ws_size,
                              hipStream_t stream) {
  Params p{};
  const float** pp = (const float**)&p;
  for (int i = 0; i < 22; i++) pp[i] = (const float*)d_in[i];
  p.out = (float*)d_out;
  p.ws = (char*)d_ws;
  static int grid_blocks = 0;
  if (!grid_blocks) {
    int dev = 0, cus = 0, per_cu = 0;
    hipGetDevice(&dev);
    hipDeviceGetAttribute(&cus, hipDeviceAttributeMultiprocessorCount, dev);
    hipFuncSetAttribute((const void*)mega_kernel, hipFuncAttributeMaxDynamicSharedMemorySize, (int)DYN_LDS);
    hipOccupancyMaxActiveBlocksPerMultiprocessor(&per_cu, mega_kernel, 512, DYN_LDS);
    if (per_cu > 1) per_cu = 1;
    grid_blocks = cus * per_cu;
    grid_blocks &= ~7;
    if (grid_blocks > 256) grid_blocks = 256;
  }
  hipMemsetAsync((char*)d_ws + O_BAR, 0, BAR_BYTES, stream);
  void* args[] = {&p};
  hipError_t e = hipLaunchCooperativeKernel((void*)mega_kernel, dim3(grid_blocks), dim3(512), args, DYN_LDS, stream);
  if (e != hipSuccess) fprintf(stderr, "cooperative launch failed: %s (grid %d)\n", hipGetErrorString(e), grid_blocks);
}
```

```cpp
#include <hip/hip_runtime.h>
#include <hip/hip_cooperative_groups.h>
#include <cstdio>
namespace cg = cooperative_groups;

typedef unsigned short u16;
typedef __attribute__((ext_vector_type(8))) __bf16 bf16x8;
typedef __attribute__((ext_vector_type(16))) float f32x16;
#define DEV __device__ __forceinline__
__device__ __forceinline__ int tid_opaque() { int t = threadIdx.x; asm volatile("" : "+v"(t)); return t; }
#define TIDX tid_

constexpr size_t A256(size_t x) { return (x + 255) & ~(size_t)255; }
constexpr size_t A512K(size_t x) { return (x + 524287) & ~(size_t)524287; }
constexpr size_t AUP(size_t x, size_t a) { return (x + a - 1) / a * a; }
constexpr size_t O_WIN = 0;
constexpr size_t O_H = O_WIN + A256(2ull * 7936 * 1024 * 2);
constexpr size_t O_WUQ = AUP(O_H + A256(8192ull * 1024 * 2), 196608);
constexpr size_t O_WUKV = AUP(O_WUQ + A256(2ull * 768 * 384 * 2), 131072);
constexpr size_t O_WBR = A512K(O_WUKV + A256(2ull * 1024 * 256 * 2));
constexpr size_t O_WOUT = A512K(O_WBR + A256(2ull * 3 * 1024 * 512 * 2));
constexpr size_t O_SGUW = O_WOUT + A256(2ull * 1024 * 1024 * 2);
constexpr size_t O_KC = O_SGUW + A256(2ull * 4 * 128 * 128 * 2);
constexpr size_t O_VTC = O_KC + A256(2ull * 8 * 256 * 512 * 2);
constexpr size_t O_MOD = O_VTC + A256(2ull * 8 * 256 * 512 * 2);
constexpr size_t O_QNA = A512K(O_MOD + A256(2ull * 9 * 3072 * 4));
constexpr size_t O_KNA = O_QNA + 8192ull * 512 * 2;
constexpr size_t O_VTNA = O_KNA + 8192ull * 512 * 2;
constexpr size_t O_GU = O_VTNA + 8192ull * 512 * 2;
constexpr size_t O_MG = O_QNA;
constexpr size_t O_ZA = A512K(O_GU + 8192ull * 512 * 2);
constexpr size_t O_ZB = O_ZA + 2 * 8192ull * 512 * 2;
constexpr size_t O_ZC = O_ZB + 2 * 8192ull * 512 * 2;
constexpr size_t O_GVT = O_ZC + 2 * 8192ull * 512 * 2;
constexpr size_t O_GATES = O_GVT + A256(8192ull * 512 * 2);
constexpr size_t O_CKV = AUP(O_GATES + A256(2ull * 8192 * 3072), 131072);
constexpr size_t O_KR = O_CKV + A256(10240ull * 256 * 2);
constexpr size_t O_KNOPE = O_KR + A256(10240ull * 32 * 2);
constexpr size_t O_VTM = O_KNOPE + A256(10240ull * 512 * 2);
constexpr size_t O_END = O_VTM + A256(10240ull * 512 * 2);
constexpr size_t O_DQN = AUP(O_END, 196608);
constexpr size_t O_DQ = O_DQN + A256(8192ull * 384 * 2);
constexpr size_t O_DKV = O_DQ + A256(8192ull * 384 * 2);
constexpr size_t O_KRF = O_DKV + A256(8192ull * 256 * 2);
constexpr size_t O_QM = O_DQ;
constexpr size_t O_BAR = O_QM + A256(8192ull * 768 * 2);
constexpr size_t BAR_BYTES = 16384;
constexpr size_t DYN_LDS = 131072 + 16;
static_assert(O_H % 524288 == 0 && O_WIN == 0 && O_WOUT % 524288 == 0, "K=1024 operands must be 256-row-tile aligned");
static_assert(O_WBR % 262144 == 0 && O_ZA % 262144 == 0 && O_ZB % 262144 == 0 && O_ZC % 262144 == 0, "K=512 operands must be 256-row-tile aligned");
static_assert(O_MG % 524288 == 0, "MERGED must be tile aligned");
static_assert(O_WUQ % 196608 == 0 && O_DQN % 196608 == 0 && O_WUKV % 131072 == 0 && O_CKV % 131072 == 0, "K=384 / K=256 operands must be 256-row-tile aligned");
static_assert(O_KRF + 8192ull * 32 * 4 <= O_BAR, "QM alias region must cover DQ/DKV/KRF");
static_assert(O_BAR + BAR_BYTES <= 256ull * 1024 * 1024, "workspace too large");

constexpr size_t OUT_Y = 0;
constexpr size_t OUT_SK = 16777216;
constexpr size_t OUT_SV = 25165824;
constexpr size_t OUT_CKV = 33554432;
constexpr size_t OUT_SKR = 37748736;

struct Params {
  const float *x_prompt, *x_sample, *cache_na_k, *cache_na_v, *cache_ckv, *cache_kr, *c, *c_ctx;
  const float *norm_g, *w_mod, *b_mod, *w_in, *na_rpb, *sgu_w, *sgu_b, *q_norm, *w_uq, *kv_norm, *w_ukv, *w_branch, *w_out, *final_g;
  float* out;
  char* ws;
};

DEV u16 f2bf(float f) { unsigned u = __float_as_uint(f); u += 0x7fffu + ((u >> 16) & 1u); return (u16)(u >> 16); }
DEV float bf2f(u16 h) { return __uint_as_float(((unsigned)h) << 16); }
typedef __attribute__((ext_vector_type(2))) __bf16 bf16x2;
DEV unsigned pack2(float a, float b) { bf16x2 v; v[0] = (__bf16)a; v[1] = (__bf16)b; return __builtin_bit_cast(unsigned, v); }
DEV void st4bf(u16* p, float a, float b, float c, float d) { uint2 v; v.x = pack2(a, b); v.y = pack2(c, d); *(uint2*)p = v; }
DEV void ld4bf(const u16* p, float& a, float& b, float& c, float& d) {
  uint2 v = *(const uint2*)p;
  a = __uint_as_float(v.x << 16); b = __uint_as_float(v.x & 0xffff0000u);
  c = __uint_as_float(v.y << 16); d = __uint_as_float(v.y & 0xffff0000u);
}
DEV size_t blk_off(int row, int k, int K) { return (size_t)(row >> 8) * 256 * K + (size_t)(k >> 6) * 16384 + (size_t)(row & 255) * 64 + (k & 63); }
DEV float rows_allmax(float v) {
  const unsigned u = __float_as_uint(v);
  const auto a = __builtin_amdgcn_permlane16_swap(u, u, false, false);
  const float m1 = fmaxf(__uint_as_float(a[0]), __uint_as_float(a[1]));
  const unsigned u2 = __float_as_uint(m1);
  const auto b = __builtin_amdgcn_permlane32_swap(u2, u2, false, false);
  return fmaxf(__uint_as_float(b[0]), __uint_as_float(b[1]));
}
DEV float wave_sum(float v) {
#pragma unroll
  for (int o = 32; o > 0; o >>= 1) v += __shfl_xor(v, o);
  return v;
}
DEV float sigmoid_f(float x) { return __builtin_amdgcn_rcpf(1.f + __expf(-x)); }
DEV float silu_f(float x) { return x * __builtin_amdgcn_rcpf(1.f + __expf(-x)); }
DEV float gelu_f(float x) { float u = 0.7978845608028654f * (x + 0.044715f * x * x * x); return x * __builtin_amdgcn_rcpf(1.f + __expf(-2.f * u)); }

DEV void gemm_mainloop_d1(const u16* P, int ldp, const u16* Q, int ldq, int K, char* smem, f32x16 (&acc)[2][2], const int tid_) {
  const int t = TIDX, lane = t & 63, w = t >> 6, wm = w >> 1, wn = w & 1;
  const int lr = t >> 3, ch = t & 7;
  const u16* pg = P + (size_t)lr * ldp + ch * 8;
  const u16* qg = Q + (size_t)lr * ldq + ch * 8;
  const size_t sp = (size_t)32 * ldp, sq = (size_t)32 * ldq;
  const int soff = lr * 128 + ((ch ^ ((t >> 4) & 7)) << 4);
  const int sw = (lane >> 1) & 7;
  const int prow = (wm * 64 + (lane & 31)) * 128;
  const int qrow = (wn * 64 + (lane & 31)) * 128;
  uint4 p0, p1, p2, p3, q0, q1, q2, q3;
#define GLOAD(k0) do { p0 = *(const uint4*)(pg + (k0)); p1 = *(const uint4*)(pg + sp + (k0)); p2 = *(const uint4*)(pg + 2 * sp + (k0)); p3 = *(const uint4*)(pg + 3 * sp + (k0)); \
                       q0 = *(const uint4*)(qg + (k0)); q1 = *(const uint4*)(qg + sq + (k0)); q2 = *(const uint4*)(qg + 2 * sq + (k0)); q3 = *(const uint4*)(qg + 3 * sq + (k0)); } while (0)
#define SWRITE(base) do { char* b_ = (base) + soff; *(uint4*)(b_) = p0; *(uint4*)(b_ + 4096) = p1; *(uint4*)(b_ + 8192) = p2; *(uint4*)(b_ + 12288) = p3; \
                          *(uint4*)(b_ + 16384) = q0; *(uint4*)(b_ + 20480) = q1; *(uint4*)(b_ + 24576) = q2; *(uint4*)(b_ + 28672) = q3; } while (0)
  GLOAD(0);
  SWRITE(smem);
  __syncthreads();
  const int nk = K >> 6;
  for (int kt = 0; kt < nk; kt++) {
    const int k0 = min(kt + 1, nk - 1) << 6;
    GLOAD(k0);
    asm volatile("" ::: "memory"); __builtin_amdgcn_sched_barrier(0);
    const char* bP = smem + (kt & 1) * 32768;
    const char* bQ = bP + 16384;
#pragma unroll
    for (int s = 0; s < 4; s++) {
      const int co = ((s * 2 + (lane >> 5)) ^ sw) << 4;
      const bf16x8 pf0 = *(const bf16x8*)(bP + prow + co), pf1 = *(const bf16x8*)(bP + prow + 4096 + co);
      const bf16x8 qf0 = *(const bf16x8*)(bQ + qrow + co), qf1 = *(const bf16x8*)(bQ + qrow + 4096 + co);
      acc[0][0] = __builtin_amdgcn_mfma_f32_32x32x16_bf16(qf0, pf0, acc[0][0], 0, 0, 0);
      acc[0][1] = __builtin_amdgcn_mfma_f32_32x32x16_bf16(qf1, pf0, acc[0][1], 0, 0, 0);
      acc[1][0] = __builtin_amdgcn_mfma_f32_32x32x16_bf16(qf0, pf1, acc[1][0], 0, 0, 0);
      acc[1][1] = __builtin_amdgcn_mfma_f32_32x32x16_bf16(qf1, pf1, acc[1][1], 0, 0, 0);
    }
    asm volatile("" ::: "memory"); __builtin_amdgcn_sched_barrier(0);
    SWRITE(smem + ((kt + 1) & 1) * 32768);
    __syncthreads();
  }
#undef GLOAD
#undef SWRITE
}

DEV void acc_zero(f32x16 (&acc)[2][2]) {
#pragma unroll
  for (int a = 0; a < 2; a++)
#pragma unroll
    for (int b = 0; b < 2; b++)
#pragma unroll
      for (int r = 0; r < 16; r++) acc[a][b][r] = 0.f;
}

template <class F>
DEV void epi_foreach(const f32x16 (&acc)[2][2], const int tid_, F f) {
  const int lane = TIDX & 63, w = TIDX >> 6, wm = w >> 1, wn = w & 1;
#pragma unroll
  for (int a = 0; a < 2; a++)
#pragma unroll
    for (int b = 0; b < 2; b++)
#pragma unroll
      for (int rg = 0; rg < 4; rg++) {
        const int i = wm * 64 + a * 32 + (lane & 31);
        const int j = wn * 64 + b * 32 + rg * 8 + (lane >> 5) * 4;
        f(i, j, acc[a][b][rg * 4 + 0], acc[a][b][rg * 4 + 1], acc[a][b][rg * 4 + 2], acc[a][b][rg * 4 + 3]);
      }
}

DEV void tile_map(int li, int MPX, int xcd, int& m, int& n) {
  const int g = MPX * 8;
  const int ng = li / g, wv = li % g;
  m = xcd * MPX + (wv % MPX);
  n = ng * 8 + (wv / MPX);
}

DEV void tconv_tile(const float* __restrict__ src, int ldsrc, int k0, int n0, u16* __restrict__ dst, int lddst, int drow0, float* tile, const int tid_, const int blkK = 0) {
  const int t = TIDX;
  {
    const int n = t & 31, kk = t >> 5;
    float v[16];
#pragma unroll
    for (int p = 0; p < 16; p++) v[p] = src[(size_t)(k0 + kk + p * 8) * ldsrc + n0 + n];
#pragma unroll
    for (int p = 0; p < 16; p++) tile[(kk + p * 8) * 33 + n] = v[p];
  }
  __syncthreads();
  {
    const int k2 = (t & 63) * 2, nn = t >> 6;
#pragma unroll
    for (int p = 0; p < 8; p++) {
      const int n2 = nn + p * 4;
      u16* dp = blkK ? (dst + blk_off(drow0 + n2, k0 + k2, blkK)) : (dst + (size_t)(drow0 + n2) * lddst + k0 + k2);
      *(unsigned*)dp = pack2(tile[k2 * 33 + n2], tile[(k2 + 1) * 33 + n2]);
    }
  }
  __syncthreads();
}

DEV void phase_prep(const Params& p, char* smem, const int tid_, const int vb_, const int vg_) {
  const int t = TIDX;
  constexpr int N_MOD = 192;
  constexpr int T_IN = 1960, T_UQ = 72, T_UKV = 64, T_BR = 384, T_OUT = 256, T_CV = 256;
  constexpr int T_L = T_IN + T_UQ + T_UKV + T_BR + T_OUT + T_CV;
  constexpr int N_TC = 2 * T_L;
  constexpr int N_SG = 64, N_KC = 1024;
  constexpr int TOTAL = N_MOD + N_TC + N_SG + N_KC;
  float* MOD = (float*)(p.ws + O_MOD);
  for (int item = vb_; item < TOTAL; item += vg_) {
    if (item < N_MOD) {
      const int l = item / 96, e0 = (item % 96) * 32;
      float* sc = (float*)smem;
      {
        float cv[36];
#pragma unroll
        for (int i = 0; i < 36; i++) { const int idx = t + i * 256; const int c9 = idx >> 10, d = idx & 1023; cv[i] = (c9 == 0) ? p.c_ctx[d] : p.c[(c9 - 1) * 1024 + d]; }
#pragma unroll
        for (int i = 0; i < 36; i++) sc[t + i * 256] = silu_f(cv[i]);
      }
      __syncthreads();
      const int col = t & 31, slab = t >> 5;
      float a[9];
#pragma unroll
      for (int c9 = 0; c9 < 9; c9++) a[c9] = 0.f;
      const float* wp = p.w_mod + ((size_t)l * 1024 + slab * 128) * 3072 + e0 + col;
#pragma unroll 1
      for (int d0 = 0; d0 < 128; d0 += 16) {
        float wv[16];
#pragma unroll
        for (int j = 0; j < 16; j++) wv[j] = wp[(size_t)(d0 + j) * 3072];
#pragma unroll
        for (int j = 0; j < 16; j++) {
          const int d = slab * 128 + d0 + j;
#pragma unroll
          for (int c9 = 0; c9 < 9; c9++) a[c9] += sc[c9 * 1024 + d] * wv[j];
        }
      }
      float* red = sc + 9216;
#pragma unroll
      for (int c9 = 0; c9 < 9; c9++) red[(slab * 9 + c9) * 32 + col] = a[c9];
      __syncthreads();
      for (int idx = t; idx < 288; idx += 256) {
        const int c9 = idx >> 5, cc = idx & 31;
        float sum = 0.f;
#pragma unroll
        for (int sl = 0; sl < 8; sl++) sum += red[(sl * 9 + c9) * 32 + cc];
        MOD[(l * 9 + c9) * 3072 + e0 + cc] = sum + p.b_mod[l * 3072 + e0 + cc];
      }
      __syncthreads();
    } else if (item < N_MOD + N_TC) {
      const int ti = item - N_MOD;
      const int l = ti / T_L;
      int r = ti % T_L;
      const float* src; u16* dst; int ldsrc, lddst, k0, n0, drow, blkK = 0;
      if (r < T_IN) {
        const int nt = r >> 3, kt = r & 7;
        src = p.w_in + (size_t)l * 1024 * 7840; ldsrc = 7840; k0 = kt * 128; n0 = nt * 32;
        dst = (u16*)(p.ws + O_WIN) + (size_t)l * 7936 * 1024; lddst = 1024; blkK = 1024;
        drow = (n0 < 4224) ? n0 : (n0 == 4224 ? 7808 : n0 - 32);
      } else if ((r -= T_IN) < T_UQ) {
        const int nt = r / 3, kt = r % 3;
        src = p.w_uq + (size_t)l * 384 * 768; ldsrc = 768; k0 = kt * 128; n0 = nt * 32;
        dst = (u16*)(p.ws + O_WUQ) + (size_t)l * 768 * 384; lddst = 384; drow = n0; blkK = 384;
      } else if ((r -= T_UQ) < T_UKV) {
        const int nt = r >> 1, kt = r & 1;
        src = p.w_ukv + (size_t)l * 256 * 1024; ldsrc = 1024; k0 = kt * 128; n0 = nt * 32;
        dst = (u16*)(p.ws + O_WUKV) + (size_t)l * 1024 * 256; lddst = 256;
        const int hh = n0 >> 7, jj = n0 & 127;
        drow = (jj < 64) ? (hh * 64 + jj) : (512 + hh * 64 + jj - 64);
        blkK = 256;
      } else if ((r -= T_UKV) < T_BR) {
        const int kb = r >> 7, r2 = r & 127;
        const int nt = r2 >> 2, kt = r2 & 3;
        src = p.w_branch + (size_t)(l * 3 + kb) * 512 * 1024; ldsrc = 1024; k0 = kt * 128; n0 = nt * 32;
        dst = (u16*)(p.ws + O_WBR) + (size_t)(l * 3 + kb) * 1024 * 512; lddst = 512; drow = n0; blkK = 512;
      } else if ((r -= T_BR) < T_OUT) {
        const int nt = r >> 3, kt = r & 7;
        src = p.w_out + (size_t)l * 1024 * 1024; ldsrc = 1024; k0 = kt * 128; n0 = nt * 32;
        dst = (u16*)(p.ws + O_WOUT) + (size_t)l * 1024 * 1024; lddst = 1024; drow = n0; blkK = 1024;
      } else {
        r -= T_OUT;
        const int b = r >> 5, r2 = r & 31;
        const int nt = r2 >> 1, kt = r2 & 1;
        src = p.cache_na_v + (size_t)(b * 2 + l) * 256 * 512; ldsrc = 512; k0 = kt * 128; n0 = nt * 32;
        dst = (u16*)(p.ws + O_VTC) + (size_t)(l * 8 + b) * 512 * 256; lddst = 256; drow = n0;
      }
      tconv_tile(src, ldsrc, k0, n0, dst, lddst, drow, (float*)smem, tid_, blkK);
    } else if (item < N_MOD + N_TC + N_SG) {
      const int it = item - N_MOD - N_TC;
      const size_t e = (size_t)it * 2048 + t * 8;
      const float4 a = *(const float4*)(p.sgu_w + e), b = *(const float4*)(p.sgu_w + e + 4);
      u16* d = (u16*)(p.ws + O_SGUW) + e;
      st4bf(d, a.x, a.y, a.z, a.w); st4bf(d + 4, b.x, b.y, b.z, b.w);
    } else {
      const int it = item - N_MOD - N_TC - N_SG;
      const size_t e = (size_t)it * 2048 + t * 8;
      const int l = (int)(e >> 20), b = (int)(e >> 17) & 7; const size_t rest = e & 131071;
      const float* s = p.cache_na_k + ((size_t)(b * 2 + l) << 17) + rest;
      const float4 a = *(const float4*)s, bb = *(const float4*)(s + 4);
      u16* d = (u16*)(p.ws + O_KC) + e;
      st4bf(d, a.x, a.y, a.z, a.w); st4bf(d + 4, bb.x, bb.y, bb.z, bb.w);
    }
  }
}

DEV const float* xrow_in(const Params& p, int l, int s, int tl) {
  if (l == 0) return (s == 0 ? p.x_prompt : p.x_sample) + (size_t)tl * 1024;
  return p.out + OUT_Y + (size_t)s * 8388608 + (size_t)tl * 1024;
}
DEV int cond_idx(int s, int tl) { return s == 0 ? 0 : 1 + (tl >> 10); }

DEV void phase_h(const Params& p, int l, int s, const int tid_, const int vb_, const int vg_) {
  const int lane = TIDX & 63, wave = TIDX >> 6;
  u16* H = (u16*)(p.ws + O_H);
  const float* MOD = (const float*)(p.ws + O_MOD);
  for (int item = vb_; item < 512; item += vg_) {
    const int tl0 = item * 16 + wave * 4;
    const float* x = xrow_in(p, l, s, tl0);
    const float* mod = MOD + (size_t)(l * 9 + cond_idx(s, tl0)) * 3072;
    float4 v[4][4];
#pragma unroll
    for (int r = 0; r < 4; r++)
#pragma unroll
      for (int i = 0; i < 4; i++) {
        if (l == 0) v[r][i] = *(const float4*)(x + (size_t)r * 1024 + i * 256 + lane * 4);
        else {
          const uint2 w = *(const uint2*)((const u16*)(p.out + OUT_Y) + (size_t)(s * 8192 + tl0 + r) * 1024 + i * 256 + lane * 4);
          v[r][i] = make_float4(__uint_as_float(w.x << 16), __uint_as_float(w.x & 0xffff0000u), __uint_as_float(w.y << 16), __uint_as_float(w.y & 0xffff0000u));
        }
      }
    float4 g[4], sh[4], sc[4];
#pragma unroll
    for (int i = 0; i < 4; i++) {
      const int col = i * 256 + lane * 4;
      g[i] = *(const float4*)(p.norm_g + l * 1024 + col);
      sh[i] = *(const float4*)(mod + col);
      sc[i] = *(const float4*)(mod + 1024 + col);
    }
    asm volatile("" ::: "memory");
    float ss[4];
#pragma unroll
    for (int r = 0; r < 4; r++) {
      ss[r] = 0.f;
#pragma unroll
      for (int i = 0; i < 4; i++) ss[r] += v[r][i].x * v[r][i].x + v[r][i].y * v[r][i].y + v[r][i].z * v[r][i].z + v[r][i].w * v[r][i].w;
    }
#pragma unroll
    for (int o = 32; o > 0; o >>= 1) {
#pragma unroll
      for (int r = 0; r < 4; r++) ss[r] += __shfl_xor(ss[r], o);
    }
#pragma unroll
    for (int r = 0; r < 4; r++) {
      const float rstd = rsqrtf(ss[r] * (1.f / 1024.f) + 1e-6f);
#pragma unroll
      for (int i = 0; i < 4; i++) {
        const int col = i * 256 + lane * 4;
        st4bf(H + blk_off(tl0 + r, col, 1024), v[r][i].x * rstd * g[i].x * (1.f + sc[i].x) + sh[i].x, v[r][i].y * rstd * g[i].y * (1.f + sc[i].y) + sh[i].y,
              v[r][i].z * rstd * g[i].z * (1.f + sc[i].z) + sh[i].z, v[r][i].w * rstd * g[i].w * (1.f + sc[i].w) + sh[i].w);
      }
    }
  }
}

DEV void phase_rows(const Params& p, int l, int s, char* smem, const int tid_, const int vb_, const int vg_) {
  const int t = TIDX, lane = t & 63, wave = t >> 6;
  const u16* DQ = (const u16*)(p.ws + O_DQ); const u16* DKV = (const u16*)(p.ws + O_DKV); const float* KRF = (const float*)(p.ws + O_KRF);
  u16* CKV = (u16*)(p.ws + O_CKV); u16* KR = (u16*)(p.ws + O_KR); u16* GVT = (u16*)(p.ws + O_GVT);
  const int n_row = 512, n_ln = 256, n_cache = (s == 1) ? 512 : 0;
  const int total = n_row + n_ln + n_cache;
  for (int item = vb_; item < total; item += vg_) {
    if (item < n_row) {
      const int tl0 = item * 16 + wave * 4;
      unsigned dqw[4][3]; uint2 dkw[4]; float k1[4], k2[4];
#pragma unroll
      for (int r = 0; r < 4; r++) {
        const unsigned* rp = (const unsigned*)(DQ + (size_t)(tl0 + r) * 384) + lane * 3;
        dqw[r][0] = rp[0]; dqw[r][1] = rp[1]; dqw[r][2] = rp[2];
        dkw[r] = *(const uint2*)(DKV + (size_t)(tl0 + r) * 256 + lane * 4);
        k1[r] = KRF[(size_t)(tl0 + r) * 32 + (lane & 15)]; k2[r] = KRF[(size_t)(tl0 + r) * 32 + 16 + (lane & 15)];
      }
      const float2* gq = (const float2*)(p.q_norm + l * 384) + lane * 3;
      const float2 g0 = gq[0], g1 = gq[1], g2 = gq[2];
      const float4 gk = *(const float4*)(p.kv_norm + l * 256 + lane * 4);
      asm volatile("" ::: "memory");
      float qv[4][6], kv4[4][4], sq[4], sk[4];
#pragma unroll
      for (int r = 0; r < 4; r++) {
#pragma unroll
        for (int j = 0; j < 3; j++) { qv[r][2 * j] = __uint_as_float(dqw[r][j] << 16); qv[r][2 * j + 1] = __uint_as_float(dqw[r][j] & 0xffff0000u); }
        kv4[r][0] = __uint_as_float(dkw[r].x << 16); kv4[r][1] = __uint_as_float(dkw[r].x & 0xffff0000u);
        kv4[r][2] = __uint_as_float(dkw[r].y << 16); kv4[r][3] = __uint_as_float(dkw[r].y & 0xffff0000u);
        sq[r] = 0.f; sk[r] = 0.f;
#pragma unroll
        for (int j = 0; j < 6; j++) sq[r] += qv[r][j] * qv[r][j];
#pragma unroll
        for (int j = 0; j < 4; j++) sk[r] += kv4[r][j] * kv4[r][j];
      }
#pragma unroll
      for (int o = 32; o > 0; o >>= 1) {
#pragma unroll
        for (int r = 0; r < 4; r++) { sq[r] += __shfl_xor(sq[r], o); sk[r] += __shfl_xor(sk[r], o); }
      }
#pragma unroll
      for (int r = 0; r < 4; r++) {
        const int tl = tl0 + r;
        const float rq = rsqrtf(sq[r] * (1.f / 384.f) + 1e-6f);
        u16* dqn = (u16*)(p.ws + O_DQN);
        *(unsigned*)(dqn + blk_off(tl, lane * 6 + 0, 384)) = pack2(qv[r][0] * rq * g0.x, qv[r][1] * rq * g0.y);
        *(unsigned*)(dqn + blk_off(tl, lane * 6 + 2, 384)) = pack2(qv[r][2] * rq * g1.x, qv[r][3] * rq * g1.y);
        *(unsigned*)(dqn + blk_off(tl, lane * 6 + 4, 384)) = pack2(qv[r][4] * rq * g2.x, qv[r][5] * rq * g2.y);
        const float rk = rsqrtf(sk[r] * (1.f / 256.f) + 1e-6f);
        const float a = kv4[r][0] * rk * gk.x, b = kv4[r][1] * rk * gk.y, c = kv4[r][2] * rk * gk.z, d = kv4[r][3] * rk * gk.w;
        const int row = (s == 0) ? tl : ((tl >> 10) * 1280 + 256 + (tl & 1023));
        st4bf(CKV + blk_off(row, lane * 4, 256), a, b, c, d);
        if (s == 0) {
          const int bb = tl >> 8, sqi = tl & 255;
          *(float4*)(p.out + OUT_CKV + ((size_t)(bb * 2 + l) * 256 + sqi) * 256 + lane * 4) = make_float4(a, b, c, d);
        }
        if (lane < 16) {
          const float x1 = k1[r], x2 = k2[r];
          if (s == 0) {
            KR[(size_t)tl * 32 + lane] = f2bf(x1);
            KR[(size_t)tl * 32 + 16 + lane] = f2bf(x2);
          } else {
            const int nn = tl & 1023;
            const float pos = (lane < 8) ? (float)(nn >> 6) : (float)(nn & 63);
            const float inv = __builtin_amdgcn_exp2f(-(float)(lane & 7) * (0.125f * 13.287712379549449f));
            const float ang = pos * inv;
            const float cs = __cosf(ang), sn = __sinf(ang);
            const int row2 = (tl >> 10) * 1280 + 256 + nn;
            KR[(size_t)row2 * 32 + lane] = f2bf(x1 * cs - x2 * sn);
            KR[(size_t)row2 * 32 + 16 + lane] = f2bf(x1 * sn + x2 * cs);
          }
        }
      }
    } else if (item < n_row + n_ln) {
      const int it = item - n_row, chunk = it >> 2, slab = it & 3;
      u16* g = GVT + (size_t)chunk * 512 * 128 + slab * 32;
      const int q = t & 31, part = t >> 5;
      float v[64];
      float sum = 0.f, sq = 0.f;
#pragma unroll
      for (int c = 0; c < 64; c++) { v[c] = gelu_f(bf2f(g[(part * 64 + c) * 128 + q])); sum += v[c]; sq += v[c] * v[c]; }
      float* red = (float*)smem;
      red[(part * 2 + 0) * 32 + q] = sum; red[(part * 2 + 1) * 32 + q] = sq;
      __syncthreads();
      sum = 0.f; sq = 0.f;
#pragma unroll
      for (int pp = 0; pp < 8; pp++) { sum += red[(pp * 2 + 0) * 32 + q]; sq += red[(pp * 2 + 1) * 32 + q]; }
      const float mu = sum * (1.f / 512.f);
      const float var = fmaxf(sq * (1.f / 512.f) - mu * mu, 0.f);
      const float rstd = rsqrtf(var + 1e-6f);
#pragma unroll
      for (int c = 0; c < 64; c++) g[(part * 64 + c) * 128 + q] = f2bf((v[c] - mu) * rstd);
      __syncthreads();
    } else {
      const int rowi = (item - n_row - n_ln) * 4 + wave;
      const int b = rowi >> 8, m = rowi & 255;
      const float4 a = *(const float4*)(p.cache_ckv + ((size_t)(b * 2 + l) * 256 + m) * 256 + lane * 4);
      st4bf(CKV + blk_off(b * 1280 + m, lane * 4, 256), a.x, a.y, a.z, a.w);
      if (lane < 32) KR[(size_t)(b * 1280 + m) * 32 + lane] = f2bf(p.cache_kr[((size_t)(b * 2 + l) * 256 + m) * 32 + lane]);
    }
  }
}

typedef __attribute__((ext_vector_type(4))) float f32x4;
struct AttnSrc { const u16* k; const u16* kr; const u16* vt; int vts; };
struct AttnState { f32x4 o[4]; float mx, ls; };
constexpr int ATT_VST = 136;

struct AttnRegs { uint4 k0, k1, k2, v0, v1; };
template <int DQK>
DEV void attn_gload(const AttnSrc& src, AttnRegs& r, int t) {
  const int row = t >> 3, c8 = (t & 7) * 8;
  r.k0 = *(const uint4*)(src.k + (size_t)row * 512 + c8);
  r.k1 = *(const uint4*)(src.k + (size_t)(row + 32) * 512 + c8);
  r.v0 = *(const uint4*)(src.vt + (size_t)row * src.vts + c8);
  r.v1 = *(const uint4*)(src.vt + (size_t)(row + 32) * src.vts + c8);
  if (DQK == 96) r.k2 = *(const uint4*)(src.kr + (size_t)(t >> 2) * 32 + (t & 3) * 8);
}
template <int DQK>
DEV void attn_swrite(char* buf, const AttnRegs& r, int t) {
  constexpr int KST = DQK * 2 + 16;
  const int row = t >> 3, c16 = (t & 7) * 16;
  char* vb = buf + 64 * KST;
  *(uint4*)(buf + row * KST + c16) = make_uint4(r.k0.x, r.k0.y, r.k0.z, r.k0.w);
  *(uint4*)(buf + (row + 32) * KST + c16) = make_uint4(r.k1.x, r.k1.y, r.k1.z, r.k1.w);
  char* vp = vb + row * ATT_VST + c16;
  *(uint2*)vp = make_uint2(r.v0.x, r.v0.y);
  *(uint2*)(vp + 8) = make_uint2(r.v0.z, r.v0.w);
  vp += 32 * ATT_VST;
  *(uint2*)vp = make_uint2(r.v1.x, r.v1.y);
  *(uint2*)(vp + 8) = make_uint2(r.v1.z, r.v1.w);
  if (DQK == 96) *(uint4*)(buf + (t >> 2) * KST + 128 + (t & 3) * 16) = make_uint4(r.k2.x, r.k2.y, r.k2.z, r.k2.w);
}

template <int DQK, int NT, bool LOCAL>
DEV void attn_compute(const char* buf, const bf16x8 qf0, const bf16x8 qf1, const bf16x8 qf2, AttnState& st, float scale, int koff0, const float* biasrow, int qc, int wlo, const int tid_) {
  constexpr int KST = DQK * 2 + 16;
  const int lane = TIDX & 63, r16 = lane & 15, g = lane >> 4;
  const char* vb = buf + 64 * KST;
  f32x4 s[NT];
#pragma unroll
  for (int t = 0; t < NT; t++) {
    s[t] = f32x4{0.f, 0.f, 0.f, 0.f};
    const char* kp = buf + (koff0 + t * 16 + r16) * KST + g * 16;
    s[t] = __builtin_amdgcn_mfma_f32_16x16x32_bf16(*(const bf16x8*)(kp), qf0, s[t], 0, 0, 0);
    s[t] = __builtin_amdgcn_mfma_f32_16x16x32_bf16(*(const bf16x8*)(kp + 64), qf1, s[t], 0, 0, 0);
    if (DQK == 96) s[t] = __builtin_amdgcn_mfma_f32_16x16x32_bf16(*(const bf16x8*)(kp + 128), qf2, s[t], 0, 0, 0);
  }
  float mloc = st.mx;
#pragma unroll
  for (int t = 0; t < NT; t++)
#pragma unroll
    for (int e = 0; e < 4; e++) {
      float v = s[t][e] * scale;
      if (LOCAL) {
        const int kc = koff0 + t * 16 + 4 * g + e;
        const int bi = min(max(kc - qc + 15, 0), 30);
        const float bv = biasrow[bi] * 1.4426950408889634f;
        v = (kc >= wlo && kc < wlo + 16) ? v + bv : -1e30f;
      }
      s[t][e] = v;
      mloc = fmaxf(mloc, v);
    }
  mloc = rows_allmax(mloc);
  const float alpha = __builtin_amdgcn_exp2f(st.mx - mloc);
  st.mx = mloc;
  float psum = 0.f;
#pragma unroll
  for (int t = 0; t < NT; t++)
#pragma unroll
    for (int e = 0; e < 4; e++) {
      const float pv = __builtin_amdgcn_exp2f(s[t][e] - mloc);
      s[t][e] = pv;
      psum += pv;
    }
  st.ls = st.ls * alpha + psum;
#pragma unroll
  for (int dt = 0; dt < 4; dt++) st.o[dt] *= alpha;
#pragma unroll
  for (int kb = 0; kb < NT / 2; kb++) {
    bf16x8 pf;
#pragma unroll
    for (int e = 0; e < 4; e++) { pf[e] = (__bf16)s[2 * kb][e]; pf[4 + e] = (__bf16)s[2 * kb + 1][e]; }
#pragma unroll
    for (int dt = 0; dt < 4; dt++) {
      const char* vp = vb + (dt * 16 + r16) * ATT_VST + (koff0 + 4 * g) * 2 + kb * 64;
      const uint2 a0 = *(const uint2*)vp, a1 = *(const uint2*)(vp + 32);
      const uint4 av = make_uint4(a0.x, a0.y, a1.x, a1.y);
      st.o[dt] = __builtin_amdgcn_mfma_f32_16x16x32_bf16(__builtin_bit_cast(bf16x8, av), pf, st.o[dt], 0, 0, 0);
    }
  }
}

template <int MODE>
DEV void attn_item(const Params& p, int l, int it, char* smem, const int tid_) {
  constexpr int DQK = (MODE >= 2) ? 96 : 64;
  constexpr int KST = DQK * 2 + 16;
  constexpr int BUFSZ = 64 * KST + 64 * ATT_VST;
  const int t = TIDX, lane = t & 63, w = t >> 6, r16 = lane & 15, g = lane >> 4;
  constexpr int QB = (MODE >= 2) ? 2 : 1;
  int b, h, tl0, nst, r = 0;
  if (MODE == 0) { b = it >> 5; h = (it >> 2) & 7; tl0 = b * 256 + (it & 3) * 64; nst = 4; }
  else if (MODE == 1) { b = it >> 7; h = (it >> 4) & 7; r = it & 15; tl0 = b * 1024 + r * 64; nst = 12; }
  else if (MODE == 2) { b = it >> 4; h = (it >> 1) & 7; tl0 = b * 256 + (it & 1) * 128; nst = 4; }
  else { b = it >> 6; h = (it >> 3) & 7; tl0 = b * 1024 + (it & 7) * 128; nst = 20; }
  const int tl = tl0 + w * (16 * QB) + r16;
  const int wr0 = min(max(r - 4, 0), 8);
  const u16* KNA = (const u16*)(p.ws + O_KNA); const u16* VTNA = (const u16*)(p.ws + O_VTNA);
  const u16* KC = (const u16*)(p.ws + O_KC); const u16* VTC = (const u16*)(p.ws + O_VTC);
  const u16* KNOPE = (const u16*)(p.ws + O_KNOPE); const u16* KR = (const u16*)(p.ws + O_KR); const u16* VTM = (const u16*)(p.ws + O_VTM);
  auto get_src = [&](int st) {
    AttnSrc s;
    s.kr = nullptr;
    if (MODE == 0) {
      s.k = KNA + (size_t)(b * 256 + st * 64) * 512 + h * 64; s.vt = VTNA + (size_t)(b * 512 + h * 64) * 256 + st * 64; s.vts = 256;
    } else if (MODE == 1) {
      if (st < 8) {
        const int krow = wr0 + st;
        s.k = KNA + (size_t)(b * 1024 + krow * 64) * 512 + h * 64; s.vt = VTNA + (size_t)(b * 512 + h * 64) * 1024 + krow * 64; s.vts = 1024;
      } else {
        const int m0 = (st - 8) * 64;
        s.k = KC + ((size_t)(l * 8 + b) * 256 + m0) * 512 + h * 64; s.vt = VTC + ((size_t)(l * 8 + b) * 512 + h * 64) * 256 + m0; s.vts = 256;
      }
    } else if (MODE == 2) {
      s.k = KNOPE + (size_t)(b * 256 + st * 64) * 512 + h * 64; s.kr = KR + (size_t)(b * 256 + st * 64) * 32;
      s.vt = VTM + (size_t)(b * 512 + h * 64) * 256 + st * 64; s.vts = 256;
    } else {
      s.k = KNOPE + (size_t)(b * 1280 + st * 64) * 512 + h * 64; s.kr = KR + (size_t)(b * 1280 + st * 64) * 32;
      s.vt = VTM + (size_t)(b * 512 + h * 64) * 1280 + st * 64; s.vts = 1280;
    }
    return s;
  };
  AttnRegs rg;
  rg.k2 = make_uint4(0, 0, 0, 0);
  {
    const AttnSrc s0 = get_src(0);
    attn_gload<DQK>(s0, rg, t);
  }
  asm volatile("" ::: "memory");
  auto load_q = [&](int tl, bf16x8& qf0, bf16x8& qf1, bf16x8& qf2) {
  if (MODE < 2) {
    const u16* qp = (const u16*)(p.ws + O_QNA) + (size_t)tl * 512 + h * 64 + 8 * g;
    qf0 = *(const bf16x8*)qp; qf1 = *(const bf16x8*)(qp + 32); qf2 = qf0;
  } else {
    const u16* qp = (const u16*)(p.ws + O_QM) + (size_t)tl * 768 + h * 96;
    qf0 = *(const bf16x8*)(qp + 8 * g); qf1 = *(const bf16x8*)(qp + 32 + 8 * g);
    if (MODE == 2) {
      qf2 = *(const bf16x8*)(qp + 64 + 8 * g);
    } else {
      const uint4 own = *(const uint4*)(qp + 64 + 8 * g), oth = *(const uint4*)(qp + 64 + 8 * (g ^ 2));
      const unsigned ow[4] = {own.x, own.y, own.z, own.w}, ot[4] = {oth.x, oth.y, oth.z, oth.w};
      const int nn = tl & 1023;
      const float pos = (g & 1) ? (float)(nn & 63) : (float)(nn >> 6);
      bf16x8 qr;
#pragma unroll
      for (int e = 0; e < 8; e++) {
        const float a = __uint_as_float((e & 1) ? (ow[e >> 1] & 0xffff0000u) : (ow[e >> 1] << 16));
        const float c = __uint_as_float((e & 1) ? (ot[e >> 1] & 0xffff0000u) : (ot[e >> 1] << 16));
        const float inv = powf(10000.f, -(float)e * 0.125f);
        const float ang = pos * inv;
        const float cs = __cosf(ang), sn = __sinf(ang);
        const float v = (g < 2) ? (a * cs - c * sn) : (c * sn + a * cs);
        qr[e] = (__bf16)v;
      }
      qf2 = qr;
    }
  }
  };
  bf16x8 qf0, qf1, qf2, qg0, qg1, qg2;
  load_q(tl, qf0, qf1, qf2);
  if (QB == 2) load_q(tl + 16, qg0, qg1, qg2); else { qg0 = qf0; qg1 = qf1; qg2 = qf2; }
  float* biasl = (float*)(smem + 2 * BUFSZ);
  if (MODE == 1) {
    for (int i = t; i < 465; i += 256) biasl[i] = p.na_rpb[(size_t)(l * 8 + h) * 465 + i];
  }
  AttnState st, st2;
#pragma unroll
  for (int dt = 0; dt < 4; dt++) { st.o[dt] = f32x4{0.f, 0.f, 0.f, 0.f}; st2.o[dt] = f32x4{0.f, 0.f, 0.f, 0.f}; }
  st.mx = -1e30f; st.ls = 0.f; st2.mx = -1e30f; st2.ls = 0.f;
  const float scale = ((MODE >= 2) ? 0.10206207261596575f : 0.125f) * 1.4426950408889634f;
  const int qc = w * 16 + r16;
  const int wlo = min(max(qc - 8, 0), 48);
  const int wstart = min(max(16 * w - 8, 0), 32);
  asm volatile("" ::: "memory"); __builtin_amdgcn_sched_barrier(0);
  attn_swrite<DQK>(smem, rg, t);
  __syncthreads();
  for (int sidx = 0; sidx < nst; sidx++) {
    { const AttnSrc sn = get_src(min(sidx + 1, nst - 1)); attn_gload<DQK>(sn, rg, t); }
    asm volatile("" ::: "memory"); __builtin_amdgcn_sched_barrier(0);
    const char* buf = smem + (sidx & 1) * BUFSZ;
    if (MODE == 1 && sidx < 8) attn_compute<DQK, 2, true>(buf, qf0, qf1, qf2, st, scale, wstart, biasl + (wr0 + sidx - r + 7) * 31, qc, wlo, tid_);
    else {
      attn_compute<DQK, 4, false>(buf, qf0, qf1, qf2, st, scale, 0, nullptr, 0, 0, tid_);
      if (QB == 2) attn_compute<DQK, 4, false>(buf, qg0, qg1, qg2, st2, scale, 0, nullptr, 0, 0, tid_);
    }
    asm volatile("" ::: "memory"); __builtin_amdgcn_sched_barrier(0);
    attn_swrite<DQK>(smem + ((sidx + 1) & 1) * BUFSZ, rg, t);
    __syncthreads();
  }
  auto finish = [&](const AttnState& st, int tl) {
    float lt = st.ls;
    lt += __shfl_xor(lt, 16);
    lt += __shfl_xor(lt, 32);
    const float inv = 1.f / lt;
    u16* Z = (u16*)(p.ws + (MODE < 2 ? O_ZA : O_ZC)) + (size_t)(MODE & 1) * 8192 * 512 + blk_off(tl, h * 64 + 4 * g, 512);
#pragma unroll
    for (int dt = 0; dt < 4; dt++) {
      float a, bb, c, d;
      ld4bf(Z + dt * 16, a, bb, c, d);
      a = silu_f(a); bb = silu_f(bb); c = silu_f(c); d = silu_f(d);
      st4bf(Z + dt * 16, st.o[dt][0] * inv * a, st.o[dt][1] * inv * bb, st.o[dt][2] * inv * c, st.o[dt][3] * inv * d);
    }
  };
  finish(st, tl);
  if (QB == 2) finish(st2, tl + 16);
}

DEV void phase_mix(const Params& p, int l, int s, char* smem, const int tid_, const int vb_, const int vg_, const int vid_) {
  if (s == 0) {
    const int vblk = vid_ >> 1, team = vid_ & 1, bq = vblk & 31;
    const int cnt = (bq < 12) ? 1 : ((bq < 20) ? 2 : 3);
    const int start = (bq < 12) ? (bq * 2) : ((bq < 20) ? (24 + (bq - 12) * 4) : (56 + (bq - 20) * 6));
    for (int j = 0; j < cnt; j++) attn_item<0>(p, l, (vblk >> 5) * 128 + start + team * cnt + j, smem, tid_);
  } else {
    for (int item = vb_; item < 1024; item += vg_) attn_item<1>(p, l, item, smem, tid_);
  }
  {
    const int vblk = vid_ >> 1, team = vid_ & 1, bq = vblk & 31;
    if (bq >= 16) {
      const int it = (vblk >> 5) * 32 + (bq - 16) * 2 + team, chunk = it >> 2, g = it & 3;
      const u16* Wg = (const u16*)(p.ws + O_SGUW) + (size_t)(l * 4 + g) * 128 * 128;
      const u16* V = (const u16*)(p.ws + O_GVT) + ((size_t)chunk * 512 + g * 128) * 128;
      const u16* GU = (const u16*)(p.ws + O_GU); u16* ZB = (u16*)(p.ws + O_ZB) + (size_t)s * 8192 * 512;
      f32x16 acc[2][2];
      acc_zero(acc);
      gemm_mainloop_d1(Wg, 128, V, 128, 128, smem, acc, tid_);
      epi_foreach(acc, tid_, [&](int i, int j, float v0, float v1, float v2, float v3) {
        const float bs = p.sgu_b[(l * 4 + g) * 128 + i];
        const size_t off = (size_t)(chunk * 128 + i) * 512 + g * 128 + j;
        float u0, u1, u2, u3, z0, z1, z2, z3;
        ld4bf(GU + off, u0, u1, u2, u3);
        const size_t zoff = blk_off(chunk * 128 + i, g * 128 + j, 512);
        ld4bf(ZB + zoff, z0, z1, z2, z3);
        u0 = gelu_f(u0); u1 = gelu_f(u1); u2 = gelu_f(u2); u3 = gelu_f(u3);
        z0 = silu_f(z0); z1 = silu_f(z1); z2 = silu_f(z2); z3 = silu_f(z3);
        st4bf(ZB + zoff, u0 * (v0 + bs) * z0, u1 * (v1 + bs) * z1, u2 * (v2 + bs) * z2, u3 * (v3 + bs) * z3);
      });
    }
  }
}

DEV void phase_mla(const Params& p, int l, int s, char* smem, const int tid_, const int vb_, const int vg_) {
  for (int item = vb_; item < 512; item += vg_) {
    if (s == 0) attn_item<2>(p, l, item, smem, tid_); else attn_item<3>(p, l, item, smem, tid_);
  }
}

DEV void phase_final(const Params& p, const int tid_, const int vb_, const int vg_) {
  const int lane = TIDX & 63, wave = TIDX >> 6;
  for (int item = vb_; item < 1024; item += vg_) {
    float* x = p.out + OUT_Y + (size_t)(item * 16 + wave * 4) * 1024;
    const u16* xb = (const u16*)(p.ws + O_ZA) + (size_t)(item * 16 + wave * 4) * 1024;
    float4 v[4][4];
#pragma unroll
    for (int r = 0; r < 4; r++)
#pragma unroll
      for (int i = 0; i < 4; i++) {
        const uint2 w = *(const uint2*)(xb + (size_t)r * 1024 + i * 256 + lane * 4);
        v[r][i] = make_float4(__uint_as_float(w.x << 16), __uint_as_float(w.x & 0xffff0000u), __uint_as_float(w.y << 16), __uint_as_float(w.y & 0xffff0000u));
      }
    float4 g[4];
#pragma unroll
    for (int i = 0; i < 4; i++) g[i] = *(const float4*)(p.final_g + i * 256 + lane * 4);
    asm volatile("" ::: "memory");
    float ss[4];
#pragma unroll
    for (int r = 0; r < 4; r++) {
      ss[r] = 0.f;
#pragma unroll
      for (int i = 0; i < 4; i++) ss[r] += v[r][i].x * v[r][i].x + v[r][i].y * v[r][i].y + v[r][i].z * v[r][i].z + v[r][i].w * v[r][i].w;
    }
#pragma unroll
    for (int o = 32; o > 0; o >>= 1) {
#pragma unroll
      for (int r = 0; r < 4; r++) ss[r] += __shfl_xor(ss[r], o);
    }
#pragma unroll
    for (int r = 0; r < 4; r++) {
      const float rstd = rsqrtf(ss[r] * (1.f / 1024.f) + 1e-6f);
#pragma unroll
      for (int i = 0; i < 4; i++)
        *(float4*)(x + (size_t)r * 1024 + i * 256 + lane * 4) =
            make_float4(v[r][i].x * rstd * g[i].x, v[r][i].y * rstd * g[i].y, v[r][i].z * rstd * g[i].z, v[r][i].w * rstd * g[i].w);
    }
  }
}

namespace pg8 {
#define PG8_LAS __attribute__((address_space(3)))
typedef unsigned short bf16_t;
typedef short bf16x8 __attribute__((ext_vector_type(8)));
typedef float f32x4 __attribute__((ext_vector_type(4)));
typedef unsigned u32x4 __attribute__((ext_vector_type(4)));
constexpr int BM = 256, BK = 64, HALF = 128, HTB = HALF * BK * 2  , STAGE_BYTES = 8 * HTB, NXCD = 8, WGM = 8;

__host__ __device__ __forceinline__ int lds_byte(int r, int c) { const int st = (r >> 4) * 2 + (c >> 5), rr = r & 15, cc = c & 31, ob = rr * 64 + cc * 2; return st * 1024 + (ob ^ (((ob >> 9) & 1) << 5)); }
__host__ __device__ __forceinline__ void stage_rc(int b, int& R, int& C) { const int st = b / 1024, sb = b % 1024, swz = sb ^ (((sb >> 9) & 1) << 5); R = (st >> 1) * 16 + swz / 64; C = (st & 1) * 32 + (swz % 64) / 2; }
__host__ __device__ __forceinline__ int perm32(int rho) { const int n = rho >> 4, i = rho & 15; return 8 * (i >> 2) + 4 * n + (i & 3); }

struct Unit { int pm, pn; };
struct Gemm { const bf16_t* A; const bf16_t* Bt; int M, N, K; };

template <class Epi, class Sched, bool STAMP = false>
__device__ __forceinline__ void gemm_phase(PG8_LAS unsigned char* lds, const Gemm g, const Sched& S, const Epi& E, unsigned long long* stamps) {
    const int tid = tid_opaque(), wid = __builtin_amdgcn_readfirstlane(tid >> 6), lane = tid & 63, wr = wid >> 2, wc = wid & 3, fr = lane & 15, fq = lane >> 4;
    const int K = g.K, nt = K / BK;
    int ts_lo = 0, ts_hi = 0, nts = 0; const unsigned long long rt_entry = STAMP ? (unsigned long long)wall_clock64() : 0ull;
#define PG8_STAMP() do { if (STAMP && wid == 0 && nts < 64) { const unsigned long long _c = (unsigned long long)clock64(); \
        ts_lo = (lane == nts) ? (int)(unsigned)_c : ts_lo; ts_hi = (lane == nts) ? (int)(unsigned)(_c >> 32) : ts_hi; ++nts; } } while (0)
    PG8_STAMP();
    unsigned voffA[2], voffB[2];
#pragma unroll
    for (int i = 0; i < 2; ++i) { int R, C; stage_rc(tid * 16 + i * 8192, R, C); const int Rb = Epi::PERM ? ((R & ~31) + perm32(R & 31)) : R;
        voffA[i] = (unsigned)(R * BK + C) * 2u; voffB[i] = (unsigned)(Rb * BK + C) * 2u; }
    const size_t kstep = (size_t)(BM * BK * 2);
    const size_t hstep = (size_t)HALF * BK * 2;
    const size_t tstep = (size_t)BM * K * 2;
    const unsigned ldsw = (unsigned)wid * 1024u;
    const int aoff = lds_byte(wr * 64 + fr, fq * 8), boff = lds_byte(wc * 32 + fr, fq * 8);
#define PG8_SA(b, h) (((b) * 2 + (h)) * HTB)
#define PG8_SB(b, h) ((4 + (b) * 2 + (h)) * HTB)
#define PG8_STAGE(bufoff, gbase, voff) do { _Pragma("unroll") for (int _i = 0; _i < 2; ++_i) \
        __builtin_amdgcn_global_load_lds((const unsigned*)((const char*)(gbase) + (voff)[_i]), (PG8_LAS unsigned*)(lds + (bufoff) + ldsw + _i * 8192), 16, 0, 0); } while (0)
#define PG8_LDA(dst, b, h) do { _Pragma("unroll") for (int m = 0; m < 4; ++m) _Pragma("unroll") for (int k = 0; k < 2; ++k) dst[m][k] = *(const PG8_LAS bf16x8*)(lds + PG8_SA(b, h) + aoff + m * 2048 + k * 1024); } while (0)
#define PG8_LDB(dst, b, h) do { _Pragma("unroll") for (int n = 0; n < 2; ++n) _Pragma("unroll") for (int k = 0; k < 2; ++k) dst[n][k] = *(const PG8_LAS bf16x8*)(lds + PG8_SB(b, h) + boff + n * 2048 + k * 1024); } while (0)
#define PG8_MMA(ai, bj, At, Bt) do { __builtin_amdgcn_s_setprio(1); _Pragma("unroll") for (int m = 0; m < 4; ++m) _Pragma("unroll") for (int n = 0; n < 2; ++n) _Pragma("unroll") for (int k = 0; k < 2; ++k) \
        acc[ai][bj][m][n] = __builtin_amdgcn_mfma_f32_16x16x32_bf16(Bt[n][k], At[m][k], acc[ai][bj][m][n], 0, 0, 0); __builtin_amdgcn_s_setprio(0); } while (0)
#define PG8_WAIT_V(n) asm volatile("s_waitcnt vmcnt(" #n ")" ::: "memory")
#define PG8_WAIT_L(n) asm volatile("s_waitcnt lgkmcnt(" #n ")" ::: "memory")
#define PG8_BAR __builtin_amdgcn_s_barrier()
#define PG8_SCHED __builtin_amdgcn_sched_barrier(0)
    Unit cur, nxt; int ui = 0;
    if (!S.next(0, cur)) return;
    f32x4 acc[2][2][4][2];
#pragma unroll
    for (int a = 0; a < 2; ++a)
#pragma unroll
        for (int b = 0; b < 2; ++b)
#pragma unroll
            for (int m = 0; m < 4; ++m)
#pragma unroll
                for (int n = 0; n < 2; ++n) acc[a][b][m][n] = (f32x4){0.f, 0.f, 0.f, 0.f};
    bf16x8 At[4][2], B0[2][2], B1[2][2];
    const char* cA = (const char*)g.A + (size_t)cur.pm * tstep; const char* cB = (const char*)g.Bt + (size_t)cur.pn * tstep;
    S.a_ready(cur);
    PG8_STAGE(PG8_SB(0, 0), cB, voffB); PG8_STAGE(PG8_SA(0, 0), cA, voffA); PG8_STAGE(PG8_SB(0, 1), cB + hstep, voffB); PG8_STAGE(PG8_SA(0, 1), cA + hstep, voffA);
    if (wr == 1) PG8_BAR;
    PG8_WAIT_V(4); PG8_BAR;
    PG8_STAGE(PG8_SB(1, 0), cB + kstep, voffB); PG8_STAGE(PG8_SA(1, 0), cA + kstep, voffA); PG8_STAGE(PG8_SB(1, 1), cB + hstep + kstep, voffB);
    PG8_WAIT_V(6); PG8_BAR;
    PG8_STAMP();
    for (;;) {
        const bool has_next = S.next(ui + 1, nxt);
        const char* nA = has_next ? (const char*)g.A + (size_t)nxt.pm * tstep : cA; const char* nB = has_next ? (const char*)g.Bt + (size_t)nxt.pn * tstep : cB;
        for (int t = 0; t < nt; t += 2) {
            const bool last = (t == nt - 2);
            const char* a1 = cA + (size_t)(t + 1) * kstep;
            const char* a2 = last ? nA : cA + (size_t)(t + 2) * kstep; const char* b2 = last ? nB : cB + (size_t)(t + 2) * kstep;
            const char* a3 = a2 + kstep; const char* b3 = b2 + kstep;
            if (last && has_next) S.a_ready(nxt);
            PG8_LDB(B0, 0, 0); PG8_SCHED; PG8_LDA(At, 0, 0); PG8_STAGE(PG8_SA(1, 1), a1 + hstep, voffA);
            PG8_WAIT_L(8); PG8_BAR; PG8_WAIT_L(0); PG8_MMA(0, 0, At, B0); PG8_BAR; PG8_SCHED;
            PG8_LDB(B1, 0, 1); PG8_STAGE(PG8_SB(0, 0), b2, voffB);
            PG8_BAR; PG8_WAIT_L(0); PG8_MMA(0, 1, At, B1); PG8_BAR;
            PG8_LDA(At, 0, 1); PG8_STAGE(PG8_SA(0, 0), a2, voffA);
            PG8_BAR; PG8_WAIT_L(0); PG8_MMA(1, 0, At, B0); PG8_BAR; PG8_SCHED;
            PG8_STAGE(PG8_SB(0, 1), b2 + hstep, voffB);
            PG8_WAIT_V(6); PG8_BAR; PG8_MMA(1, 1, At, B1); PG8_BAR;
            PG8_LDB(B0, 1, 0); PG8_SCHED; PG8_LDA(At, 1, 0); PG8_STAGE(PG8_SA(0, 1), a2 + hstep, voffA);
            PG8_WAIT_L(8); PG8_BAR; PG8_WAIT_L(0); PG8_MMA(0, 0, At, B0); PG8_BAR; PG8_SCHED;
            PG8_LDB(B1, 1, 1); PG8_STAGE(PG8_SB(1, 0), b3, voffB);
            PG8_BAR; PG8_WAIT_L(0); PG8_MMA(0, 1, At, B1); PG8_BAR;
            PG8_LDA(At, 1, 1); PG8_STAGE(PG8_SA(1, 0), a3, voffA);
            PG8_BAR; PG8_WAIT_L(0); PG8_MMA(1, 0, At, B0); PG8_BAR; PG8_SCHED;
            PG8_STAGE(PG8_SB(1, 1), b3 + hstep, voffB);
            PG8_WAIT_V(6); PG8_BAR; PG8_MMA(1, 1, At, B1); PG8_BAR;
        }
        PG8_STAMP();
        if constexpr (!Epi::AFTER_DRAIN) { E(acc, cur, wr, wc, fr, fq); S.done(cur); }
        PG8_STAMP();
        if (!has_next) break;
        if constexpr (!Epi::KEEP_ACC) {
#pragma unroll
        for (int a = 0; a < 2; ++a)
#pragma unroll
            for (int b = 0; b < 2; ++b)
#pragma unroll
                for (int m = 0; m < 4; ++m)
#pragma unroll
                    for (int n = 0; n < 2; ++n) acc[a][b][m][n] = (f32x4){0.f, 0.f, 0.f, 0.f};
        }
        cur = nxt; cA = nA; cB = nB; ++ui;
    }
    PG8_WAIT_V(0);
    if (wr == 0) PG8_BAR;
    PG8_BAR;
    if constexpr (Epi::AFTER_DRAIN) { E.fused(acc, cur, wr, wc, fr, fq, lds, wid, lane); S.done(cur); }
    PG8_STAMP();
    if (STAMP && wid == 0) { stamps[lane] = lane < nts ? (((unsigned long long)(unsigned)ts_hi << 32) | (unsigned)ts_lo) : 0ull;
        if (lane == 62) stamps[62] = rt_entry; if (lane == 63) stamps[63] = (unsigned long long)wall_clock64(); }
#undef PG8_STAMP
#undef PG8_SA
#undef PG8_SB
#undef PG8_STAGE
#undef PG8_LDA
#undef PG8_LDB
#undef PG8_MMA
#undef PG8_WAIT_V
#undef PG8_WAIT_L
#undef PG8_BAR
#undef PG8_SCHED
}
}


struct InSched {
  int l, c;
  __device__ __forceinline__ bool next(int i, pg8::Unit& u) const {
    const int x = c >> 5, q = c & 31;
    const int e = i * 32 + q;
    if (e >= 124) return false;
    const int it = 4 * x + (e & 3), jt = e >> 2;
    const bool swapped = (jt == 4) || (jt == 5) || (jt == 10) || (jt == 11);
    if (swapped) { u.pm = l * 31 + jt; u.pn = 62 + it; } else { u.pm = 62 + it; u.pn = l * 31 + jt; }
    return true;
  }
  __device__ __forceinline__ void a_ready(const pg8::Unit&) const {}
  __device__ __forceinline__ void done(const pg8::Unit&) const {}
};

DEV void st8bf(u16* p, const pg8::f32x4& a, const pg8::f32x4& b) {
  uint4 w; w.x = pack2(a[0], a[1]); w.y = pack2(a[2], a[3]); w.z = pack2(b[0], b[1]); w.w = pack2(b[2], b[3]);
  *(uint4*)p = w;
}
template <class F> DEV pg8::f32x4 map4(const pg8::f32x4& v, F f) { pg8::f32x4 r; r[0] = f(v[0]); r[1] = f(v[1]); r[2] = f(v[2]); r[3] = f(v[3]); return r; }

struct InEpi {
  static constexpr bool PERM = true, AFTER_DRAIN = false, KEEP_ACC = false;
  char* ws; float* out; int l, s;
  __device__ __forceinline__ void operator()(const pg8::f32x4 (&acc)[2][2][4][2], const pg8::Unit& u, int wr, int wc, int fr, int fq) const {
    u16* QNA = (u16*)(ws + O_QNA); u16* KNA = (u16*)(ws + O_KNA); u16* VTNA = (u16*)(ws + O_VTNA);
    const size_t zs = (size_t)s * 8192 * 512;
    u16* ZA = (u16*)(ws + O_ZA) + zs; u16* ZB = (u16*)(ws + O_ZB) + zs; u16* ZC = (u16*)(ws + O_ZC) + zs;
    u16* GU = (u16*)(ws + O_GU); u16* GVT = (u16*)(ws + O_GVT);
    u16* DQ = (u16*)(ws + O_DQ); u16* DKV = (u16*)(ws + O_DKV); float* KRF = (float*)(ws + O_KRF);
    unsigned char* GATES = (unsigned char*)(ws + O_GATES) + (size_t)s * 8192 * 3072;
    if (u.pm >= 62) {
      const int t0 = (u.pm - 62) * 256 + wr * 64 + fr;
      const int cbase = (u.pn - l * 31) * 256;
#pragma unroll
      for (int bj = 0; bj < 2; ++bj) {
        const int seg0 = cbase + bj * 128;
        const int n = seg0 >> 7;
        const int c0 = seg0 + wc * 32 + 8 * fq;
#pragma unroll
        for (int ai = 0; ai < 2; ++ai)
#pragma unroll
          for (int m = 0; m < 4; ++m) {
            const int T = t0 + ai * 128 + m * 16;
            const pg8::f32x4 v0 = acc[ai][bj][m][0], v1 = acc[ai][bj][m][1];
            if (n < 4) {
              st8bf(QNA + (size_t)T * 512 + c0, v0, v1);
            } else if (n < 8) {
              const int col = c0 - 512;
              st8bf(KNA + (size_t)T * 512 + col, v0, v1);
              if (s == 0) {
                const int b = T >> 8, sq = T & 255;
                float* o = out + OUT_SK + ((size_t)(b * 2 + l) * 256 + sq) * 512 + col;
                *(float4*)o = make_float4(v0[0], v0[1], v0[2], v0[3]); *(float4*)(o + 4) = make_float4(v1[0], v1[1], v1[2], v1[3]);
              }
            } else if (n < 16) {
              st8bf(ZA + blk_off(T, c0 - 1536, 512), v0, v1);
            } else if (n < 20) {
              st8bf(GU + (size_t)T * 512 + c0 - 2048, v0, v1);
            } else if (n < 28) {
              st8bf(ZB + blk_off(T, c0 - 3072, 512), v0, v1);
            } else if (n < 31) {
              st8bf(DQ + (size_t)T * 384 + c0 - 3584, v0, v1);
            } else if (n < 33) {
              st8bf(DKV + (size_t)T * 256 + c0 - 3968, v0, v1);
            } else if (n < 37) {
              st8bf(ZC + blk_off(T, c0 - 4224, 512), v0, v1);
            } else if (n < 61) {
              unsigned q[8];
#pragma unroll
              for (int e = 0; e < 4; e++) { q[e] = (unsigned)(sigmoid_f(v0[e]) * 255.f + 0.5f); q[4 + e] = (unsigned)(sigmoid_f(v1[e]) * 255.f + 0.5f); }
              uint2 gw; gw.x = q[0] | (q[1] << 8) | (q[2] << 16) | (q[3] << 24); gw.y = q[4] | (q[5] << 8) | (q[6] << 16) | (q[7] << 24);
              *(uint2*)(GATES + (size_t)T * 3072 + c0 - 4736) = gw;
            } else if (c0 < 7808 + 32) {
              const int j = c0 - 7808;
              float* kp = KRF + (size_t)T * 32 + j;
              *(float4*)kp = make_float4(v0[0], v0[1], v0[2], v0[3]); *(float4*)(kp + 4) = make_float4(v1[0], v1[1], v1[2], v1[3]);
              if (s == 0) {
                const int b = T >> 8, sq = T & 255;
                float* o = out + OUT_SKR + ((size_t)(b * 2 + l) * 256 + sq) * 32 + j;
                *(float4*)o = make_float4(v0[0], v0[1], v0[2], v0[3]); *(float4*)(o + 4) = make_float4(v1[0], v1[1], v1[2], v1[3]);
              }
            }
          }
      }
    } else {
      const int jt = u.pm - l * 31;
      const int ch0 = jt * 256 + wr * 64 + fr;
      const int tk0 = (u.pn - 62) * 256 + wc * 32 + 8 * fq;
#pragma unroll
      for (int ai = 0; ai < 2; ++ai)
#pragma unroll
        for (int m = 0; m < 4; ++m) {
          const int ch = ch0 + ai * 128 + m * 16;
#pragma unroll
          for (int bj = 0; bj < 2; ++bj) {
            const int tok = tk0 + bj * 128;
            const pg8::f32x4 v0 = acc[ai][bj][m][0], v1 = acc[ai][bj][m][1];
            if (jt < 8) {
              const int dva = ch - 1024;
              if (s == 0) {
                const int b = tok >> 8, sq = tok & 255;
                st8bf(VTNA + ((size_t)(b * 512 + dva)) * 256 + sq, v0, v1);
                float* o = out + OUT_SV + ((size_t)(b * 2 + l) * 256 + sq) * 512 + dva;
                o[0] = v0[0]; o[512] = v0[1]; o[1024] = v0[2]; o[1536] = v0[3]; o[2048] = v1[0]; o[2560] = v1[1]; o[3072] = v1[2]; o[3584] = v1[3];
              } else {
                const int b = tok >> 10, nn = tok & 1023;
                st8bf(VTNA + ((size_t)(b * 512 + dva)) * 1024 + nn, v0, v1);
              }
            } else {
              const int c = ch - 2560;
              const int chunk = tok >> 7, q = tok & 127;
              st8bf(GVT + ((size_t)chunk * 512 + c) * 128 + q, v0, v1);
            }
          }
        }
    }
  }
};

DEV void phase_in8(const Params& p, int l, int s, char* smem_full, int vid) {
  pg8::Gemm g; g.A = (const pg8::bf16_t*)(p.ws + O_WIN); g.Bt = g.A; g.M = 0; g.N = 0; g.K = 1024;
  InSched S; S.l = l; S.c = vid;
  InEpi E; E.ws = p.ws; E.out = p.out; E.l = l; E.s = s;
  pg8::gemm_phase<InEpi, InSched, false>((PG8_LAS unsigned char*)smem_full, g, S, E, nullptr);
}


struct MergeSched {
  int l, c;
  __device__ __forceinline__ bool next(int i, pg8::Unit& u) const {
    const int x = c >> 5, q = c & 31;
    if (i >= 3) return false;
    const int it = 8 * x + (q & 7), jt = q >> 3;
    const size_t zo = (i == 0) ? O_ZA : (i == 1 ? O_ZB : O_ZC);
    u.pm = (int)(zo / 262144) + it;
    u.pn = (int)(O_WBR / 262144) + (l * 3 + i) * 4 + jt;
    return true;
  }
  __device__ __forceinline__ void a_ready(const pg8::Unit&) const {}
  __device__ __forceinline__ void done(const pg8::Unit&) const {}
};
struct MergeEpi {
  static constexpr bool PERM = true, AFTER_DRAIN = false, KEEP_ACC = true;
  char* ws; int l;
  __device__ __forceinline__ void operator()(pg8::f32x4 (&acc)[2][2][4][2], const pg8::Unit& u, int wr, int wc, int fr, int fq) const {
    const int wrel = u.pn - (int)(O_WBR / 262144) - l * 12;
    const int k = wrel >> 2, jt = wrel & 3;
    const size_t zo = (k == 0) ? O_ZA : (k == 1 ? O_ZB : O_ZC);
    const int it = u.pm - (int)(zo / 262144);
    const unsigned char* GATES = (const unsigned char*)(ws + O_GATES);
    u16* MG = (u16*)(ws + O_MG);
    const int t0 = it * 256 + wr * 64 + fr;
#pragma unroll
    for (int ai = 0; ai < 2; ++ai) {
      uint2 ga[4][2], gb[4][2];
#pragma unroll
      for (int m = 0; m < 4; ++m)
#pragma unroll
        for (int bj = 0; bj < 2; ++bj) {
          const int T = t0 + ai * 128 + m * 16;
          const int c0 = jt * 256 + bj * 128 + wc * 32 + 8 * fq;
          const unsigned char* gp = GATES + (size_t)T * 3072 + k * 1024 + c0;
          ga[m][bj] = *(const uint2*)gp;
          gb[m][bj] = (k < 2) ? *(const uint2*)(gp + 1024) : make_uint2(0u, 0u);
        }
      asm volatile("" ::: "memory");
#pragma unroll
      for (int m = 0; m < 4; ++m)
#pragma unroll
        for (int bj = 0; bj < 2; ++bj) {
          const int T = t0 + ai * 128 + m * 16;
          const int c0 = jt * 256 + bj * 128 + wc * 32 + 8 * fq;
          float f[8];
#pragma unroll
          for (int e = 0; e < 8; e++) {
            const float qa = fmaxf((float)((((e < 4) ? ga[m][bj].x : ga[m][bj].y) >> (8 * (e & 3))) & 0xffu), 1.f);
            if (k < 2) {
              const float qb = fmaxf((float)((((e < 4) ? gb[m][bj].x : gb[m][bj].y) >> (8 * (e & 3))) & 0xffu), 1.f);
              f[e] = qa * __builtin_amdgcn_rcpf(qb);
            } else {
              f[e] = qa * (1.f / 255.f);
            }
          }
#pragma unroll
          for (int e = 0; e < 4; e++) { acc[ai][bj][m][0][e] *= f[e]; acc[ai][bj][m][1][e] *= f[4 + e]; }
          if (k == 2) {
            uint4 o;
            o.x = pack2(acc[ai][bj][m][0][0], acc[ai][bj][m][0][1]); o.y = pack2(acc[ai][bj][m][0][2], acc[ai][bj][m][0][3]);
            o.z = pack2(acc[ai][bj][m][1][0], acc[ai][bj][m][1][1]); o.w = pack2(acc[ai][bj][m][1][2], acc[ai][bj][m][1][3]);
            *(uint4*)(MG + blk_off(T, c0, 1024)) = o;
          }
        }
    }
  }
};
DEV void phase_merge8(const Params& p, int l, char* smem_full, int vid) {
  pg8::Gemm g; g.A = (const pg8::bf16_t*)p.ws; g.Bt = g.A; g.M = 0; g.N = 0; g.K = 512;
  MergeSched S; S.l = l; S.c = vid;
  MergeEpi E; E.ws = p.ws; E.l = l;
  pg8::gemm_phase<MergeEpi, MergeSched, false>((PG8_LAS unsigned char*)smem_full, g, S, E, nullptr);
}

struct OutSched {
  int l, c;
  __device__ __forceinline__ bool next(int i, pg8::Unit& u) const {
    const int x = c >> 5, q = c & 31;
    if (i >= 1) return false;
    u.pm = (int)(O_MG / 524288) + 8 * x + (q & 7);
    u.pn = (int)(O_WOUT / 524288) + l * 4 + (q >> 3);
    return true;
  }
  __device__ __forceinline__ void a_ready(const pg8::Unit&) const {}
  __device__ __forceinline__ void done(const pg8::Unit&) const {}
};
struct OutEpi {
  static constexpr bool PERM = true, AFTER_DRAIN = false, KEEP_ACC = false;
  const float* x0; const float* x1; const u16* xb_in; u16* xb_out; const float* MOD; int l;
  __device__ __forceinline__ void operator()(const pg8::f32x4 (&acc)[2][2][4][2], const pg8::Unit& u, int wr, int wc, int fr, int fq) const {
    const int it = u.pm - (int)(O_MG / 524288), jt = u.pn - (int)(O_WOUT / 524288) - l * 4;
    const int s = it >> 5;
    const int t0 = it * 256 + wr * 64 + fr;
    typedef __attribute__((address_space(1))) pg8::f32x4 GF4;
    typedef __attribute__((address_space(1))) pg8::u32x4 GU4;
    const GF4* xg = (const GF4*)(unsigned long long)((s == 0) ? x0 : x1 - (size_t)8192 * 1024);
    const GU4* xbg = (const GU4*)(unsigned long long)xb_in;
    GU4* og = (GU4*)(unsigned long long)xb_out;
    const float* gr = MOD + (size_t)(l * 9 + cond_idx(s, t0 & 8191)) * 3072 + 2048;
    float4 gv[2][2];
#pragma unroll
    for (int bj = 0; bj < 2; ++bj)
#pragma unroll
      for (int h2 = 0; h2 < 2; ++h2) gv[bj][h2] = *(const float4*)(gr + jt * 256 + bj * 128 + wc * 32 + 8 * fq + 4 * h2);
#pragma unroll
    for (int ai = 0; ai < 2; ++ai)
#pragma unroll
      for (int mp = 0; mp < 2; ++mp) {
        float xr[2][2][8];
        if (l == 0) {
          pg8::f32x4 xv[2][2][2];
#pragma unroll
          for (int mm = 0; mm < 2; ++mm)
#pragma unroll
            for (int bj = 0; bj < 2; ++bj)
#pragma unroll
              for (int h2 = 0; h2 < 2; ++h2)
                xv[mm][bj][h2] = *(xg + (size_t)(t0 + ai * 128 + (mp * 2 + mm) * 16) * 256 + jt * 64 + bj * 32 + wc * 8 + 2 * fq + h2);
          asm volatile("" ::: "memory"); __builtin_amdgcn_sched_barrier(0);
#pragma unroll
          for (int mm = 0; mm < 2; ++mm)
#pragma unroll
            for (int bj = 0; bj < 2; ++bj)
#pragma unroll
              for (int e = 0; e < 8; ++e) xr[mm][bj][e] = xv[mm][bj][e >> 2][e & 3];
        } else {
          pg8::u32x4 xw[2][2];
#pragma unroll
          for (int mm = 0; mm < 2; ++mm)
#pragma unroll
            for (int bj = 0; bj < 2; ++bj)
              xw[mm][bj] = *(xbg + (size_t)(t0 + ai * 128 + (mp * 2 + mm) * 16) * 128 + jt * 32 + bj * 16 + wc * 4 + fq);
          asm volatile("" ::: "memory"); __builtin_amdgcn_sched_barrier(0);
#pragma unroll
          for (int mm = 0; mm < 2; ++mm)
#pragma unroll
            for (int bj = 0; bj < 2; ++bj)
#pragma unroll
              for (int e = 0; e < 8; ++e) { const unsigned w = xw[mm][bj][e >> 1]; xr[mm][bj][e] = __uint_as_float((e & 1) ? (w & 0xffff0000u) : (w << 16)); }
        }
#pragma unroll
        for (int mm = 0; mm < 2; ++mm)
#pragma unroll
          for (int bj = 0; bj < 2; ++bj) {
            const int m = mp * 2 + mm;
            const pg8::f32x4 v0 = acc[ai][bj][m][0], v1 = acc[ai][bj][m][1];
            const float4 g0 = gv[bj][0], g1 = gv[bj][1];
            pg8::u32x4 o;
            o[0] = pack2(xr[mm][bj][0] + g0.x * v0[0], xr[mm][bj][1] + g0.y * v0[1]);
            o[1] = pack2(xr[mm][bj][2] + g0.z * v0[2], xr[mm][bj][3] + g0.w * v0[3]);
            o[2] = pack2(xr[mm][bj][4] + g1.x * v1[0], xr[mm][bj][5] + g1.y * v1[1]);
            o[3] = pack2(xr[mm][bj][6] + g1.z * v1[2], xr[mm][bj][7] + g1.w * v1[3]);
            *(og + (size_t)(t0 + ai * 128 + m * 16) * 128 + jt * 32 + bj * 16 + wc * 4 + fq) = o;
          }
        asm volatile("" ::: "memory"); __builtin_amdgcn_sched_barrier(0);
      }
  }
};
DEV void phase_out8(const Params& p, int l, char* smem_full, int vid) {
  pg8::Gemm g; g.A = (const pg8::bf16_t*)p.ws; g.Bt = g.A; g.M = 0; g.N = 0; g.K = 1024;
  OutSched S; S.l = l; S.c = vid;
  OutEpi E; E.x0 = p.x_prompt; E.x1 = p.x_sample; E.xb_in = (const u16*)(p.out + OUT_Y);
  E.xb_out = (l == 0) ? (u16*)(p.out + OUT_Y) : (u16*)(p.ws + O_ZA);
  E.MOD = (const float*)(p.ws + O_MOD); E.l = l;
  pg8::gemm_phase<OutEpi, OutSched, false>((PG8_LAS unsigned char*)smem_full, g, S, E, nullptr);
}


struct QSched {
  int l, c;
  __device__ __forceinline__ bool next(int i, pg8::Unit& u) const {
    const int x = c >> 5, q = c & 31;
    if (q >= 12 || i >= 1) return false;
    u.pm = (int)(O_DQN / 196608) + 4 * x + (q & 3);
    u.pn = (int)(O_WUQ / 196608) + l * 3 + (q >> 2);
    return true;
  }
  __device__ __forceinline__ void a_ready(const pg8::Unit&) const {}
  __device__ __forceinline__ void done(const pg8::Unit&) const {}
};
struct QEpi {
  static constexpr bool PERM = true, AFTER_DRAIN = false, KEEP_ACC = false;
  char* ws; int l;
  __device__ __forceinline__ void operator()(const pg8::f32x4 (&acc)[2][2][4][2], const pg8::Unit& u, int wr, int wc, int fr, int fq) const {
    const int it = u.pm - (int)(O_DQN / 196608), jt = u.pn - (int)(O_WUQ / 196608) - l * 3;
    u16* QM = (u16*)(ws + O_QM);
#pragma unroll
    for (int ai = 0; ai < 2; ++ai)
#pragma unroll
      for (int m = 0; m < 4; ++m) {
        const int T = it * 256 + ai * 128 + wr * 64 + m * 16 + fr;
#pragma unroll
        for (int bj = 0; bj < 2; ++bj)
          st8bf(QM + (size_t)T * 768 + jt * 256 + bj * 128 + wc * 32 + 8 * fq, acc[ai][bj][m][0], acc[ai][bj][m][1]);
      }
  }
};
struct KvSched {
  int l, c, nt;
  __device__ __forceinline__ bool next(int i, pg8::Unit& u) const {
    const int x = c >> 5, q = c & 31, per = nt >> 3;
    if (q >= 4 * per || i >= 1) return false;
    const int it = per * x + (q % per), jt = q / per;
    const int wt = (int)(O_WUKV / 131072) + l * 4 + jt, ct = (int)(O_CKV / 131072) + it;
    if (jt < 2) { u.pm = ct; u.pn = wt; } else { u.pm = wt; u.pn = ct; }
    return true;
  }
  __device__ __forceinline__ void a_ready(const pg8::Unit&) const {}
  __device__ __forceinline__ void done(const pg8::Unit&) const {}
};
struct KvEpi {
  static constexpr bool PERM = true, AFTER_DRAIN = false, KEEP_ACC = false;
  char* ws; int l, S;
  __device__ __forceinline__ void operator()(const pg8::f32x4 (&acc)[2][2][4][2], const pg8::Unit& u, int wr, int wc, int fr, int fq) const {
    const int c0t = (int)(O_CKV / 131072), w0t = (int)(O_WUKV / 131072) + l * 4;
    if (u.pm >= c0t) {
      const int it = u.pm - c0t, jt = u.pn - w0t;
      u16* KNOPE = (u16*)(ws + O_KNOPE);
#pragma unroll
      for (int ai = 0; ai < 2; ++ai)
#pragma unroll
        for (int m = 0; m < 4; ++m) {
          const int R = it * 256 + ai * 128 + wr * 64 + m * 16 + fr;
#pragma unroll
          for (int bj = 0; bj < 2; ++bj)
            st8bf(KNOPE + (size_t)R * 512 + jt * 256 + bj * 128 + wc * 32 + 8 * fq, acc[ai][bj][m][0], acc[ai][bj][m][1]);
        }
    } else {
      const int jt = u.pm - w0t - 2, it = u.pn - c0t;
      u16* VTM = (u16*)(ws + O_VTM);
#pragma unroll
      for (int ai = 0; ai < 2; ++ai)
#pragma unroll
        for (int m = 0; m < 4; ++m) {
          const int ch = jt * 256 + ai * 128 + wr * 64 + m * 16 + fr;
#pragma unroll
          for (int bj = 0; bj < 2; ++bj) {
            const int row = it * 256 + bj * 128 + wc * 32 + 8 * fq;
            const int b = row / S, mm = row % S;
            st8bf(VTM + ((size_t)b * 512 + ch) * S + mm, acc[ai][bj][m][0], acc[ai][bj][m][1]);
          }
        }
    }
  }
};
DEV void phase_qkv8(const Params& p, int l, int s, char* smem_full, int vid) {
  {
    pg8::Gemm g; g.A = (const pg8::bf16_t*)p.ws; g.Bt = g.A; g.M = 0; g.N = 0; g.K = 384;
    QSched S; S.l = l; S.c = vid;
    QEpi E; E.ws = p.ws; E.l = l;
    pg8::gemm_phase<QEpi, QSched, false>((PG8_LAS unsigned char*)smem_full, g, S, E, nullptr);
  }
  {
    pg8::Gemm g; g.A = (const pg8::bf16_t*)p.ws; g.Bt = g.A; g.M = 0; g.N = 0; g.K = 256;
    KvSched S; S.l = l; S.c = vid; S.nt = (s == 0) ? 32 : 40;
    KvEpi E; E.ws = p.ws; E.l = l; E.S = (s == 0) ? 256 : 1280;
    pg8::gemm_phase<KvEpi, KvSched, false>((PG8_LAS unsigned char*)smem_full, g, S, E, nullptr);
  }
}

#define XB_TMO      128
#define XB_XCNT(j)  (256  + 64 * (j))
#define XB_XSUB(j)  (1280 + 64 * (j))
#define XB_XGEN(j)  (2304 + 64 * (j))
#define XB_TOP      3328
#define XB_TOPGEN   3392
#define XCD_BAR_WORDS 3456
#define XB_SPIN_CAP (1u << 18)
#define LAS __attribute__((address_space(3)))

__device__ __forceinline__ unsigned xb_ld(unsigned* p)              { return __hip_atomic_load(p, __ATOMIC_RELAXED, __HIP_MEMORY_SCOPE_AGENT); }
__device__ __forceinline__ unsigned xb_add(unsigned* p, unsigned v) { return __hip_atomic_fetch_add(p, v, __ATOMIC_RELAXED, __HIP_MEMORY_SCOPE_AGENT); }
__device__ __forceinline__ unsigned xb_xcc_id() { return (unsigned)__builtin_amdgcn_s_getreg((3 << 11) | 20) & 0xFu; }
#define XB_SPIN(cond, bar) do { unsigned _sp = 0; while (cond) { __builtin_amdgcn_s_sleep(1); \
    if ((++_sp & 255u) == 0u) { if (xb_ld(&(bar)[XB_TMO])) break; if (_sp > XB_SPIN_CAP) { atomicAdd(&(bar)[XB_TMO], 1u); break; } } } } while (0)

struct XcdBarrier {
    unsigned* bar; unsigned x;
    volatile LAS unsigned* st;
};

__device__ __forceinline__ XcdBarrier xcd_barrier_post(unsigned* bar, volatile LAS unsigned* st) {
    XcdBarrier b; b.bar = bar; b.x = xb_xcc_id(); b.st = st;
    if ((int)threadIdx.x == 0) st[2] = xb_add(&bar[XB_XCNT(b.x)], 1u);
    return b;
}
__device__ __forceinline__ void xcd_barrier_complete(unsigned* bar, unsigned x, unsigned& nloc, unsigned& nx) {
    const unsigned G = gridDim.x * gridDim.y * gridDim.z;
    unsigned sum, cnt, mine, sp = 0u;
    for (;;) {
        sum = 0u; cnt = 0u; mine = 0u;
#pragma unroll
        for (unsigned j = 0; j < 16; ++j) { const unsigned c = xb_ld(&bar[XB_XCNT(j)]); sum += c; cnt += (c > 0u) ? 1u : 0u; mine = (j == x) ? c : mine; }
        if (sum == G) break;
        __builtin_amdgcn_s_sleep(1);
        if ((++sp & 255u) == 0u) { if (xb_ld(&bar[XB_TMO])) break; if (sp > XB_SPIN_CAP) { atomicAdd(&bar[XB_TMO], 1u); break; } }
    }
    nloc = mine > 0u ? mine : 1u; nx = cnt > 0u ? cnt : 1u;
}

__device__ __forceinline__ void xcd_barrier(const XcdBarrier& b) {
    asm volatile("s_waitcnt vmcnt(0)" ::: "memory");
    __syncthreads();
    if ((int)threadIdx.x == 0) {
        unsigned* bar = b.bar;
        __builtin_amdgcn_s_waitcnt(0);
        unsigned nloc = b.st[0], nx = b.st[1];
        if (nloc == 0u) { xcd_barrier_complete(bar, b.x, nloc, nx); b.st[0] = nloc; b.st[1] = nx; }
        const unsigned old = xb_add(&bar[XB_XSUB(b.x)], 1u);
        const unsigned gen = old / nloc;
        if (old + 1u == (gen + 1u) * nloc) {
            __builtin_amdgcn_fence(__ATOMIC_RELEASE, "agent");
            asm volatile("s_waitcnt vmcnt(0)" ::: "memory");
            const unsigned og = xb_add(&bar[XB_TOP], 1u);
            const unsigned tg = og / nx;
            if (og + 1u == (tg + 1u) * nx) xb_add(&bar[XB_TOPGEN], 1u);
            else XB_SPIN(xb_ld(&bar[XB_TOPGEN]) == tg, bar);
            __builtin_amdgcn_fence(__ATOMIC_ACQUIRE, "agent");
            xb_add(&bar[XB_XGEN(b.x)], 1u);
            asm volatile("s_waitcnt vmcnt(0)" ::: "memory");
        } else {
            XB_SPIN(xb_ld(&bar[XB_XGEN(b.x)]) == gen, bar);
            __builtin_amdgcn_fence(__ATOMIC_ACQUIRE, "agent");
            asm volatile("s_waitcnt vmcnt(0)" ::: "memory");
        }
    }
    __syncthreads();
}


DEV void run_phase(const Params& p, int ph, int l, int s, char* smem, const int vid_, const int tid_, const int vb_, const int vg_) {
  switch (ph) {
    case 0: phase_prep(p, smem, tid_, vb_, vg_); break;
    case 1: phase_h(p, l, s, tid_, vb_, vg_); break;
    case 3: phase_rows(p, l, s, smem, tid_, vb_, vg_); break;
    case 4: phase_mix(p, l, s, smem, tid_, vb_, vg_, vid_); break;
    case 5: phase_mla(p, l, s, smem, tid_, vb_, vg_); break;
    default: phase_final(p, tid_, vb_, vg_); break;
  }
}

__global__ void __launch_bounds__(512, 2) mega_kernel(Params p) {
  extern __shared__ __attribute__((aligned(16))) unsigned char dyn_lds[];
  char* smem = (char*)dyn_lds;
  uint4& xb_words = *(uint4*)(dyn_lds + 131072);
  if (threadIdx.x == 0) xb_words = make_uint4(0u, 0u, 0u, 0u);
  __syncthreads();
  XcdBarrier xb = xcd_barrier_post((unsigned*)(p.ws + O_BAR), (volatile LAS unsigned*)(dyn_lds + 131072));
  if (p.ws == nullptr) cg::this_grid().sync();
  int vid = blockIdx.x;
#pragma unroll 1
  for (int step = 0; step < 24; step++) {
    int ph, l = 0, s = 0;
    bool also_h1 = false;
    if (step == 0) ph = 0;
    else if (step == 23) ph = 8;
    else {
      const int idx = step - 1; l = idx / 11; const int r = idx % 11;
      if (r < 5) { s = 0; ph = 1 + r; also_h1 = (r == 4); }
      else if (r < 9) { s = 1; ph = 2 + (r - 5); }
      else ph = 6 + (r - 9);
    }
    {
      const int tfull = tid_opaque();
      const int team = tfull >> 8;
      Params q = p;
      size_t zoff = 0;
      asm volatile("" : "+s"(zoff));
      q.ws = p.ws + zoff;
      q.out = p.out + zoff;
      if (ph == 4) { phase_qkv8(q, l, s, smem, vid); __syncthreads(); }
      if (ph == 2) phase_in8(q, l, s, smem, vid);
      else if (ph == 6) phase_merge8(q, l, smem, vid);
      else if (ph == 7) phase_out8(q, l, smem, vid);
      else run_phase(q, ph, l, s, smem + team * 65536, vid * 2 + team, tfull & 255, blockIdx.x * 2 + team, gridDim.x * 2);
      if (also_h1) run_phase(q, 1, l, 1, smem + team * 65536, vid * 2 + team, tfull & 255, blockIdx.x * 2 + team, gridDim.x * 2);
    }
    if (step < 23) xcd_barrier(xb);
    if (step == 0) {
      if (threadIdx.x == 0) {
        unsigned base = 0;
        for (unsigned j = 0; j < 16; ++j) { const unsigned c = xb_ld(&xb.bar[XB_XCNT(j)]); if (j < xb.x) base += c; }
        unsigned v = base + xb_words.z;
        if (v >= gridDim.x) v = blockIdx.x;
        xb_words.w = v;
      }
      __syncthreads();
      vid = __builtin_amdgcn_readfirstlane((int)xb_words.w);
    }
  }
}

extern "C" void kernel_launch(void* const* d_in, const int* in_sizes, int n_in, void* d_out, int out_size, void* d_ws, size_t ws_size,
                              hipStream_t stream) {
  Params p{};
  const float** pp = (const float**)&p;
  for (int i = 0; i < 22; i++) pp[i] = (const float*)d_in[i];
  p.out = (float*)d_out;
  p.ws = (char*)d_ws;
  static int grid_blocks = 0;
  if (!grid_blocks) {
    int dev = 0, cus = 0, per_cu = 0;
    hipGetDevice(&dev);
    hipDeviceGetAttribute(&cus, hipDeviceAttributeMultiprocessorCount, dev);
    hipFuncSetAttribute((const void*)mega_kernel, hipFuncAttributeMaxDynamicSharedMemorySize, (int)DYN_LDS);
    hipOccupancyMaxActiveBlocksPerMultiprocessor(&per_cu, mega_kernel, 512, DYN_LDS);
    if (per_cu > 1) per_cu = 1;
    grid_blocks = cus * per_cu;
    grid_blocks &= ~7;
    if (grid_blocks > 256) grid_blocks = 256;
  }
  hipMemsetAsync((char*)d_ws + O_BAR, 0, BAR_BYTES, stream);
  void* args[] = {&p};
  hipError_t e = hipLaunchCooperativeKernel((void*)mega_kernel, dim3(grid_blocks), dim3(512), args, DYN_LDS, stream);
  if (e != hipSuccess) fprintf(stderr, "cooperative launch failed: %s (grid %d)\n", hipGetErrorString(e), grid_blocks);
}
```
